# Optimizing an MI355X kernel written in HIP

```python
import jax, jax.numpy as jnp
from jax import lax
import numpy as np


D_MODEL = 1024
BATCH = 16
SEQ = 4096
DEPTH = 1

PLE_DIM = 256
M_HEADS = 4
M_HEAD_DIM = 128
M_WIDTH = M_HEADS * M_HEAD_DIM
M_CHUNK = 64
A_HEADS = 8
A_KV_GROUPS = 2
A_HEAD_DIM = 64
A_WIDTH = A_HEADS * A_HEAD_DIM
KV_WIDTH = A_KV_GROUPS * A_HEAD_DIM
CMP_BLOCK = 32
CMP_STRIDE = 16
CMP_HIDDEN = 128
SEL_BLOCK = 64
N_SELECT = 16
WINDOW = 512
A_Q_BLOCK = 32
ALIBI_MAX = 8.0
MIX_WIDTH = M_WIDTH + A_WIDTH
IN_WIDTH = 4 * M_WIDTH + 2 * M_HEADS + A_WIDTH + 6 * KV_WIDTH + 3 * A_HEADS
D_FF = 2048
CONV_WIDTH = 3
EPS = 1e-6
NEG = -1e30
BIG = 1e30

kernel_name = "hymba_mlstm_nsa_convffn_ple"


def rms_norm(x, g):
    xf = x.astype(jnp.float32)
    y = xf * lax.rsqrt(jnp.mean(xf * xf, axis=-1, keepdims=True) + EPS)
    return (y * g.astype(jnp.float32)).astype(x.dtype)


def alibi_slopes(n):
    return jnp.exp2(-ALIBI_MAX * jnp.arange(1, n + 1, dtype=jnp.float32) / n)


def mlstm(q, k, v, i_pre, f_pre):
    B, S, H, dh = q.shape
    L = M_CHUNK
    NC = S // L
    f32 = jnp.float32

    def chunks(t):
        t = t.astype(f32).reshape((B, NC, L, H) + t.shape[3:])
        return jnp.moveaxis(t, 3, 1)

    qc = chunks(q) * (dh ** -0.5)
    kc = chunks(k)
    vc = chunks(v)
    ig = chunks(i_pre)
    b = jnp.cumsum(jax.nn.log_sigmoid(chunks(f_pre)), axis=-1)
    bL = b[..., -1]
    a = bL[..., None] - b + ig

    def step(carry, inp):
        C, n, m = carry
        k_, v_, a_, bL_ = inp
        m_new = jnp.maximum(bL_ + m, jnp.max(a_, axis=-1))
        decay = jnp.exp(bL_ + m - m_new)
        w = jnp.exp(a_ - m_new[..., None])
        C_new = decay[..., None, None] * C + jnp.einsum('bhl,bhlk,bhlv->bhkv', w, k_, v_)
        n_new = decay[..., None] * n + jnp.einsum('bhl,bhlk->bhk', w, k_)
        return (C_new, n_new, m_new), (C, n, m)

    init = (jnp.zeros((B, H, dh, dh), f32), jnp.zeros((B, H, dh), f32), jnp.zeros((B, H), f32))
    xs = (jnp.moveaxis(kc, 2, 0), jnp.moveaxis(vc, 2, 0), jnp.moveaxis(a, 2, 0), jnp.moveaxis(bL, 2, 0))
    _, (Cs, ns, ms) = lax.scan(step, init, xs)
    Cs = jnp.moveaxis(Cs, 0, 2)
    ns = jnp.moveaxis(ns, 0, 2)
    ms = jnp.moveaxis(ms, 0, 2)

    bq = b + ms[..., None]
    causal = jnp.tril(jnp.ones((L, L), dtype=bool))
    Dm = jnp.where(causal, b[..., :, None] - b[..., None, :] + ig[..., None, :], -jnp.inf)
    m = jnp.maximum(bq, jnp.max(Dm, axis=-1))
    inter = jnp.exp(bq - m)
    Wt = jnp.exp(Dm - m[..., None]) * jnp.einsum('bhcld,bhcsd->bhcls', qc, kc)
    num = inter[..., None] * jnp.einsum('bhcld,bhcdv->bhclv', qc, Cs) + jnp.einsum('bhcls,bhcsv->bhclv', Wt, vc)
    den = inter * jnp.einsum('bhcld,bhcd->bhcl', qc, ns) + jnp.sum(Wt, axis=-1)
    h = num / jnp.maximum(jnp.abs(den), jnp.exp(-m))[..., None]
    return jnp.moveaxis(h, 1, 3).reshape(B, S, H, dh)


def nsa(q, kc_raw, vc_raw, ks_raw, vs_raw, kw_raw, vw_raw, g_pre, pe_k, pe_v, ck_w1, ck_w2, cv_w1, cv_w2):
    f32 = jnp.float32
    B, S, H, dh = q.shape
    G = A_KV_GROUPS
    R = H // G
    qg = q.astype(f32).reshape(B, S, G, R, dh).transpose(0, 2, 3, 1, 4) * (dh ** -0.5)
    gates = jax.nn.sigmoid(g_pre.astype(f32).reshape(B, S, G, R, 3)).transpose(0, 2, 3, 1, 4)
    to_g = lambda t: t.astype(f32).transpose(0, 2, 1, 3)

    Nc = (S - CMP_BLOCK) // CMP_STRIDE + 1
    cidx = jnp.arange(Nc)[:, None] * CMP_STRIDE + jnp.arange(CMP_BLOCK)[None, :]

    def compress(t, pe, w1, w2):
        blk = to_g(t)[:, :, cidx] + pe.astype(f32)
        flat = blk.reshape(B, G, Nc, CMP_BLOCK * dh)
        return jax.nn.gelu(flat @ w1.astype(f32)) @ w2.astype(f32)

    Kc = compress(kc_raw, pe_k, ck_w1, ck_w2)
    Vc = compress(vc_raw, pe_v, cv_w1, cv_w2)
    cmp_start = jnp.arange(Nc) * CMP_STRIDE
    cmp_end = cmp_start + CMP_BLOCK - 1

    Ns = S // SEL_BLOCK
    n_sel = min(N_SELECT, Ns)
    Ks = to_g(ks_raw).reshape(B, G, Ns, SEL_BLOCK, dh)
    Vs = to_g(vs_raw).reshape(B, G, Ns, SEL_BLOCK, dh)
    sel_start = jnp.arange(Ns) * SEL_BLOCK
    overlap = ((cmp_start[:, None] <= sel_start[None, :] + SEL_BLOCK - 1)
               & (cmp_end[:, None] >= sel_start[None, :])).astype(f32)

    pad = ((0, 0), (0, 0), (WINDOW, 0), (0, 0))
    Kw = jnp.pad(to_g(kw_raw), pad)
    Vw = jnp.pad(to_g(vw_raw), pad)

    slope = alibi_slopes(H).reshape(1, G, R, 1, 1)
    bi = jnp.arange(B)[:, None, None, None]
    gi = jnp.arange(G)[None, :, None, None]
    T = A_Q_BLOCK

    def block(qb):
        t0 = qb * T
        t = t0 + jnp.arange(T)
        qblk = lax.dynamic_slice_in_dim(qg, t0, T, axis=3)
        gblk = lax.dynamic_slice_in_dim(gates, t0, T, axis=3)

        valid_c = cmp_end[None, :] <= t[:, None]
        dist_c = (t[:, None] - cmp_end[None, :]).astype(f32)
        s_c = jnp.einsum('bgrtd,bgnd->bgrtn', qblk, Kc) - slope * dist_c
        p_c = jnp.where(valid_c, jax.nn.softmax(jnp.where(valid_c, s_c, NEG), axis=-1), 0.0)
        o_c = jnp.einsum('bgrtn,bgnd->bgrtd', p_c, Vc)

        imp = jnp.einsum('bgrtn,nj->bgtj', p_c, overlap)
        j = jnp.arange(Ns)[None, :]
        cur = (t // SEL_BLOCK)[:, None]
        forced = (j == 0) | (j == cur) | (j == cur - 1)
        causal_b = sel_start[None, :] <= t[:, None]
        score = jnp.where(causal_b, jnp.where(forced, BIG, imp), NEG)
        sel_idx = lax.top_k(score, n_sel)[1]
        Ksel = Ks[bi, gi, sel_idx]
        Vsel = Vs[bi, gi, sel_idx]
        pos_s = sel_idx[..., None] * SEL_BLOCK + jnp.arange(SEL_BLOCK)
        dist_s = (t[None, None, :, None, None] - pos_s)
        valid_s = (dist_s >= 0)[:, :, None]
        s_s = jnp.einsum('bgrtd,bgtnld->bgrtnl', qblk, Ksel) - slope[..., None] * dist_s[:, :, None].astype(f32)
        s_s = jnp.where(valid_s, s_s, NEG).reshape(B, G, R, T, n_sel * SEL_BLOCK)
        p_s = jax.nn.softmax(s_s, axis=-1).reshape(B, G, R, T, n_sel, SEL_BLOCK)
        o_s = jnp.einsum('bgrtnl,bgtnld->bgrtd', p_s, Vsel)

        kwin = lax.dynamic_slice_in_dim(Kw, t0, WINDOW + T, axis=2)
        vwin = lax.dynamic_slice_in_dim(Vw, t0, WINDOW + T, axis=2)
        pos_w = t0 - WINDOW + jnp.arange(WINDOW + T)
        dist_w = t[:, None] - pos_w[None, :]
        valid_w = (pos_w[None, :] >= 0) & (dist_w >= 0) & (dist_w < WINDOW)
        s_w = jnp.einsum('bgrtd,bgsd->bgrts', qblk, kwin) - slope * dist_w.astype(f32)
        p_w = jax.nn.softmax(jnp.where(valid_w, s_w, NEG), axis=-1)
        o_w = jnp.einsum('bgrts,bgsd->bgrtd', p_w, vwin)

        return gblk[..., 0:1] * o_c + gblk[..., 1:2] * o_s + gblk[..., 2:3] * o_w

    outs = lax.map(block, jnp.arange(S // T))
    return outs.transpose(1, 0, 4, 2, 3, 5).reshape(B, S, H * dh)


def conv_ffn(h, w_up, conv_w, conv_b, w_down):
    u = h @ w_up
    gate, val = jnp.split(u, 2, axis=-1)
    gate = lax.conv_general_dilated(gate, conv_w[:, None, :].astype(gate.dtype), window_strides=(1,),
                                    padding=[(CONV_WIDTH - 1, 0)],
                                    dimension_numbers=('NWC', 'WIO', 'NWC'),
                                    feature_group_count=D_FF) + conv_b
    return (jax.nn.silu(gate) * val) @ w_down


def setup_inputs(seed: int = 0) -> dict:
    key = jax.random.key(seed)
    ks = jax.random.split(key, 24)
    f32 = jnp.float32
    nrm = lambda k, shape, scale: jax.random.normal(k, shape, f32) * scale
    gain = lambda k, shape: 1.0 + 0.05 * jax.random.normal(k, shape, f32)
    i_bias = nrm(ks[4], (DEPTH, M_HEADS), 0.1)
    f_bias = jnp.linspace(3.0, 6.0, M_HEADS, dtype=f32)[None, :] + nrm(ks[5], (DEPTH, M_HEADS), 0.1)
    return {
        "x": nrm(ks[0], (BATCH, SEQ, D_MODEL), 1.0),
        "p": nrm(ks[1], (DEPTH, BATCH, SEQ, PLE_DIM), 1.0),
        "ln1_g": gain(ks[2], (DEPTH, D_MODEL)),
        "w_in": nrm(ks[3], (DEPTH, D_MODEL, IN_WIDTH), D_MODEL ** -0.5),
        "mlstm_gate_bias": jnp.concatenate([i_bias, f_bias], axis=-1),
        "mlstm_norm_g": gain(ks[6], (DEPTH, M_WIDTH)),
        "cmp_pos_k": nrm(ks[7], (DEPTH, CMP_BLOCK, A_HEAD_DIM), 0.02),
        "cmp_pos_v": nrm(ks[8], (DEPTH, CMP_BLOCK, A_HEAD_DIM), 0.02),
        "cmp_k_w1": nrm(ks[9], (DEPTH, CMP_BLOCK * A_HEAD_DIM, CMP_HIDDEN), (CMP_BLOCK * A_HEAD_DIM) ** -0.5),
        "cmp_k_w2": nrm(ks[10], (DEPTH, CMP_HIDDEN, A_HEAD_DIM), CMP_HIDDEN ** -0.5),
        "cmp_v_w1": nrm(ks[11], (DEPTH, CMP_BLOCK * A_HEAD_DIM, CMP_HIDDEN), (CMP_BLOCK * A_HEAD_DIM) ** -0.5),
        "cmp_v_w2": nrm(ks[12], (DEPTH, CMP_HIDDEN, A_HEAD_DIM), CMP_HIDDEN ** -0.5),
        "w_out": nrm(ks[13], (DEPTH, MIX_WIDTH, D_MODEL), MIX_WIDTH ** -0.5),
        "ln2_g": gain(ks[14], (DEPTH, D_MODEL)),
        "w_up": nrm(ks[15], (DEPTH, D_MODEL, 2 * D_FF), D_MODEL ** -0.5),
        "conv_w": nrm(ks[16], (DEPTH, CONV_WIDTH, D_FF), CONV_WIDTH ** -0.5),
        "conv_b": nrm(ks[17], (DEPTH, D_FF), 0.02),
        "w_down": nrm(ks[18], (DEPTH, D_FF, D_MODEL), D_FF ** -0.5),
        "ple_norm_g": gain(ks[19], (DEPTH, D_MODEL)),
        "w_ple_gate": nrm(ks[20], (DEPTH, D_MODEL, D_MODEL), D_MODEL ** -0.5),
        "w_ple_proj": nrm(ks[21], (DEPTH, PLE_DIM, D_MODEL), PLE_DIM ** -0.5),
        "final_g": gain(ks[22], (D_MODEL,)),
    }


def reference(x, p, ln1_g, w_in, mlstm_gate_bias, mlstm_norm_g, cmp_pos_k, cmp_pos_v, cmp_k_w1, cmp_k_w2,
              cmp_v_w1, cmp_v_w2, w_out, ln2_g, w_up, conv_w, conv_b, w_down, ple_norm_g, w_ple_gate,
              w_ple_proj, final_g):
    B, S, _ = x.shape
    sizes = [M_WIDTH] * 4 + [M_HEADS, M_HEADS, A_WIDTH] + [KV_WIDTH] * 6 + [3 * A_HEADS]
    offs = np.cumsum(sizes)[:-1].tolist()
    for i in range(DEPTH):
        h = rms_norm(x, ln1_g[i])
        z = h @ w_in[i]
        mq, mk, mv, mo, mi, mf, aq, akc, avc, aks, avs, akw, avw, ag = jnp.split(z, offs, axis=-1)
        mshape = (B, S, M_HEADS, M_HEAD_DIM)
        hm = mlstm(mq.reshape(mshape), mk.reshape(mshape), mv.reshape(mshape),
                   mi + mlstm_gate_bias[i, :M_HEADS], mf + mlstm_gate_bias[i, M_HEADS:])
        hm = rms_norm(hm, mlstm_norm_g[i].reshape(M_HEADS, M_HEAD_DIM)).reshape(B, S, M_WIDTH)
        m_out = (hm * jax.nn.sigmoid(mo.astype(jnp.float32))).astype(x.dtype)
        kvshape = (B, S, A_KV_GROUPS, A_HEAD_DIM)
        a_out = nsa(aq.reshape(B, S, A_HEADS, A_HEAD_DIM), akc.reshape(kvshape), avc.reshape(kvshape),
                    aks.reshape(kvshape), avs.reshape(kvshape), akw.reshape(kvshape), avw.reshape(kvshape),
                    ag, cmp_pos_k[i], cmp_pos_v[i], cmp_k_w1[i], cmp_k_w2[i], cmp_v_w1[i], cmp_v_w2[i]).astype(x.dtype)
        x = x + jnp.concatenate([m_out, a_out], axis=-1) @ w_out[i]
        x = x + conv_ffn(rms_norm(x, ln2_g[i]), w_up[i], conv_w[i], conv_b[i], w_down[i])
        gate = jax.nn.sigmoid(rms_norm(x, ple_norm_g[i]) @ w_ple_gate[i])
        x = x + gate * (p[i].astype(x.dtype) @ w_ple_proj[i])
    return rms_norm(x, final_g)
```

```cpp
#include <hip/hip_runtime.h>
#include <hip/hip_cooperative_groups.h>
#include <cstdio>
#include <cstdint>
namespace cg = cooperative_groups;
namespace pg8 {
#define PG8_LAS __attribute__((address_space(3)))
typedef unsigned short bf16_t;
typedef short bf16x8 __attribute__((ext_vector_type(8)));
typedef float f32x4 __attribute__((ext_vector_type(4)));
typedef unsigned u32x4 __attribute__((ext_vector_type(4)));
constexpr int BM = 256, BK = 64, HALF = 128, HTB = HALF * BK * 2  , STAGE_BYTES = 8 * HTB, NXCD = 8, WGM = 8;

__host__ __device__ __forceinline__ int lds_byte(int r, int c) { const int st = (r >> 4) * 2 + (c >> 5), rr = r & 15, cc = c & 31, ob = rr * 64 + cc * 2; return st * 1024 + (ob ^ (((ob >> 9) & 1) << 5)); }
__host__ __device__ __forceinline__ void stage_rc(int b, int& R, int& C) { const int st = b / 1024, sb = b % 1024, swz = sb ^ (((sb >> 9) & 1) << 5); R = (st >> 1) * 16 + swz / 64; C = (st & 1) * 32 + (swz % 64) / 2; }
__host__ __device__ __forceinline__ int perm32(int rho) { const int n = rho >> 4, i = rho & 15; return 8 * (i >> 2) + 4 * n + (i & 3); }

struct Unit { int pm, pn; };
struct Gemm { const bf16_t* A; const bf16_t* Bt; int M, N, K; };

struct StaticOrder {
    int nM, nN, nwg, G, c;
    __host__ __device__ void init(int M, int N, int G_, int c_) { nM = M / BM; nN = N / BM; nwg = nM * nN; G = G_; c = c_; }
    __host__ __device__ bool next(int i, Unit& u) const {
        const long L = (long)i * G + c; if (L >= nwg) return false;
        int wgid = (int)L; { const int q = nwg / NXCD, r = nwg % NXCD, xcd = wgid % NXCD, off = wgid / NXCD; wgid = (xcd < r ? xcd * (q + 1) : r * (q + 1) + (xcd - r) * q) + off; }
        const int nig = WGM * nN, gid = wgid / nig, fm = gid * WGM, gsz = (nM - fm) < WGM ? (nM - fm) : WGM;
        u.pm = fm + ((wgid % nig) % gsz); u.pn = (wgid % nig) / gsz; return true;
    }
    __device__ __forceinline__ void a_ready(const Unit&) const {}
    __device__ __forceinline__ void done(const Unit&) const {}
};

__device__ __forceinline__ unsigned cvt_pk_bf16(float lo, float hi) { unsigned r; asm volatile("v_cvt_pk_bf16_f32 %0, %1, %2" : "=v"(r) : "v"(lo), "v"(hi)); return r; }
typedef float f32x2 __attribute__((ext_vector_type(2)));
__device__ __forceinline__ f32x2 gelu_pk(f32x2 v) {
    const f32x2 av = __builtin_elementwise_abs(v), d = av * 0.2316418882f + 1.0f;
    f32x2 t; t.x = __builtin_amdgcn_rcpf(d.x); t.y = __builtin_amdgcn_rcpf(d.y);
    f32x2 q = t * 0.5307027145f + (-0.7265760135f); q = q * t + 0.7107068705f; q = q * t + (-0.142248368f); q = q * t + 0.127414796f; q = q * t;
    const f32x2 s = (v * v) * (-0.72134752044f);
    f32x2 e; e.x = __builtin_amdgcn_exp2f(s.x); e.y = __builtin_amdgcn_exp2f(s.y);
    const f32x2 m = v * (q * e), r = v - m;
    f32x2 o; o.x = v.x < 0.f ? m.x : r.x; o.y = v.y < 0.f ? m.y : r.y; return o;
}

template <int ACT  > struct EpiBf16 {
    static constexpr bool PERM = true, AFTER_DRAIN = false; static_assert(ACT == 0 || ACT == 1, "EpiBf16: ACT is 0 (none) or 1 (gelu_pk)");
    bf16_t* O; int ldc; const float* bias; int split_cols; size_t split_stride; float scale0;
    __device__ __forceinline__ void operator()(const f32x4 (&acc)[2][2][4][2], const Unit& u, int wr, int wc, int fr, int fq) const {
        const int row0 = u.pm * BM + wr * 64 + fr; int colt = u.pn * BM; bf16_t* base = O;
        float sc = 1.f; if (split_cols) { const int t = colt / split_cols; base += (size_t)t * split_stride; colt -= t * split_cols; if (t == 0) sc = scale0; }
        const int col0 = colt + wc * 32 + 8 * fq, bcol0 = u.pn * BM + wc * 32 + 8 * fq;
        f32x4 bv[2][2];
#pragma unroll
        for (int bj = 0; bj < 2; ++bj)
#pragma unroll
            for (int n = 0; n < 2; ++n) bv[bj][n] = bias ? *(const f32x4*)(bias + bcol0 + bj * HALF + 4 * n) : (f32x4){0.f, 0.f, 0.f, 0.f};
#pragma unroll
        for (int ai = 0; ai < 2; ++ai)
#pragma unroll
            for (int m = 0; m < 4; ++m) { bf16_t* rowp = base + (size_t)(row0 + ai * HALF + m * 16) * ldc + col0;
#pragma unroll
                for (int bj = 0; bj < 2; ++bj) { f32x4 v0 = acc[ai][bj][m][0] + bv[bj][0], v1 = acc[ai][bj][m][1] + bv[bj][1];
                    if (ACT == 1) { f32x2 a = gelu_pk((f32x2){v0[0], v0[1]}), b = gelu_pk((f32x2){v0[2], v0[3]}), c = gelu_pk((f32x2){v1[0], v1[1]}), d = gelu_pk((f32x2){v1[2], v1[3]});
                        v0 = (f32x4){a.x, a.y, b.x, b.y}; v1 = (f32x4){c.x, c.y, d.x, d.y}; }
                    v0 = v0 * sc; v1 = v1 * sc; u32x4 w; w.x = cvt_pk_bf16(v0[0], v0[1]); w.y = cvt_pk_bf16(v0[2], v0[3]); w.z = cvt_pk_bf16(v1[0], v1[1]); w.w = cvt_pk_bf16(v1[2], v1[3]);
                    *(u32x4*)(rowp + bj * HALF) = w; } }
    }
};
template <class Epi, class Sched, bool ALIGN_EPI = false, bool SP2 = false>
__device__ __forceinline__ void gemm_phase(PG8_LAS unsigned char* lds, const Gemm g, const Sched& S, Epi& E) {
    const int tid = threadIdx.x, wid = __builtin_amdgcn_readfirstlane(tid >> 6), lane = tid & 63, wr = wid >> 2, wc = wid & 3, fr = lane & 15, fq = lane >> 4;
    int K_ = g.K; asm volatile("" : "+s"(K_)); const int K = K_, nt = K / BK;
    unsigned voffA[2], voffB[2];
#pragma unroll
    for (int i = 0; i < 2; ++i) { int R, C; stage_rc(tid * 16 + i * 8192, R, C); const int Rb = Epi::PERM ? ((R & ~31) + perm32(R & 31)) : R;
        voffA[i] = (unsigned)(R * K + C) * 2u; voffB[i] = (unsigned)(Rb * K + C) * 2u; }
    const size_t kstep = (size_t)(BK * 2);
    const size_t hstep = (size_t)HALF * K * 2;
    const size_t tstep = 2 * hstep;
    const unsigned ldsw = (unsigned)wid * 1024u;
    const int aoff = lds_byte(wr * 64 + fr, fq * 8), boff = lds_byte(wc * 32 + fr, fq * 8);
#define PG8_SA(b, h) (((b) * 2 + (h)) * HTB)
#define PG8_SB(b, h) ((4 + (b) * 2 + (h)) * HTB)
#define PG8_STAGE(bufoff, gbase, voff) do { _Pragma("unroll") for (int _i = 0; _i < 2; ++_i) \
        __builtin_amdgcn_global_load_lds((const unsigned*)((const char*)(gbase) + (voff)[_i]), (PG8_LAS unsigned*)(lds + (bufoff) + ldsw + _i * 8192), 16, 0, 0); } while (0)
#define PG8_LDA(dst, b, h) do { _Pragma("unroll") for (int m = 0; m < 4; ++m) _Pragma("unroll") for (int k = 0; k < 2; ++k) dst[m][k] = *(const PG8_LAS bf16x8*)(lds + PG8_SA(b, h) + aoff + m * 2048 + k * 1024); } while (0)
#define PG8_LDB(dst, b, h) do { _Pragma("unroll") for (int n = 0; n < 2; ++n) _Pragma("unroll") for (int k = 0; k < 2; ++k) dst[n][k] = *(const PG8_LAS bf16x8*)(lds + PG8_SB(b, h) + boff + n * 2048 + k * 1024); } while (0)
#define PG8_MMA(ai, bj, At, Bt) do { __builtin_amdgcn_s_setprio(1); _Pragma("unroll") for (int m = 0; m < 4; ++m) _Pragma("unroll") for (int n = 0; n < 2; ++n) _Pragma("unroll") for (int k = 0; k < 2; ++k) \
        acc[ai][bj][m][n] = __builtin_amdgcn_mfma_f32_16x16x32_bf16(Bt[n][k], At[m][k], acc[ai][bj][m][n], 0, 0, 0); __builtin_amdgcn_s_setprio(0); } while (0)
#define PG8_WAIT_V(n) asm volatile("s_waitcnt vmcnt(" #n ")" ::: "memory")
#define PG8_WAIT_L(n) asm volatile("s_waitcnt lgkmcnt(" #n ")" ::: "memory")
#define PG8_BAR __builtin_amdgcn_s_barrier()
#define PG8_SCHED __builtin_amdgcn_sched_barrier(0)
    Unit cur, nxt; int ui = 0;
    if (!S.next(0, cur)) return;
    f32x4 acc[2][2][4][2];
#pragma unroll
    for (int a = 0; a < 2; ++a)
#pragma unroll
        for (int b = 0; b < 2; ++b)
#pragma unroll
            for (int m = 0; m < 4; ++m)
#pragma unroll
                for (int n = 0; n < 2; ++n) acc[a][b][m][n] = (f32x4){0.f, 0.f, 0.f, 0.f};
    bf16x8 At[4][2], B0[2][2], B1[2][2];
    const char* cA = (const char*)g.A + (size_t)cur.pm * tstep; const char* cB = (const char*)g.Bt + (size_t)cur.pn * tstep;
    S.a_ready(cur);
    if constexpr (SP2) {
        PG8_STAGE(PG8_SB(0, 0), cB, voffB); PG8_STAGE(PG8_SB(0, 1), cB + hstep, voffB); PG8_STAGE(PG8_SA(0, 0), cA, voffA); PG8_STAGE(PG8_SA(0, 1), cA + hstep, voffA);
        if (wr == 1) PG8_BAR;
        PG8_WAIT_V(2); PG8_BAR;
        PG8_STAGE(PG8_SB(1, 0), cB + kstep, voffB); PG8_STAGE(PG8_SA(1, 0), cA + kstep, voffA); PG8_STAGE(PG8_SB(1, 1), cB + hstep + kstep, voffB);
        PG8_WAIT_V(6); PG8_BAR;
    } else {
        PG8_STAGE(PG8_SB(0, 0), cB, voffB); PG8_STAGE(PG8_SA(0, 0), cA, voffA); PG8_STAGE(PG8_SB(0, 1), cB + hstep, voffB); PG8_STAGE(PG8_SA(0, 1), cA + hstep, voffA);
        if (wr == 1) PG8_BAR;
        PG8_WAIT_V(4); PG8_BAR;
        PG8_STAGE(PG8_SB(1, 0), cB + kstep, voffB); PG8_STAGE(PG8_SA(1, 0), cA + kstep, voffA); PG8_STAGE(PG8_SB(1, 1), cB + hstep + kstep, voffB);
        PG8_WAIT_V(6); PG8_BAR;
    }
    for (;;) {
        const bool has_next = S.next(ui + 1, nxt);
        const char* nA = has_next ? (const char*)g.A + (size_t)nxt.pm * tstep : cA; const char* nB = has_next ? (const char*)g.Bt + (size_t)nxt.pn * tstep : cB;
        for (int t = 0; t < nt; t += 2) {
            const bool last = (t == nt - 2);
            const char* a1 = cA + (size_t)(t + 1) * kstep;
            const char* a2 = last ? nA : cA + (size_t)(t + 2) * kstep; const char* b2 = last ? nB : cB + (size_t)(t + 2) * kstep;
            const char* a3 = a2 + kstep; const char* b3 = b2 + kstep;
            if (last && has_next) S.a_ready(nxt);
            if constexpr (SP2) {
            PG8_LDB(B0, 0, 0); PG8_LDB(B1, 0, 1); PG8_SCHED; PG8_LDA(At, 0, 0); PG8_STAGE(PG8_SA(1, 1), a1 + hstep, voffA);
            PG8_WAIT_V(8); PG8_WAIT_L(0); PG8_BAR; PG8_MMA(0, 0, At, B0); PG8_MMA(0, 1, At, B1); PG8_BAR; PG8_SCHED;
            PG8_LDA(At, 0, 1); PG8_STAGE(PG8_SB(0, 0), b2, voffB); PG8_STAGE(PG8_SB(0, 1), b2 + hstep, voffB); PG8_STAGE(PG8_SA(0, 0), a2, voffA);
            PG8_WAIT_V(8); PG8_WAIT_L(0); PG8_BAR; PG8_MMA(1, 0, At, B0); PG8_MMA(1, 1, At, B1); PG8_BAR; PG8_SCHED;
            PG8_LDB(B0, 1, 0); PG8_LDB(B1, 1, 1); PG8_SCHED; PG8_LDA(At, 1, 0); PG8_STAGE(PG8_SA(0, 1), a2 + hstep, voffA);
            PG8_WAIT_V(8); PG8_WAIT_L(0); PG8_BAR; PG8_MMA(0, 0, At, B0); PG8_MMA(0, 1, At, B1); PG8_BAR; PG8_SCHED;
            PG8_LDA(At, 1, 1); PG8_STAGE(PG8_SB(1, 0), b3, voffB); PG8_STAGE(PG8_SB(1, 1), b3 + hstep, voffB); PG8_STAGE(PG8_SA(1, 0), a3, voffA);
            PG8_WAIT_V(8); PG8_WAIT_L(0); PG8_BAR; PG8_MMA(1, 0, At, B0); PG8_MMA(1, 1, At, B1); PG8_BAR; PG8_SCHED;
            } else {
            PG8_LDB(B0, 0, 0); PG8_SCHED; PG8_LDA(At, 0, 0); PG8_STAGE(PG8_SA(1, 1), a1 + hstep, voffA);
            PG8_WAIT_L(8); PG8_BAR; PG8_WAIT_L(0); PG8_MMA(0, 0, At, B0); PG8_BAR; PG8_SCHED;
            PG8_LDB(B1, 0, 1); PG8_STAGE(PG8_SB(0, 0), b2, voffB);
            PG8_BAR; PG8_WAIT_L(0); PG8_MMA(0, 1, At, B1); PG8_BAR;
            PG8_LDA(At, 0, 1); PG8_STAGE(PG8_SA(0, 0), a2, voffA);
            PG8_BAR; PG8_WAIT_L(0); PG8_MMA(1, 0, At, B0); PG8_BAR; PG8_SCHED;
            PG8_STAGE(PG8_SB(0, 1), b2 + hstep, voffB);
            PG8_WAIT_V(6); PG8_BAR; PG8_MMA(1, 1, At, B1); PG8_BAR;
            PG8_LDB(B0, 1, 0); PG8_SCHED; PG8_LDA(At, 1, 0); PG8_STAGE(PG8_SA(0, 1), a2 + hstep, voffA);
            PG8_WAIT_L(8); PG8_BAR; PG8_WAIT_L(0); PG8_MMA(0, 0, At, B0); PG8_BAR; PG8_SCHED;
            PG8_LDB(B1, 1, 1); PG8_STAGE(PG8_SB(1, 0), b3, voffB);
            PG8_BAR; PG8_WAIT_L(0); PG8_MMA(0, 1, At, B1); PG8_BAR;
            PG8_LDA(At, 1, 1); PG8_STAGE(PG8_SA(1, 0), a3, voffA);
            PG8_BAR; PG8_WAIT_L(0); PG8_MMA(1, 0, At, B0); PG8_BAR; PG8_SCHED;
            PG8_STAGE(PG8_SB(1, 1), b3 + hstep, voffB);
            PG8_WAIT_V(6); PG8_BAR; PG8_MMA(1, 1, At, B1); PG8_BAR;
            }
        }
        if constexpr (ALIGN_EPI) { if (wr == 0) PG8_BAR; }
        if constexpr (!Epi::AFTER_DRAIN) { E(acc, cur, wr, wc, fr, fq); S.done(cur); }
        if (!has_next) break;
#pragma unroll
        for (int a = 0; a < 2; ++a)
#pragma unroll
            for (int b = 0; b < 2; ++b)
#pragma unroll
                for (int m = 0; m < 4; ++m)
#pragma unroll
                    for (int n = 0; n < 2; ++n) acc[a][b][m][n] = (f32x4){0.f, 0.f, 0.f, 0.f};
        cur = nxt; cA = nA; cB = nB; ++ui;
        if constexpr (ALIGN_EPI) { if (wr == 1) PG8_BAR; }
    }
    PG8_WAIT_V(0);
    if constexpr (!ALIGN_EPI) { if (wr == 0) PG8_BAR; }
    PG8_BAR;
    if constexpr (Epi::AFTER_DRAIN) { E.fused(acc, cur, wr, wc, fr, fq, lds, wid, lane); S.done(cur); }
#undef PG8_SA
#undef PG8_SB
#undef PG8_STAGE
#undef PG8_LDA
#undef PG8_LDB
#undef PG8_MMA
#undef PG8_WAIT_V
#undef PG8_WAIT_L
#undef PG8_BAR
#undef PG8_SCHED
}
}

constexpr int BATCH = 16, SEQ = 4096, DM = 1024, MTOK = BATCH * SEQ;
constexpr int NZ = 3584;
constexpr int ZC_MQ = 0, ZC_MK = 512, ZC_MV = 1024, ZC_MO = 1536, ZC_AQ = 2056, ZC_AKC = 2568, ZC_AVC = 2696, ZC_AKS = 2824, ZC_AVS = 2952, ZC_AKW = 3080, ZC_AVW = 3208;
constexpr int DFF = 2048, PLE = 256, NCMP = 255;
constexpr float EPS = 1e-6f;
constexpr int NWAVES = 8, NTHREADS = 512;
constexpr int LDS_BYTES = 147456;

typedef unsigned short bf16_t;
typedef float f32x4 __attribute__((ext_vector_type(4)));
typedef unsigned u32x4 __attribute__((ext_vector_type(4)));
typedef unsigned u32x2 __attribute__((ext_vector_type(2)));

constexpr size_t MiB = 1u << 20;
constexpr size_t WS_CTL = 0;
constexpr size_t WS_WIN = 1 * MiB, WS_WOUT = 8 * MiB, WS_WUP = 10 * MiB, WS_WDN = 18 * MiB, WS_WPG = 22 * MiB, WS_WPP = 24 * MiB;
constexpr size_t WS_KC = 25 * MiB, WS_VC = 27 * MiB;
constexpr size_t WS_GATES = 32 * MiB, WS_PB = 40 * MiB, WS_XB = 72 * MiB;
constexpr size_t WS_MIX = 200 * MiB, WS_ACT = 200 * MiB;
constexpr size_t WS_Z = 456 * MiB, WS_U = 456 * MiB, WS_PROJ = 456 * MiB;
constexpr size_t WS_RS2 = 968 * MiB, WS_RS3 = 972 * MiB;
constexpr size_t WS_END = 976 * MiB;

struct Params { const float* in[22]; float* out; unsigned char* ws; };

__device__ __forceinline__ float bf2f(unsigned u16) { return __uint_as_float(u16 << 16); }
__device__ __forceinline__ float bflo(unsigned w) { return __uint_as_float(w << 16); }
__device__ __forceinline__ float bfhi(unsigned w) { return __uint_as_float(w & 0xffff0000u); }
__device__ __forceinline__ unsigned f2bf(float f) { unsigned u = __float_as_uint(f); return (u + 0x7fffu + ((u >> 16) & 1u)) >> 16; }
__device__ __forceinline__ unsigned pk2(float lo, float hi) { return f2bf(lo) | (f2bf(hi) << 16); }
__device__ __forceinline__ float wave_sum(float v) {
#pragma unroll
    for (int o = 1; o < 64; o <<= 1) v += __shfl_xor(v, o);
    return v;
}
__device__ __forceinline__ float wave_max(float v) {
#pragma unroll
    for (int o = 1; o < 64; o <<= 1) v = fmaxf(v, __shfl_xor(v, o));
    return v;
}
__device__ __forceinline__ float sigmoidf_(float x) { return 1.0f / (1.0f + __expf(-x)); }
__device__ __forceinline__ float log_sigmoidf_(float x) { return fminf(x, 0.f) - log1pf(__expf(-fabsf(x))); }
#define WAVE_LDS_SYNC() asm volatile("s_waitcnt lgkmcnt(0)" ::: "memory")

namespace pg8 {
__device__ __forceinline__ float row_rstd(const float* rs, int row) {
    const f32x4* p = (const f32x4*)(rs + (size_t)row * 16); const f32x4 a = p[0], b = p[1], c = p[2], d = p[3];
    const float s = (((a[0] + a[1]) + (a[2] + a[3])) + ((b[0] + b[1]) + (b[2] + b[3]))) + (((c[0] + c[1]) + (c[2] + c[3])) + ((d[0] + d[1]) + (d[2] + d[3])));
    return 1.0f / sqrtf(s * (1.0f / 1024.0f) + EPS);
}
struct EpiZ {
    static constexpr bool PERM = true, AFTER_DRAIN = false;
    bf16_t* Z; float* gates;
    __device__ __forceinline__ void operator()(const f32x4 (&acc)[2][2][4][2], const Unit& u, int wr, int wc, int fr, int fq) {
        const int row0 = u.pm * BM + wr * 64 + fr; const int col0 = u.pn * BM + wc * 32 + 8 * fq;
#pragma unroll
        for (int ai = 0; ai < 2; ++ai)
#pragma unroll
            for (int m = 0; m < 4; ++m) { const int row = row0 + ai * HALF + m * 16; bf16_t* rowp = Z + (size_t)row * NZ + col0;
#pragma unroll
                for (int bj = 0; bj < 2; ++bj) { const f32x4 v0 = acc[ai][bj][m][0], v1 = acc[ai][bj][m][1];
                    u32x4 w; w.x = cvt_pk_bf16(v0[0], v0[1]); w.y = cvt_pk_bf16(v0[2], v0[3]); w.z = cvt_pk_bf16(v1[0], v1[1]); w.w = cvt_pk_bf16(v1[2], v1[3]);
                    *(u32x4*)(rowp + bj * HALF) = w; }
                if (wc == 0) {
                    if ((u.pn == 8 && fq == 0) || (u.pn == 13 && fq >= 1)) {
                        float* gp = gates + (size_t)row * 32 + 8 * fq;
                        *(f32x4*)(gp) = acc[ai][0][m][0]; *(f32x4*)(gp + 4) = acc[ai][0][m][1];
                    }
                }
            }
    }
};
template <bool ROWSCALE> struct EpiBf {
    static constexpr bool PERM = true, AFTER_DRAIN = false;
    bf16_t* O; int ldc; const float* rs;
    __device__ __forceinline__ void operator()(const f32x4 (&acc)[2][2][4][2], const Unit& u, int wr, int wc, int fr, int fq) {
        const int row0 = u.pm * BM + wr * 64 + fr; const int col0 = u.pn * BM + wc * 32 + 8 * fq;
#pragma unroll
        for (int ai = 0; ai < 2; ++ai)
#pragma unroll
            for (int m = 0; m < 4; ++m) { const int row = row0 + ai * HALF + m * 16; bf16_t* rowp = O + (size_t)row * ldc + col0;
                float sc = 1.f;
                if (ROWSCALE) sc = row_rstd(rs, row);
#pragma unroll
                for (int bj = 0; bj < 2; ++bj) { const f32x4 v0 = acc[ai][bj][m][0] * sc, v1 = acc[ai][bj][m][1] * sc;
                    u32x4 w; w.x = cvt_pk_bf16(v0[0], v0[1]); w.y = cvt_pk_bf16(v0[2], v0[3]); w.z = cvt_pk_bf16(v1[0], v1[1]); w.w = cvt_pk_bf16(v1[2], v1[3]);
                    *(u32x4*)(rowp + bj * HALF) = w; }
            }
    }
};
struct EpiRes {
    static constexpr bool PERM = false, AFTER_DRAIN = false;
    const float* base; float* out; bf16_t* xb; float* rs;
    __device__ __forceinline__ void operator()(const f32x4 (&acc)[2][2][4][2], const Unit& u, int wr, int wc, int fr, int fq) {
        const int col0 = u.pn * BM + wc * 32 + 4 * fq;
#pragma unroll
        for (int ai = 0; ai < 2; ++ai)
#pragma unroll
            for (int m = 0; m < 4; ++m) { const int row = u.pm * BM + ai * HALF + wr * 64 + m * 16 + fr; const size_t off = (size_t)row * DM + col0; float s = 0.f;
#pragma unroll
                for (int bj = 0; bj < 2; ++bj)
#pragma unroll
                    for (int n = 0; n < 2; ++n) { const size_t o2 = off + bj * HALF + n * 16; const f32x4 bs = *(const f32x4*)(base + o2); const f32x4 o = bs + acc[ai][bj][m][n];
                        *(f32x4*)(out + o2) = o; u32x2 w; w.x = cvt_pk_bf16(o[0], o[1]); w.y = cvt_pk_bf16(o[2], o[3]); *(u32x2*)(xb + o2) = w;
                        s += (o[0] * o[0] + o[1] * o[1]) + (o[2] * o[2] + o[3] * o[3]); }
                s += __shfl_xor(s, 16); s += __shfl_xor(s, 32);
                if (fq == 0) rs[(size_t)row * 16 + u.pn * 4 + wc] = s; }
    }
};
struct EpiPle {
    static constexpr bool PERM = false, AFTER_DRAIN = false;
    float* out; const bf16_t* proj; const float* rs;
    __device__ __forceinline__ void operator()(const f32x4 (&acc)[2][2][4][2], const Unit& u, int wr, int wc, int fr, int fq) {
        const int col0 = u.pn * BM + wc * 32 + 4 * fq;
#pragma unroll
        for (int ai = 0; ai < 2; ++ai)
#pragma unroll
            for (int m = 0; m < 4; ++m) { const int row = u.pm * BM + ai * HALF + wr * 64 + m * 16 + fr; const size_t off = (size_t)row * DM + col0;
                const float sc = row_rstd(rs, row);
#pragma unroll
                for (int bj = 0; bj < 2; ++bj)
#pragma unroll
                    for (int n = 0; n < 2; ++n) { const size_t o2 = off + bj * HALF + n * 16; const f32x4 bs = *(const f32x4*)(out + o2); const u32x2 pw = *(const u32x2*)(proj + o2);
                        const f32x4 a = acc[ai][bj][m][n] * sc; f32x4 o;
                        o[0] = bs[0] + sigmoidf_(a[0]) * bflo(pw.x); o[1] = bs[1] + sigmoidf_(a[1]) * bfhi(pw.x); o[2] = bs[2] + sigmoidf_(a[2]) * bflo(pw.y); o[3] = bs[3] + sigmoidf_(a[3]) * bfhi(pw.y);
                        *(f32x4*)(out + o2) = o; }
            }
    }
};
struct PanelOrder {
    int nM, G, c;
    __host__ __device__ void init(int M, int G_, int c_) { nM = M / BM; G = G_; c = c_; }
    __host__ __device__ bool next(int i, Unit& u) const { const int p = c + G * (i >> 2); if (p >= nM) return false; u.pm = p; u.pn = i & 3; return true; }
    __device__ __forceinline__ void a_ready(const Unit&) const {}
    __device__ __forceinline__ void done(const Unit&) const {}
};
}

__device__ __forceinline__ void p0_transpose_item(const float* W, const float* gk, int K, int N, bf16_t* WT, float* scr, int item, int lane) {
    const int nblk = N / 32, kb = item / nblk, nb = item % nblk, k0 = 64 * kb, n0 = 32 * nb;
#pragma unroll 8
    for (int i = 0; i < 32; ++i) { const int kk = 2 * i + (lane >> 5); float w = W[(size_t)(k0 + kk) * N + n0 + (lane & 31)]; if (gk) w *= gk[k0 + kk]; scr[kk * 33 + (lane & 31)] = w; }
    WAVE_LDS_SYNC();
    const int c = lane & 7;
#pragma unroll
    for (int j = 0; j < 4; ++j) { const int n = (lane >> 3) + 8 * j; const float* s = scr + (8 * c) * 33 + n;
        u32x4 o; o.x = pk2(s[0 * 33], s[1 * 33]); o.y = pk2(s[2 * 33], s[3 * 33]); o.z = pk2(s[4 * 33], s[5 * 33]); o.w = pk2(s[6 * 33], s[7 * 33]);
        *(u32x4*)(WT + (size_t)(n0 + n) * K + k0 + 8 * c) = o; }
    WAVE_LDS_SYNC();
}

__device__ __forceinline__ float dot64_bf(const float* qv, const bf16_t* krow) {
    const u32x4* kp = (const u32x4*)krow; float acc = 0.f;
#pragma unroll
    for (int i = 0; i < 8; ++i) { const u32x4 w = kp[i]; const f32x4 q0 = *(const f32x4*)(qv + 8 * i), q1 = *(const f32x4*)(qv + 8 * i + 4);
        acc += q0[0] * bflo(w.x) + q0[1] * bfhi(w.x) + q0[2] * bflo(w.y) + q0[3] * bfhi(w.y) + q1[0] * bflo(w.z) + q1[1] * bfhi(w.z) + q1[2] * bflo(w.w) + q1[3] * bfhi(w.w); }
    return acc;
}
__device__ __forceinline__ float dot64_f(const float* qv, const float* krow) {
    float acc = 0.f;
#pragma unroll
    for (int i = 0; i < 16; ++i) { const f32x4 w = *(const f32x4*)(krow + 4 * i), q = *(const f32x4*)(qv + 4 * i); acc += q[0] * w[0] + q[1] * w[1] + q[2] * w[2] + q[3] * w[3]; }
    return acc;
}

__device__ __forceinline__ void compress_unit_simple(const bf16_t* Z, int zcol, const float* pe, const float* w1, const float* w2, float* outc, int b, int g, int ng, float* lds_f, int tid) {
    float* tok = lds_f;
    float* pes = lds_f + 144 * 64;
    float* hid = pes + 32 * 64;
    const int n0 = 8 * ng, t0 = 16 * n0;
    for (int i = tid; i < 144 * 64; i += NTHREADS) { const int tt = i >> 6, d = i & 63; const int t = t0 + tt;
        tok[i] = (t < SEQ) ? bf2f(Z[((size_t)b * SEQ + t) * NZ + zcol + g * 64 + d]) : 0.f; }
    for (int i = tid; i < 32 * 64; i += NTHREADS) pes[i] = pe[i];
    __syncthreads();
    const int j = tid & 127, sub = tid >> 7;
    float a0 = 0.f, a1 = 0.f;
    const float* tk0 = tok + (2 * sub) * 16 * 64; const float* tk1 = tk0 + 16 * 64;
    for (int ld = 0; ld < 2048; ++ld) { const float w = w1[(size_t)ld * 128 + j]; const float pv = pes[ld]; a0 += (tk0[ld] + pv) * w; a1 += (tk1[ld] + pv) * w; }
    { const float x0 = a0, x1 = a1;
      hid[(2 * sub) * 128 + j] = 0.5f * x0 * (1.0f + tanhf(0.7978845608028654f * (x0 + 0.044715f * x0 * x0 * x0)));
      hid[(2 * sub + 1) * 128 + j] = 0.5f * x1 * (1.0f + tanhf(0.7978845608028654f * (x1 + 0.044715f * x1 * x1 * x1))); }
    __syncthreads();
    { const int nl = tid >> 6, d = tid & 63; float o = 0.f;
      for (int jj = 0; jj < 128; ++jj) o += hid[nl * 128 + jj] * w2[jj * 64 + d];
      const int n = n0 + nl; if (n < NCMP) outc[(((size_t)b * 2 + g) * 256 + n) * 64 + d] = o; }
    __syncthreads();
}

struct MixPtrs { const bf16_t* Z; const float* gates; const float* KC; const float* VC; bf16_t* MIX; const float* gate_bias; const float* mnorm_g; };

__device__ __forceinline__ void nsa_token_simple(const MixPtrs& P, int b, int g, int t, float* qs, float* pc, float* pb, int lane) {
    const size_t row = (size_t)b * SEQ + t;
    const bf16_t* zrow = P.Z + row * NZ;
    const bf16_t* zb = P.Z + (size_t)b * SEQ * NZ;
#pragma unroll
    for (int r = 0; r < 4; ++r) qs[r * 64 + lane] = bf2f(zrow[ZC_AQ + (g * 4 + r) * 64 + lane]) * 0.125f;
    WAVE_LDS_SYNC();
    const int nv = (t >= 31) ? min((t - 31) / 16 + 1, NCMP) : 0;
    const float* kc = P.KC + ((size_t)b * 2 + g) * 256 * 64; const float* vc = P.VC + ((size_t)b * 2 + g) * 256 * 64;
    float oc[4], os[4], ow[4];
#pragma unroll 1
    for (int r = 0; r < 4; ++r) {
        const float slope = exp2f(-(float)(g * 4 + r + 1));
        float sv[4]; float mx = -3.0e38f;
#pragma unroll
        for (int i = 0; i < 4; ++i) { const int n = lane + 64 * i; sv[i] = -3.0e38f;
            if (n < nv) { const float s = dot64_f(qs + r * 64, kc + (size_t)n * 64) - slope * (float)(t - (16 * n + 31)); sv[i] = s; mx = fmaxf(mx, s); } }
        mx = wave_max(mx);
        float sum = 0.f;
#pragma unroll
        for (int i = 0; i < 4; ++i) { const int n = lane + 64 * i; float e = 0.f; if (n < nv) e = __expf(sv[i] - mx); sv[i] = e; sum += e; }
        sum = wave_sum(sum);
        const float inv = (nv > 0) ? 1.0f / sum : 0.f;
#pragma unroll
        for (int i = 0; i < 4; ++i) pc[r * 256 + lane + 64 * i] = sv[i] * inv;
        WAVE_LDS_SYNC();
        float a = 0.f;
        for (int n = 0; n < nv; ++n) a += pc[r * 256 + n] * vc[(size_t)n * 64 + lane];
        oc[r] = a;
    }
    unsigned long long selmask;
    {
        float imp = 0.f;
        for (int n = 4 * lane - 1; n <= 4 * lane + 3; ++n) if (n >= 0 && n < NCMP) imp += (pc[n] + pc[256 + n]) + (pc[512 + n] + pc[768 + n]);
        const int cur = t >> 6;
        const bool causal = lane <= cur; const bool forced = (lane == 0) || (lane == cur) || (lane == cur - 1);
        const float score = causal ? (forced ? 1.0e30f : imp) : -1.0e30f;
        int rank = 0;
        for (int i = 0; i < 64; ++i) { const float si = __shfl(score, i); rank += ((si > score) || (si == score && i < lane)) ? 1 : 0; }
        selmask = __ballot(rank < 16);
    }
#pragma unroll 1
    for (int r = 0; r < 4; ++r) {
        const float slope = exp2f(-(float)(g * 4 + r + 1));
        float mx = -3.0e38f; int idx = 0;
        for (unsigned long long mm = selmask; mm; mm &= mm - 1, ++idx) { const int j = __builtin_ctzll(mm); const int pos = 64 * j + lane;
            float s = -1.0e30f;
            if (pos <= t) s = dot64_bf(qs + r * 64, zb + (size_t)pos * NZ + ZC_AKS + g * 64) - slope * (float)(t - pos);
            pb[idx * 64 + lane] = s; mx = fmaxf(mx, s); }
        mx = wave_max(mx);
        float sum = 0.f;
        for (int i = 0; i < 16; ++i) { const float e = __expf(pb[i * 64 + lane] - mx); pb[i * 64 + lane] = e; sum += e; }
        sum = wave_sum(sum);
        WAVE_LDS_SYNC();
        float a = 0.f; idx = 0;
        for (unsigned long long mm = selmask; mm; mm &= mm - 1, ++idx) { const int j = __builtin_ctzll(mm);
            if (64 * j > t) continue;
            const bf16_t* vp = zb + (size_t)(64 * j) * NZ + ZC_AVS + g * 64 + lane;
            for (int l = 0; l < 64; ++l) a += pb[idx * 64 + l] * bf2f(vp[(size_t)l * NZ]); }
        os[r] = a / sum;
        WAVE_LDS_SYNC();
    }
    const int lo = max(0, t - 511);
#pragma unroll 1
    for (int r = 0; r < 4; ++r) {
        const float slope = exp2f(-(float)(g * 4 + r + 1));
        float mx = -3.0e38f;
        for (int i = 0; i < 8; ++i) { const int pos = lo + 64 * i + lane; float s = -1.0e30f;
            if (pos <= t) s = dot64_bf(qs + r * 64, zb + (size_t)pos * NZ + ZC_AKW + g * 64) - slope * (float)(t - pos);
            pb[i * 64 + lane] = s; mx = fmaxf(mx, s); }
        mx = wave_max(mx);
        float sum = 0.f;
        for (int i = 0; i < 8; ++i) { const float e = __expf(pb[i * 64 + lane] - mx); pb[i * 64 + lane] = e; sum += e; }
        sum = wave_sum(sum);
        WAVE_LDS_SYNC();
        float a = 0.f; const int cnt = t - lo + 1;
        const bf16_t* vp = zb + (size_t)lo * NZ + ZC_AVW + g * 64 + lane;
        for (int l = 0; l < cnt; ++l) a += pb[l] * bf2f(vp[(size_t)l * NZ]);
        ow[r] = a / sum;
        WAVE_LDS_SYNC();
    }
    const float* gp = P.gates + row * 32 + 8;
#pragma unroll
    for (int r = 0; r < 4; ++r) { const int hh = g * 4 + r;
        const float o = sigmoidf_(gp[hh * 3 + 0]) * oc[r] + sigmoidf_(gp[hh * 3 + 1]) * os[r] + sigmoidf_(gp[hh * 3 + 2]) * ow[r];
        P.MIX[row * DM + 512 + hh * 64 + lane] = (bf16_t)f2bf(o); }
}

__device__ __forceinline__ void mlstm_unit_simple(const MixPtrs& P, int b, int h, float* lds_f, int tid) {
    float* qs = lds_f;
    float* ks = qs + 64 * 128;
    float* vs = ks + 64 * 128;
    float* hraw = vs + 64 * 128;
    float* red = hraw + 64 * 128;
    float* redn = red + 2 * 4 * 128;
    float* igs = redn + 8;
    float* lfs = igs + 64;
    const int dv = tid & 127, kg = tid >> 7, lane = tid & 63, wave = tid >> 6;
    float C[32], nn[32];
#pragma unroll
    for (int i = 0; i < 32; ++i) { C[i] = 0.f; nn[i] = 0.f; }
    float mst = 0.f;
    const float bi = P.gate_bias[h], bff = P.gate_bias[4 + h];
    const float qscale = 0.08838834764831845f;
#pragma unroll 1
    for (int c = 0; c < SEQ / 64; ++c) {
        const size_t row0 = (size_t)b * SEQ + c * 64;
        for (int i = tid; i < 64 * 128; i += NTHREADS) { const int tt = i >> 7, d = i & 127; const bf16_t* zr = P.Z + (row0 + tt) * NZ + h * 128 + d;
            qs[i] = bf2f(zr[ZC_MQ]) * qscale; ks[i] = bf2f(zr[ZC_MK]); vs[i] = bf2f(zr[ZC_MV]); }
        if (tid < 64) { const float* gr = P.gates + (row0 + tid) * 32; igs[tid] = gr[h] + bi; lfs[tid] = log_sigmoidf_(gr[4 + h] + bff); }
        __syncthreads();
#pragma unroll 1
        for (int t = 0; t < 64; ++t) {
            const float lf = lfs[t], ig = igs[t];
            const float mnew = fmaxf(lf + mst, ig);
            const float fs = __expf(lf + mst - mnew), is = __expf(ig - mnew);
            mst = mnew;
            const float v = vs[t * 128 + dv] * is;
            float pn = 0.f, pd = 0.f;
            const float* kr = ks + t * 128 + kg * 32; const float* qr = qs + t * 128 + kg * 32;
#pragma unroll
            for (int i = 0; i < 32; ++i) { const float kk = kr[i], qq = qr[i];
                C[i] = fs * C[i] + kk * v; nn[i] = fs * nn[i] + is * kk; pn += qq * C[i]; pd += qq * nn[i]; }
            float* rb = red + (t & 1) * 512; float* rn = redn + (t & 1) * 4;
            rb[kg * 128 + dv] = pn; if (dv == 0) rn[kg] = pd;
            __syncthreads();
            if (tid < 128) { const float num = (rb[tid] + rb[128 + tid]) + (rb[256 + tid] + rb[384 + tid]); const float den = (rn[0] + rn[1]) + (rn[2] + rn[3]);
                hraw[t * 128 + tid] = num / fmaxf(fabsf(den), __expf(-mnew)); }
        }
        __syncthreads();
        for (int k = 0; k < 8; ++k) { const int tt = wave * 8 + k; const float h0 = hraw[tt * 128 + lane], h1 = hraw[tt * 128 + 64 + lane];
            const float ss = wave_sum(h0 * h0 + h1 * h1); const float rstd = 1.0f / sqrtf(ss * (1.0f / 128.0f) + EPS);
            const bf16_t* zo = P.Z + (row0 + tt) * NZ + ZC_MO + h * 128;
            const float o0 = h0 * rstd * P.mnorm_g[h * 128 + lane] * sigmoidf_(bf2f(zo[lane])), o1 = h1 * rstd * P.mnorm_g[h * 128 + 64 + lane] * sigmoidf_(bf2f(zo[64 + lane]));
            bf16_t* mo = P.MIX + (row0 + tt) * DM + h * 128;
            mo[lane] = (bf16_t)f2bf(o0); mo[64 + lane] = (bf16_t)f2bf(o1); }
        __syncthreads();
    }
}

__global__ void __launch_bounds__(NTHREADS, 2) fwd_kernel(Params prm) {
    extern __shared__ __attribute__((aligned(16))) unsigned char lds[];
    cg::grid_group grid = cg::this_grid();
    PG8_LAS unsigned char* ldsl = (PG8_LAS unsigned char*)lds;
    float* lds_f = (float*)lds;
#define TID ((int)threadIdx.x)
#define LANE ((int)(threadIdx.x & 63))
#define WAVE (__builtin_amdgcn_readfirstlane((int)(threadIdx.x >> 6)))
#define GRIDN ((int)gridDim.x)
#define BX ((int)blockIdx.x)
#define WSP(T, name, off) T* name; { unsigned char* w_ = prm.ws; asm volatile("" : "+s"(w_)); name = (T*)(w_ + (off)); }

    {
        const int lane = LANE, wave = WAVE, G = GRIDN, bx = BX, tid = TID; const int gw = bx * NWAVES + wave, NGW = G * NWAVES;
        WSP(bf16_t, Win_t, WS_WIN) WSP(bf16_t, Wout_t, WS_WOUT) WSP(bf16_t, Wup_t, WS_WUP) WSP(bf16_t, Wdn_t, WS_WDN) WSP(bf16_t, Wpg_t, WS_WPG) WSP(bf16_t, Wpp_t, WS_WPP)
        WSP(bf16_t, XB, WS_XB) WSP(bf16_t, PB, WS_PB)
        const float* x = prm.in[0]; const float* pin = prm.in[1];
        float* scr = lds_f + wave * 4096;
        constexpr int I_IN = (DM / 64) * (3360 / 32), I_OUT = (DM / 64) * (DM / 32), I_UP = (DM / 64) * (4096 / 32), I_DN = (DFF / 64) * (DM / 32), I_PG = I_OUT, I_PP = (PLE / 64) * (DM / 32);
        constexpr int NITEMS = I_IN + I_OUT + I_UP + I_DN + I_PG + I_PP;
        for (int it = gw; it < NITEMS; it += NGW) {
            int r = it;
            if (r < I_IN) { p0_transpose_item(prm.in[3], nullptr, DM, 3360, Win_t, scr, r, lane); continue; } r -= I_IN;
            if (r < I_OUT) { p0_transpose_item(prm.in[12], nullptr, DM, DM, Wout_t, scr, r, lane); continue; } r -= I_OUT;
            if (r < I_UP) { p0_transpose_item(prm.in[14], prm.in[13], DM, 4096, Wup_t, scr, r, lane); continue; } r -= I_UP;
            if (r < I_DN) { p0_transpose_item(prm.in[17], nullptr, DFF, DM, Wdn_t, scr, r, lane); continue; } r -= I_DN;
            if (r < I_PG) { p0_transpose_item(prm.in[19], prm.in[18], DM, DM, Wpg_t, scr, r, lane); continue; } r -= I_PG;
            p0_transpose_item(prm.in[20], nullptr, PLE, DM, Wpp_t, scr, r, lane);
        }
        for (int i = bx * NTHREADS + tid; i < (NZ - 3360) * DM / 8; i += G * NTHREADS) ((u32x4*)(Win_t + (size_t)3360 * DM))[i] = (u32x4){0u, 0u, 0u, 0u};
        const float* g1 = prm.in[2];
        f32x4 gv[4];
#pragma unroll
        for (int j = 0; j < 4; ++j) gv[j] = ((const f32x4*)g1)[lane + 64 * j];
        for (int m = gw; m < MTOK; m += NGW) {
            const f32x4* xr = (const f32x4*)(x + (size_t)m * DM) + lane; f32x4 v[4]; float s = 0.f;
#pragma unroll
            for (int j = 0; j < 4; ++j) { v[j] = xr[64 * j]; s += (v[j][0] * v[j][0] + v[j][1] * v[j][1]) + (v[j][2] * v[j][2] + v[j][3] * v[j][3]); }
            const float rstd = 1.0f / sqrtf(wave_sum(s) * (1.0f / DM) + EPS);
            u32x2* o8 = (u32x2*)(XB + (size_t)m * DM) + lane;
#pragma unroll
            for (int j = 0; j < 4; ++j) { u32x2 w; w.x = pk2(v[j][0] * rstd * gv[j][0], v[j][1] * rstd * gv[j][1]); w.y = pk2(v[j][2] * rstd * gv[j][2], v[j][3] * rstd * gv[j][3]); o8[64 * j] = w; }
        }
        for (size_t i = (size_t)bx * NTHREADS + tid; i < (size_t)MTOK * PLE / 8; i += (size_t)G * NTHREADS) {
            const f32x4 a = ((const f32x4*)pin)[2 * i], c = ((const f32x4*)pin)[2 * i + 1];
            u32x4 w; w.x = pk2(a[0], a[1]); w.y = pk2(a[2], a[3]); w.z = pk2(c[0], c[1]); w.w = pk2(c[2], c[3]); ((u32x4*)PB)[i] = w; }
    }
    grid.sync();

    {
        WSP(bf16_t, XB, WS_XB) WSP(bf16_t, Win_t, WS_WIN) WSP(bf16_t, Z, WS_Z) WSP(float, GATES, WS_GATES)
        pg8::Gemm g{XB, Win_t, MTOK, NZ, DM}; pg8::StaticOrder S; S.init(MTOK, NZ, GRIDN, BX);
        pg8::EpiZ E{Z, GATES};
        pg8::gemm_phase<pg8::EpiZ, pg8::StaticOrder, true, true>(ldsl, g, S, E);
    }
    grid.sync();

    {
        WSP(bf16_t, Z, WS_Z) WSP(float, KC, WS_KC) WSP(float, VC, WS_VC)
        for (int un = BX; un < 2 * BATCH * 2 * 32; un += GRIDN) {
            const int kv = un & 1, ng = (un >> 1) & 31, g = (un >> 6) & 1, b = un >> 7;
            if (kv == 0) compress_unit_simple(Z, ZC_AKC, prm.in[6], prm.in[8], prm.in[9], KC, b, g, ng, lds_f, TID);
            else         compress_unit_simple(Z, ZC_AVC, prm.in[7], prm.in[10], prm.in[11], VC, b, g, ng, lds_f, TID);
        }
    }
    grid.sync();

    {
        WSP(bf16_t, Z, WS_Z) WSP(float, KC, WS_KC) WSP(float, VC, WS_VC) WSP(float, GATES, WS_GATES) WSP(bf16_t, MIX, WS_MIX)
        MixPtrs MP{Z, GATES, KC, VC, MIX, prm.in[4], prm.in[5]};
        for (int un = BX; un < BATCH * 4; un += GRIDN) mlstm_unit_simple(MP, un >> 2, un & 3, lds_f, TID);
        __syncthreads();
        const int wave = WAVE, lane = LANE; const int gw = BX * NWAVES + wave, NGW = GRIDN * NWAVES;
        float* wl = lds_f + wave * 2304;
        for (int idx = gw; idx < BATCH * 2 * SEQ; idx += NGW) { const int t = idx & (SEQ - 1), g = (idx >> 12) & 1, b = idx >> 13;
            nsa_token_simple(MP, b, g, t, wl, wl + 256, wl + 1280, lane); }
    }
    grid.sync();

    {
        WSP(bf16_t, MIX, WS_MIX) WSP(bf16_t, Wout_t, WS_WOUT) WSP(bf16_t, XB, WS_XB) WSP(float, RS2, WS_RS2)
        pg8::Gemm g{MIX, Wout_t, MTOK, DM, DM}; pg8::PanelOrder S; S.init(MTOK, GRIDN, BX);
        pg8::EpiRes E{prm.in[0], prm.out, XB, RS2};
        pg8::gemm_phase<pg8::EpiRes, pg8::PanelOrder, true, true>(ldsl, g, S, E);
    }
    grid.sync();

    {
        WSP(bf16_t, XB, WS_XB) WSP(bf16_t, Wup_t, WS_WUP) WSP(bf16_t, U, WS_U) WSP(float, RS2, WS_RS2)
        pg8::Gemm g{XB, Wup_t, MTOK, 4096, DM}; pg8::StaticOrder S; S.init(MTOK, 4096, GRIDN, BX);
        pg8::EpiBf<true> E{U, 4096, RS2};
        pg8::gemm_phase<pg8::EpiBf<true>, pg8::StaticOrder, true, true>(ldsl, g, S, E);
    }
    grid.sync();

    {
        WSP(bf16_t, U, WS_U) WSP(bf16_t, ACT, WS_ACT)
        const float* cw = prm.in[15]; const float* cb = prm.in[16];
        for (size_t it = (size_t)BX * NTHREADS + TID; it < (size_t)MTOK * 256; it += (size_t)GRIDN * NTHREADS) {
            const size_t row = it >> 8; const int c8 = (int)(it & 255) * 8; const int t = (int)(row & (SEQ - 1));
            const bf16_t* u0 = U + row * 4096 + c8;
            const u32x4 z4 = (u32x4){0u, 0u, 0u, 0u};
            const u32x4 g2 = *(const u32x4*)u0; const u32x4 g1 = (t >= 1) ? *(const u32x4*)(u0 - 4096) : z4; const u32x4 g0 = (t >= 2) ? *(const u32x4*)(u0 - 8192) : z4;
            const u32x4 vv = *(const u32x4*)(u0 + 2048);
            float G0[8] = {bflo(g0.x), bfhi(g0.x), bflo(g0.y), bfhi(g0.y), bflo(g0.z), bfhi(g0.z), bflo(g0.w), bfhi(g0.w)};
            float G1[8] = {bflo(g1.x), bfhi(g1.x), bflo(g1.y), bfhi(g1.y), bflo(g1.z), bfhi(g1.z), bflo(g1.w), bfhi(g1.w)};
            float G2[8] = {bflo(g2.x), bfhi(g2.x), bflo(g2.y), bfhi(g2.y), bflo(g2.z), bfhi(g2.z), bflo(g2.w), bfhi(g2.w)};
            float V[8] = {bflo(vv.x), bfhi(vv.x), bflo(vv.y), bfhi(vv.y), bflo(vv.z), bfhi(vv.z), bflo(vv.w), bfhi(vv.w)};
            float A[8];
#pragma unroll
            for (int j = 0; j < 8; ++j) { const float cv = cw[c8 + j] * G0[j] + cw[DFF + c8 + j] * G1[j] + cw[2 * DFF + c8 + j] * G2[j] + cb[c8 + j]; A[j] = cv * sigmoidf_(cv) * V[j]; }
            u32x4 w; w.x = pk2(A[0], A[1]); w.y = pk2(A[2], A[3]); w.z = pk2(A[4], A[5]); w.w = pk2(A[6], A[7]);
            *(u32x4*)(ACT + row * DFF + c8) = w;
        }
    }
    grid.sync();

    {
        WSP(bf16_t, ACT, WS_ACT) WSP(bf16_t, Wdn_t, WS_WDN) WSP(bf16_t, XB, WS_XB) WSP(float, RS3, WS_RS3)
        pg8::Gemm g{ACT, Wdn_t, MTOK, DM, DFF}; pg8::PanelOrder S; S.init(MTOK, GRIDN, BX);
        pg8::EpiRes E{prm.out, prm.out, XB, RS3};
        pg8::gemm_phase<pg8::EpiRes, pg8::PanelOrder, true, true>(ldsl, g, S, E);
    }
    {
        WSP(bf16_t, PB, WS_PB) WSP(bf16_t, Wpp_t, WS_WPP) WSP(bf16_t, PROJ, WS_PROJ)
        pg8::Gemm g{PB, Wpp_t, MTOK, DM, PLE}; pg8::StaticOrder S; S.init(MTOK, DM, GRIDN, BX);
        pg8::EpiBf<false> E{PROJ, DM, nullptr};
        pg8::gemm_phase<pg8::EpiBf<false>, pg8::StaticOrder, true, true>(ldsl, g, S, E);
    }
    grid.sync();

    {
        WSP(bf16_t, XB, WS_XB) WSP(bf16_t, Wpg_t, WS_WPG) WSP(bf16_t, PROJ, WS_PROJ) WSP(float, RS3, WS_RS3)
        pg8::Gemm g{XB, Wpg_t, MTOK, DM, DM}; pg8::PanelOrder S; S.init(MTOK, GRIDN, BX);
        pg8::EpiPle E{prm.out, PROJ, RS3};
        pg8::gemm_phase<pg8::EpiPle, pg8::PanelOrder, true, true>(ldsl, g, S, E);
    }
    grid.sync();

    {
        const int lane = LANE; const int gw = BX * NWAVES + WAVE, NGW = GRIDN * NWAVES;
        const float* fg = prm.in[21]; float* out = prm.out;
        f32x4 gv[4];
#pragma unroll
        for (int j = 0; j < 4; ++j) gv[j] = ((const f32x4*)fg)[lane + 64 * j];
        for (int m = gw; m < MTOK; m += NGW) {
            f32x4* xr = (f32x4*)(out + (size_t)m * DM) + lane; f32x4 v[4]; float s = 0.f;
#pragma unroll
            for (int j = 0; j < 4; ++j) { v[j] = xr[64 * j]; s += (v[j][0] * v[j][0] + v[j][1] * v[j][1]) + (v[j][2] * v[j][2] + v[j][3] * v[j][3]); }
            const float rstd = 1.0f / sqrtf(wave_sum(s) * (1.0f / DM) + EPS);
#pragma unroll
            for (int j = 0; j < 4; ++j) xr[64 * j] = v[j] * rstd * gv[j];
        }
    }
}

extern "C" void kernel_launch(void* const* d_in, const int* in_sizes, int n_in, void* d_out, int out_size, void* d_ws, size_t ws_size, hipStream_t stream) {
    static int grid = 0;
    if (grid == 0) {
        if (n_in != 22 || out_size != MTOK * DM || ws_size < WS_END) { fprintf(stderr, "kernel_launch: unexpected problem (n_in %d, out %d, ws %zu)\n", n_in, out_size, ws_size); grid = -1; return; }
        int dev = 0, cus = 0, per_cu = 0;
        if (hipGetDevice(&dev) != hipSuccess || hipDeviceGetAttribute(&cus, hipDeviceAttributeMultiprocessorCount, dev) != hipSuccess) { grid = -1; return; }
        if (hipFuncSetAttribute((const void*)fwd_kernel, hipFuncAttributeMaxDynamicSharedMemorySize, LDS_BYTES) != hipSuccess) { fprintf(stderr, "kernel_launch: hipFuncSetAttribute failed\n"); grid = -1; return; }
        if (hipOccupancyMaxActiveBlocksPerMultiprocessor(&per_cu, (const void*)fwd_kernel, NTHREADS, LDS_BYTES) != hipSuccess || per_cu < 1) { fprintf(stderr, "kernel_launch: occupancy query says %d\n", per_cu); (void)hipGetLastError(); per_cu = 1; }
        grid = cus * 1;
    }
    if (grid < 0) return;
    Params p{};
    for (int i = 0; i < 22; ++i) p.in[i] = (const float*)d_in[i];
    p.out = (float*)d_out; p.ws = (unsigned char*)d_ws;
    void* args[] = {&p};
    hipError_t e = hipLaunchCooperativeKernel((const void*)fwd_kernel, dim3(grid), dim3(NTHREADS), args, LDS_BYTES, stream);
    if (e != hipSuccess) fprintf(stderr, "kernel_launch: cooperative launch failed: %s (grid %d)\n", hipGetErrorString(e), grid);
}
```

```cpp
#include <hip/hip_runtime.h>
#include <hip/hip_cooperative_groups.h>
#include <cstdio>
#include <cstdint>
namespace cg = cooperative_groups;
namespace pg8 {
#define PG8_LAS __attribute__((address_space(3)))
typedef unsigned short bf16_t;
typedef short bf16x8 __attribute__((ext_vector_type(8)));
typedef float f32x4 __attribute__((ext_vector_type(4)));
typedef unsigned u32x4 __attribute__((ext_vector_type(4)));
constexpr int BM = 256, BK = 64, HALF = 128, HTB = HALF * BK * 2  , STAGE_BYTES = 8 * HTB, NXCD = 8, WGM = 8;

__host__ __device__ __forceinline__ int lds_byte(int r, int c) { const int st = (r >> 4) * 2 + (c >> 5), rr = r & 15, cc = c & 31, ob = rr * 64 + cc * 2; return st * 1024 + (ob ^ (((ob >> 9) & 1) << 5)); }
__host__ __device__ __forceinline__ void stage_rc(int b, int& R, int& C) { const int st = b / 1024, sb = b % 1024, swz = sb ^ (((sb >> 9) & 1) << 5); R = (st >> 1) * 16 + swz / 64; C = (st & 1) * 32 + (swz % 64) / 2; }
__host__ __device__ __forceinline__ int perm32(int rho) { const int n = rho >> 4, i = rho & 15; return 8 * (i >> 2) + 4 * n + (i & 3); }

struct Unit { int pm, pn; };
struct Gemm { const bf16_t* A; const bf16_t* Bt; int M, N, K; };

struct StaticOrder {
    int nM, nN, nwg, G, c;
    __host__ __device__ void init(int M, int N, int G_, int c_) { nM = M / BM; nN = N / BM; nwg = nM * nN; G = G_; c = c_; }
    __host__ __device__ bool next(int i, Unit& u) const {
        const long L = (long)i * G + c; if (L >= nwg) return false;
        int wgid = (int)L; { const int q = nwg / NXCD, r = nwg % NXCD, xcd = wgid % NXCD, off = wgid / NXCD; wgid = (xcd < r ? xcd * (q + 1) : r * (q + 1) + (xcd - r) * q) + off; }
        const int nig = WGM * nN, gid = wgid / nig, fm = gid * WGM, gsz = (nM - fm) < WGM ? (nM - fm) : WGM;
        u.pm = fm + ((wgid % nig) % gsz); u.pn = (wgid % nig) / gsz; return true;
    }
    __device__ __forceinline__ void a_ready(const Unit&) const {}
    __device__ __forceinline__ void done(const Unit&) const {}
};

__device__ __forceinline__ unsigned cvt_pk_bf16(float lo, float hi) { unsigned r; asm volatile("v_cvt_pk_bf16_f32 %0, %1, %2" : "=v"(r) : "v"(lo), "v"(hi)); return r; }
typedef float f32x2 __attribute__((ext_vector_type(2)));
__device__ __forceinline__ f32x2 gelu_pk(f32x2 v) {
    const f32x2 av = __builtin_elementwise_abs(v), d = av * 0.2316418882f + 1.0f;
    f32x2 t; t.x = __builtin_amdgcn_rcpf(d.x); t.y = __builtin_amdgcn_rcpf(d.y);
    f32x2 q = t * 0.5307027145f + (-0.7265760135f); q = q * t + 0.7107068705f; q = q * t + (-0.142248368f); q = q * t + 0.127414796f; q = q * t;
    const f32x2 s = (v * v) * (-0.72134752044f);
    f32x2 e; e.x = __builtin_amdgcn_exp2f(s.x); e.y = __builtin_amdgcn_exp2f(s.y);
    const f32x2 m = v * (q * e), r = v - m;
    f32x2 o; o.x = v.x < 0.f ? m.x : r.x; o.y = v.y < 0.f ? m.y : r.y; return o;
}

template <int ACT  > struct EpiBf16 {
    static constexpr bool PERM = true, AFTER_DRAIN = false; static_assert(ACT == 0 || ACT == 1, "EpiBf16: ACT is 0 (none) or 1 (gelu_pk)");
    bf16_t* O; int ldc; const float* bias; int split_cols; size_t split_stride; float scale0;
    __device__ __forceinline__ void operator()(const f32x4 (&acc)[2][2][4][2], const Unit& u, int wr, int wc, int fr, int fq) const {
        const int row0 = u.pm * BM + wr * 64 + fr; int colt = u.pn * BM; bf16_t* base = O;
        float sc = 1.f; if (split_cols) { const int t = colt / split_cols; base += (size_t)t * split_stride; colt -= t * split_cols; if (t == 0) sc = scale0; }
        const int col0 = colt + wc * 32 + 8 * fq, bcol0 = u.pn * BM + wc * 32 + 8 * fq;
        f32x4 bv[2][2];
#pragma unroll
        for (int bj = 0; bj < 2; ++bj)
#pragma unroll
            for (int n = 0; n < 2; ++n) bv[bj][n] = bias ? *(const f32x4*)(bias + bcol0 + bj * HALF + 4 * n) : (f32x4){0.f, 0.f, 0.f, 0.f};
#pragma unroll
        for (int ai = 0; ai < 2; ++ai)
#pragma unroll
            for (int m = 0; m < 4; ++m) { bf16_t* rowp = base + (size_t)(row0 + ai * HALF + m * 16) * ldc + col0;
#pragma unroll
                for (int bj = 0; bj < 2; ++bj) { f32x4 v0 = acc[ai][bj][m][0] + bv[bj][0], v1 = acc[ai][bj][m][1] + bv[bj][1];
                    if (ACT == 1) { f32x2 a = gelu_pk((f32x2){v0[0], v0[1]}), b = gelu_pk((f32x2){v0[2], v0[3]}), c = gelu_pk((f32x2){v1[0], v1[1]}), d = gelu_pk((f32x2){v1[2], v1[3]});
                        v0 = (f32x4){a.x, a.y, b.x, b.y}; v1 = (f32x4){c.x, c.y, d.x, d.y}; }
                    v0 = v0 * sc; v1 = v1 * sc; u32x4 w; w.x = cvt_pk_bf16(v0[0], v0[1]); w.y = cvt_pk_bf16(v0[2], v0[3]); w.z = cvt_pk_bf16(v1[0], v1[1]); w.w = cvt_pk_bf16(v1[2], v1[3]);
                    *(u32x4*)(rowp + bj * HALF) = w; } }
    }
};
template <class Epi, class Sched, bool ALIGN_EPI = false, bool SP2 = false>
__device__ __forceinline__ void gemm_phase(PG8_LAS unsigned char* lds, const Gemm g, const Sched& S, Epi& E) {
    const int tid = threadIdx.x, wid = __builtin_amdgcn_readfirstlane(tid >> 6), lane = tid & 63, wr = wid >> 2, wc = wid & 3, fr = lane & 15, fq = lane >> 4;
    int K_ = g.K; asm volatile("" : "+s"(K_)); const int K = K_, nt = K / BK;
    unsigned voffA[2], voffB[2];
#pragma unroll
    for (int i = 0; i < 2; ++i) { int R, C; stage_rc(tid * 16 + i * 8192, R, C); const int Rb = Epi::PERM ? ((R & ~31) + perm32(R & 31)) : R;
        voffA[i] = (unsigned)(R * K + C) * 2u; voffB[i] = (unsigned)(Rb * K + C) * 2u; }
    const size_t kstep = (size_t)(BK * 2);
    const size_t hstep = (size_t)HALF * K * 2;
    const size_t tstep = 2 * hstep;
    const unsigned ldsw = (unsigned)wid * 1024u;
    const int aoff = lds_byte(wr * 64 + fr, fq * 8), boff = lds_byte(wc * 32 + fr, fq * 8);
#define PG8_SA(b, h) (((b) * 2 + (h)) * HTB)
#define PG8_SB(b, h) ((4 + (b) * 2 + (h)) * HTB)
#define PG8_STAGE(bufoff, gbase, voff) do { _Pragma("unroll") for (int _i = 0; _i < 2; ++_i) \
        __builtin_amdgcn_global_load_lds((const unsigned*)((const char*)(gbase) + (voff)[_i]), (PG8_LAS unsigned*)(lds + (bufoff) + ldsw + _i * 8192), 16, 0, 0); } while (0)
#define PG8_LDA(dst, b, h) do { _Pragma("unroll") for (int m = 0; m < 4; ++m) _Pragma("unroll") for (int k = 0; k < 2; ++k) dst[m][k] = *(const PG8_LAS bf16x8*)(lds + PG8_SA(b, h) + aoff + m * 2048 + k * 1024); } while (0)
#define PG8_LDB(dst, b, h) do { _Pragma("unroll") for (int n = 0; n < 2; ++n) _Pragma("unroll") for (int k = 0; k < 2; ++k) dst[n][k] = *(const PG8_LAS bf16x8*)(lds + PG8_SB(b, h) + boff + n * 2048 + k * 1024); } while (0)
#define PG8_MMA(ai, bj, At, Bt) do { __builtin_amdgcn_s_setprio(1); _Pragma("unroll") for (int m = 0; m < 4; ++m) _Pragma("unroll") for (int n = 0; n < 2; ++n) _Pragma("unroll") for (int k = 0; k < 2; ++k) \
        acc[ai][bj][m][n] = __builtin_amdgcn_mfma_f32_16x16x32_bf16(Bt[n][k], At[m][k], acc[ai][bj][m][n], 0, 0, 0); __builtin_amdgcn_s_setprio(0); } while (0)
#define PG8_WAIT_V(n) asm volatile("s_waitcnt vmcnt(" #n ")" ::: "memory")
#define PG8_WAIT_L(n) asm volatile("s_waitcnt lgkmcnt(" #n ")" ::: "memory")
#define PG8_BAR __builtin_amdgcn_s_barrier()
#define PG8_SCHED __builtin_amdgcn_sched_barrier(0)
    Unit cur, nxt; int ui = 0;
    if (!S.next(0, cur)) return;
    f32x4 acc[2][2][4][2];
#pragma unroll
    for (int a = 0; a < 2; ++a)
#pragma unroll
        for (int b = 0; b < 2; ++b)
#pragma unroll
            for (int m = 0; m < 4; ++m)
#pragma unroll
                for (int n = 0; n < 2; ++n) acc[a][b][m][n] = (f32x4){0.f, 0.f, 0.f, 0.f};
    bf16x8 At[4][2], B0[2][2], B1[2][2];
    const char* cA = (const char*)g.A + (size_t)cur.pm * tstep; const char* cB = (const char*)g.Bt + (size_t)cur.pn * tstep;
    S.a_ready(cur);
    if constexpr (SP2) {
        PG8_STAGE(PG8_SB(0, 0), cB, voffB); PG8_STAGE(PG8_SB(0, 1), cB + hstep, voffB); PG8_STAGE(PG8_SA(0, 0), cA, voffA); PG8_STAGE(PG8_SA(0, 1), cA + hstep, voffA);
        if (wr == 1) PG8_BAR;
        PG8_WAIT_V(2); PG8_BAR;
        PG8_STAGE(PG8_SB(1, 0), cB + kstep, voffB); PG8_STAGE(PG8_SA(1, 0), cA + kstep, voffA); PG8_STAGE(PG8_SB(1, 1), cB + hstep + kstep, voffB);
        PG8_WAIT_V(6); PG8_BAR;
    } else {
        PG8_STAGE(PG8_SB(0, 0), cB, voffB); PG8_STAGE(PG8_SA(0, 0), cA, voffA); PG8_STAGE(PG8_SB(0, 1), cB + hstep, voffB); PG8_STAGE(PG8_SA(0, 1), cA + hstep, voffA);
        if (wr == 1) PG8_BAR;
        PG8_WAIT_V(4); PG8_BAR;
        PG8_STAGE(PG8_SB(1, 0), cB + kstep, voffB); PG8_STAGE(PG8_SA(1, 0), cA + kstep, voffA); PG8_STAGE(PG8_SB(1, 1), cB + hstep + kstep, voffB);
        PG8_WAIT_V(6); PG8_BAR;
    }
    for (;;) {
        const bool has_next = S.next(ui + 1, nxt);
        const char* nA = has_next ? (const char*)g.A + (size_t)nxt.pm * tstep : cA; const char* nB = has_next ? (const char*)g.Bt + (size_t)nxt.pn * tstep : cB;
        for (int t = 0; t < nt; t += 2) {
            const bool last = (t == nt - 2);
            const char* a1 = cA + (size_t)(t + 1) * kstep;
            const char* a2 = last ? nA : cA + (size_t)(t + 2) * kstep; const char* b2 = last ? nB : cB + (size_t)(t + 2) * kstep;
            const char* a3 = a2 + kstep; const char* b3 = b2 + kstep;
            if (last && has_next) S.a_ready(nxt);
            if constexpr (SP2) {
            PG8_LDB(B0, 0, 0); PG8_LDB(B1, 0, 1); PG8_SCHED; PG8_LDA(At, 0, 0); PG8_STAGE(PG8_SA(1, 1), a1 + hstep, voffA);
            PG8_WAIT_V(8); PG8_WAIT_L(0); PG8_BAR; PG8_MMA(0, 0, At, B0); PG8_MMA(0, 1, At, B1); PG8_BAR; PG8_SCHED;
            PG8_LDA(At, 0, 1); PG8_STAGE(PG8_SB(0, 0), b2, voffB); PG8_STAGE(PG8_SB(0, 1), b2 + hstep, voffB); PG8_STAGE(PG8_SA(0, 0), a2, voffA);
            PG8_WAIT_V(8); PG8_WAIT_L(0); PG8_BAR; PG8_MMA(1, 0, At, B0); PG8_MMA(1, 1, At, B1); PG8_BAR; PG8_SCHED;
            PG8_LDB(B0, 1, 0); PG8_LDB(B1, 1, 1); PG8_SCHED; PG8_LDA(At, 1, 0); PG8_STAGE(PG8_SA(0, 1), a2 + hstep, voffA);
            PG8_WAIT_V(8); PG8_WAIT_L(0); PG8_BAR; PG8_MMA(0, 0, At, B0); PG8_MMA(0, 1, At, B1); PG8_BAR; PG8_SCHED;
            PG8_LDA(At, 1, 1); PG8_STAGE(PG8_SB(1, 0), b3, voffB); PG8_STAGE(PG8_SB(1, 1), b3 + hstep, voffB); PG8_STAGE(PG8_SA(1, 0), a3, voffA);
            PG8_WAIT_V(8); PG8_WAIT_L(0); PG8_BAR; PG8_MMA(1, 0, At, B0); PG8_MMA(1, 1, At, B1); PG8_BAR; PG8_SCHED;
            } else {
            PG8_LDB(B0, 0, 0); PG8_SCHED; PG8_LDA(At, 0, 0); PG8_STAGE(PG8_SA(1, 1), a1 + hstep, voffA);
            PG8_WAIT_L(8); PG8_BAR; PG8_WAIT_L(0); PG8_MMA(0, 0, At, B0); PG8_BAR; PG8_SCHED;
            PG8_LDB(B1, 0, 1); PG8_STAGE(PG8_SB(0, 0), b2, voffB);
            PG8_BAR; PG8_WAIT_L(0); PG8_MMA(0, 1, At, B1); PG8_BAR;
            PG8_LDA(At, 0, 1); PG8_STAGE(PG8_SA(0, 0), a2, voffA);
            PG8_BAR; PG8_WAIT_L(0); PG8_MMA(1, 0, At, B0); PG8_BAR; PG8_SCHED;
            PG8_STAGE(PG8_SB(0, 1), b2 + hstep, voffB);
            PG8_WAIT_V(6); PG8_BAR; PG8_MMA(1, 1, At, B1); PG8_BAR;
            PG8_LDB(B0, 1, 0); PG8_SCHED; PG8_LDA(At, 1, 0); PG8_STAGE(PG8_SA(0, 1), a2 + hstep, voffA);
            PG8_WAIT_L(8); PG8_BAR; PG8_WAIT_L(0); PG8_MMA(0, 0, At, B0); PG8_BAR; PG8_SCHED;
            PG8_LDB(B1, 1, 1); PG8_STAGE(PG8_SB(1, 0), b3, voffB);
            PG8_BAR; PG8_WAIT_L(0); PG8_MMA(0, 1, At, B1); PG8_BAR;
            PG8_LDA(At, 1, 1); PG8_STAGE(PG8_SA(1, 0), a3, voffA);
            PG8_BAR; PG8_WAIT_L(0); PG8_MMA(1, 0, At, B0); PG8_BAR; PG8_SCHED;
            PG8_STAGE(PG8_SB(1, 1), b3 + hstep, voffB);
            PG8_WAIT_V(6); PG8_BAR; PG8_MMA(1, 1, At, B1); PG8_BAR;
            }
        }
        if constexpr (ALIGN_EPI) { if (wr == 0) PG8_BAR; }
        if constexpr (!Epi::AFTER_DRAIN) { E(acc, cur, wr, wc, fr, fq); S.done(cur); }
        if (!has_next) break;
#pragma unroll
        for (int a = 0; a < 2; ++a)
#pragma unroll
            for (int b = 0; b < 2; ++b)
#pragma unroll
                for (int m = 0; m < 4; ++m)
#pragma unroll
                    for (int n = 0; n < 2; ++n) acc[a][b][m][n] = (f32x4){0.f, 0.f, 0.f, 0.f};
        cur = nxt; cA = nA; cB = nB; ++ui;
        if constexpr (ALIGN_EPI) { if (wr == 1) PG8_BAR; }
    }
    PG8_WAIT_V(0);
    if constexpr (!ALIGN_EPI) { if (wr == 0) PG8_BAR; }
    PG8_BAR;
    if constexpr (Epi::AFTER_DRAIN) { E.fused(acc, cur, wr, wc, fr, fq, lds, wid, lane); S.done(cur); }
#undef PG8_SA
#undef PG8_SB
#undef PG8_STAGE
#undef PG8_LDA
#undef PG8_LDB
#undef PG8_MMA
#undef PG8_WAIT_V
#undef PG8_WAIT_L
#undef PG8_BAR
#undef PG8_SCHED
}
}

constexpr int BATCH = 16, SEQ = 4096, DM = 1024, MTOK = BATCH * SEQ;
constexpr int NZ = 3584;
constexpr int ZC_MQ = 0, ZC_MK = 512, ZC_MV = 1024, ZC_MO = 1536, ZC_AQ = 2056, ZC_AKC = 2568, ZC_AVC = 2696, ZC_AKS = 2824, ZC_AVS = 2952, ZC_AKW = 3080, ZC_AVW = 3208;
constexpr int DFF = 2048, PLE = 256, NCMP = 255;
constexpr float EPS = 1e-6f;
constexpr int NWAVES = 8, NTHREADS = 512;
constexpr int LDS_BYTES = 147456;

typedef unsigned short bf16_t;
typedef float f32x4 __attribute__((ext_vector_type(4)));
typedef unsigned u32x4 __attribute__((ext_vector_type(4)));
typedef unsigned u32x2 __attribute__((ext_vector_type(2)));

constexpr size_t MiB = 1u << 20;
constexpr size_t WS_CTL = 0;
constexpr size_t WS_WIN = 1 * MiB, WS_WOUT = 8 * MiB, WS_WUP = 10 * MiB, WS_WDN = 18 * MiB, WS_WPG = 22 * MiB, WS_WPP = 24 * MiB;
constexpr size_t WS_KC = 25 * MiB, WS_VC = 27 * MiB, WS_KCB = 29 * MiB, WS_VCT = 30 * MiB;
constexpr size_t WS_GATES = 32 * MiB, WS_PB = 40 * MiB, WS_XB = 72 * MiB;
constexpr size_t WS_MIX = 200 * MiB, WS_ACT = 200 * MiB;
constexpr size_t WS_Z = 456 * MiB, WS_U = 456 * MiB, WS_PROJ = 456 * MiB;
constexpr size_t WS_RS2 = 968 * MiB, WS_RS3 = 972 * MiB;
constexpr size_t WS_VST = 976 * MiB, WS_VWT = 992 * MiB;
constexpr size_t WS_END = 1008 * MiB;

struct Params { const float* in[22]; float* out; unsigned char* ws; };

__device__ __forceinline__ float bf2f(unsigned u16) { return __uint_as_float(u16 << 16); }
__device__ __forceinline__ float bflo(unsigned w) { return __uint_as_float(w << 16); }
__device__ __forceinline__ float bfhi(unsigned w) { return __uint_as_float(w & 0xffff0000u); }
__device__ __forceinline__ unsigned f2bf(float f) { unsigned u = __float_as_uint(f); return (u + 0x7fffu + ((u >> 16) & 1u)) >> 16; }
__device__ __forceinline__ unsigned pk2(float lo, float hi) { return f2bf(lo) | (f2bf(hi) << 16); }
__device__ __forceinline__ float wave_sum(float v) {
#pragma unroll
    for (int o = 1; o < 64; o <<= 1) v += __shfl_xor(v, o);
    return v;
}
__device__ __forceinline__ float wave_max(float v) {
#pragma unroll
    for (int o = 1; o < 64; o <<= 1) v = fmaxf(v, __shfl_xor(v, o));
    return v;
}
__device__ __forceinline__ float sigmoidf_(float x) { return 1.0f / (1.0f + __expf(-x)); }
__device__ __forceinline__ float log_sigmoidf_(float x) { return fminf(x, 0.f) - log1pf(__expf(-fabsf(x))); }
#define WAVE_LDS_SYNC() asm volatile("s_waitcnt lgkmcnt(0)" ::: "memory")

namespace pg8 {
__device__ __forceinline__ float row_rstd(const float* rs, int row) {
    const f32x4* p = (const f32x4*)(rs + (size_t)row * 16); const f32x4 a = p[0], b = p[1], c = p[2], d = p[3];
    const float s = (((a[0] + a[1]) + (a[2] + a[3])) + ((b[0] + b[1]) + (b[2] + b[3]))) + (((c[0] + c[1]) + (c[2] + c[3])) + ((d[0] + d[1]) + (d[2] + d[3])));
    return 1.0f / sqrtf(s * (1.0f / 1024.0f) + EPS);
}
struct EpiZ {
    static constexpr bool PERM = true, AFTER_DRAIN = false;
    bf16_t* Z; float* gates;
    __device__ __forceinline__ void operator()(const f32x4 (&acc)[2][2][4][2], const Unit& u, int wr, int wc, int fr, int fq) {
        const int row0 = u.pm * BM + wr * 64 + fr; const int col0 = u.pn * BM + wc * 32 + 8 * fq;
#pragma unroll
        for (int ai = 0; ai < 2; ++ai)
#pragma unroll
            for (int m = 0; m < 4; ++m) { const int row = row0 + ai * HALF + m * 16; bf16_t* rowp = Z + (size_t)row * NZ + col0;
#pragma unroll
                for (int bj = 0; bj < 2; ++bj) { const f32x4 v0 = acc[ai][bj][m][0], v1 = acc[ai][bj][m][1];
                    u32x4 w; w.x = cvt_pk_bf16(v0[0], v0[1]); w.y = cvt_pk_bf16(v0[2], v0[3]); w.z = cvt_pk_bf16(v1[0], v1[1]); w.w = cvt_pk_bf16(v1[2], v1[3]);
                    *(u32x4*)(rowp + bj * HALF) = w; }
                if (wc == 0) {
                    if ((u.pn == 8 && fq == 0) || (u.pn == 13 && fq >= 1)) {
                        float* gp = gates + (size_t)row * 32 + 8 * fq;
                        *(f32x4*)(gp) = acc[ai][0][m][0]; *(f32x4*)(gp + 4) = acc[ai][0][m][1];
                    }
                }
            }
    }
};
template <bool ROWSCALE> struct EpiBf {
    static constexpr bool PERM = true, AFTER_DRAIN = false;
    bf16_t* O; int ldc; const float* rs;
    __device__ __forceinline__ void operator()(const f32x4 (&acc)[2][2][4][2], const Unit& u, int wr, int wc, int fr, int fq) {
        const int row0 = u.pm * BM + wr * 64 + fr; const int col0 = u.pn * BM + wc * 32 + 8 * fq;
#pragma unroll
        for (int ai = 0; ai < 2; ++ai)
#pragma unroll
            for (int m = 0; m < 4; ++m) { const int row = row0 + ai * HALF + m * 16; bf16_t* rowp = O + (size_t)row * ldc + col0;
                float sc = 1.f;
                if (ROWSCALE) sc = row_rstd(rs, row);
#pragma unroll
                for (int bj = 0; bj < 2; ++bj) { const f32x4 v0 = acc[ai][bj][m][0] * sc, v1 = acc[ai][bj][m][1] * sc;
                    u32x4 w; w.x = cvt_pk_bf16(v0[0], v0[1]); w.y = cvt_pk_bf16(v0[2], v0[3]); w.z = cvt_pk_bf16(v1[0], v1[1]); w.w = cvt_pk_bf16(v1[2], v1[3]);
                    *(u32x4*)(rowp + bj * HALF) = w; }
            }
    }
};
struct EpiRes {
    static constexpr bool PERM = false, AFTER_DRAIN = false;
    const float* base; float* out; bf16_t* xb; float* rs;
    __device__ __forceinline__ void operator()(const f32x4 (&acc)[2][2][4][2], const Unit& u, int wr, int wc, int fr, int fq) {
        const int col0 = u.pn * BM + wc * 32 + 4 * fq;
#pragma unroll
        for (int ai = 0; ai < 2; ++ai)
#pragma unroll
            for (int m = 0; m < 4; ++m) { const int row = u.pm * BM + ai * HALF + wr * 64 + m * 16 + fr; const size_t off = (size_t)row * DM + col0; float s = 0.f;
#pragma unroll
                for (int bj = 0; bj < 2; ++bj)
#pragma unroll
                    for (int n = 0; n < 2; ++n) { const size_t o2 = off + bj * HALF + n * 16; const f32x4 bs = *(const f32x4*)(base + o2); const f32x4 o = bs + acc[ai][bj][m][n];
                        *(f32x4*)(out + o2) = o; u32x2 w; w.x = cvt_pk_bf16(o[0], o[1]); w.y = cvt_pk_bf16(o[2], o[3]); *(u32x2*)(xb + o2) = w;
                        s += (o[0] * o[0] + o[1] * o[1]) + (o[2] * o[2] + o[3] * o[3]); }
                s += __shfl_xor(s, 16); s += __shfl_xor(s, 32);
                if (fq == 0) rs[(size_t)row * 16 + u.pn * 4 + wc] = s; }
    }
};
struct EpiPle {
    static constexpr bool PERM = false, AFTER_DRAIN = false;
    float* out; const bf16_t* proj; const float* rs;
    __device__ __forceinline__ void operator()(const f32x4 (&acc)[2][2][4][2], const Unit& u, int wr, int wc, int fr, int fq) {
        const int col0 = u.pn * BM + wc * 32 + 4 * fq;
#pragma unroll
        for (int ai = 0; ai < 2; ++ai)
#pragma unroll
            for (int m = 0; m < 4; ++m) { const int row = u.pm * BM + ai * HALF + wr * 64 + m * 16 + fr; const size_t off = (size_t)row * DM + col0;
                const float sc = row_rstd(rs, row);
#pragma unroll
                for (int bj = 0; bj < 2; ++bj)
#pragma unroll
                    for (int n = 0; n < 2; ++n) { const size_t o2 = off + bj * HALF + n * 16; const f32x4 bs = *(const f32x4*)(out + o2); const u32x2 pw = *(const u32x2*)(proj + o2);
                        const f32x4 a = acc[ai][bj][m][n] * sc; f32x4 o;
                        o[0] = bs[0] + sigmoidf_(a[0]) * bflo(pw.x); o[1] = bs[1] + sigmoidf_(a[1]) * bfhi(pw.x); o[2] = bs[2] + sigmoidf_(a[2]) * bflo(pw.y); o[3] = bs[3] + sigmoidf_(a[3]) * bfhi(pw.y);
                        *(f32x4*)(out + o2) = o; }
            }
    }
};
struct PanelOrder {
    int nM, G, c;
    __host__ __device__ void init(int M, int G_, int c_) { nM = M / BM; G = G_; c = c_; }
    __host__ __device__ bool next(int i, Unit& u) const { const int p = c + G * (i >> 2); if (p >= nM) return false; u.pm = p; u.pn = i & 3; return true; }
    __device__ __forceinline__ void a_ready(const Unit&) const {}
    __device__ __forceinline__ void done(const Unit&) const {}
};
}

__device__ __forceinline__ void p0_transpose_item(const float* W, const float* gk, int K, int N, bf16_t* WT, float* scr, int item, int lane) {
    const int nblk = N / 32, kb = item / nblk, nb = item % nblk, k0 = 64 * kb, n0 = 32 * nb;
#pragma unroll 8
    for (int i = 0; i < 32; ++i) { const int kk = 2 * i + (lane >> 5); float w = W[(size_t)(k0 + kk) * N + n0 + (lane & 31)]; if (gk) w *= gk[k0 + kk]; scr[kk * 33 + (lane & 31)] = w; }
    WAVE_LDS_SYNC();
    const int c = lane & 7;
#pragma unroll
    for (int j = 0; j < 4; ++j) { const int n = (lane >> 3) + 8 * j; const float* s = scr + (8 * c) * 33 + n;
        u32x4 o; o.x = pk2(s[0 * 33], s[1 * 33]); o.y = pk2(s[2 * 33], s[3 * 33]); o.z = pk2(s[4 * 33], s[5 * 33]); o.w = pk2(s[6 * 33], s[7 * 33]);
        *(u32x4*)(WT + (size_t)(n0 + n) * K + k0 + 8 * c) = o; }
    WAVE_LDS_SYNC();
}

__device__ __forceinline__ float dot64_bf(const float* qv, const bf16_t* krow) {
    const u32x4* kp = (const u32x4*)krow; float acc = 0.f;
#pragma unroll
    for (int i = 0; i < 8; ++i) { const u32x4 w = kp[i]; const f32x4 q0 = *(const f32x4*)(qv + 8 * i), q1 = *(const f32x4*)(qv + 8 * i + 4);
        acc += q0[0] * bflo(w.x) + q0[1] * bfhi(w.x) + q0[2] * bflo(w.y) + q0[3] * bfhi(w.y) + q1[0] * bflo(w.z) + q1[1] * bfhi(w.z) + q1[2] * bflo(w.w) + q1[3] * bfhi(w.w); }
    return acc;
}
__device__ __forceinline__ float dot64_f(const float* qv, const float* krow) {
    float acc = 0.f;
#pragma unroll
    for (int i = 0; i < 16; ++i) { const f32x4 w = *(const f32x4*)(krow + 4 * i), q = *(const f32x4*)(qv + 4 * i); acc += q[0] * w[0] + q[1] * w[1] + q[2] * w[2] + q[3] * w[3]; }
    return acc;
}

__device__ __forceinline__ void compress_unit_simple(const bf16_t* Z, int zcol, const float* pe, const float* w1, const float* w2, float* outc, bf16_t* kcb, bf16_t* vct, int b, int g, int ng, float* lds_f, int tid) {
    float* tok = lds_f;
    float* pes = lds_f + 144 * 64;
    float* hid = pes + 32 * 64;
    const int n0 = 8 * ng, t0 = 16 * n0;
    for (int i = tid; i < 144 * 64; i += NTHREADS) { const int tt = i >> 6, d = i & 63; const int t = t0 + tt;
        tok[i] = (t < SEQ) ? bf2f(Z[((size_t)b * SEQ + t) * NZ + zcol + g * 64 + d]) : 0.f; }
    for (int i = tid; i < 32 * 64; i += NTHREADS) pes[i] = pe[i];
    __syncthreads();
    const int j = tid & 127, sub = tid >> 7;
    float a0 = 0.f, a1 = 0.f;
    const float* tk0 = tok + (2 * sub) * 16 * 64; const float* tk1 = tk0 + 16 * 64;
    for (int ld = 0; ld < 2048; ++ld) { const float w = w1[(size_t)ld * 128 + j]; const float pv = pes[ld]; a0 += (tk0[ld] + pv) * w; a1 += (tk1[ld] + pv) * w; }
    { const float x0 = a0, x1 = a1;
      hid[(2 * sub) * 128 + j] = 0.5f * x0 * (1.0f + tanhf(0.7978845608028654f * (x0 + 0.044715f * x0 * x0 * x0)));
      hid[(2 * sub + 1) * 128 + j] = 0.5f * x1 * (1.0f + tanhf(0.7978845608028654f * (x1 + 0.044715f * x1 * x1 * x1))); }
    __syncthreads();
    { const int nl = tid >> 6, d = tid & 63; float o = 0.f;
      for (int jj = 0; jj < 128; ++jj) o += hid[nl * 128 + jj] * w2[jj * 64 + d];
      const int n = n0 + nl; if (n < NCMP) outc[(((size_t)b * 2 + g) * 256 + n) * 64 + d] = o;
      const unsigned ob = (n < NCMP) ? f2bf(o) : 0u;
      if (kcb) kcb[(((size_t)b * 2 + g) * 256 + n) * 64 + d] = (bf16_t)ob;
      if (vct) { const int n16 = n & 15; vct[(((size_t)b * 2 + g) * 64 + d) * 256 + (n & ~15) + 8 * ((n16 >> 2) & 1) + (n16 & 3) + 4 * (n16 >> 3)] = (bf16_t)ob; } }
    __syncthreads();
}

struct MixPtrs { const bf16_t* Z; const float* gates; const float* KC; const float* VC; bf16_t* MIX; const float* gate_bias; const float* mnorm_g; };

__device__ __forceinline__ void nsa_token_simple(const MixPtrs& P, int b, int g, int t, float* qs, float* pc, float* pb, int lane) {
    const size_t row = (size_t)b * SEQ + t;
    const bf16_t* zrow = P.Z + row * NZ;
    const bf16_t* zb = P.Z + (size_t)b * SEQ * NZ;
#pragma unroll
    for (int r = 0; r < 4; ++r) qs[r * 64 + lane] = bf2f(zrow[ZC_AQ + (g * 4 + r) * 64 + lane]) * 0.125f;
    WAVE_LDS_SYNC();
    const int nv = (t >= 31) ? min((t - 31) / 16 + 1, NCMP) : 0;
    const float* kc = P.KC + ((size_t)b * 2 + g) * 256 * 64; const float* vc = P.VC + ((size_t)b * 2 + g) * 256 * 64;
    float oc[4], os[4], ow[4];
#pragma unroll 1
    for (int r = 0; r < 4; ++r) {
        const float slope = exp2f(-(float)(g * 4 + r + 1));
        float sv[4]; float mx = -3.0e38f;
#pragma unroll
        for (int i = 0; i < 4; ++i) { const int n = lane + 64 * i; sv[i] = -3.0e38f;
            if (n < nv) { const float s = dot64_f(qs + r * 64, kc + (size_t)n * 64) - slope * (float)(t - (16 * n + 31)); sv[i] = s; mx = fmaxf(mx, s); } }
        mx = wave_max(mx);
        float sum = 0.f;
#pragma unroll
        for (int i = 0; i < 4; ++i) { const int n = lane + 64 * i; float e = 0.f; if (n < nv) e = __expf(sv[i] - mx); sv[i] = e; sum += e; }
        sum = wave_sum(sum);
        const float inv = (nv > 0) ? 1.0f / sum : 0.f;
#pragma unroll
        for (int i = 0; i < 4; ++i) pc[r * 256 + lane + 64 * i] = sv[i] * inv;
        WAVE_LDS_SYNC();
        float a = 0.f;
        for (int n = 0; n < nv; ++n) a += pc[r * 256 + n] * vc[(size_t)n * 64 + lane];
        oc[r] = a;
    }
    unsigned long long selmask;
    {
        float imp = 0.f;
        for (int n = 4 * lane - 1; n <= 4 * lane + 3; ++n) if (n >= 0 && n < NCMP) imp += (pc[n] + pc[256 + n]) + (pc[512 + n] + pc[768 + n]);
        const int cur = t >> 6;
        const bool causal = lane <= cur; const bool forced = (lane == 0) || (lane == cur) || (lane == cur - 1);
        const float score = causal ? (forced ? 1.0e30f : imp) : -1.0e30f;
        int rank = 0;
        for (int i = 0; i < 64; ++i) { const float si = __shfl(score, i); rank += ((si > score) || (si == score && i < lane)) ? 1 : 0; }
        selmask = __ballot(rank < 16);
    }
#pragma unroll 1
    for (int r = 0; r < 4; ++r) {
        const float slope = exp2f(-(float)(g * 4 + r + 1));
        float mx = -3.0e38f; int idx = 0;
        for (unsigned long long mm = selmask; mm; mm &= mm - 1, ++idx) { const int j = __builtin_ctzll(mm); const int pos = 64 * j + lane;
            float s = -1.0e30f;
            if (pos <= t) s = dot64_bf(qs + r * 64, zb + (size_t)pos * NZ + ZC_AKS + g * 64) - slope * (float)(t - pos);
            pb[idx * 64 + lane] = s; mx = fmaxf(mx, s); }
        mx = wave_max(mx);
        float sum = 0.f;
        for (int i = 0; i < 16; ++i) { const float e = __expf(pb[i * 64 + lane] - mx); pb[i * 64 + lane] = e; sum += e; }
        sum = wave_sum(sum);
        WAVE_LDS_SYNC();
        float a = 0.f; idx = 0;
        for (unsigned long long mm = selmask; mm; mm &= mm - 1, ++idx) { const int j = __builtin_ctzll(mm);
            if (64 * j > t) continue;
            const bf16_t* vp = zb + (size_t)(64 * j) * NZ + ZC_AVS + g * 64 + lane;
            for (int l = 0; l < 64; ++l) a += pb[idx * 64 + l] * bf2f(vp[(size_t)l * NZ]); }
        os[r] = a / sum;
        WAVE_LDS_SYNC();
    }
    const int lo = max(0, t - 511);
#pragma unroll 1
    for (int r = 0; r < 4; ++r) {
        const float slope = exp2f(-(float)(g * 4 + r + 1));
        float mx = -3.0e38f;
        for (int i = 0; i < 8; ++i) { const int pos = lo + 64 * i + lane; float s = -1.0e30f;
            if (pos <= t) s = dot64_bf(qs + r * 64, zb + (size_t)pos * NZ + ZC_AKW + g * 64) - slope * (float)(t - pos);
            pb[i * 64 + lane] = s; mx = fmaxf(mx, s); }
        mx = wave_max(mx);
        float sum = 0.f;
        for (int i = 0; i < 8; ++i) { const float e = __expf(pb[i * 64 + lane] - mx); pb[i * 64 + lane] = e; sum += e; }
        sum = wave_sum(sum);
        WAVE_LDS_SYNC();
        float a = 0.f; const int cnt = t - lo + 1;
        const bf16_t* vp = zb + (size_t)lo * NZ + ZC_AVW + g * 64 + lane;
        for (int l = 0; l < cnt; ++l) a += pb[l] * bf2f(vp[(size_t)l * NZ]);
        ow[r] = a / sum;
        WAVE_LDS_SYNC();
    }
    const float* gp = P.gates + row * 32 + 8;
#pragma unroll
    for (int r = 0; r < 4; ++r) { const int hh = g * 4 + r;
        const float o = sigmoidf_(gp[hh * 3 + 0]) * oc[r] + sigmoidf_(gp[hh * 3 + 1]) * os[r] + sigmoidf_(gp[hh * 3 + 2]) * ow[r];
        P.MIX[row * DM + 512 + hh * 64 + lane] = (bf16_t)f2bf(o); }
}

__device__ __forceinline__ void mlstm_unit_simple(const MixPtrs& P, int b, int h, float* lds_f, int tid) {
    float* qs = lds_f;
    float* ks = qs + 64 * 128;
    float* vs = ks + 64 * 128;
    float* hraw = vs + 64 * 128;
    float* red = hraw + 64 * 128;
    float* redn = red + 2 * 4 * 128;
    float* igs = redn + 8;
    float* lfs = igs + 64;
    const int dv = tid & 127, kg = tid >> 7, lane = tid & 63, wave = tid >> 6;
    float C[32], nn[32];
#pragma unroll
    for (int i = 0; i < 32; ++i) { C[i] = 0.f; nn[i] = 0.f; }
    float mst = 0.f;
    const float bi = P.gate_bias[h], bff = P.gate_bias[4 + h];
    const float qscale = 0.08838834764831845f;
#pragma unroll 1
    for (int c = 0; c < SEQ / 64; ++c) {
        const size_t row0 = (size_t)b * SEQ + c * 64;
        for (int i = tid; i < 64 * 128; i += NTHREADS) { const int tt = i >> 7, d = i & 127; const bf16_t* zr = P.Z + (row0 + tt) * NZ + h * 128 + d;
            qs[i] = bf2f(zr[ZC_MQ]) * qscale; ks[i] = bf2f(zr[ZC_MK]); vs[i] = bf2f(zr[ZC_MV]); }
        if (tid < 64) { const float* gr = P.gates + (row0 + tid) * 32; igs[tid] = gr[h] + bi; lfs[tid] = log_sigmoidf_(gr[4 + h] + bff); }
        __syncthreads();
#pragma unroll 1
        for (int t = 0; t < 64; ++t) {
            const float lf = lfs[t], ig = igs[t];
            const float mnew = fmaxf(lf + mst, ig);
            const float fs = __expf(lf + mst - mnew), is = __expf(ig - mnew);
            mst = mnew;
            const float v = vs[t * 128 + dv] * is;
            float pn = 0.f, pd = 0.f;
            const float* kr = ks + t * 128 + kg * 32; const float* qr = qs + t * 128 + kg * 32;
#pragma unroll
            for (int i = 0; i < 32; ++i) { const float kk = kr[i], qq = qr[i];
                C[i] = fs * C[i] + kk * v; nn[i] = fs * nn[i] + is * kk; pn += qq * C[i]; pd += qq * nn[i]; }
            float* rb = red + (t & 1) * 512; float* rn = redn + (t & 1) * 4;
            rb[kg * 128 + dv] = pn; if (dv == 0) rn[kg] = pd;
            __syncthreads();
            if (tid < 128) { const float num = (rb[tid] + rb[128 + tid]) + (rb[256 + tid] + rb[384 + tid]); const float den = (rn[0] + rn[1]) + (rn[2] + rn[3]);
                hraw[t * 128 + tid] = num / fmaxf(fabsf(den), __expf(-mnew)); }
        }
        __syncthreads();
        for (int k = 0; k < 8; ++k) { const int tt = wave * 8 + k; const float h0 = hraw[tt * 128 + lane], h1 = hraw[tt * 128 + 64 + lane];
            const float ss = wave_sum(h0 * h0 + h1 * h1); const float rstd = 1.0f / sqrtf(ss * (1.0f / 128.0f) + EPS);
            const bf16_t* zo = P.Z + (row0 + tt) * NZ + ZC_MO + h * 128;
            const float o0 = h0 * rstd * P.mnorm_g[h * 128 + lane] * sigmoidf_(bf2f(zo[lane])), o1 = h1 * rstd * P.mnorm_g[h * 128 + 64 + lane] * sigmoidf_(bf2f(zo[64 + lane]));
            bf16_t* mo = P.MIX + (row0 + tt) * DM + h * 128;
            mo[lane] = (bf16_t)f2bf(o0); mo[64 + lane] = (bf16_t)f2bf(o1); }
        __syncthreads();
    }
}


typedef short bf16x8 __attribute__((ext_vector_type(8)));
typedef float f32x16 __attribute__((ext_vector_type(16)));
typedef float f32x2_t __attribute__((ext_vector_type(2)));
typedef __bf16 bf16x2_t __attribute__((ext_vector_type(2)));
__device__ __forceinline__ unsigned cvtpk(float lo, float hi) { f32x2_t v = {lo, hi}; bf16x2_t b = __builtin_convertvector(v, bf16x2_t); return __builtin_bit_cast(unsigned, b); }
#define MFMA32(a, b, c) __builtin_amdgcn_mfma_f32_32x32x16_bf16((a), (b), (c), 0, 0, 0)
#define NEG_INF (-__builtin_inff())
constexpr float LOG2E = 1.4426950408889634f;
__device__ __forceinline__ unsigned other_half_u(unsigned v, int hi) { auto rr = __builtin_amdgcn_permlane32_swap(v, v, false, false); return hi ? rr[0] : rr[1]; }
__device__ __forceinline__ float other_half_f(float v, int hi) { return __uint_as_float(other_half_u(__float_as_uint(v), hi)); }
__device__ __forceinline__ float max16(const f32x16& u) {
    float a = fmaxf(fmaxf(u[0], u[1]), fmaxf(u[2], u[3])), b = fmaxf(fmaxf(u[4], u[5]), fmaxf(u[6], u[7]));
    float c = fmaxf(fmaxf(u[8], u[9]), fmaxf(u[10], u[11])), d = fmaxf(fmaxf(u[12], u[13]), fmaxf(u[14], u[15]));
    return fmaxf(fmaxf(a, b), fmaxf(c, d));
}
__device__ __forceinline__ unsigned long long spread_even(unsigned x) {
    unsigned long long s = x;
    s = (s | (s << 16)) & 0x0000FFFF0000FFFFull; s = (s | (s << 8)) & 0x00FF00FF00FF00FFull; s = (s | (s << 4)) & 0x0F0F0F0F0F0F0F0Full;
    s = (s | (s << 2)) & 0x3333333333333333ull; s = (s | (s << 1)) & 0x5555555555555555ull; return s;
}
struct NsaF { const bf16_t* Z; const float* gates; const bf16_t* KCB; const bf16_t* VCT; const bf16_t* VST; const bf16_t* VWT; bf16_t* MIX; };

__device__ __forceinline__ void nsa_load_q(bf16x8 (&qf)[4], const bf16_t* qp) {
    const float QSC = 0.125f * LOG2E;
#pragma unroll
    for (int s = 0; s < 4; ++s) { const u32x4 w = *(const u32x4*)(qp + 16 * s); u32x4 o;
        o.x = cvtpk(bflo(w.x) * QSC, bfhi(w.x) * QSC); o.y = cvtpk(bflo(w.y) * QSC, bfhi(w.y) * QSC); o.z = cvtpk(bflo(w.z) * QSC, bfhi(w.z) * QSC); o.w = cvtpk(bflo(w.w) * QSC, bfhi(w.w) * QSC);
        qf[s] = __builtin_bit_cast(bf16x8, o); }
}
__device__ __forceinline__ f32x16 nsa_st(const bf16_t* kp, const bf16x8 (&qf)[4], const f32x16& cinit) {
    f32x16 acc = MFMA32(*(const bf16x8*)(kp), qf[0], cinit);
    acc = MFMA32(*(const bf16x8*)(kp + 16), qf[1], acc); acc = MFMA32(*(const bf16x8*)(kp + 32), qf[2], acc); acc = MFMA32(*(const bf16x8*)(kp + 48), qf[3], acc);
    return acc;
}
__device__ __forceinline__ void nsa_soft_pv(f32x16& u, float tb, float& M, float& l, f32x16& O0, f32x16& O1, const bf16_t* v0, const bf16_t* v1, int hi) {
    float tm = max16(u); tm = fmaxf(tm, other_half_f(tm, hi));
    const float cand = tm + tb;
    if (__any(cand > M)) { const float mn = fmaxf(M, cand); const float al = __builtin_amdgcn_exp2f(M - mn); l *= al; O0 *= al; O1 *= al; M = mn; }
    const float ms = M - tb; float sum = 0.f;
#pragma unroll
    for (int i = 0; i < 16; ++i) { const float p = __builtin_amdgcn_exp2f(u[i] - ms); u[i] = p; sum += p; }
    l += sum;
    u32x4 a, b2;
    a.x = cvtpk(u[0], u[1]); a.y = cvtpk(u[2], u[3]); a.z = cvtpk(u[4], u[5]); a.w = cvtpk(u[6], u[7]);
    b2.x = cvtpk(u[8], u[9]); b2.y = cvtpk(u[10], u[11]); b2.z = cvtpk(u[12], u[13]); b2.w = cvtpk(u[14], u[15]);
    const bf16x8 p0 = __builtin_bit_cast(bf16x8, a), p1 = __builtin_bit_cast(bf16x8, b2);
    O0 = MFMA32(*(const bf16x8*)(v0), p0, O0); O0 = MFMA32(*(const bf16x8*)(v0 + 16), p1, O0);
    O1 = MFMA32(*(const bf16x8*)(v1), p0, O1); O1 = MFMA32(*(const bf16x8*)(v1 + 16), p1, O1);
}
__device__ __forceinline__ void nsa_mask_lt(f32x16& u, int limh) {
    asm volatile("" : "+v"(limh));
#pragma unroll
    for (int i = 0; i < 16; ++i) { const int c = (i & 3) + 8 * (i >> 2); if (!(c < limh)) u[i] = NEG_INF; }
}
__device__ __forceinline__ void nsa_mask_gt(f32x16& u, int limh) {
    asm volatile("" : "+v"(limh));
#pragma unroll
    for (int i = 0; i < 16; ++i) { const int c = (i & 3) + 8 * (i >> 2); if (!(c > limh)) u[i] = NEG_INF; }
}

__device__ __forceinline__ void nsa_unit_fast(const NsaF& P, int b, int g, int tb, int lane, float* acc_lds) {
    const int tq = lane & 31, hi = lane >> 5, t0 = tb * 32, cur = tb >> 1;
    const size_t rowq = (size_t)b * SEQ + t0 + tq;
    const bf16_t* zq = P.Z + rowq * NZ + ZC_AQ + (g * 4) * 64 + 8 * hi;
    const size_t bg = (size_t)b * 2 + g;
    const bf16_t* kcb_u = P.KCB + bg * 256 * 64; const unsigned koff = (unsigned)(tq * 64 + 8 * hi);
    const bf16_t* vct_u = P.VCT + bg * 64 * 256; const unsigned vcoff = (unsigned)(tq * 256 + 8 * hi);
    const bf16_t* zb_u = P.Z + (size_t)b * SEQ * NZ + g * 64;   const unsigned zoff = (unsigned)(tq * NZ + 8 * hi);
    const bf16_t* vst_u = P.VST + bg * 64 * SEQ; const bf16_t* vwt_u = P.VWT + bg * 64 * SEQ; const unsigned voff = (unsigned)(tq * SEQ + 8 * hi);
    const int nval = max(0, 2 * tb + 1 - (tq < 31 ? 1 : 0) - (tq < 15 ? 1 : 0));
    const int ntc = (2 * tb + 1 + 31) >> 5;
    const int tqh = tq - 4 * hi;
    const float hif = (float)(4 * hi);

    unsigned long long selmask;
    if (cur < 16) selmask = (2ull << cur) - 1ull;
    else {
        float* il = acc_lds + lane;
#pragma unroll
        for (int q = 0; q < 32; ++q) il[64 * q] = 0.f;
#pragma unroll 1
        for (int r = 0; r < 4; ++r) {
            bf16x8 qf[4]; nsa_load_q(qf, zq + r * 64);
            const float slope2 = __builtin_amdgcn_exp2f(-(float)(g * 4 + r + 1)) * LOG2E;
            f32x16 cb;
#pragma unroll
            for (int i = 0; i < 16; ++i) cb[i] = slope2 * 16.0f * ((float)((i & 3) + 8 * (i >> 2)) + hif);
            float M = -1.0e30f, l = 0.f;
#pragma unroll 1
            for (int nt = ntc - 1; nt >= 0; --nt) {
                f32x16 u = nsa_st(kcb_u + nt * 32 * 64 + koff, qf, cb); nsa_mask_lt(u, nval - 32 * nt - 4 * hi);
                const float tbs = slope2 * 512.0f * (float)nt;
                float tm = max16(u); tm = fmaxf(tm, other_half_f(tm, hi));
                const float mn = fmaxf(M, tm + tbs); float sum = 0.f; const float ms = mn - tbs;
#pragma unroll
                for (int i = 0; i < 16; ++i) sum += __builtin_amdgcn_exp2f(u[i] - ms);
                l = l * __builtin_amdgcn_exp2f(M - mn) + sum; M = mn;
            }
            const float lt = l + other_half_f(l, hi); const float linv = lt > 0.f ? 1.0f / lt : 0.f;
            float carry = 0.f;
#pragma unroll 1
            for (int nt = 0; nt < ntc; ++nt) {
                f32x16 u = nsa_st(kcb_u + nt * 32 * 64 + koff, qf, cb); nsa_mask_lt(u, nval - 32 * nt - 4 * hi);
                const float ms = M - slope2 * 512.0f * (float)nt;
#pragma unroll
                for (int i = 0; i < 16; ++i) u[i] = __builtin_amdgcn_exp2f(u[i] - ms) * linv;
                float x[4], qs[4];
#pragma unroll
                for (int gq = 0; gq < 4; ++gq) { qs[gq] = (u[4 * gq] + u[4 * gq + 1]) + (u[4 * gq + 2] + u[4 * gq + 3]); x[gq] = other_half_f(u[4 * gq + 3], hi); }
                float* ip = il + 256 * nt;
                ip[0] += qs[0] + (hi ? x[0] : carry); ip[64] += qs[1] + (hi ? x[1] : x[0]); ip[128] += qs[2] + (hi ? x[2] : x[1]); ip[192] += qs[3] + (hi ? x[3] : x[2]);
                carry = x[3];
            }
        }
        unsigned uu[32];
        const int qlo = hi ? 0 : 1, qhi = (cur - 2 - hi) >> 1;
        const unsigned candm = (unsigned)((2ull << qhi) - 1ull) & ~((1u << qlo) - 1u);
#pragma unroll
        for (int q = 0; q < 32; ++q) uu[q] = __float_as_uint(il[64 * q]) & (unsigned)(-(int)((candm >> q) & 1u));
        unsigned T = 0u;
#pragma unroll 1
        for (int bit = 30; bit >= 0; --bit) { const unsigned c = T | (1u << bit); unsigned cnt = 0;
#pragma unroll
            for (int q = 0; q < 32; ++q) cnt += (uu[q] >= c) ? 1u : 0u;
            cnt += other_half_u(cnt, hi);
            if (cnt >= 13u) T = c; }
        unsigned gtm = 0u, eqm = 0u;
#pragma unroll
        for (int q = 0; q < 32; ++q) { gtm |= (uu[q] > T ? 1u : 0u) << q; eqm |= (uu[q] == T ? 1u : 0u) << q; }
        eqm &= candm;
        const unsigned ogt = other_half_u(gtm, hi), oeq = other_half_u(eqm, hi);
        const unsigned long long fgt = spread_even(hi ? ogt : gtm) | (spread_even(hi ? gtm : ogt) << 1);
        const unsigned long long feq = spread_even(hi ? oeq : eqm) | (spread_even(hi ? eqm : oeq) << 1);
        const int need = 13 - __builtin_popcountll(fgt);
        unsigned long long rem = feq;
#pragma unroll 1
        for (int i = 0; i < 13; ++i) if (i < need) rem &= rem - 1ull;
        selmask = fgt | (feq & ~rem) | 1ull | (3ull << (cur - 1));
    }
    unsigned ulo = (unsigned)selmask, uhi = (unsigned)(selmask >> 32);
#pragma unroll
    for (int o = 1; o < 32; o <<= 1) { ulo |= __shfl_xor(ulo, o); uhi |= __shfl_xor(uhi, o); }
    const unsigned long long U = ((unsigned long long)__builtin_amdgcn_readfirstlane(uhi) << 32) | (unsigned long long)__builtin_amdgcn_readfirstlane(ulo);

    float* al = acc_lds + lane;
#pragma unroll 1
    for (int r = 0; r < 4; ++r) {
        const int hh = g * 4 + r;
        bf16x8 qf[4]; nsa_load_q(qf, zq + r * 64);
        const float slope2 = __builtin_amdgcn_exp2f(-(float)(hh + 1)) * LOG2E;
        f32x16 cb;
#pragma unroll
        for (int i = 0; i < 16; ++i) cb[i] = slope2 * ((float)((i & 3) + 8 * (i >> 2)) + hif);
        const float* gp = P.gates + rowq * 32 + 8 + hh * 3;
        {
            const f32x16 cb16 = cb * 16.0f;
            float M = -1.0e30f, l = 0.f; f32x16 O0, O1;
#pragma unroll
            for (int i = 0; i < 16; ++i) { O0[i] = 0.f; O1[i] = 0.f; }
#pragma unroll 1
            for (int nt = ntc - 1; nt >= 0; --nt) {
                f32x16 u = nsa_st(kcb_u + nt * 32 * 64 + koff, qf, cb16); nsa_mask_lt(u, nval - 32 * nt - 4 * hi);
                const bf16_t* vp = vct_u + 32 * nt + vcoff;
                nsa_soft_pv(u, slope2 * 512.0f * (float)nt, M, l, O0, O1, vp, vp + 32 * 256, hi);
            }
            const float lt = l + other_half_f(l, hi); const float sc = lt > 0.f ? sigmoidf_(gp[0]) / lt : 0.f;
#pragma unroll
            for (int i = 0; i < 16; ++i) { al[64 * i] = O0[i] * sc; al[64 * (16 + i)] = O1[i] * sc; }
        }
        {
            float M = -1.0e30f, l = 0.f; f32x16 O0, O1;
#pragma unroll
            for (int i = 0; i < 16; ++i) { O0[i] = 0.f; O1[i] = 0.f; }
#pragma unroll 1
            for (int j = cur; j >= 0; --j) {
                if (!((U >> j) & 1ull)) continue;
                const bool mine = (selmask >> j) & 1ull;
#pragma unroll 1
                for (int half = 1; half >= 0; --half) {
                    const int kb = 64 * j + 32 * half;
                    if (kb > t0) continue;
                    f32x16 u = nsa_st(zb_u + (size_t)kb * NZ + ZC_AKS + zoff, qf, cb);
                    if (kb == t0) nsa_mask_lt(u, tqh + 1);
                    if (!mine) {
#pragma unroll
                        for (int i = 0; i < 16; ++i) u[i] = NEG_INF; }
                    const bf16_t* vp = vst_u + kb + voff;
                    nsa_soft_pv(u, slope2 * (float)(kb - t0), M, l, O0, O1, vp, vp + 32 * SEQ, hi);
                }
            }
            const float lt = l + other_half_f(l, hi); const float sc = lt > 0.f ? sigmoidf_(gp[1]) / lt : 0.f;
#pragma unroll
            for (int i = 0; i < 16; ++i) { al[64 * i] += O0[i] * sc; al[64 * (16 + i)] += O1[i] * sc; }
        }
        {
            float M = -1.0e30f, l = 0.f; f32x16 O0, O1;
#pragma unroll
            for (int i = 0; i < 16; ++i) { O0[i] = 0.f; O1[i] = 0.f; }
#pragma unroll 1
            for (int i16 = 16; i16 >= 0; --i16) {
                const int kb = t0 - 512 + 32 * i16;
                if (kb < 0) break;
                f32x16 u = nsa_st(zb_u + (size_t)kb * NZ + ZC_AKW + zoff, qf, cb);
                if (i16 == 16) nsa_mask_lt(u, tqh + 1);
                if (i16 == 0) nsa_mask_gt(u, tqh);
                const bf16_t* vp = vwt_u + kb + voff;
                nsa_soft_pv(u, slope2 * (float)(kb - t0), M, l, O0, O1, vp, vp + 32 * SEQ, hi);
            }
            const float lt = l + other_half_f(l, hi); const float sc = lt > 0.f ? sigmoidf_(gp[2]) / lt : 0.f;
            bf16_t* op = P.MIX + rowq * DM + 512 + hh * 64 + 4 * hi;
#pragma unroll
            for (int q4 = 0; q4 < 4; ++q4) {
                float a[4], c[4];
#pragma unroll
                for (int e = 0; e < 4; ++e) { a[e] = al[64 * (4 * q4 + e)] + O0[4 * q4 + e] * sc; c[e] = al[64 * (16 + 4 * q4 + e)] + O1[4 * q4 + e] * sc; }
                u32x2 w0; w0.x = cvtpk(a[0], a[1]); w0.y = cvtpk(a[2], a[3]); *(u32x2*)(op + 8 * q4) = w0;
                u32x2 w1; w1.x = cvtpk(c[0], c[1]); w1.y = cvtpk(c[2], c[3]); *(u32x2*)(op + 32 + 8 * q4) = w1; }
        }
    }
}

__device__ __forceinline__ void vt_unit(const bf16_t* Z, int zcol, bf16_t* VT, int b, int g, int ch, unsigned short* tile  , int tid) {
    { const int pos = tid >> 3, c8 = (tid & 7) * 8;
      const u32x4 w = *(const u32x4*)(Z + ((size_t)b * SEQ + ch * 64 + pos) * NZ + zcol + g * 64 + c8);
      *(u32x4*)(tile + pos * 72 + c8) = w; }
    __syncthreads();
    { const int d = tid >> 3, chunk = tid & 7, gi = chunk >> 1, h = chunk & 1; unsigned short e[8];
#pragma unroll
      for (int j = 0; j < 8; ++j) { const int pos = 16 * gi + 8 * (j >> 2) + 4 * h + (j & 3); e[j] = tile[pos * 72 + d]; }
      u32x4 o; o.x = e[0] | ((unsigned)e[1] << 16); o.y = e[2] | ((unsigned)e[3] << 16); o.z = e[4] | ((unsigned)e[5] << 16); o.w = e[6] | ((unsigned)e[7] << 16);
      *(u32x4*)(VT + (((size_t)b * 2 + g) * 64 + d) * SEQ + ch * 64 + chunk * 8) = o; }
    __syncthreads();
}

__global__ void __launch_bounds__(NTHREADS, 2) fwd_kernel(Params prm) {
    extern __shared__ __attribute__((aligned(16))) unsigned char lds[];
    cg::grid_group grid = cg::this_grid();
    PG8_LAS unsigned char* ldsl = (PG8_LAS unsigned char*)lds;
    float* lds_f = (float*)lds;
#define TID ((int)threadIdx.x)
#define LANE ((int)(threadIdx.x & 63))
#define WAVE (__builtin_amdgcn_readfirstlane((int)(threadIdx.x >> 6)))
#define GRIDN ((int)gridDim.x)
#define BX ((int)blockIdx.x)
#define WSP(T, name, off) T* name; { unsigned char* w_ = prm.ws; asm volatile("" : "+s"(w_)); name = (T*)(w_ + (off)); }

    {
        const int lane = LANE, wave = WAVE, G = GRIDN, bx = BX, tid = TID; const int gw = bx * NWAVES + wave, NGW = G * NWAVES;
        WSP(bf16_t, Win_t, WS_WIN) WSP(bf16_t, Wout_t, WS_WOUT) WSP(bf16_t, Wup_t, WS_WUP) WSP(bf16_t, Wdn_t, WS_WDN) WSP(bf16_t, Wpg_t, WS_WPG) WSP(bf16_t, Wpp_t, WS_WPP)
        WSP(bf16_t, XB, WS_XB) WSP(bf16_t, PB, WS_PB)
        const float* x = prm.in[0]; const float* pin = prm.in[1];
        float* scr = lds_f + wave * 4096;
        constexpr int I_IN = (DM / 64) * (3360 / 32), I_OUT = (DM / 64) * (DM / 32), I_UP = (DM / 64) * (4096 / 32), I_DN = (DFF / 64) * (DM / 32), I_PG = I_OUT, I_PP = (PLE / 64) * (DM / 32);
        constexpr int NITEMS = I_IN + I_OUT + I_UP + I_DN + I_PG + I_PP;
        for (int it = gw; it < NITEMS; it += NGW) {
            int r = it;
            if (r < I_IN) { p0_transpose_item(prm.in[3], nullptr, DM, 3360, Win_t, scr, r, lane); continue; } r -= I_IN;
            if (r < I_OUT) { p0_transpose_item(prm.in[12], nullptr, DM, DM, Wout_t, scr, r, lane); continue; } r -= I_OUT;
            if (r < I_UP) { p0_transpose_item(prm.in[14], prm.in[13], DM, 4096, Wup_t, scr, r, lane); continue; } r -= I_UP;
            if (r < I_DN) { p0_transpose_item(prm.in[17], nullptr, DFF, DM, Wdn_t, scr, r, lane); continue; } r -= I_DN;
            if (r < I_PG) { p0_transpose_item(prm.in[19], prm.in[18], DM, DM, Wpg_t, scr, r, lane); continue; } r -= I_PG;
            p0_transpose_item(prm.in[20], nullptr, PLE, DM, Wpp_t, scr, r, lane);
        }
        for (int i = bx * NTHREADS + tid; i < (NZ - 3360) * DM / 8; i += G * NTHREADS) ((u32x4*)(Win_t + (size_t)3360 * DM))[i] = (u32x4){0u, 0u, 0u, 0u};
        const float* g1 = prm.in[2];
        f32x4 gv[4];
#pragma unroll
        for (int j = 0; j < 4; ++j) gv[j] = ((const f32x4*)g1)[lane + 64 * j];
        for (int m = gw; m < MTOK; m += NGW) {
            const f32x4* xr = (const f32x4*)(x + (size_t)m * DM) + lane; f32x4 v[4]; float s = 0.f;
#pragma unroll
            for (int j = 0; j < 4; ++j) { v[j] = xr[64 * j]; s += (v[j][0] * v[j][0] + v[j][1] * v[j][1]) + (v[j][2] * v[j][2] + v[j][3] * v[j][3]); }
            const float rstd = 1.0f / sqrtf(wave_sum(s) * (1.0f / DM) + EPS);
            u32x2* o8 = (u32x2*)(XB + (size_t)m * DM) + lane;
#pragma unroll
            for (int j = 0; j < 4; ++j) { u32x2 w; w.x = pk2(v[j][0] * rstd * gv[j][0], v[j][1] * rstd * gv[j][1]); w.y = pk2(v[j][2] * rstd * gv[j][2], v[j][3] * rstd * gv[j][3]); o8[64 * j] = w; }
        }
        for (size_t i = (size_t)bx * NTHREADS + tid; i < (size_t)MTOK * PLE / 8; i += (size_t)G * NTHREADS) {
            const f32x4 a = ((const f32x4*)pin)[2 * i], c = ((const f32x4*)pin)[2 * i + 1];
            u32x4 w; w.x = pk2(a[0], a[1]); w.y = pk2(a[2], a[3]); w.z = pk2(c[0], c[1]); w.w = pk2(c[2], c[3]); ((u32x4*)PB)[i] = w; }
    }
    grid.sync();

    {
        WSP(bf16_t, XB, WS_XB) WSP(bf16_t, Win_t, WS_WIN) WSP(bf16_t, Z, WS_Z) WSP(float, GATES, WS_GATES)
        pg8::Gemm g{XB, Win_t, MTOK, NZ, DM}; pg8::StaticOrder S; S.init(MTOK, NZ, GRIDN, BX);
        pg8::EpiZ E{Z, GATES};
        pg8::gemm_phase<pg8::EpiZ, pg8::StaticOrder, true, true>(ldsl, g, S, E);
    }
    grid.sync();

    {
        WSP(bf16_t, Z, WS_Z) WSP(float, KC, WS_KC) WSP(float, VC, WS_VC) WSP(bf16_t, KCB, WS_KCB) WSP(bf16_t, VCT, WS_VCT) WSP(bf16_t, VST, WS_VST) WSP(bf16_t, VWT, WS_VWT)
        for (int un = BX; un < 2 * BATCH * 2 * 32; un += GRIDN) {
            const int kv = un & 1, ng = (un >> 1) & 31, g = (un >> 6) & 1, b = un >> 7;
            if (kv == 0) compress_unit_simple(Z, ZC_AKC, prm.in[6], prm.in[8], prm.in[9], KC, KCB, nullptr, b, g, ng, lds_f, TID);
            else         compress_unit_simple(Z, ZC_AVC, prm.in[7], prm.in[10], prm.in[11], VC, nullptr, VCT, b, g, ng, lds_f, TID);
        }
        for (int un = BX; un < BATCH * 2 * 2 * 64; un += GRIDN) {
            const int ch = un & 63, br = (un >> 6) & 1, g = (un >> 7) & 1, b = un >> 8;
            vt_unit(Z, br ? ZC_AVW : ZC_AVS, br ? VWT : VST, b, g, ch, (unsigned short*)lds, TID);
        }
    }
    grid.sync();

    {
        WSP(bf16_t, Z, WS_Z) WSP(float, KC, WS_KC) WSP(float, VC, WS_VC) WSP(float, GATES, WS_GATES) WSP(bf16_t, MIX, WS_MIX)
        {
            MixPtrs MP{Z, GATES, KC, VC, MIX, prm.in[4], prm.in[5]};
            for (int un = BX; un < BATCH * 4; un += GRIDN) mlstm_unit_simple(MP, un >> 2, un & 3, lds_f, TID);
        }
        __syncthreads();
        {
            WSP(bf16_t, KCB, WS_KCB) WSP(bf16_t, VCT, WS_VCT) WSP(bf16_t, VST, WS_VST) WSP(bf16_t, VWT, WS_VWT)
            NsaF NP{Z, GATES, KCB, VCT, VST, VWT, MIX};
            const int lane = LANE; const int gw = BX * NWAVES + WAVE, NGW = GRIDN * NWAVES;
            for (int un = gw; un < BATCH * 2 * (SEQ / 32); un += NGW) { const int tb = 127 - (un >> 5), g = un & 1, b = (un >> 1) & 15;
                nsa_unit_fast(NP, b, g, tb, lane, lds_f + WAVE * 2048); }
        }
    }
    grid.sync();

    {
        WSP(bf16_t, MIX, WS_MIX) WSP(bf16_t, Wout_t, WS_WOUT) WSP(bf16_t, XB, WS_XB) WSP(float, RS2, WS_RS2)
        pg8::Gemm g{MIX, Wout_t, MTOK, DM, DM}; pg8::PanelOrder S; S.init(MTOK, GRIDN, BX);
        pg8::EpiRes E{prm.in[0], prm.out, XB, RS2};
        pg8::gemm_phase<pg8::EpiRes, pg8::PanelOrder, true, true>(ldsl, g, S, E);
    }
    grid.sync();

    {
        WSP(bf16_t, XB, WS_XB) WSP(bf16_t, Wup_t, WS_WUP) WSP(bf16_t, U, WS_U) WSP(float, RS2, WS_RS2)
        pg8::Gemm g{XB, Wup_t, MTOK, 4096, DM}; pg8::StaticOrder S; S.init(MTOK, 4096, GRIDN, BX);
        pg8::EpiBf<true> E{U, 4096, RS2};
        pg8::gemm_phase<pg8::EpiBf<true>, pg8::StaticOrder, true, true>(ldsl, g, S, E);
    }
    grid.sync();

    {
        WSP(bf16_t, U, WS_U) WSP(bf16_t, ACT, WS_ACT)
        const float* cw = prm.in[15]; const float* cb = prm.in[16];
        for (size_t it = (size_t)BX * NTHREADS + TID; it < (size_t)MTOK * 256; it += (size_t)GRIDN * NTHREADS) {
            const size_t row = it >> 8; const int c8 = (int)(it & 255) * 8; const int t = (int)(row & (SEQ - 1));
            const bf16_t* u0 = U + row * 4096 + c8;
            const u32x4 z4 = (u32x4){0u, 0u, 0u, 0u};
            const u32x4 g2 = *(const u32x4*)u0; const u32x4 g1 = (t >= 1) ? *(const u32x4*)(u0 - 4096) : z4; const u32x4 g0 = (t >= 2) ? *(const u32x4*)(u0 - 8192) : z4;
            const u32x4 vv = *(const u32x4*)(u0 + 2048);
            float G0[8] = {bflo(g0.x), bfhi(g0.x), bflo(g0.y), bfhi(g0.y), bflo(g0.z), bfhi(g0.z), bflo(g0.w), bfhi(g0.w)};
            float G1[8] = {bflo(g1.x), bfhi(g1.x), bflo(g1.y), bfhi(g1.y), bflo(g1.z), bfhi(g1.z), bflo(g1.w), bfhi(g1.w)};
            float G2[8] = {bflo(g2.x), bfhi(g2.x), bflo(g2.y), bfhi(g2.y), bflo(g2.z), bfhi(g2.z), bflo(g2.w), bfhi(g2.w)};
            float V[8] = {bflo(vv.x), bfhi(vv.x), bflo(vv.y), bfhi(vv.y), bflo(vv.z), bfhi(vv.z), bflo(vv.w), bfhi(vv.w)};
            float A[8];
#pragma unroll
            for (int j = 0; j < 8; ++j) { const float cv = cw[c8 + j] * G0[j] + cw[DFF + c8 + j] * G1[j] + cw[2 * DFF + c8 + j] * G2[j] + cb[c8 + j]; A[j] = cv * sigmoidf_(cv) * V[j]; }
            u32x4 w; w.x = pk2(A[0], A[1]); w.y = pk2(A[2], A[3]); w.z = pk2(A[4], A[5]); w.w = pk2(A[6], A[7]);
            *(u32x4*)(ACT + row * DFF + c8) = w;
        }
    }
    grid.sync();

    {
        WSP(bf16_t, ACT, WS_ACT) WSP(bf16_t, Wdn_t, WS_WDN) WSP(bf16_t, XB, WS_XB) WSP(float, RS3, WS_RS3)
        pg8::Gemm g{ACT, Wdn_t, MTOK, DM, DFF}; pg8::PanelOrder S; S.init(MTOK, GRIDN, BX);
        pg8::EpiRes E{prm.out, prm.out, XB, RS3};
        pg8::gemm_phase<pg8::EpiRes, pg8::PanelOrder, true, true>(ldsl, g, S, E);
    }
    {
        WSP(bf16_t, PB, WS_PB) WSP(bf16_t, Wpp_t, WS_WPP) WSP(bf16_t, PROJ, WS_PROJ)
        pg8::Gemm g{PB, Wpp_t, MTOK, DM, PLE}; pg8::StaticOrder S; S.init(MTOK, DM, GRIDN, BX);
        pg8::EpiBf<false> E{PROJ, DM, nullptr};
        pg8::gemm_phase<pg8::EpiBf<false>, pg8::StaticOrder, true, true>(ldsl, g, S, E);
    }
    grid.sync();

    {
        WSP(bf16_t, XB, WS_XB) WSP(bf16_t, Wpg_t, WS_WPG) WSP(bf16_t, PROJ, WS_PROJ) WSP(float, RS3, WS_RS3)
        pg8::Gemm g{XB, Wpg_t, MTOK, DM, DM}; pg8::PanelOrder S; S.init(MTOK, GRIDN, BX);
        pg8::EpiPle E{prm.out, PROJ, RS3};
        pg8::gemm_phase<pg8::EpiPle, pg8::PanelOrder, true, true>(ldsl, g, S, E);
    }
    grid.sync();

    {
        const int lane = LANE; const int gw = BX * NWAVES + WAVE, NGW = GRIDN * NWAVES;
        const float* fg = prm.in[21]; float* out = prm.out;
        f32x4 gv[4];
#pragma unroll
        for (int j = 0; j < 4; ++j) gv[j] = ((const f32x4*)fg)[lane + 64 * j];
        for (int m = gw; m < MTOK; m += NGW) {
            f32x4* xr = (f32x4*)(out + (size_t)m * DM) + lane; f32x4 v[4]; float s = 0.f;
#pragma unroll
            for (int j = 0; j < 4; ++j) { v[j] = xr[64 * j]; s += (v[j][0] * v[j][0] + v[j][1] * v[j][1]) + (v[j][2] * v[j][2] + v[j][3] * v[j][3]); }
            const float rstd = 1.0f / sqrtf(wave_sum(s) * (1.0f / DM) + EPS);
#pragma unroll
            for (int j = 0; j < 4; ++j) xr[64 * j] = v[j] * rstd * gv[j];
        }
    }
}

extern "C" void kernel_launch(void* const* d_in, const int* in_sizes, int n_in, void* d_out, int out_size, void* d_ws, size_t ws_size, hipStream_t stream) {
    static int grid = 0;
    if (grid == 0) {
        if (n_in != 22 || out_size != MTOK * DM || ws_size < WS_END) { fprintf(stderr, "kernel_launch: unexpected problem (n_in %d, out %d, ws %zu)\n", n_in, out_size, ws_size); grid = -1; return; }
        int dev = 0, cus = 0, per_cu = 0;
        if (hipGetDevice(&dev) != hipSuccess || hipDeviceGetAttribute(&cus, hipDeviceAttributeMultiprocessorCount, dev) != hipSuccess) { grid = -1; return; }
        if (hipFuncSetAttribute((const void*)fwd_kernel, hipFuncAttributeMaxDynamicSharedMemorySize, LDS_BYTES) != hipSuccess) { fprintf(stderr, "kernel_launch: hipFuncSetAttribute failed\n"); grid = -1; return; }
        if (hipOccupancyMaxActiveBlocksPerMultiprocessor(&per_cu, (const void*)fwd_kernel, NTHREADS, LDS_BYTES) != hipSuccess || per_cu < 1) { fprintf(stderr, "kernel_launch: occupancy query says %d\n", per_cu); (void)hipGetLastError(); per_cu = 1; }
        grid = cus * 1;
    }
    if (grid < 0) return;
    Params p{};
    for (int i = 0; i < 22; ++i) p.in[i] = (const float*)d_in[i];
    p.out = (float*)d_out; p.ws = (unsigned char*)d_ws;
    void* args[] = {&p};
    hipError_t e = hipLaunchCooperativeKernel((const void*)fwd_kernel, dim3(grid), dim3(NTHREADS), args, LDS_BYTES, stream);
    if (e != hipSuccess) fprintf(stderr, "kernel_launch: cooperative launch failed: %s (grid %d)\n", hipGetErrorString(e), grid);
}
```

```cpp
#include <hip/hip_runtime.h>
#include <hip/hip_cooperative_groups.h>
#include <cstdio>
#include <cstdint>
namespace cg = cooperative_groups;
namespace pg8 {
#define PG8_LAS __attribute__((address_space(3)))
typedef unsigned short bf16_t;
typedef short bf16x8 __attribute__((ext_vector_type(8)));
typedef float f32x4 __attribute__((ext_vector_type(4)));
typedef unsigned u32x4 __attribute__((ext_vector_type(4)));
constexpr int BM = 256, BK = 64, HALF = 128, HTB = HALF * BK * 2  , STAGE_BYTES = 8 * HTB, NXCD = 8, WGM = 8;

__host__ __device__ __forceinline__ int lds_byte(int r, int c) { const int st = (r >> 4) * 2 + (c >> 5), rr = r & 15, cc = c & 31, ob = rr * 64 + cc * 2; return st * 1024 + (ob ^ (((ob >> 9) & 1) << 5)); }
__host__ __device__ __forceinline__ void stage_rc(int b, int& R, int& C) { const int st = b / 1024, sb = b % 1024, swz = sb ^ (((sb >> 9) & 1) << 5); R = (st >> 1) * 16 + swz / 64; C = (st & 1) * 32 + (swz % 64) / 2; }
__host__ __device__ __forceinline__ int perm32(int rho) { const int n = rho >> 4, i = rho & 15; return 8 * (i >> 2) + 4 * n + (i & 3); }

struct Unit { int pm, pn; };
struct Gemm { const bf16_t* A; const bf16_t* Bt; int M, N, K; };

struct StaticOrder {
    int nM, nN, nwg, G, c;
    __host__ __device__ void init(int M, int N, int G_, int c_) { nM = M / BM; nN = N / BM; nwg = nM * nN; G = G_; c = c_; }
    __host__ __device__ bool next(int i, Unit& u) const {
        const long L = (long)i * G + c; if (L >= nwg) return false;
        int wgid = (int)L; { const int q = nwg / NXCD, r = nwg % NXCD, xcd = wgid % NXCD, off = wgid / NXCD; wgid = (xcd < r ? xcd * (q + 1) : r * (q + 1) + (xcd - r) * q) + off; }
        const int nig = WGM * nN, gid = wgid / nig, fm = gid * WGM, gsz = (nM - fm) < WGM ? (nM - fm) : WGM;
        u.pm = fm + ((wgid % nig) % gsz); u.pn = (wgid % nig) / gsz; return true;
    }
    __device__ __forceinline__ void a_ready(const Unit&) const {}
    __device__ __forceinline__ void done(const Unit&) const {}
};

__device__ __forceinline__ unsigned cvt_pk_bf16(float lo, float hi) { unsigned r; asm volatile("v_cvt_pk_bf16_f32 %0, %1, %2" : "=v"(r) : "v"(lo), "v"(hi)); return r; }
typedef float f32x2 __attribute__((ext_vector_type(2)));
__device__ __forceinline__ f32x2 gelu_pk(f32x2 v) {
    const f32x2 av = __builtin_elementwise_abs(v), d = av * 0.2316418882f + 1.0f;
    f32x2 t; t.x = __builtin_amdgcn_rcpf(d.x); t.y = __builtin_amdgcn_rcpf(d.y);
    f32x2 q = t * 0.5307027145f + (-0.7265760135f); q = q * t + 0.7107068705f; q = q * t + (-0.142248368f); q = q * t + 0.127414796f; q = q * t;
    const f32x2 s = (v * v) * (-0.72134752044f);
    f32x2 e; e.x = __builtin_amdgcn_exp2f(s.x); e.y = __builtin_amdgcn_exp2f(s.y);
    const f32x2 m = v * (q * e), r = v - m;
    f32x2 o; o.x = v.x < 0.f ? m.x : r.x; o.y = v.y < 0.f ? m.y : r.y; return o;
}

template <int ACT  > struct EpiBf16 {
    static constexpr bool PERM = true, AFTER_DRAIN = false; static_assert(ACT == 0 || ACT == 1, "EpiBf16: ACT is 0 (none) or 1 (gelu_pk)");
    bf16_t* O; int ldc; const float* bias; int split_cols; size_t split_stride; float scale0;
    __device__ __forceinline__ void operator()(const f32x4 (&acc)[2][2][4][2], const Unit& u, int wr, int wc, int fr, int fq) const {
        const int row0 = u.pm * BM + wr * 64 + fr; int colt = u.pn * BM; bf16_t* base = O;
        float sc = 1.f; if (split_cols) { const int t = colt / split_cols; base += (size_t)t * split_stride; colt -= t * split_cols; if (t == 0) sc = scale0; }
        const int col0 = colt + wc * 32 + 8 * fq, bcol0 = u.pn * BM + wc * 32 + 8 * fq;
        f32x4 bv[2][2];
#pragma unroll
        for (int bj = 0; bj < 2; ++bj)
#pragma unroll
            for (int n = 0; n < 2; ++n) bv[bj][n] = bias ? *(const f32x4*)(bias + bcol0 + bj * HALF + 4 * n) : (f32x4){0.f, 0.f, 0.f, 0.f};
#pragma unroll
        for (int ai = 0; ai < 2; ++ai)
#pragma unroll
            for (int m = 0; m < 4; ++m) { bf16_t* rowp = base + (size_t)(row0 + ai * HALF + m * 16) * ldc + col0;
#pragma unroll
                for (int bj = 0; bj < 2; ++bj) { f32x4 v0 = acc[ai][bj][m][0] + bv[bj][0], v1 = acc[ai][bj][m][1] + bv[bj][1];
                    if (ACT == 1) { f32x2 a = gelu_pk((f32x2){v0[0], v0[1]}), b = gelu_pk((f32x2){v0[2], v0[3]}), c = gelu_pk((f32x2){v1[0], v1[1]}), d = gelu_pk((f32x2){v1[2], v1[3]});
                        v0 = (f32x4){a.x, a.y, b.x, b.y}; v1 = (f32x4){c.x, c.y, d.x, d.y}; }
                    v0 = v0 * sc; v1 = v1 * sc; u32x4 w; w.x = cvt_pk_bf16(v0[0], v0[1]); w.y = cvt_pk_bf16(v0[2], v0[3]); w.z = cvt_pk_bf16(v1[0], v1[1]); w.w = cvt_pk_bf16(v1[2], v1[3]);
                    *(u32x4*)(rowp + bj * HALF) = w; } }
    }
};
template <class Epi, class Sched, bool ALIGN_EPI = false, bool SP2 = false>
__device__ __forceinline__ void gemm_phase(PG8_LAS unsigned char* lds, const Gemm g, const Sched& S, Epi& E) {
    int tid_ = threadIdx.x; asm volatile("" : "+v"(tid_));
    const int tid = tid_, wid = __builtin_amdgcn_readfirstlane(tid >> 6), lane = tid & 63, wr = wid >> 2, wc = wid & 3, fr = lane & 15, fq = lane >> 4;
    int K_ = g.K; asm volatile("" : "+s"(K_)); const int K = K_, nt = K / BK;
    unsigned voffA[2], voffB[2];
#pragma unroll
    for (int i = 0; i < 2; ++i) { int R, C; stage_rc(tid * 16 + i * 8192, R, C); const int Rb = Epi::PERM ? ((R & ~31) + perm32(R & 31)) : R;
        voffA[i] = (unsigned)(R * K + C) * 2u; voffB[i] = (unsigned)(Rb * K + C) * 2u; }
    const size_t kstep = (size_t)(BK * 2);
    const size_t hstep = (size_t)HALF * K * 2;
    const size_t tstep = 2 * hstep;
    const unsigned ldsw = (unsigned)wid * 1024u;
    const int aoff = lds_byte(wr * 64 + fr, fq * 8), boff = lds_byte(wc * 32 + fr, fq * 8);
#define PG8_SA(b, h) (((b) * 2 + (h)) * HTB)
#define PG8_SB(b, h) ((4 + (b) * 2 + (h)) * HTB)
#define PG8_STAGE(bufoff, gbase, voff) do { _Pragma("unroll") for (int _i = 0; _i < 2; ++_i) \
        __builtin_amdgcn_global_load_lds((const unsigned*)((const char*)(gbase) + (voff)[_i]), (PG8_LAS unsigned*)(lds + (bufoff) + ldsw + _i * 8192), 16, 0, 0); } while (0)
#define PG8_LDA(dst, b, h) do { _Pragma("unroll") for (int m = 0; m < 4; ++m) _Pragma("unroll") for (int k = 0; k < 2; ++k) dst[m][k] = *(const PG8_LAS bf16x8*)(lds + PG8_SA(b, h) + aoff + m * 2048 + k * 1024); } while (0)
#define PG8_LDB(dst, b, h) do { _Pragma("unroll") for (int n = 0; n < 2; ++n) _Pragma("unroll") for (int k = 0; k < 2; ++k) dst[n][k] = *(const PG8_LAS bf16x8*)(lds + PG8_SB(b, h) + boff + n * 2048 + k * 1024); } while (0)
#define PG8_MMA(ai, bj, At, Bt) do { __builtin_amdgcn_s_setprio(1); _Pragma("unroll") for (int m = 0; m < 4; ++m) _Pragma("unroll") for (int n = 0; n < 2; ++n) _Pragma("unroll") for (int k = 0; k < 2; ++k) \
        acc[ai][bj][m][n] = __builtin_amdgcn_mfma_f32_16x16x32_bf16(Bt[n][k], At[m][k], acc[ai][bj][m][n], 0, 0, 0); __builtin_amdgcn_s_setprio(0); } while (0)
#define PG8_WAIT_V(n) asm volatile("s_waitcnt vmcnt(" #n ")" ::: "memory")
#define PG8_WAIT_L(n) asm volatile("s_waitcnt lgkmcnt(" #n ")" ::: "memory")
#define PG8_BAR __builtin_amdgcn_s_barrier()
#define PG8_SCHED __builtin_amdgcn_sched_barrier(0)
    Unit cur, nxt; int ui = 0;
    if (!S.next(0, cur)) return;
    f32x4 acc[2][2][4][2];
#pragma unroll
    for (int a = 0; a < 2; ++a)
#pragma unroll
        for (int b = 0; b < 2; ++b)
#pragma unroll
            for (int m = 0; m < 4; ++m)
#pragma unroll
                for (int n = 0; n < 2; ++n) acc[a][b][m][n] = (f32x4){0.f, 0.f, 0.f, 0.f};
    bf16x8 At[4][2], B0[2][2], B1[2][2];
    const char* cA = (const char*)g.A + (size_t)cur.pm * tstep; const char* cB = (const char*)g.Bt + (size_t)cur.pn * tstep;
    S.a_ready(cur);
    if constexpr (SP2) {
        PG8_STAGE(PG8_SB(0, 0), cB, voffB); PG8_STAGE(PG8_SB(0, 1), cB + hstep, voffB); PG8_STAGE(PG8_SA(0, 0), cA, voffA); PG8_STAGE(PG8_SA(0, 1), cA + hstep, voffA);
        if (wr == 1) PG8_BAR;
        PG8_WAIT_V(2); PG8_BAR;
        PG8_STAGE(PG8_SB(1, 0), cB + kstep, voffB); PG8_STAGE(PG8_SA(1, 0), cA + kstep, voffA); PG8_STAGE(PG8_SB(1, 1), cB + hstep + kstep, voffB);
        PG8_WAIT_V(6); PG8_BAR;
    } else {
        PG8_STAGE(PG8_SB(0, 0), cB, voffB); PG8_STAGE(PG8_SA(0, 0), cA, voffA); PG8_STAGE(PG8_SB(0, 1), cB + hstep, voffB); PG8_STAGE(PG8_SA(0, 1), cA + hstep, voffA);
        if (wr == 1) PG8_BAR;
        PG8_WAIT_V(4); PG8_BAR;
        PG8_STAGE(PG8_SB(1, 0), cB + kstep, voffB); PG8_STAGE(PG8_SA(1, 0), cA + kstep, voffA); PG8_STAGE(PG8_SB(1, 1), cB + hstep + kstep, voffB);
        PG8_WAIT_V(6); PG8_BAR;
    }
    for (;;) {
        const bool has_next = S.next(ui + 1, nxt);
        const char* nA = has_next ? (const char*)g.A + (size_t)nxt.pm * tstep : cA; const char* nB = has_next ? (const char*)g.Bt + (size_t)nxt.pn * tstep : cB;
        for (int t = 0; t < nt; t += 2) {
            const bool last = (t == nt - 2);
            const char* a1 = cA + (size_t)(t + 1) * kstep;
            const char* a2 = last ? nA : cA + (size_t)(t + 2) * kstep; const char* b2 = last ? nB : cB + (size_t)(t + 2) * kstep;
            const char* a3 = a2 + kstep; const char* b3 = b2 + kstep;
            if (last && has_next) S.a_ready(nxt);
            if constexpr (SP2) {
            PG8_LDB(B0, 0, 0); PG8_LDB(B1, 0, 1); PG8_SCHED; PG8_LDA(At, 0, 0); PG8_STAGE(PG8_SA(1, 1), a1 + hstep, voffA);
            PG8_WAIT_V(8); PG8_WAIT_L(0); PG8_BAR; PG8_MMA(0, 0, At, B0); PG8_MMA(0, 1, At, B1); PG8_BAR; PG8_SCHED;
            PG8_LDA(At, 0, 1); PG8_STAGE(PG8_SB(0, 0), b2, voffB); PG8_STAGE(PG8_SB(0, 1), b2 + hstep, voffB); PG8_STAGE(PG8_SA(0, 0), a2, voffA);
            PG8_WAIT_V(8); PG8_WAIT_L(0); PG8_BAR; PG8_MMA(1, 0, At, B0); PG8_MMA(1, 1, At, B1); PG8_BAR; PG8_SCHED;
            PG8_LDB(B0, 1, 0); PG8_LDB(B1, 1, 1); PG8_SCHED; PG8_LDA(At, 1, 0); PG8_STAGE(PG8_SA(0, 1), a2 + hstep, voffA);
            PG8_WAIT_V(8); PG8_WAIT_L(0); PG8_BAR; PG8_MMA(0, 0, At, B0); PG8_MMA(0, 1, At, B1); PG8_BAR; PG8_SCHED;
            PG8_LDA(At, 1, 1); PG8_STAGE(PG8_SB(1, 0), b3, voffB); PG8_STAGE(PG8_SB(1, 1), b3 + hstep, voffB); PG8_STAGE(PG8_SA(1, 0), a3, voffA);
            PG8_WAIT_V(8); PG8_WAIT_L(0); PG8_BAR; PG8_MMA(1, 0, At, B0); PG8_MMA(1, 1, At, B1); PG8_BAR; PG8_SCHED;
            } else {
            PG8_LDB(B0, 0, 0); PG8_SCHED; PG8_LDA(At, 0, 0); PG8_STAGE(PG8_SA(1, 1), a1 + hstep, voffA);
            PG8_WAIT_L(8); PG8_BAR; PG8_WAIT_L(0); PG8_MMA(0, 0, At, B0); PG8_BAR; PG8_SCHED;
            PG8_LDB(B1, 0, 1); PG8_STAGE(PG8_SB(0, 0), b2, voffB);
            PG8_BAR; PG8_WAIT_L(0); PG8_MMA(0, 1, At, B1); PG8_BAR;
            PG8_LDA(At, 0, 1); PG8_STAGE(PG8_SA(0, 0), a2, voffA);
            PG8_BAR; PG8_WAIT_L(0); PG8_MMA(1, 0, At, B0); PG8_BAR; PG8_SCHED;
            PG8_STAGE(PG8_SB(0, 1), b2 + hstep, voffB);
            PG8_WAIT_V(6); PG8_BAR; PG8_MMA(1, 1, At, B1); PG8_BAR;
            PG8_LDB(B0, 1, 0); PG8_SCHED; PG8_LDA(At, 1, 0); PG8_STAGE(PG8_SA(0, 1), a2 + hstep, voffA);
            PG8_WAIT_L(8); PG8_BAR; PG8_WAIT_L(0); PG8_MMA(0, 0, At, B0); PG8_BAR; PG8_SCHED;
            PG8_LDB(B1, 1, 1); PG8_STAGE(PG8_SB(1, 0), b3, voffB);
            PG8_BAR; PG8_WAIT_L(0); PG8_MMA(0, 1, At, B1); PG8_BAR;
            PG8_LDA(At, 1, 1); PG8_STAGE(PG8_SA(1, 0), a3, voffA);
            PG8_BAR; PG8_WAIT_L(0); PG8_MMA(1, 0, At, B0); PG8_BAR; PG8_SCHED;
            PG8_STAGE(PG8_SB(1, 1), b3 + hstep, voffB);
            PG8_WAIT_V(6); PG8_BAR; PG8_MMA(1, 1, At, B1); PG8_BAR;
            }
        }
        if constexpr (ALIGN_EPI) { if (wr == 0) PG8_BAR; }
        if constexpr (!Epi::AFTER_DRAIN) { E(acc, cur, wr, wc, fr, fq); S.done(cur); }
        if (!has_next) break;
#pragma unroll
        for (int a = 0; a < 2; ++a)
#pragma unroll
            for (int b = 0; b < 2; ++b)
#pragma unroll
                for (int m = 0; m < 4; ++m)
#pragma unroll
                    for (int n = 0; n < 2; ++n) acc[a][b][m][n] = (f32x4){0.f, 0.f, 0.f, 0.f};
        cur = nxt; cA = nA; cB = nB; ++ui;
        if constexpr (ALIGN_EPI) { if (wr == 1) PG8_BAR; }
    }
    PG8_WAIT_V(0);
    if constexpr (!ALIGN_EPI) { if (wr == 0) PG8_BAR; }
    PG8_BAR;
    if constexpr (Epi::AFTER_DRAIN) { E.fused(acc, cur, wr, wc, fr, fq, lds, wid, lane); S.done(cur); }
#undef PG8_SA
#undef PG8_SB
#undef PG8_STAGE
#undef PG8_LDA
#undef PG8_LDB
#undef PG8_MMA
#undef PG8_WAIT_V
#undef PG8_WAIT_L
#undef PG8_BAR
#undef PG8_SCHED
}
}

constexpr int BATCH = 16, SEQ = 4096, DM = 1024, MTOK = BATCH * SEQ;
constexpr int NZ = 3584;
constexpr int ZC_MQ = 0, ZC_MK = 512, ZC_MV = 1024, ZC_MO = 1536, ZC_AQ = 2056, ZC_AKC = 2568, ZC_AVC = 2696, ZC_AKS = 2824, ZC_AVS = 2952, ZC_AKW = 3080, ZC_AVW = 3208;
constexpr int DFF = 2048, PLE = 256, NCMP = 255;
constexpr float EPS = 1e-6f;
constexpr int NWAVES = 8, NTHREADS = 512;
constexpr int LDS_BYTES = 147456;

typedef unsigned short bf16_t;
typedef float f32x4 __attribute__((ext_vector_type(4)));
typedef unsigned u32x4 __attribute__((ext_vector_type(4)));
typedef unsigned u32x2 __attribute__((ext_vector_type(2)));

constexpr size_t MiB = 1u << 20;
constexpr size_t WS_CTL = 0;
constexpr size_t WS_WIN = 1 * MiB, WS_WOUT = 8 * MiB, WS_WUP = 10 * MiB, WS_WDN = 18 * MiB, WS_WPG = 22 * MiB, WS_WPP = 24 * MiB;
constexpr size_t WS_KC = 25 * MiB, WS_VC = 27 * MiB, WS_KCB = 29 * MiB, WS_VCT = 30 * MiB;
constexpr size_t WS_GATES = 32 * MiB, WS_PB = 40 * MiB, WS_XB = 72 * MiB;
constexpr size_t WS_MIX = 200 * MiB, WS_ACT = 200 * MiB;
constexpr size_t WS_Z = 456 * MiB, WS_U = 456 * MiB, WS_PROJ = 456 * MiB;
constexpr size_t WS_RS2 = 968 * MiB, WS_RS3 = 972 * MiB;
constexpr size_t WS_VST = 976 * MiB, WS_VWT = 992 * MiB;
constexpr size_t WS_END = 1008 * MiB;

struct Params { const float* in[22]; float* out; unsigned char* ws; };

__device__ __forceinline__ float bf2f(unsigned u16) { return __uint_as_float(u16 << 16); }
__device__ __forceinline__ float bflo(unsigned w) { return __uint_as_float(w << 16); }
__device__ __forceinline__ float bfhi(unsigned w) { return __uint_as_float(w & 0xffff0000u); }
__device__ __forceinline__ unsigned f2bf(float f) { unsigned u = __float_as_uint(f); return (u + 0x7fffu + ((u >> 16) & 1u)) >> 16; }
__device__ __forceinline__ unsigned pk2(float lo, float hi) { return f2bf(lo) | (f2bf(hi) << 16); }
__device__ __forceinline__ float wave_sum(float v) {
#pragma unroll
    for (int o = 1; o < 64; o <<= 1) v += __shfl_xor(v, o);
    return v;
}
__device__ __forceinline__ float wave_max(float v) {
#pragma unroll
    for (int o = 1; o < 64; o <<= 1) v = fmaxf(v, __shfl_xor(v, o));
    return v;
}
__device__ __forceinline__ float sigmoidf_(float x) { return 1.0f / (1.0f + __expf(-x)); }
__device__ __forceinline__ float log_sigmoidf_(float x) { return fminf(x, 0.f) - log1pf(__expf(-fabsf(x))); }
#define WAVE_LDS_SYNC() asm volatile("s_waitcnt lgkmcnt(0)" ::: "memory")

namespace pg8 {
__device__ __forceinline__ float row_rstd(const float* rs, int row) {
    const f32x4* p = (const f32x4*)(rs + (size_t)row * 16); const f32x4 a = p[0], b = p[1], c = p[2], d = p[3];
    const float s = (((a[0] + a[1]) + (a[2] + a[3])) + ((b[0] + b[1]) + (b[2] + b[3]))) + (((c[0] + c[1]) + (c[2] + c[3])) + ((d[0] + d[1]) + (d[2] + d[3])));
    return 1.0f / sqrtf(s * (1.0f / 1024.0f) + EPS);
}
struct EpiZ {
    static constexpr bool PERM = true, AFTER_DRAIN = false;
    bf16_t* Z; float* gates;
    __device__ __forceinline__ void operator()(const f32x4 (&acc)[2][2][4][2], const Unit& u, int wr, int wc, int fr, int fq) {
        const int row0 = u.pm * BM + wr * 64 + fr; const int col0 = u.pn * BM + wc * 32 + 8 * fq;
#pragma unroll
        for (int ai = 0; ai < 2; ++ai)
#pragma unroll
            for (int m = 0; m < 4; ++m) { const int row = row0 + ai * HALF + m * 16; bf16_t* rowp = Z + (size_t)row * NZ + col0;
#pragma unroll
                for (int bj = 0; bj < 2; ++bj) { const f32x4 v0 = acc[ai][bj][m][0], v1 = acc[ai][bj][m][1];
                    u32x4 w; w.x = cvt_pk_bf16(v0[0], v0[1]); w.y = cvt_pk_bf16(v0[2], v0[3]); w.z = cvt_pk_bf16(v1[0], v1[1]); w.w = cvt_pk_bf16(v1[2], v1[3]);
                    *(u32x4*)(rowp + bj * HALF) = w; }
                if (wc == 0) {
                    if ((u.pn == 8 && fq == 0) || (u.pn == 13 && fq >= 1)) {
                        float* gp = gates + (size_t)row * 32 + 8 * fq;
                        *(f32x4*)(gp) = acc[ai][0][m][0]; *(f32x4*)(gp + 4) = acc[ai][0][m][1];
                    }
                }
            }
    }
};
template <bool ROWSCALE> struct EpiBf {
    static constexpr bool PERM = true, AFTER_DRAIN = false;
    bf16_t* O; int ldc; const float* rs;
    __device__ __forceinline__ void operator()(const f32x4 (&acc)[2][2][4][2], const Unit& u, int wr, int wc, int fr, int fq) {
        const int row0 = u.pm * BM + wr * 64 + fr; const int col0 = u.pn * BM + wc * 32 + 8 * fq;
#pragma unroll
        for (int ai = 0; ai < 2; ++ai)
#pragma unroll
            for (int m = 0; m < 4; ++m) { const int row = row0 + ai * HALF + m * 16; bf16_t* rowp = O + (size_t)row * ldc + col0;
                float sc = 1.f;
                if (ROWSCALE) sc = row_rstd(rs, row);
#pragma unroll
                for (int bj = 0; bj < 2; ++bj) { const f32x4 v0 = acc[ai][bj][m][0] * sc, v1 = acc[ai][bj][m][1] * sc;
                    u32x4 w; w.x = cvt_pk_bf16(v0[0], v0[1]); w.y = cvt_pk_bf16(v0[2], v0[3]); w.z = cvt_pk_bf16(v1[0], v1[1]); w.w = cvt_pk_bf16(v1[2], v1[3]);
                    *(u32x4*)(rowp + bj * HALF) = w; }
            }
    }
};
struct EpiRes {
    static constexpr bool PERM = false, AFTER_DRAIN = false;
    const float* base; float* out; bf16_t* xb; float* rs;
    __device__ __forceinline__ void operator()(const f32x4 (&acc)[2][2][4][2], const Unit& u, int wr, int wc, int fr, int fq) {
        const int col0 = u.pn * BM + wc * 32 + 4 * fq;
#pragma unroll
        for (int ai = 0; ai < 2; ++ai)
#pragma unroll
            for (int m = 0; m < 4; ++m) { const int row = u.pm * BM + ai * HALF + wr * 64 + m * 16 + fr; const size_t off = (size_t)row * DM + col0; float s = 0.f;
#pragma unroll
                for (int bj = 0; bj < 2; ++bj)
#pragma unroll
                    for (int n = 0; n < 2; ++n) { const size_t o2 = off + bj * HALF + n * 16; const f32x4 bs = *(const f32x4*)(base + o2); const f32x4 o = bs + acc[ai][bj][m][n];
                        *(f32x4*)(out + o2) = o; u32x2 w; w.x = cvt_pk_bf16(o[0], o[1]); w.y = cvt_pk_bf16(o[2], o[3]); *(u32x2*)(xb + o2) = w;
                        s += (o[0] * o[0] + o[1] * o[1]) + (o[2] * o[2] + o[3] * o[3]); }
                s += __shfl_xor(s, 16); s += __shfl_xor(s, 32);
                if (fq == 0) rs[(size_t)row * 16 + u.pn * 4 + wc] = s; }
    }
};
struct EpiPle {
    static constexpr bool PERM = false, AFTER_DRAIN = false;
    float* out; const bf16_t* proj; const float* rs;
    __device__ __forceinline__ void operator()(const f32x4 (&acc)[2][2][4][2], const Unit& u, int wr, int wc, int fr, int fq) {
        const int col0 = u.pn * BM + wc * 32 + 4 * fq;
#pragma unroll
        for (int ai = 0; ai < 2; ++ai)
#pragma unroll
            for (int m = 0; m < 4; ++m) { const int row = u.pm * BM + ai * HALF + wr * 64 + m * 16 + fr; const size_t off = (size_t)row * DM + col0;
                const float sc = row_rstd(rs, row);
#pragma unroll
                for (int bj = 0; bj < 2; ++bj)
#pragma unroll
                    for (int n = 0; n < 2; ++n) { const size_t o2 = off + bj * HALF + n * 16; const f32x4 bs = *(const f32x4*)(out + o2); const u32x2 pw = *(const u32x2*)(proj + o2);
                        const f32x4 a = acc[ai][bj][m][n] * sc; f32x4 o;
                        o[0] = bs[0] + sigmoidf_(a[0]) * bflo(pw.x); o[1] = bs[1] + sigmoidf_(a[1]) * bfhi(pw.x); o[2] = bs[2] + sigmoidf_(a[2]) * bflo(pw.y); o[3] = bs[3] + sigmoidf_(a[3]) * bfhi(pw.y);
                        *(f32x4*)(out + o2) = o; }
            }
    }
};
struct PanelOrder {
    int nM, G, c;
    __host__ __device__ void init(int M, int G_, int c_) { nM = M / BM; G = G_; c = c_; }
    __host__ __device__ bool next(int i, Unit& u) const { const int p = c + G * (i >> 2); if (p >= nM) return false; u.pm = p; u.pn = i & 3; return true; }
    __device__ __forceinline__ void a_ready(const Unit&) const {}
    __device__ __forceinline__ void done(const Unit&) const {}
};
}

__device__ __forceinline__ void p0_transpose_item(const float* W, const float* gk, int K, int N, bf16_t* WT, float* scr, int item, int lane) {
    const int nblk = N / 32, kb = item / nblk, nb = item % nblk, k0 = 64 * kb, n0 = 32 * nb;
#pragma unroll 8
    for (int i = 0; i < 32; ++i) { const int kk = 2 * i + (lane >> 5); float w = W[(size_t)(k0 + kk) * N + n0 + (lane & 31)]; if (gk) w *= gk[k0 + kk]; scr[kk * 33 + (lane & 31)] = w; }
    WAVE_LDS_SYNC();
    const int c = lane & 7;
#pragma unroll
    for (int j = 0; j < 4; ++j) { const int n = (lane >> 3) + 8 * j; const float* s = scr + (8 * c) * 33 + n;
        u32x4 o; o.x = pk2(s[0 * 33], s[1 * 33]); o.y = pk2(s[2 * 33], s[3 * 33]); o.z = pk2(s[4 * 33], s[5 * 33]); o.w = pk2(s[6 * 33], s[7 * 33]);
        *(u32x4*)(WT + (size_t)(n0 + n) * K + k0 + 8 * c) = o; }
    WAVE_LDS_SYNC();
}

__device__ __forceinline__ float dot64_bf(const float* qv, const bf16_t* krow) {
    const u32x4* kp = (const u32x4*)krow; float acc = 0.f;
#pragma unroll
    for (int i = 0; i < 8; ++i) { const u32x4 w = kp[i]; const f32x4 q0 = *(const f32x4*)(qv + 8 * i), q1 = *(const f32x4*)(qv + 8 * i + 4);
        acc += q0[0] * bflo(w.x) + q0[1] * bfhi(w.x) + q0[2] * bflo(w.y) + q0[3] * bfhi(w.y) + q1[0] * bflo(w.z) + q1[1] * bfhi(w.z) + q1[2] * bflo(w.w) + q1[3] * bfhi(w.w); }
    return acc;
}
__device__ __forceinline__ float dot64_f(const float* qv, const float* krow) {
    float acc = 0.f;
#pragma unroll
    for (int i = 0; i < 16; ++i) { const f32x4 w = *(const f32x4*)(krow + 4 * i), q = *(const f32x4*)(qv + 4 * i); acc += q[0] * w[0] + q[1] * w[1] + q[2] * w[2] + q[3] * w[3]; }
    return acc;
}

__device__ __forceinline__ void compress_unit_simple(const bf16_t* Z, int zcol, const float* pe, const float* w1, const float* w2, float* outc, bf16_t* kcb, bf16_t* vct, int b, int g, int ng, float* lds_f, int tid) {
    float* tok = lds_f;
    float* pes = lds_f + 144 * 64;
    float* hid = pes + 32 * 64;
    const int n0 = 8 * ng, t0 = 16 * n0;
    for (int i = tid; i < 144 * 64; i += NTHREADS) { const int tt = i >> 6, d = i & 63; const int t = t0 + tt;
        tok[i] = (t < SEQ) ? bf2f(Z[((size_t)b * SEQ + t) * NZ + zcol + g * 64 + d]) : 0.f; }
    for (int i = tid; i < 32 * 64; i += NTHREADS) pes[i] = pe[i];
    __syncthreads();
    const int j = tid & 127, sub = tid >> 7;
    float a0 = 0.f, a1 = 0.f;
    const float* tk0 = tok + (2 * sub) * 16 * 64; const float* tk1 = tk0 + 16 * 64;
    for (int ld = 0; ld < 2048; ++ld) { const float w = w1[(size_t)ld * 128 + j]; const float pv = pes[ld]; a0 += (tk0[ld] + pv) * w; a1 += (tk1[ld] + pv) * w; }
    { const float x0 = a0, x1 = a1;
      hid[(2 * sub) * 128 + j] = 0.5f * x0 * (1.0f + tanhf(0.7978845608028654f * (x0 + 0.044715f * x0 * x0 * x0)));
      hid[(2 * sub + 1) * 128 + j] = 0.5f * x1 * (1.0f + tanhf(0.7978845608028654f * (x1 + 0.044715f * x1 * x1 * x1))); }
    __syncthreads();
    { const int nl = tid >> 6, d = tid & 63; float o = 0.f;
      for (int jj = 0; jj < 128; ++jj) o += hid[nl * 128 + jj] * w2[jj * 64 + d];
      const int n = n0 + nl; if (n < NCMP) outc[(((size_t)b * 2 + g) * 256 + n) * 64 + d] = o;
      const unsigned ob = (n < NCMP) ? f2bf(o) : 0u;
      if (kcb) kcb[(((size_t)b * 2 + g) * 256 + n) * 64 + d] = (bf16_t)ob;
      if (vct) { const int n16 = n & 15; vct[(((size_t)b * 2 + g) * 64 + d) * 256 + (n & ~15) + 8 * ((n16 >> 2) & 1) + (n16 & 3) + 4 * (n16 >> 3)] = (bf16_t)ob; } }
    __syncthreads();
}

struct MixPtrs { const bf16_t* Z; const float* gates; const float* KC; const float* VC; bf16_t* MIX; const float* gate_bias; const float* mnorm_g; };

__device__ __forceinline__ void nsa_token_simple(const MixPtrs& P, int b, int g, int t, float* qs, float* pc, float* pb, int lane) {
    const size_t row = (size_t)b * SEQ + t;
    const bf16_t* zrow = P.Z + row * NZ;
    const bf16_t* zb = P.Z + (size_t)b * SEQ * NZ;
#pragma unroll
    for (int r = 0; r < 4; ++r) qs[r * 64 + lane] = bf2f(zrow[ZC_AQ + (g * 4 + r) * 64 + lane]) * 0.125f;
    WAVE_LDS_SYNC();
    const int nv = (t >= 31) ? min((t - 31) / 16 + 1, NCMP) : 0;
    const float* kc = P.KC + ((size_t)b * 2 + g) * 256 * 64; const float* vc = P.VC + ((size_t)b * 2 + g) * 256 * 64;
    float oc[4], os[4], ow[4];
#pragma unroll 1
    for (int r = 0; r < 4; ++r) {
        const float slope = exp2f(-(float)(g * 4 + r + 1));
        float sv[4]; float mx = -3.0e38f;
#pragma unroll
        for (int i = 0; i < 4; ++i) { const int n = lane + 64 * i; sv[i] = -3.0e38f;
            if (n < nv) { const float s = dot64_f(qs + r * 64, kc + (size_t)n * 64) - slope * (float)(t - (16 * n + 31)); sv[i] = s; mx = fmaxf(mx, s); } }
        mx = wave_max(mx);
        float sum = 0.f;
#pragma unroll
        for (int i = 0; i < 4; ++i) { const int n = lane + 64 * i; float e = 0.f; if (n < nv) e = __expf(sv[i] - mx); sv[i] = e; sum += e; }
        sum = wave_sum(sum);
        const float inv = (nv > 0) ? 1.0f / sum : 0.f;
#pragma unroll
        for (int i = 0; i < 4; ++i) pc[r * 256 + lane + 64 * i] = sv[i] * inv;
        WAVE_LDS_SYNC();
        float a = 0.f;
        for (int n = 0; n < nv; ++n) a += pc[r * 256 + n] * vc[(size_t)n * 64 + lane];
        oc[r] = a;
    }
    unsigned long long selmask;
    {
        float imp = 0.f;
        for (int n = 4 * lane - 1; n <= 4 * lane + 3; ++n) if (n >= 0 && n < NCMP) imp += (pc[n] + pc[256 + n]) + (pc[512 + n] + pc[768 + n]);
        const int cur = t >> 6;
        const bool causal = lane <= cur; const bool forced = (lane == 0) || (lane == cur) || (lane == cur - 1);
        const float score = causal ? (forced ? 1.0e30f : imp) : -1.0e30f;
        int rank = 0;
        for (int i = 0; i < 64; ++i) { const float si = __shfl(score, i); rank += ((si > score) || (si == score && i < lane)) ? 1 : 0; }
        selmask = __ballot(rank < 16);
    }
#pragma unroll 1
    for (int r = 0; r < 4; ++r) {
        const float slope = exp2f(-(float)(g * 4 + r + 1));
        float mx = -3.0e38f; int idx = 0;
        for (unsigned long long mm = selmask; mm; mm &= mm - 1, ++idx) { const int j = __builtin_ctzll(mm); const int pos = 64 * j + lane;
            float s = -1.0e30f;
            if (pos <= t) s = dot64_bf(qs + r * 64, zb + (size_t)pos * NZ + ZC_AKS + g * 64) - slope * (float)(t - pos);
            pb[idx * 64 + lane] = s; mx = fmaxf(mx, s); }
        mx = wave_max(mx);
        float sum = 0.f;
        for (int i = 0; i < 16; ++i) { const float e = __expf(pb[i * 64 + lane] - mx); pb[i * 64 + lane] = e; sum += e; }
        sum = wave_sum(sum);
        WAVE_LDS_SYNC();
        float a = 0.f; idx = 0;
        for (unsigned long long mm = selmask; mm; mm &= mm - 1, ++idx) { const int j = __builtin_ctzll(mm);
            if (64 * j > t) continue;
            const bf16_t* vp = zb + (size_t)(64 * j) * NZ + ZC_AVS + g * 64 + lane;
            for (int l = 0; l < 64; ++l) a += pb[idx * 64 + l] * bf2f(vp[(size_t)l * NZ]); }
        os[r] = a / sum;
        WAVE_LDS_SYNC();
    }
    const int lo = max(0, t - 511);
#pragma unroll 1
    for (int r = 0; r < 4; ++r) {
        const float slope = exp2f(-(float)(g * 4 + r + 1));
        float mx = -3.0e38f;
        for (int i = 0; i < 8; ++i) { const int pos = lo + 64 * i + lane; float s = -1.0e30f;
            if (pos <= t) s = dot64_bf(qs + r * 64, zb + (size_t)pos * NZ + ZC_AKW + g * 64) - slope * (float)(t - pos);
            pb[i * 64 + lane] = s; mx = fmaxf(mx, s); }
        mx = wave_max(mx);
        float sum = 0.f;
        for (int i = 0; i < 8; ++i) { const float e = __expf(pb[i * 64 + lane] - mx); pb[i * 64 + lane] = e; sum += e; }
        sum = wave_sum(sum);
        WAVE_LDS_SYNC();
        float a = 0.f; const int cnt = t - lo + 1;
        const bf16_t* vp = zb + (size_t)lo * NZ + ZC_AVW + g * 64 + lane;
        for (int l = 0; l < cnt; ++l) a += pb[l] * bf2f(vp[(size_t)l * NZ]);
        ow[r] = a / sum;
        WAVE_LDS_SYNC();
    }
    const float* gp = P.gates + row * 32 + 8;
#pragma unroll
    for (int r = 0; r < 4; ++r) { const int hh = g * 4 + r;
        const float o = sigmoidf_(gp[hh * 3 + 0]) * oc[r] + sigmoidf_(gp[hh * 3 + 1]) * os[r] + sigmoidf_(gp[hh * 3 + 2]) * ow[r];
        P.MIX[row * DM + 512 + hh * 64 + lane] = (bf16_t)f2bf(o); }
}

__device__ __forceinline__ void mlstm_unit_simple(const MixPtrs& P, int b, int h, float* lds_f, int tid) {
    float* qs = lds_f;
    float* ks = qs + 64 * 128;
    float* vs = ks + 64 * 128;
    float* hraw = vs + 64 * 128;
    float* red = hraw + 64 * 128;
    float* redn = red + 2 * 4 * 128;
    float* igs = redn + 8;
    float* lfs = igs + 64;
    const int dv = tid & 127, kg = tid >> 7, lane = tid & 63, wave = tid >> 6;
    float C[32], nn[32];
#pragma unroll
    for (int i = 0; i < 32; ++i) { C[i] = 0.f; nn[i] = 0.f; }
    float mst = 0.f;
    const float bi = P.gate_bias[h], bff = P.gate_bias[4 + h];
    const float qscale = 0.08838834764831845f;
#pragma unroll 1
    for (int c = 0; c < SEQ / 64; ++c) {
        const size_t row0 = (size_t)b * SEQ + c * 64;
        for (int i = tid; i < 64 * 128; i += NTHREADS) { const int tt = i >> 7, d = i & 127; const bf16_t* zr = P.Z + (row0 + tt) * NZ + h * 128 + d;
            qs[i] = bf2f(zr[ZC_MQ]) * qscale; ks[i] = bf2f(zr[ZC_MK]); vs[i] = bf2f(zr[ZC_MV]); }
        if (tid < 64) { const float* gr = P.gates + (row0 + tid) * 32; igs[tid] = gr[h] + bi; lfs[tid] = log_sigmoidf_(gr[4 + h] + bff); }
        __syncthreads();
#pragma unroll 1
        for (int t = 0; t < 64; ++t) {
            const float lf = lfs[t], ig = igs[t];
            const float mnew = fmaxf(lf + mst, ig);
            const float fs = __expf(lf + mst - mnew), is = __expf(ig - mnew);
            mst = mnew;
            const float v = vs[t * 128 + dv] * is;
            float pn = 0.f, pd = 0.f;
            const float* kr = ks + t * 128 + kg * 32; const float* qr = qs + t * 128 + kg * 32;
#pragma unroll
            for (int i = 0; i < 32; ++i) { const float kk = kr[i], qq = qr[i];
                C[i] = fs * C[i] + kk * v; nn[i] = fs * nn[i] + is * kk; pn += qq * C[i]; pd += qq * nn[i]; }
            float* rb = red + (t & 1) * 512; float* rn = redn + (t & 1) * 4;
            rb[kg * 128 + dv] = pn; if (dv == 0) rn[kg] = pd;
            __syncthreads();
            if (tid < 128) { const float num = (rb[tid] + rb[128 + tid]) + (rb[256 + tid] + rb[384 + tid]); const float den = (rn[0] + rn[1]) + (rn[2] + rn[3]);
                hraw[t * 128 + tid] = num / fmaxf(fabsf(den), __expf(-mnew)); }
        }
        __syncthreads();
        for (int k = 0; k < 8; ++k) { const int tt = wave * 8 + k; const float h0 = hraw[tt * 128 + lane], h1 = hraw[tt * 128 + 64 + lane];
            const float ss = wave_sum(h0 * h0 + h1 * h1); const float rstd = 1.0f / sqrtf(ss * (1.0f / 128.0f) + EPS);
            const bf16_t* zo = P.Z + (row0 + tt) * NZ + ZC_MO + h * 128;
            const float o0 = h0 * rstd * P.mnorm_g[h * 128 + lane] * sigmoidf_(bf2f(zo[lane])), o1 = h1 * rstd * P.mnorm_g[h * 128 + 64 + lane] * sigmoidf_(bf2f(zo[64 + lane]));
            bf16_t* mo = P.MIX + (row0 + tt) * DM + h * 128;
            mo[lane] = (bf16_t)f2bf(o0); mo[64 + lane] = (bf16_t)f2bf(o1); }
        __syncthreads();
    }
}


typedef short bf16x8 __attribute__((ext_vector_type(8)));
typedef float f32x16 __attribute__((ext_vector_type(16)));
typedef float f32x2_t __attribute__((ext_vector_type(2)));
typedef __bf16 bf16x2_t __attribute__((ext_vector_type(2)));
__device__ __forceinline__ unsigned cvtpk(float lo, float hi) { f32x2_t v = {lo, hi}; bf16x2_t b = __builtin_convertvector(v, bf16x2_t); return __builtin_bit_cast(unsigned, b); }
#define MFMA32(a, b, c) __builtin_amdgcn_mfma_f32_32x32x16_bf16((a), (b), (c), 0, 0, 0)
#define NEG_INF (-__builtin_inff())
constexpr float LOG2E = 1.4426950408889634f;
__device__ __forceinline__ unsigned other_half_u(unsigned v, int hi) { auto rr = __builtin_amdgcn_permlane32_swap(v, v, false, false); return hi ? rr[0] : rr[1]; }
__device__ __forceinline__ float other_half_f(float v, int hi) { return __uint_as_float(other_half_u(__float_as_uint(v), hi)); }
__device__ __forceinline__ float max16(const f32x16& u) {
    float a = fmaxf(fmaxf(u[0], u[1]), fmaxf(u[2], u[3])), b = fmaxf(fmaxf(u[4], u[5]), fmaxf(u[6], u[7]));
    float c = fmaxf(fmaxf(u[8], u[9]), fmaxf(u[10], u[11])), d = fmaxf(fmaxf(u[12], u[13]), fmaxf(u[14], u[15]));
    return fmaxf(fmaxf(a, b), fmaxf(c, d));
}
__device__ __forceinline__ unsigned long long spread_even(unsigned x) {
    unsigned long long s = x;
    s = (s | (s << 16)) & 0x0000FFFF0000FFFFull; s = (s | (s << 8)) & 0x00FF00FF00FF00FFull; s = (s | (s << 4)) & 0x0F0F0F0F0F0F0F0Full;
    s = (s | (s << 2)) & 0x3333333333333333ull; s = (s | (s << 1)) & 0x5555555555555555ull; return s;
}
struct NsaF { const bf16_t* Z; const float* gates; const bf16_t* KCB; const bf16_t* VCT; const bf16_t* VST; const bf16_t* VWT; bf16_t* MIX; };

__device__ __forceinline__ void nsa_load_q(bf16x8 (&qf)[4], const bf16_t* qp) {
    const float QSC = 0.125f * LOG2E;
#pragma unroll
    for (int s = 0; s < 4; ++s) { const u32x4 w = *(const u32x4*)(qp + 16 * s); u32x4 o;
        o.x = cvtpk(bflo(w.x) * QSC, bfhi(w.x) * QSC); o.y = cvtpk(bflo(w.y) * QSC, bfhi(w.y) * QSC); o.z = cvtpk(bflo(w.z) * QSC, bfhi(w.z) * QSC); o.w = cvtpk(bflo(w.w) * QSC, bfhi(w.w) * QSC);
        qf[s] = __builtin_bit_cast(bf16x8, o); }
}
__device__ __forceinline__ f32x16 nsa_st(const bf16_t* kp, const bf16x8 (&qf)[4], const f32x16& cinit) {
    f32x16 acc = MFMA32(*(const bf16x8*)(kp), qf[0], cinit);
    acc = MFMA32(*(const bf16x8*)(kp + 16), qf[1], acc); acc = MFMA32(*(const bf16x8*)(kp + 32), qf[2], acc); acc = MFMA32(*(const bf16x8*)(kp + 48), qf[3], acc);
    return acc;
}
__device__ __forceinline__ void nsa_soft_pv(f32x16& u, float tb, float& M, float& l, f32x16& O0, f32x16& O1, const bf16_t* v0, const bf16_t* v1, int hi) {
    float tm = max16(u); tm = fmaxf(tm, other_half_f(tm, hi));
    const float cand = tm + tb;
    if (__any(cand > M)) { const float mn = fmaxf(M, cand); const float al = __builtin_amdgcn_exp2f(M - mn); l *= al; O0 *= al; O1 *= al; M = mn; }
    const float ms = M - tb; float sum = 0.f;
#pragma unroll
    for (int i = 0; i < 16; ++i) { const float p = __builtin_amdgcn_exp2f(u[i] - ms); u[i] = p; sum += p; }
    l += sum;
    u32x4 a, b2;
    a.x = cvtpk(u[0], u[1]); a.y = cvtpk(u[2], u[3]); a.z = cvtpk(u[4], u[5]); a.w = cvtpk(u[6], u[7]);
    b2.x = cvtpk(u[8], u[9]); b2.y = cvtpk(u[10], u[11]); b2.z = cvtpk(u[12], u[13]); b2.w = cvtpk(u[14], u[15]);
    const bf16x8 p0 = __builtin_bit_cast(bf16x8, a), p1 = __builtin_bit_cast(bf16x8, b2);
    O0 = MFMA32(*(const bf16x8*)(v0), p0, O0); O0 = MFMA32(*(const bf16x8*)(v0 + 16), p1, O0);
    O1 = MFMA32(*(const bf16x8*)(v1), p0, O1); O1 = MFMA32(*(const bf16x8*)(v1 + 16), p1, O1);
}
__device__ __forceinline__ void nsa_mask_lt(f32x16& u, int limh) {
    asm volatile("" : "+v"(limh));
#pragma unroll
    for (int i = 0; i < 16; ++i) { const int c = (i & 3) + 8 * (i >> 2); if (!(c < limh)) u[i] = NEG_INF; }
}
__device__ __forceinline__ void nsa_mask_gt(f32x16& u, int limh) {
    asm volatile("" : "+v"(limh));
#pragma unroll
    for (int i = 0; i < 16; ++i) { const int c = (i & 3) + 8 * (i >> 2); if (!(c > limh)) u[i] = NEG_INF; }
}

__device__ __forceinline__ void nsa_unit_fast(const NsaF& P, int b, int g, int tb, int lane, float* acc_lds) {
    const int tq = lane & 31, hi = lane >> 5, t0 = tb * 32, cur = tb >> 1;
    const size_t rowq = (size_t)b * SEQ + t0 + tq;
    const bf16_t* zq = P.Z + rowq * NZ + ZC_AQ + (g * 4) * 64 + 8 * hi;
    const size_t bg = (size_t)b * 2 + g;
    const bf16_t* kcb_u = P.KCB + bg * 256 * 64; const unsigned koff = (unsigned)(tq * 64 + 8 * hi);
    const bf16_t* vct_u = P.VCT + bg * 64 * 256; const unsigned vcoff = (unsigned)(tq * 256 + 8 * hi);
    const bf16_t* zb_u = P.Z + (size_t)b * SEQ * NZ + g * 64;   const unsigned zoff = (unsigned)(tq * NZ + 8 * hi);
    const bf16_t* vst_u = P.VST + bg * 64 * SEQ; const bf16_t* vwt_u = P.VWT + bg * 64 * SEQ; const unsigned voff = (unsigned)(tq * SEQ + 8 * hi);
    const int nval = max(0, 2 * tb + 1 - (tq < 31 ? 1 : 0) - (tq < 15 ? 1 : 0));
    const int ntc = (2 * tb + 1 + 31) >> 5;
    const int tqh = tq - 4 * hi;
    const float hif = (float)(4 * hi);

    unsigned long long selmask;
    if (cur < 16) selmask = (2ull << cur) - 1ull;
    else {
        float* il = acc_lds + lane;
#pragma unroll
        for (int q = 0; q < 32; ++q) il[64 * q] = 0.f;
#pragma unroll 1
        for (int r = 0; r < 4; ++r) {
            bf16x8 qf[4]; nsa_load_q(qf, zq + r * 64);
            const float slope2 = __builtin_amdgcn_exp2f(-(float)(g * 4 + r + 1)) * LOG2E;
            f32x16 cb;
#pragma unroll
            for (int i = 0; i < 16; ++i) cb[i] = slope2 * 16.0f * ((float)((i & 3) + 8 * (i >> 2)) + hif);
            float M = -1.0e30f, l = 0.f;
#pragma unroll 1
            for (int nt = ntc - 1; nt >= 0; --nt) {
                f32x16 u = nsa_st(kcb_u + nt * 32 * 64 + koff, qf, cb); nsa_mask_lt(u, nval - 32 * nt - 4 * hi);
                const float tbs = slope2 * 512.0f * (float)nt;
                float tm = max16(u); tm = fmaxf(tm, other_half_f(tm, hi));
                const float mn = fmaxf(M, tm + tbs); float sum = 0.f; const float ms = mn - tbs;
#pragma unroll
                for (int i = 0; i < 16; ++i) sum += __builtin_amdgcn_exp2f(u[i] - ms);
                l = l * __builtin_amdgcn_exp2f(M - mn) + sum; M = mn;
            }
            const float lt = l + other_half_f(l, hi); const float linv = lt > 0.f ? 1.0f / lt : 0.f;
            float carry = 0.f;
#pragma unroll 1
            for (int nt = 0; nt < ntc; ++nt) {
                f32x16 u = nsa_st(kcb_u + nt * 32 * 64 + koff, qf, cb); nsa_mask_lt(u, nval - 32 * nt - 4 * hi);
                const float ms = M - slope2 * 512.0f * (float)nt;
#pragma unroll
                for (int i = 0; i < 16; ++i) u[i] = __builtin_amdgcn_exp2f(u[i] - ms) * linv;
                float x[4], qs[4];
#pragma unroll
                for (int gq = 0; gq < 4; ++gq) { qs[gq] = (u[4 * gq] + u[4 * gq + 1]) + (u[4 * gq + 2] + u[4 * gq + 3]); x[gq] = other_half_f(u[4 * gq + 3], hi); }
                float* ip = il + 256 * nt;
                ip[0] += qs[0] + (hi ? x[0] : carry); ip[64] += qs[1] + (hi ? x[1] : x[0]); ip[128] += qs[2] + (hi ? x[2] : x[1]); ip[192] += qs[3] + (hi ? x[3] : x[2]);
                carry = x[3];
            }
        }
        unsigned uu[32];
        const int qlo = hi ? 0 : 1, qhi = (cur - 2 - hi) >> 1;
        const unsigned candm = (unsigned)((2ull << qhi) - 1ull) & ~((1u << qlo) - 1u);
#pragma unroll
        for (int q = 0; q < 32; ++q) uu[q] = __float_as_uint(il[64 * q]) & (unsigned)(-(int)((candm >> q) & 1u));
        unsigned T = 0u;
#pragma unroll 1
        for (int bit = 30; bit >= 0; --bit) { const unsigned c = T | (1u << bit); unsigned cnt = 0;
#pragma unroll
            for (int q = 0; q < 32; ++q) cnt += (uu[q] >= c) ? 1u : 0u;
            cnt += other_half_u(cnt, hi);
            if (cnt >= 13u) T = c; }
        unsigned gtm = 0u, eqm = 0u;
#pragma unroll
        for (int q = 0; q < 32; ++q) { gtm |= (uu[q] > T ? 1u : 0u) << q; eqm |= (uu[q] == T ? 1u : 0u) << q; }
        eqm &= candm;
        const unsigned ogt = other_half_u(gtm, hi), oeq = other_half_u(eqm, hi);
        const unsigned long long fgt = spread_even(hi ? ogt : gtm) | (spread_even(hi ? gtm : ogt) << 1);
        const unsigned long long feq = spread_even(hi ? oeq : eqm) | (spread_even(hi ? eqm : oeq) << 1);
        const int need = 13 - __builtin_popcountll(fgt);
        unsigned long long rem = feq;
#pragma unroll 1
        for (int i = 0; i < 13; ++i) if (i < need) rem &= rem - 1ull;
        selmask = fgt | (feq & ~rem) | 1ull | (3ull << (cur - 1));
    }
    unsigned ulo = (unsigned)selmask, uhi = (unsigned)(selmask >> 32);
#pragma unroll
    for (int o = 1; o < 32; o <<= 1) { ulo |= __shfl_xor(ulo, o); uhi |= __shfl_xor(uhi, o); }
    const unsigned long long U = ((unsigned long long)__builtin_amdgcn_readfirstlane(uhi) << 32) | (unsigned long long)__builtin_amdgcn_readfirstlane(ulo);

    float* al = acc_lds + lane;
#pragma unroll 1
    for (int r = 0; r < 4; ++r) {
        const int hh = g * 4 + r;
        bf16x8 qf[4]; nsa_load_q(qf, zq + r * 64);
        const float slope2 = __builtin_amdgcn_exp2f(-(float)(hh + 1)) * LOG2E;
        f32x16 cb;
#pragma unroll
        for (int i = 0; i < 16; ++i) cb[i] = slope2 * ((float)((i & 3) + 8 * (i >> 2)) + hif);
        const float* gp = P.gates + rowq * 32 + 8 + hh * 3;
        {
            const f32x16 cb16 = cb * 16.0f;
            float M = -1.0e30f, l = 0.f; f32x16 O0, O1;
#pragma unroll
            for (int i = 0; i < 16; ++i) { O0[i] = 0.f; O1[i] = 0.f; }
#pragma unroll 1
            for (int nt = ntc - 1; nt >= 0; --nt) {
                f32x16 u = nsa_st(kcb_u + nt * 32 * 64 + koff, qf, cb16); nsa_mask_lt(u, nval - 32 * nt - 4 * hi);
                const bf16_t* vp = vct_u + 32 * nt + vcoff;
                nsa_soft_pv(u, slope2 * 512.0f * (float)nt, M, l, O0, O1, vp, vp + 32 * 256, hi);
            }
            const float lt = l + other_half_f(l, hi); const float sc = lt > 0.f ? sigmoidf_(gp[0]) / lt : 0.f;
#pragma unroll
            for (int i = 0; i < 16; ++i) { al[64 * i] = O0[i] * sc; al[64 * (16 + i)] = O1[i] * sc; }
        }
        {
            float M = -1.0e30f, l = 0.f; f32x16 O0, O1;
#pragma unroll
            for (int i = 0; i < 16; ++i) { O0[i] = 0.f; O1[i] = 0.f; }
#pragma unroll 1
            for (int j = cur; j >= 0; --j) {
                if (!((U >> j) & 1ull)) continue;
                const bool mine = (selmask >> j) & 1ull;
#pragma unroll 1
                for (int half = 1; half >= 0; --half) {
                    const int kb = 64 * j + 32 * half;
                    if (kb > t0) continue;
                    f32x16 u = nsa_st(zb_u + (size_t)kb * NZ + ZC_AKS + zoff, qf, cb);
                    if (kb == t0) nsa_mask_lt(u, tqh + 1);
                    if (!mine) {
#pragma unroll
                        for (int i = 0; i < 16; ++i) u[i] = NEG_INF; }
                    const bf16_t* vp = vst_u + kb + voff;
                    nsa_soft_pv(u, slope2 * (float)(kb - t0), M, l, O0, O1, vp, vp + 32 * SEQ, hi);
                }
            }
            const float lt = l + other_half_f(l, hi); const float sc = lt > 0.f ? sigmoidf_(gp[1]) / lt : 0.f;
#pragma unroll
            for (int i = 0; i < 16; ++i) { al[64 * i] += O0[i] * sc; al[64 * (16 + i)] += O1[i] * sc; }
        }
        {
            float M = -1.0e30f, l = 0.f; f32x16 O0, O1;
#pragma unroll
            for (int i = 0; i < 16; ++i) { O0[i] = 0.f; O1[i] = 0.f; }
#pragma unroll 1
            for (int i16 = 16; i16 >= 0; --i16) {
                const int kb = t0 - 512 + 32 * i16;
                if (kb < 0) break;
                f32x16 u = nsa_st(zb_u + (size_t)kb * NZ + ZC_AKW + zoff, qf, cb);
                if (i16 == 16) nsa_mask_lt(u, tqh + 1);
                if (i16 == 0) nsa_mask_gt(u, tqh);
                const bf16_t* vp = vwt_u + kb + voff;
                nsa_soft_pv(u, slope2 * (float)(kb - t0), M, l, O0, O1, vp, vp + 32 * SEQ, hi);
            }
            const float lt = l + other_half_f(l, hi); const float sc = lt > 0.f ? sigmoidf_(gp[2]) / lt : 0.f;
            bf16_t* op = P.MIX + rowq * DM + 512 + hh * 64 + 4 * hi;
#pragma unroll
            for (int q4 = 0; q4 < 4; ++q4) {
                float a[4], c[4];
#pragma unroll
                for (int e = 0; e < 4; ++e) { a[e] = al[64 * (4 * q4 + e)] + O0[4 * q4 + e] * sc; c[e] = al[64 * (16 + 4 * q4 + e)] + O1[4 * q4 + e] * sc; }
                u32x2 w0; w0.x = cvtpk(a[0], a[1]); w0.y = cvtpk(a[2], a[3]); *(u32x2*)(op + 8 * q4) = w0;
                u32x2 w1; w1.x = cvtpk(c[0], c[1]); w1.y = cvtpk(c[2], c[3]); *(u32x2*)(op + 32 + 8 * q4) = w1; }
        }
    }
}

__device__ __forceinline__ void vt_unit(const bf16_t* Z, int zcol, bf16_t* VT, int b, int g, int ch, unsigned short* tile  , int tid) {
    { const int pos = tid >> 3, c8 = (tid & 7) * 8;
      const u32x4 w = *(const u32x4*)(Z + ((size_t)b * SEQ + ch * 64 + pos) * NZ + zcol + g * 64 + c8);
      *(u32x4*)(tile + pos * 72 + c8) = w; }
    __syncthreads();
    { const int d = tid >> 3, chunk = tid & 7, gi = chunk >> 1, h = chunk & 1; unsigned short e[8];
#pragma unroll
      for (int j = 0; j < 8; ++j) { const int pos = 16 * gi + 8 * (j >> 2) + 4 * h + (j & 3); e[j] = tile[pos * 72 + d]; }
      u32x4 o; o.x = e[0] | ((unsigned)e[1] << 16); o.y = e[2] | ((unsigned)e[3] << 16); o.z = e[4] | ((unsigned)e[5] << 16); o.w = e[6] | ((unsigned)e[7] << 16);
      *(u32x4*)(VT + (((size_t)b * 2 + g) * 64 + d) * SEQ + ch * 64 + chunk * 8) = o; }
    __syncthreads();
}

#define LAS3 __attribute__((address_space(3)))
constexpr int ML_QC = 0, ML_KC = 17408, ML_KT = 34816, ML_VT = 53248, ML_EG = 71680, ML_N = 71936, ML_SSQ = 72960, ML_CF = 73984, ML_END = 106752;
constexpr int ML_RS = 272, ML_TS = 144;
struct MlF { const bf16_t* Z; const float* gates; bf16_t* MIX; const float* gate_bias; const float* mnorm_g; };

__device__ __forceinline__ float scan_add64(float v, int lane) {
#pragma unroll
    for (int o = 1; o < 64; o <<= 1) { const float t = __shfl_up(v, o); if (lane >= o) v += t; }
    return v;
}
__device__ __forceinline__ float scan_max64(float v, int lane) {
#pragma unroll
    for (int o = 1; o < 64; o <<= 1) { const float t = __shfl_up(v, o); if (lane >= o) v = fmaxf(v, t); }
    return v;
}
__device__ __forceinline__ bf16x8 pack8(const f32x16& x, int s) {
    u32x4 p; p.x = cvtpk(x[8 * s], x[8 * s + 1]); p.y = cvtpk(x[8 * s + 2], x[8 * s + 3]); p.z = cvtpk(x[8 * s + 4], x[8 * s + 5]); p.w = cvtpk(x[8 * s + 6], x[8 * s + 7]);
    return __builtin_bit_cast(bf16x8, p);
}
struct MlScal { float eg, inter_s, rowf_s, floorv, decay, cfac, mnew; };
__device__ __forceinline__ MlScal ml_scalars(float ipre, float fpre, float m, int lane) {
    const float lf = log_sigmoidf_(fpre);
    const float bcs = scan_add64(lf, lane);
    const float bL = __shfl(bcs, 63);
    const float g = ipre - bcs;
    const float pm = scan_max64(g, lane);
    const float gmax = __shfl(pm, 63);
    const float mm = fmaxf(m, pm), mg = fmaxf(m, gmax);
    MlScal s; const float scale = 0.08838834764831845f;
    s.eg = __expf(g - gmax); s.inter_s = __expf(m - mm) * scale; s.rowf_s = __expf(gmax - mm) * scale; s.floorv = __expf(-bcs - mm);
    s.decay = __expf(m - mg); s.cfac = __expf(gmax - mg); s.mnew = bL + mg;
    return s;
}

__device__ __forceinline__ void mlstm_unit_fast(const MlF& P, int b, int h, LAS3 unsigned char* L, int tid) {
    const int lane = tid & 63, wave = __builtin_amdgcn_readfirstlane(tid >> 6), lt = wave >> 2, dvt = wave & 3, tq = lane & 31, hi = lane >> 5;
    const float bi = P.gate_bias[h], bff = P.gate_bias[4 + h];
    const size_t row0 = (size_t)b * SEQ;
    const int ss = tid >> 3, d0 = 8 * (tid & 7);
    const bf16_t* zst = P.Z + (row0 + ss) * NZ + h * 128 + d0;
    const int s16 = ss & 15; const int sperm = (ss & ~15) + 8 * ((s16 >> 2) & 1) + (s16 & 3) + 4 * (s16 >> 3);
    const int offlo = (d0 & ~15) + ((d0 & 8) ? 4 : 0), offhi = (d0 & ~15) + ((d0 & 8) ? 12 : 8);
    const int wv_ = tid >> 6, ltv = wv_ >> 2, dvtv = wv_ & 3;
    const int lrow = 32 * ltv + tq;
    const unsigned a_qc = ML_QC + lrow * ML_RS + 16 * hi, a_kc = ML_KC + tq * ML_RS + 16 * hi, a_cf = ML_CF + (dvtv * 512 + lane) * 16;
    const unsigned a_vt = ML_VT + (32 * dvtv + tq) * ML_TS + 16 * hi, a_kt = ML_KT + (64 * ltv + tq) * ML_TS + 16 * hi, a_eg = ML_EG + 16 * hi, a_n = ML_N + 256 * hi;
    f32x16 C0, C1;
#pragma unroll
    for (int i = 0; i < 16; ++i) { C0[i] = 0.f; C1[i] = 0.f; }
    for (int i = tid; i < 256; i += NTHREADS) ((LAS3 float*)(L + ML_N))[i] = 0.f;
    for (int i = tid; i < 32768 / 16; i += NTHREADS) ((LAS3 u32x4*)(L + ML_CF))[i] = (u32x4){0u, 0u, 0u, 0u};
    float mst = 0.f;
    u32x4 rq[2], rk[2], rv[2]; float gi_, gf_;
#pragma unroll
    for (int p = 0; p < 2; ++p) { rq[p] = *(const u32x4*)(zst + ZC_MQ + 64 * p); rk[p] = *(const u32x4*)(zst + ZC_MK + 64 * p); rv[p] = *(const u32x4*)(zst + ZC_MV + 64 * p); }
    { const float* gr = P.gates + (row0 + lane) * 32; gi_ = gr[h] + bi; gf_ = gr[4 + h] + bff; }
    MlScal sc = ml_scalars(gi_, gf_, mst, lane);
#define ML_STAGE() do { \
        const float egs = __shfl(sc.eg, ss); const float cf = sc.cfac; \
        _Pragma("unroll") for (int p = 0; p < 2; ++p) { \
            *(LAS3 u32x2*)(L + ML_QC + ss * ML_RS + (offlo + 64 * p) * 2) = (u32x2){rq[p].x, rq[p].y}; *(LAS3 u32x2*)(L + ML_QC + ss * ML_RS + (offhi + 64 * p) * 2) = (u32x2){rq[p].z, rq[p].w}; \
            *(LAS3 u32x2*)(L + ML_KC + ss * ML_RS + (offlo + 64 * p) * 2) = (u32x2){rk[p].x, rk[p].y}; *(LAS3 u32x2*)(L + ML_KC + ss * ML_RS + (offhi + 64 * p) * 2) = (u32x2){rk[p].z, rk[p].w}; \
            const unsigned kw[4] = {rk[p].x, rk[p].y, rk[p].z, rk[p].w}; const unsigned vw[4] = {rv[p].x, rv[p].y, rv[p].z, rv[p].w}; \
            _Pragma("unroll") for (int e = 0; e < 4; ++e) { const int d = d0 + 64 * p + 2 * e; \
                *(LAS3 unsigned short*)(L + ML_KT + d * ML_TS + sperm * 2) = (unsigned short)f2bf(bflo(kw[e]) * cf); *(LAS3 unsigned short*)(L + ML_KT + (d + 1) * ML_TS + sperm * 2) = (unsigned short)f2bf(bfhi(kw[e]) * cf); \
                *(LAS3 unsigned short*)(L + ML_VT + d * ML_TS + sperm * 2) = (unsigned short)f2bf(bflo(vw[e]) * egs); *(LAS3 unsigned short*)(L + ML_VT + (d + 1) * ML_TS + sperm * 2) = (unsigned short)f2bf(bfhi(vw[e]) * egs); } } \
        if (wave == 0) ((LAS3 float*)(L + ML_EG))[lane] = sc.eg; } while (0)
    __syncthreads();
    ML_STAGE();
    float inter_s = __shfl(sc.inter_s, lrow), rowf_s = __shfl(sc.rowf_s, lrow), floorv = __shfl(sc.floorv, lrow), decay = sc.decay, cfac_n = sc.cfac;
    mst = sc.mnew;
#pragma unroll 1
    for (int c = 0; c < SEQ / 64; ++c) {
        __syncthreads();
        const bool more = (c + 1 < SEQ / 64);
        if (more) { const bf16_t* zn = zst + (size_t)(c + 1) * 64 * NZ;
#pragma unroll
            for (int p = 0; p < 2; ++p) { rq[p] = *(const u32x4*)(zn + ZC_MQ + 64 * p); rk[p] = *(const u32x4*)(zn + ZC_MK + 64 * p); rv[p] = *(const u32x4*)(zn + ZC_MV + 64 * p); }
            const float* gr = P.gates + (row0 + (size_t)(c + 1) * 64 + lane) * 32; gi_ = gr[h] + bi; gf_ = gr[4 + h] + bff; }
        const size_t orow = row0 + (size_t)c * 64 + lrow;
        u32x2 mo[4];
#pragma unroll
        for (int q = 0; q < 4; ++q) mo[q] = *(const u32x2*)(P.Z + orow * NZ + ZC_MO + h * 128 + 32 * dvtv + 8 * q + 4 * hi);
        bf16x8 qf[8];
#pragma unroll
        for (int kk = 0; kk < 8; ++kk) qf[kk] = *(const LAS3 bf16x8*)(L + a_qc + 32 * kk);
        float den = 0.f;
        bf16x8 xf[4];
        f32x16 z16;
#pragma unroll
        for (int i = 0; i < 16; ++i) z16[i] = 0.f;
#pragma unroll
        for (int st = 0; st < 2; ++st) {
            if (st <= lt) {
                f32x16 X = z16;
#pragma unroll
                for (int kk = 0; kk < 8; ++kk) X = MFMA32(*(const LAS3 bf16x8*)(L + a_kc + 32 * st * ML_RS + 32 * kk), qf[kk], X);
                const bool diag = (st == lt);
                int tqo = tq - 4 * hi; asm volatile("" : "+v"(tqo));
                float dsum = 0.f;
#pragma unroll
                for (int q = 0; q < 4; ++q) { const f32x4 e4 = *(const LAS3 f32x4*)(L + a_eg + (32 * st + 8 * q) * 4);
#pragma unroll
                    for (int e = 0; e < 4; ++e) { const int i = 4 * q + e; float x = X[i] * rowf_s; if (diag && (8 * q + e > tqo)) x = 0.f; X[i] = x; dsum += x * e4[e]; } }
                den += dsum;
                xf[2 * st] = pack8(X, 0); xf[2 * st + 1] = pack8(X, 1);
            }
        }
        den += other_half_f(den, hi);
        f32x16 acc = z16;
#pragma unroll
        for (int kk = 0; kk < 8; ++kk) acc = MFMA32(*(const LAS3 bf16x8*)(L + a_cf + kk * 1024), qf[kk], acc);
        float qn = 0.f;
        { const unsigned an = a_n + (c & 1) * 512; const unsigned aq = a_qc + 112 * hi;
#pragma unroll
          for (int k8 = 0; k8 < 8; ++k8) { const u32x4 w = *(const LAS3 u32x4*)(L + aq + 16 * k8); const f32x4 n0 = *(const LAS3 f32x4*)(L + an + 32 * k8), n1 = *(const LAS3 f32x4*)(L + an + 32 * k8 + 16);
              qn += bflo(w.x) * n0[0] + bfhi(w.x) * n0[1] + bflo(w.y) * n0[2] + bfhi(w.y) * n0[3] + bflo(w.z) * n1[0] + bfhi(w.z) * n1[1] + bflo(w.w) * n1[2] + bfhi(w.w) * n1[3]; } }
        qn += other_half_f(qn, hi);
        acc *= inter_s;
        bf16x8 vf[4];
#pragma unroll
        for (int s4 = 0; s4 < 4; ++s4) vf[s4] = *(const LAS3 bf16x8*)(L + a_vt + 32 * s4);
#pragma unroll
        for (int s4 = 0; s4 < 4; ++s4) if ((s4 >> 1) <= lt) acc = MFMA32(vf[s4], xf[s4], acc);
        den = inter_s * qn + den;
        const float inv = 1.0f / fmaxf(fabsf(den), floorv);
        float ssq = 0.f;
#pragma unroll
        for (int i = 0; i < 16; ++i) { acc[i] *= inv; ssq += acc[i] * acc[i]; }
        ssq += other_half_f(ssq, hi);
        if (hi == 0) *(LAS3 float*)(L + ML_SSQ + (dvtv * 64 + lrow) * 4) = ssq;
        C0 *= decay; C1 *= decay;
#pragma unroll
        for (int s4 = 0; s4 < 4; ++s4) {
            C0 = MFMA32(*(const LAS3 bf16x8*)(L + a_kt + 32 * s4), vf[s4], C0);
            C1 = MFMA32(*(const LAS3 bf16x8*)(L + a_kt + 32 * ML_TS + 32 * s4), vf[s4], C1); }
        if (tid < 128) { const int d16 = tid & 15; const int dperm = (tid & ~15) + 8 * ((d16 >> 2) & 1) + (d16 & 3) + 4 * (d16 >> 3);
            float a = 0.f;
            for (int s = 0; s < 64; ++s) a += ((const LAS3 float*)(L + ML_EG))[s] * bf2f(*(const LAS3 unsigned short*)(L + ML_KC + s * ML_RS + dperm * 2));
            LAS3 float* nn = (LAS3 float*)(L + ML_N);
            nn[((c + 1) & 1) * 128 + dperm] = decay * nn[(c & 1) * 128 + dperm] + cfac_n * a; }
        __syncthreads();
        { const LAS3 float* sq = (const LAS3 float*)(L + ML_SSQ + lrow * 4); const float ss4 = (sq[0] + sq[64]) + (sq[128] + sq[192]);
          const float rstd = 1.0f / sqrtf(ss4 * (1.0f / 128.0f) + EPS);
          bf16_t* op = P.MIX + orow * DM + h * 128 + 32 * dvtv + 4 * hi;
#pragma unroll
          for (int q = 0; q < 4; ++q) { const f32x4 gg = *(const f32x4*)(P.mnorm_g + h * 128 + 32 * dvtv + 8 * q + 4 * hi);
              const float o0 = acc[4 * q] * rstd * gg[0] * sigmoidf_(bflo(mo[q].x)), o1 = acc[4 * q + 1] * rstd * gg[1] * sigmoidf_(bfhi(mo[q].x));
              const float o2 = acc[4 * q + 2] * rstd * gg[2] * sigmoidf_(bflo(mo[q].y)), o3 = acc[4 * q + 3] * rstd * gg[3] * sigmoidf_(bfhi(mo[q].y));
              u32x2 w; w.x = cvtpk(o0, o1); w.y = cvtpk(o2, o3); *(u32x2*)(op + 8 * q) = w; } }
        { const unsigned aw = a_cf + ltv * 4096;
          *(LAS3 bf16x8*)(L + aw) = pack8(C0, 0); *(LAS3 bf16x8*)(L + aw + 1024) = pack8(C0, 1); *(LAS3 bf16x8*)(L + aw + 2048) = pack8(C1, 0); *(LAS3 bf16x8*)(L + aw + 3072) = pack8(C1, 1); }
        if (more) {
            sc = ml_scalars(gi_, gf_, mst, lane);
            ML_STAGE();
            inter_s = __shfl(sc.inter_s, lrow); rowf_s = __shfl(sc.rowf_s, lrow); floorv = __shfl(sc.floorv, lrow); decay = sc.decay; cfac_n = sc.cfac; mst = sc.mnew;
        }
    }
#undef ML_STAGE
    __syncthreads();
}

__global__ void __launch_bounds__(NTHREADS, 2) fwd_kernel(Params prm) {
    extern __shared__ __attribute__((aligned(16))) unsigned char lds[];
    cg::grid_group grid = cg::this_grid();
    PG8_LAS unsigned char* ldsl = (PG8_LAS unsigned char*)lds;
    float* lds_f = (float*)lds;
#define TID ((int)threadIdx.x)
#define LANE ((int)(threadIdx.x & 63))
#define WAVE (__builtin_amdgcn_readfirstlane((int)(threadIdx.x >> 6)))
#define GRIDN ((int)gridDim.x)
#define BX ((int)blockIdx.x)
#define WSP(T, name, off) T* name; { unsigned char* w_ = prm.ws; asm volatile("" : "+s"(w_)); name = (T*)(w_ + (off)); }

    {
        const int lane = LANE, wave = WAVE, G = GRIDN, bx = BX, tid = TID; const int gw = bx * NWAVES + wave, NGW = G * NWAVES;
        WSP(bf16_t, Win_t, WS_WIN) WSP(bf16_t, Wout_t, WS_WOUT) WSP(bf16_t, Wup_t, WS_WUP) WSP(bf16_t, Wdn_t, WS_WDN) WSP(bf16_t, Wpg_t, WS_WPG) WSP(bf16_t, Wpp_t, WS_WPP)
        WSP(bf16_t, XB, WS_XB) WSP(bf16_t, PB, WS_PB)
        const float* x = prm.in[0]; const float* pin = prm.in[1];
        float* scr = lds_f + wave * 4096;
        constexpr int I_IN = (DM / 64) * (3360 / 32), I_OUT = (DM / 64) * (DM / 32), I_UP = (DM / 64) * (4096 / 32), I_DN = (DFF / 64) * (DM / 32), I_PG = I_OUT, I_PP = (PLE / 64) * (DM / 32);
        constexpr int NITEMS = I_IN + I_OUT + I_UP + I_DN + I_PG + I_PP;
        for (int it = gw; it < NITEMS; it += NGW) {
            int r = it;
            if (r < I_IN) { p0_transpose_item(prm.in[3], nullptr, DM, 3360, Win_t, scr, r, lane); continue; } r -= I_IN;
            if (r < I_OUT) { p0_transpose_item(prm.in[12], nullptr, DM, DM, Wout_t, scr, r, lane); continue; } r -= I_OUT;
            if (r < I_UP) { p0_transpose_item(prm.in[14], prm.in[13], DM, 4096, Wup_t, scr, r, lane); continue; } r -= I_UP;
            if (r < I_DN) { p0_transpose_item(prm.in[17], nullptr, DFF, DM, Wdn_t, scr, r, lane); continue; } r -= I_DN;
            if (r < I_PG) { p0_transpose_item(prm.in[19], prm.in[18], DM, DM, Wpg_t, scr, r, lane); continue; } r -= I_PG;
            p0_transpose_item(prm.in[20], nullptr, PLE, DM, Wpp_t, scr, r, lane);
        }
        for (int i = bx * NTHREADS + tid; i < (NZ - 3360) * DM / 8; i += G * NTHREADS) ((u32x4*)(Win_t + (size_t)3360 * DM))[i] = (u32x4){0u, 0u, 0u, 0u};
        const float* g1 = prm.in[2];
        f32x4 gv[4];
#pragma unroll
        for (int j = 0; j < 4; ++j) gv[j] = ((const f32x4*)g1)[lane + 64 * j];
        for (int m = gw; m < MTOK; m += NGW) {
            const f32x4* xr = (const f32x4*)(x + (size_t)m * DM) + lane; f32x4 v[4]; float s = 0.f;
#pragma unroll
            for (int j = 0; j < 4; ++j) { v[j] = xr[64 * j]; s += (v[j][0] * v[j][0] + v[j][1] * v[j][1]) + (v[j][2] * v[j][2] + v[j][3] * v[j][3]); }
            const float rstd = 1.0f / sqrtf(wave_sum(s) * (1.0f / DM) + EPS);
            u32x2* o8 = (u32x2*)(XB + (size_t)m * DM) + lane;
#pragma unroll
            for (int j = 0; j < 4; ++j) { u32x2 w; w.x = pk2(v[j][0] * rstd * gv[j][0], v[j][1] * rstd * gv[j][1]); w.y = pk2(v[j][2] * rstd * gv[j][2], v[j][3] * rstd * gv[j][3]); o8[64 * j] = w; }
        }
        for (size_t i = (size_t)bx * NTHREADS + tid; i < (size_t)MTOK * PLE / 8; i += (size_t)G * NTHREADS) {
            const f32x4 a = ((const f32x4*)pin)[2 * i], c = ((const f32x4*)pin)[2 * i + 1];
            u32x4 w; w.x = pk2(a[0], a[1]); w.y = pk2(a[2], a[3]); w.z = pk2(c[0], c[1]); w.w = pk2(c[2], c[3]); ((u32x4*)PB)[i] = w; }
    }
    grid.sync();

    {
        WSP(bf16_t, XB, WS_XB) WSP(bf16_t, Win_t, WS_WIN) WSP(bf16_t, Z, WS_Z) WSP(float, GATES, WS_GATES)
        pg8::Gemm g{XB, Win_t, MTOK, NZ, DM}; pg8::StaticOrder S; S.init(MTOK, NZ, GRIDN, BX);
        pg8::EpiZ E{Z, GATES};
        pg8::gemm_phase<pg8::EpiZ, pg8::StaticOrder, true, true>(ldsl, g, S, E);
    }
    grid.sync();

    {
        WSP(bf16_t, Z, WS_Z) WSP(float, KC, WS_KC) WSP(float, VC, WS_VC) WSP(bf16_t, KCB, WS_KCB) WSP(bf16_t, VCT, WS_VCT) WSP(bf16_t, VST, WS_VST) WSP(bf16_t, VWT, WS_VWT)
        for (int un = BX; un < 2 * BATCH * 2 * 32; un += GRIDN) {
            const int kv = un & 1, ng = (un >> 1) & 31, g = (un >> 6) & 1, b = un >> 7;
            if (kv == 0) compress_unit_simple(Z, ZC_AKC, prm.in[6], prm.in[8], prm.in[9], KC, KCB, nullptr, b, g, ng, lds_f, TID);
            else         compress_unit_simple(Z, ZC_AVC, prm.in[7], prm.in[10], prm.in[11], VC, nullptr, VCT, b, g, ng, lds_f, TID);
        }
        for (int un = BX; un < BATCH * 2 * 2 * 64; un += GRIDN) {
            const int ch = un & 63, br = (un >> 6) & 1, g = (un >> 7) & 1, b = un >> 8;
            vt_unit(Z, br ? ZC_AVW : ZC_AVS, br ? VWT : VST, b, g, ch, (unsigned short*)lds, TID);
        }
    }
    grid.sync();

    {
        WSP(bf16_t, Z, WS_Z) WSP(float, KC, WS_KC) WSP(float, VC, WS_VC) WSP(float, GATES, WS_GATES) WSP(bf16_t, MIX, WS_MIX)
        {
            MlF MP{Z, GATES, MIX, prm.in[4], prm.in[5]};
            for (int un = BX; un < BATCH * 4; un += GRIDN) mlstm_unit_fast(MP, un >> 2, un & 3, (LAS3 unsigned char*)lds, TID);
        }
        __syncthreads();
        {
            WSP(bf16_t, KCB, WS_KCB) WSP(bf16_t, VCT, WS_VCT) WSP(bf16_t, VST, WS_VST) WSP(bf16_t, VWT, WS_VWT)
            NsaF NP{Z, GATES, KCB, VCT, VST, VWT, MIX};
            const int lane = LANE; const int gw = BX * NWAVES + WAVE, NGW = GRIDN * NWAVES;
            for (int un = gw; un < BATCH * 2 * (SEQ / 32); un += NGW) { const int tb = 127 - (un >> 5), g = un & 1, b = (un >> 1) & 15;
                nsa_unit_fast(NP, b, g, tb, lane, lds_f + WAVE * 2048); }
        }
    }
    grid.sync();

    {
        WSP(bf16_t, MIX, WS_MIX) WSP(bf16_t, Wout_t, WS_WOUT) WSP(bf16_t, XB, WS_XB) WSP(float, RS2, WS_RS2)
        pg8::Gemm g{MIX, Wout_t, MTOK, DM, DM}; pg8::PanelOrder S; S.init(MTOK, GRIDN, BX);
        pg8::EpiRes E{prm.in[0], prm.out, XB, RS2};
        pg8::gemm_phase<pg8::EpiRes, pg8::PanelOrder, true, true>(ldsl, g, S, E);
    }
    grid.sync();

    {
        WSP(bf16_t, XB, WS_XB) WSP(bf16_t, Wup_t, WS_WUP) WSP(bf16_t, U, WS_U) WSP(float, RS2, WS_RS2)
        pg8::Gemm g{XB, Wup_t, MTOK, 4096, DM}; pg8::StaticOrder S; S.init(MTOK, 4096, GRIDN, BX);
        pg8::EpiBf<true> E{U, 4096, RS2};
        pg8::gemm_phase<pg8::EpiBf<true>, pg8::StaticOrder, true, true>(ldsl, g, S, E);
    }
    grid.sync();

    {
        WSP(bf16_t, U, WS_U) WSP(bf16_t, ACT, WS_ACT)
        const float* cw = prm.in[15]; const float* cb = prm.in[16];
        for (size_t it = (size_t)BX * NTHREADS + TID; it < (size_t)MTOK * 256; it += (size_t)GRIDN * NTHREADS) {
            const size_t row = it >> 8; const int c8 = (int)(it & 255) * 8; const int t = (int)(row & (SEQ - 1));
            const bf16_t* u0 = U + row * 4096 + c8;
            const u32x4 z4 = (u32x4){0u, 0u, 0u, 0u};
            const u32x4 g2 = *(const u32x4*)u0; const u32x4 g1 = (t >= 1) ? *(const u32x4*)(u0 - 4096) : z4; const u32x4 g0 = (t >= 2) ? *(const u32x4*)(u0 - 8192) : z4;
            const u32x4 vv = *(const u32x4*)(u0 + 2048);
            float G0[8] = {bflo(g0.x), bfhi(g0.x), bflo(g0.y), bfhi(g0.y), bflo(g0.z), bfhi(g0.z), bflo(g0.w), bfhi(g0.w)};
            float G1[8] = {bflo(g1.x), bfhi(g1.x), bflo(g1.y), bfhi(g1.y), bflo(g1.z), bfhi(g1.z), bflo(g1.w), bfhi(g1.w)};
            float G2[8] = {bflo(g2.x), bfhi(g2.x), bflo(g2.y), bfhi(g2.y), bflo(g2.z), bfhi(g2.z), bflo(g2.w), bfhi(g2.w)};
            float V[8] = {bflo(vv.x), bfhi(vv.x), bflo(vv.y), bfhi(vv.y), bflo(vv.z), bfhi(vv.z), bflo(vv.w), bfhi(vv.w)};
            float A[8];
#pragma unroll
            for (int j = 0; j < 8; ++j) { const float cv = cw[c8 + j] * G0[j] + cw[DFF + c8 + j] * G1[j] + cw[2 * DFF + c8 + j] * G2[j] + cb[c8 + j]; A[j] = cv * sigmoidf_(cv) * V[j]; }
            u32x4 w; w.x = pk2(A[0], A[1]); w.y = pk2(A[2], A[3]); w.z = pk2(A[4], A[5]); w.w = pk2(A[6], A[7]);
            *(u32x4*)(ACT + row * DFF + c8) = w;
        }
    }
    grid.sync();

    {
        WSP(bf16_t, ACT, WS_ACT) WSP(bf16_t, Wdn_t, WS_WDN) WSP(bf16_t, XB, WS_XB) WSP(float, RS3, WS_RS3)
        pg8::Gemm g{ACT, Wdn_t, MTOK, DM, DFF}; pg8::PanelOrder S; S.init(MTOK, GRIDN, BX);
        pg8::EpiRes E{prm.out, prm.out, XB, RS3};
        pg8::gemm_phase<pg8::EpiRes, pg8::PanelOrder, true, true>(ldsl, g, S, E);
    }
    {
        WSP(bf16_t, PB, WS_PB) WSP(bf16_t, Wpp_t, WS_WPP) WSP(bf16_t, PROJ, WS_PROJ)
        pg8::Gemm g{PB, Wpp_t, MTOK, DM, PLE}; pg8::StaticOrder S; S.init(MTOK, DM, GRIDN, BX);
        pg8::EpiBf<false> E{PROJ, DM, nullptr};
        pg8::gemm_phase<pg8::EpiBf<false>, pg8::StaticOrder, true, true>(ldsl, g, S, E);
    }
    grid.sync();

    {
        WSP(bf16_t, XB, WS_XB) WSP(bf16_t, Wpg_t, WS_WPG) WSP(bf16_t, PROJ, WS_PROJ) WSP(float, RS3, WS_RS3)
        pg8::Gemm g{XB, Wpg_t, MTOK, DM, DM}; pg8::PanelOrder S; S.init(MTOK, GRIDN, BX);
        pg8::EpiPle E{prm.out, PROJ, RS3};
        pg8::gemm_phase<pg8::EpiPle, pg8::PanelOrder, true, true>(ldsl, g, S, E);
    }
    grid.sync();

    {
        const int lane = LANE; const int gw = BX * NWAVES + WAVE, NGW = GRIDN * NWAVES;
        const float* fg = prm.in[21]; float* out = prm.out;
        f32x4 gv[4];
#pragma unroll
        for (int j = 0; j < 4; ++j) gv[j] = ((const f32x4*)fg)[lane + 64 * j];
        for (int m = gw; m < MTOK; m += NGW) {
            f32x4* xr = (f32x4*)(out + (size_t)m * DM) + lane; f32x4 v[4]; float s = 0.f;
#pragma unroll
            for (int j = 0; j < 4; ++j) { v[j] = xr[64 * j]; s += (v[j][0] * v[j][0] + v[j][1] * v[j][1]) + (v[j][2] * v[j][2] + v[j][3] * v[j][3]); }
            const float rstd = 1.0f / sqrtf(wave_sum(s) * (1.0f / DM) + EPS);
#pragma unroll
            for (int j = 0; j < 4; ++j) xr[64 * j] = v[j] * rstd * gv[j];
        }
    }
}

extern "C" void kernel_launch(void* const* d_in, const int* in_sizes, int n_in, void* d_out, int out_size, void* d_ws, size_t ws_size, hipStream_t stream) {
    static int grid = 0;
    if (grid == 0) {
        if (n_in != 22 || out_size != MTOK * DM || ws_size < WS_END) { fprintf(stderr, "kernel_launch: unexpected problem (n_in %d, out %d, ws %zu)\n", n_in, out_size, ws_size); grid = -1; return; }
        int dev = 0, cus = 0, per_cu = 0;
        if (hipGetDevice(&dev) != hipSuccess || hipDeviceGetAttribute(&cus, hipDeviceAttributeMultiprocessorCount, dev) != hipSuccess) { grid = -1; return; }
        if (hipFuncSetAttribute((const void*)fwd_kernel, hipFuncAttributeMaxDynamicSharedMemorySize, LDS_BYTES) != hipSuccess) { fprintf(stderr, "kernel_launch: hipFuncSetAttribute failed\n"); grid = -1; return; }
        if (hipOccupancyMaxActiveBlocksPerMultiprocessor(&per_cu, (const void*)fwd_kernel, NTHREADS, LDS_BYTES) != hipSuccess || per_cu < 1) { fprintf(stderr, "kernel_launch: occupancy query says %d\n", per_cu); (void)hipGetLastError(); per_cu = 1; }
        grid = cus * 1;
    }
    if (grid < 0) return;
    Params p{};
    for (int i = 0; i < 22; ++i) p.in[i] = (const float*)d_in[i];
    p.out = (float*)d_out; p.ws = (unsigned char*)d_ws;
    void* args[] = {&p};
    hipError_t e = hipLaunchCooperativeKernel((const void*)fwd_kernel, dim3(grid), dim3(NTHREADS), args, LDS_BYTES, stream);
    if (e != hipSuccess) fprintf(stderr, "kernel_launch: cooperative launch failed: %s (grid %d)\n", hipGetErrorString(e), grid);
}
```

```cpp
#include <hip/hip_runtime.h>
#include <hip/hip_cooperative_groups.h>
#include <cstdio>
#include <cstdint>
namespace cg = cooperative_groups;
namespace pg8 {
#define PG8_LAS __attribute__((address_space(3)))
typedef unsigned short bf16_t;
typedef short bf16x8 __attribute__((ext_vector_type(8)));
typedef float f32x4 __attribute__((ext_vector_type(4)));
typedef unsigned u32x4 __attribute__((ext_vector_type(4)));
constexpr int BM = 256, BK = 64, HALF = 128, HTB = HALF * BK * 2  , STAGE_BYTES = 8 * HTB, NXCD = 8, WGM = 8;

__host__ __device__ __forceinline__ int lds_byte(int r, int c) { const int st = (r >> 4) * 2 + (c >> 5), rr = r & 15, cc = c & 31, ob = rr * 64 + cc * 2; return st * 1024 + (ob ^ (((ob >> 9) & 1) << 5)); }
__host__ __device__ __forceinline__ void stage_rc(int b, int& R, int& C) { const int st = b / 1024, sb = b % 1024, swz = sb ^ (((sb >> 9) & 1) << 5); R = (st >> 1) * 16 + swz / 64; C = (st & 1) * 32 + (swz % 64) / 2; }
__host__ __device__ __forceinline__ int perm32(int rho) { const int n = rho >> 4, i = rho & 15; return 8 * (i >> 2) + 4 * n + (i & 3); }

struct Unit { int pm, pn; };
struct Gemm { const bf16_t* A; const bf16_t* Bt; int M, N, K; int lda, kstepA; };

struct StaticOrder {
    int nM, nN, nwg, G, c;
    __host__ __device__ void init(int M, int N, int G_, int c_) { nM = M / BM; nN = N / BM; nwg = nM * nN; G = G_; c = c_; }
    __host__ __device__ bool next(int i, Unit& u) const {
        const long L = (long)i * G + c; if (L >= nwg) return false;
        int wgid = (int)L; { const int q = nwg / NXCD, r = nwg % NXCD, xcd = wgid % NXCD, off = wgid / NXCD; wgid = (xcd < r ? xcd * (q + 1) : r * (q + 1) + (xcd - r) * q) + off; }
        const int nig = WGM * nN, gid = wgid / nig, fm = gid * WGM, gsz = (nM - fm) < WGM ? (nM - fm) : WGM;
        u.pm = fm + ((wgid % nig) % gsz); u.pn = (wgid % nig) / gsz; return true;
    }
    __device__ __forceinline__ void a_ready(const Unit&) const {}
    __device__ __forceinline__ void done(const Unit&) const {}
    __device__ __forceinline__ const char* a_tile(const Gemm& g, const Unit& u, size_t tstepA) const { return (const char*)g.A + (size_t)u.pm * tstepA; }
    __device__ __forceinline__ const char* b_tile(const Gemm& g, const Unit& u, size_t tstepB) const { return (const char*)g.Bt + (size_t)u.pn * tstepB; }
};

__device__ __forceinline__ unsigned cvt_pk_bf16(float lo, float hi) { unsigned r; asm volatile("v_cvt_pk_bf16_f32 %0, %1, %2" : "=v"(r) : "v"(lo), "v"(hi)); return r; }
typedef float f32x2 __attribute__((ext_vector_type(2)));
__device__ __forceinline__ f32x2 gelu_pk(f32x2 v) {
    const f32x2 av = __builtin_elementwise_abs(v), d = av * 0.2316418882f + 1.0f;
    f32x2 t; t.x = __builtin_amdgcn_rcpf(d.x); t.y = __builtin_amdgcn_rcpf(d.y);
    f32x2 q = t * 0.5307027145f + (-0.7265760135f); q = q * t + 0.7107068705f; q = q * t + (-0.142248368f); q = q * t + 0.127414796f; q = q * t;
    const f32x2 s = (v * v) * (-0.72134752044f);
    f32x2 e; e.x = __builtin_amdgcn_exp2f(s.x); e.y = __builtin_amdgcn_exp2f(s.y);
    const f32x2 m = v * (q * e), r = v - m;
    f32x2 o; o.x = v.x < 0.f ? m.x : r.x; o.y = v.y < 0.f ? m.y : r.y; return o;
}

template <int ACT  > struct EpiBf16 {
    static constexpr bool PERM = true, AFTER_DRAIN = false; static_assert(ACT == 0 || ACT == 1, "EpiBf16: ACT is 0 (none) or 1 (gelu_pk)");
    bf16_t* O; int ldc; const float* bias; int split_cols; size_t split_stride; float scale0;
    __device__ __forceinline__ void operator()(const f32x4 (&acc)[2][2][4][2], const Unit& u, int wr, int wc, int fr, int fq) const {
        const int row0 = u.pm * BM + wr * 64 + fr; int colt = u.pn * BM; bf16_t* base = O;
        float sc = 1.f; if (split_cols) { const int t = colt / split_cols; base += (size_t)t * split_stride; colt -= t * split_cols; if (t == 0) sc = scale0; }
        const int col0 = colt + wc * 32 + 8 * fq, bcol0 = u.pn * BM + wc * 32 + 8 * fq;
        f32x4 bv[2][2];
#pragma unroll
        for (int bj = 0; bj < 2; ++bj)
#pragma unroll
            for (int n = 0; n < 2; ++n) bv[bj][n] = bias ? *(const f32x4*)(bias + bcol0 + bj * HALF + 4 * n) : (f32x4){0.f, 0.f, 0.f, 0.f};
#pragma unroll
        for (int ai = 0; ai < 2; ++ai)
#pragma unroll
            for (int m = 0; m < 4; ++m) { bf16_t* rowp = base + (size_t)(row0 + ai * HALF + m * 16) * ldc + col0;
#pragma unroll
                for (int bj = 0; bj < 2; ++bj) { f32x4 v0 = acc[ai][bj][m][0] + bv[bj][0], v1 = acc[ai][bj][m][1] + bv[bj][1];
                    if (ACT == 1) { f32x2 a = gelu_pk((f32x2){v0[0], v0[1]}), b = gelu_pk((f32x2){v0[2], v0[3]}), c = gelu_pk((f32x2){v1[0], v1[1]}), d = gelu_pk((f32x2){v1[2], v1[3]});
                        v0 = (f32x4){a.x, a.y, b.x, b.y}; v1 = (f32x4){c.x, c.y, d.x, d.y}; }
                    v0 = v0 * sc; v1 = v1 * sc; u32x4 w; w.x = cvt_pk_bf16(v0[0], v0[1]); w.y = cvt_pk_bf16(v0[2], v0[3]); w.z = cvt_pk_bf16(v1[0], v1[1]); w.w = cvt_pk_bf16(v1[2], v1[3]);
                    *(u32x4*)(rowp + bj * HALF) = w; } }
    }
};
template <class Epi, class Sched, bool ALIGN_EPI = false, bool SP2 = false>
__device__ __forceinline__ void gemm_phase(PG8_LAS unsigned char* lds, const Gemm g, const Sched& S, Epi& E) {
    int tid_ = threadIdx.x; asm volatile("" : "+v"(tid_));
    const int tid = tid_, wid = __builtin_amdgcn_readfirstlane(tid >> 6), lane = tid & 63, wr = wid >> 2, wc = wid & 3, fr = lane & 15, fq = lane >> 4;
    int K_ = g.K; asm volatile("" : "+s"(K_)); const int K = K_, nt = K / BK;
    const int lda = g.lda ? g.lda : K;
    unsigned voffA[2], voffB[2];
#pragma unroll
    for (int i = 0; i < 2; ++i) { int R, C; stage_rc(tid * 16 + i * 8192, R, C); const int Rb = Epi::PERM ? ((R & ~31) + perm32(R & 31)) : R;
        voffA[i] = (unsigned)(R * lda + C) * 2u; voffB[i] = (unsigned)(Rb * K + C) * 2u; }
    const size_t kstepB = (size_t)(BK * 2), kstepA = g.kstepA ? (size_t)g.kstepA : kstepB;
    const size_t hstepB = (size_t)HALF * K * 2, hstepA = (size_t)HALF * lda * 2;
    const size_t tstepB = 2 * hstepB, tstepA = 2 * hstepA;
    const unsigned ldsw = (unsigned)wid * 1024u;
    const int aoff = lds_byte(wr * 64 + fr, fq * 8), boff = lds_byte(wc * 32 + fr, fq * 8);
#define PG8_SA(b, h) (((b) * 2 + (h)) * HTB)
#define PG8_SB(b, h) ((4 + (b) * 2 + (h)) * HTB)
#define PG8_STAGE(bufoff, gbase, voff) do { _Pragma("unroll") for (int _i = 0; _i < 2; ++_i) \
        __builtin_amdgcn_global_load_lds((const unsigned*)((const char*)(gbase) + (voff)[_i]), (PG8_LAS unsigned*)(lds + (bufoff) + ldsw + _i * 8192), 16, 0, 0); } while (0)
#define PG8_LDA(dst, b, h) do { _Pragma("unroll") for (int m = 0; m < 4; ++m) _Pragma("unroll") for (int k = 0; k < 2; ++k) dst[m][k] = *(const PG8_LAS bf16x8*)(lds + PG8_SA(b, h) + aoff + m * 2048 + k * 1024); } while (0)
#define PG8_LDB(dst, b, h) do { _Pragma("unroll") for (int n = 0; n < 2; ++n) _Pragma("unroll") for (int k = 0; k < 2; ++k) dst[n][k] = *(const PG8_LAS bf16x8*)(lds + PG8_SB(b, h) + boff + n * 2048 + k * 1024); } while (0)
#define PG8_MMA(ai, bj, At, Bt) do { __builtin_amdgcn_s_setprio(1); _Pragma("unroll") for (int m = 0; m < 4; ++m) _Pragma("unroll") for (int n = 0; n < 2; ++n) _Pragma("unroll") for (int k = 0; k < 2; ++k) \
        acc[ai][bj][m][n] = __builtin_amdgcn_mfma_f32_16x16x32_bf16(Bt[n][k], At[m][k], acc[ai][bj][m][n], 0, 0, 0); __builtin_amdgcn_s_setprio(0); } while (0)
#define PG8_WAIT_V(n) asm volatile("s_waitcnt vmcnt(" #n ")" ::: "memory")
#define PG8_WAIT_L(n) asm volatile("s_waitcnt lgkmcnt(" #n ")" ::: "memory")
#define PG8_BAR __builtin_amdgcn_s_barrier()
#define PG8_SCHED __builtin_amdgcn_sched_barrier(0)
    Unit cur, nxt; int ui = 0;
    if (!S.next(0, cur)) return;
    f32x4 acc[2][2][4][2];
#pragma unroll
    for (int a = 0; a < 2; ++a)
#pragma unroll
        for (int b = 0; b < 2; ++b)
#pragma unroll
            for (int m = 0; m < 4; ++m)
#pragma unroll
                for (int n = 0; n < 2; ++n) acc[a][b][m][n] = (f32x4){0.f, 0.f, 0.f, 0.f};
    bf16x8 At[4][2], B0[2][2], B1[2][2];
    const char* cA = S.a_tile(g, cur, tstepA); const char* cB = S.b_tile(g, cur, tstepB);
    S.a_ready(cur);
    if constexpr (SP2) {
        PG8_STAGE(PG8_SB(0, 0), cB, voffB); PG8_STAGE(PG8_SB(0, 1), cB + hstepB, voffB); PG8_STAGE(PG8_SA(0, 0), cA, voffA); PG8_STAGE(PG8_SA(0, 1), cA + hstepA, voffA);
        if (wr == 1) PG8_BAR;
        PG8_WAIT_V(2); PG8_BAR;
        PG8_STAGE(PG8_SB(1, 0), cB + kstepB, voffB); PG8_STAGE(PG8_SA(1, 0), cA + kstepA, voffA); PG8_STAGE(PG8_SB(1, 1), cB + hstepB + kstepB, voffB);
        PG8_WAIT_V(6); PG8_BAR;
    } else {
        PG8_STAGE(PG8_SB(0, 0), cB, voffB); PG8_STAGE(PG8_SA(0, 0), cA, voffA); PG8_STAGE(PG8_SB(0, 1), cB + hstepB, voffB); PG8_STAGE(PG8_SA(0, 1), cA + hstepA, voffA);
        if (wr == 1) PG8_BAR;
        PG8_WAIT_V(4); PG8_BAR;
        PG8_STAGE(PG8_SB(1, 0), cB + kstepB, voffB); PG8_STAGE(PG8_SA(1, 0), cA + kstepA, voffA); PG8_STAGE(PG8_SB(1, 1), cB + hstepB + kstepB, voffB);
        PG8_WAIT_V(6); PG8_BAR;
    }
    for (;;) {
        const bool has_next = S.next(ui + 1, nxt);
        const char* nA = has_next ? S.a_tile(g, nxt, tstepA) : cA; const char* nB = has_next ? S.b_tile(g, nxt, tstepB) : cB;
        for (int t = 0; t < nt; t += 2) {
            const bool last = (t == nt - 2);
            const char* a1 = cA + (size_t)(t + 1) * kstepA;
            const char* a2 = last ? nA : cA + (size_t)(t + 2) * kstepA; const char* b2 = last ? nB : cB + (size_t)(t + 2) * kstepB;
            const char* a3 = a2 + kstepA; const char* b3 = b2 + kstepB;
            if (last && has_next) S.a_ready(nxt);
            if constexpr (SP2) {
            PG8_LDB(B0, 0, 0); PG8_LDB(B1, 0, 1); PG8_SCHED; PG8_LDA(At, 0, 0); PG8_STAGE(PG8_SA(1, 1), a1 + hstepA, voffA);
            PG8_WAIT_V(8); PG8_WAIT_L(0); PG8_BAR; PG8_MMA(0, 0, At, B0); PG8_MMA(0, 1, At, B1); PG8_BAR; PG8_SCHED;
            PG8_LDA(At, 0, 1); PG8_STAGE(PG8_SB(0, 0), b2, voffB); PG8_STAGE(PG8_SB(0, 1), b2 + hstepB, voffB); PG8_STAGE(PG8_SA(0, 0), a2, voffA);
            PG8_WAIT_V(8); PG8_WAIT_L(0); PG8_BAR; PG8_MMA(1, 0, At, B0); PG8_MMA(1, 1, At, B1); PG8_BAR; PG8_SCHED;
            PG8_LDB(B0, 1, 0); PG8_LDB(B1, 1, 1); PG8_SCHED; PG8_LDA(At, 1, 0); PG8_STAGE(PG8_SA(0, 1), a2 + hstepA, voffA);
            PG8_WAIT_V(8); PG8_WAIT_L(0); PG8_BAR; PG8_MMA(0, 0, At, B0); PG8_MMA(0, 1, At, B1); PG8_BAR; PG8_SCHED;
            PG8_LDA(At, 1, 1); PG8_STAGE(PG8_SB(1, 0), b3, voffB); PG8_STAGE(PG8_SB(1, 1), b3 + hstepB, voffB); PG8_STAGE(PG8_SA(1, 0), a3, voffA);
            PG8_WAIT_V(8); PG8_WAIT_L(0); PG8_BAR; PG8_MMA(1, 0, At, B0); PG8_MMA(1, 1, At, B1); PG8_BAR; PG8_SCHED;
            } else {
            PG8_LDB(B0, 0, 0); PG8_SCHED; PG8_LDA(At, 0, 0); PG8_STAGE(PG8_SA(1, 1), a1 + hstepA, voffA);
            PG8_WAIT_L(8); PG8_BAR; PG8_WAIT_L(0); PG8_MMA(0, 0, At, B0); PG8_BAR; PG8_SCHED;
            PG8_LDB(B1, 0, 1); PG8_STAGE(PG8_SB(0, 0), b2, voffB);
            PG8_BAR; PG8_WAIT_L(0); PG8_MMA(0, 1, At, B1); PG8_BAR;
            PG8_LDA(At, 0, 1); PG8_STAGE(PG8_SA(0, 0), a2, voffA);
            PG8_BAR; PG8_WAIT_L(0); PG8_MMA(1, 0, At, B0); PG8_BAR; PG8_SCHED;
            PG8_STAGE(PG8_SB(0, 1), b2 + hstepB, voffB);
            PG8_WAIT_V(6); PG8_BAR; PG8_MMA(1, 1, At, B1); PG8_BAR;
            PG8_LDB(B0, 1, 0); PG8_SCHED; PG8_LDA(At, 1, 0); PG8_STAGE(PG8_SA(0, 1), a2 + hstepA, voffA);
            PG8_WAIT_L(8); PG8_BAR; PG8_WAIT_L(0); PG8_MMA(0, 0, At, B0); PG8_BAR; PG8_SCHED;
            PG8_LDB(B1, 1, 1); PG8_STAGE(PG8_SB(1, 0), b3, voffB);
            PG8_BAR; PG8_WAIT_L(0); PG8_MMA(0, 1, At, B1); PG8_BAR;
            PG8_LDA(At, 1, 1); PG8_STAGE(PG8_SA(1, 0), a3, voffA);
            PG8_BAR; PG8_WAIT_L(0); PG8_MMA(1, 0, At, B0); PG8_BAR; PG8_SCHED;
            PG8_STAGE(PG8_SB(1, 1), b3 + hstepB, voffB);
            PG8_WAIT_V(6); PG8_BAR; PG8_MMA(1, 1, At, B1); PG8_BAR;
            }
        }
        if constexpr (ALIGN_EPI) { if (wr == 0) PG8_BAR; }
        if constexpr (!Epi::AFTER_DRAIN) { E(acc, cur, wr, wc, fr, fq); S.done(cur); }
        if (!has_next) break;
#pragma unroll
        for (int a = 0; a < 2; ++a)
#pragma unroll
            for (int b = 0; b < 2; ++b)
#pragma unroll
                for (int m = 0; m < 4; ++m)
#pragma unroll
                    for (int n = 0; n < 2; ++n) acc[a][b][m][n] = (f32x4){0.f, 0.f, 0.f, 0.f};
        cur = nxt; cA = nA; cB = nB; ++ui;
        if constexpr (ALIGN_EPI) { if (wr == 1) PG8_BAR; }
    }
    PG8_WAIT_V(0);
    if constexpr (!ALIGN_EPI) { if (wr == 0) PG8_BAR; }
    PG8_BAR;
    if constexpr (Epi::AFTER_DRAIN) { E.fused(acc, cur, wr, wc, fr, fq, lds, wid, lane); S.done(cur); }
#undef PG8_SA
#undef PG8_SB
#undef PG8_STAGE
#undef PG8_LDA
#undef PG8_LDB
#undef PG8_MMA
#undef PG8_WAIT_V
#undef PG8_WAIT_L
#undef PG8_BAR
#undef PG8_SCHED
}
}

constexpr int BATCH = 16, SEQ = 4096, DM = 1024, MTOK = BATCH * SEQ;
constexpr int NZ = 3584;
constexpr int ZC_MQ = 0, ZC_MK = 512, ZC_MV = 1024, ZC_MO = 1536, ZC_AQ = 2056, ZC_AKC = 2568, ZC_AVC = 2696, ZC_AKS = 2824, ZC_AVS = 2952, ZC_AKW = 3080, ZC_AVW = 3208;
constexpr int DFF = 2048, PLE = 256, NCMP = 255;
constexpr float EPS = 1e-6f;
constexpr int NWAVES = 8, NTHREADS = 512;
constexpr int LDS_BYTES = 163840;
constexpr int XBAR_LDS = 163840 - 256;

typedef unsigned short bf16_t;
typedef float f32x4 __attribute__((ext_vector_type(4)));
typedef unsigned u32x4 __attribute__((ext_vector_type(4)));
typedef unsigned u32x2 __attribute__((ext_vector_type(2)));

constexpr size_t MiB = 1u << 20;
constexpr size_t WS_CTL = 0;
constexpr size_t WS_WIN = 1 * MiB, WS_WOUT = 8 * MiB, WS_WUP = 10 * MiB, WS_WDN = 18 * MiB, WS_WPG = 22 * MiB, WS_WPP = 24 * MiB;
constexpr size_t WS_W1T = 25 * MiB, WS_W2T = 26 * MiB, WS_C1 = WS_CTL + 32768, WS_KCB = 29 * MiB, WS_VCT = 30 * MiB;
constexpr size_t WS_GATES = 32 * MiB, WS_PB = 40 * MiB, WS_XB = 72 * MiB;
constexpr size_t WS_MIX = 200 * MiB, WS_ACT = 200 * MiB;
constexpr size_t WS_Z = 456 * MiB, WS_U = 456 * MiB, WS_PROJ = 456 * MiB;
constexpr size_t WS_RS2 = 968 * MiB, WS_RS3 = 972 * MiB;
constexpr size_t WS_RSTD2 = 31 * MiB, WS_RSTD3 = 31 * MiB + 512 * 1024;
constexpr size_t WS_VST = 976 * MiB, WS_VWT = 992 * MiB;
constexpr size_t WS_END = 1008 * MiB;

struct Params { const float* in[22]; float* out; unsigned char* ws; };

__device__ __forceinline__ float bf2f(unsigned u16) { return __uint_as_float(u16 << 16); }
__device__ __forceinline__ float bflo(unsigned w) { return __uint_as_float(w << 16); }
__device__ __forceinline__ float bfhi(unsigned w) { return __uint_as_float(w & 0xffff0000u); }
__device__ __forceinline__ unsigned f2bf(float f) { unsigned u = __float_as_uint(f); return (u + 0x7fffu + ((u >> 16) & 1u)) >> 16; }
__device__ __forceinline__ unsigned pk2(float lo, float hi) { return f2bf(lo) | (f2bf(hi) << 16); }
__device__ __forceinline__ float wave_sum(float v) {
#pragma unroll
    for (int o = 1; o < 64; o <<= 1) v += __shfl_xor(v, o);
    return v;
}
__device__ __forceinline__ float wave_max(float v) {
#pragma unroll
    for (int o = 1; o < 64; o <<= 1) v = fmaxf(v, __shfl_xor(v, o));
    return v;
}
__device__ __forceinline__ float sigmoidf_(float x) { return 1.0f / (1.0f + __expf(-x)); }
__device__ __forceinline__ float log_sigmoidf_(float x) { return fminf(x, 0.f) - log1pf(__expf(-fabsf(x))); }
#define WAVE_LDS_SYNC() asm volatile("s_waitcnt lgkmcnt(0)" ::: "memory")

namespace pg8 {
__device__ __forceinline__ float row_rstd(const float* rs, int row) {
    const f32x4* p = (const f32x4*)(rs + (size_t)row * 16); const f32x4 a = p[0], b = p[1], c = p[2], d = p[3];
    const float s = (((a[0] + a[1]) + (a[2] + a[3])) + ((b[0] + b[1]) + (b[2] + b[3]))) + (((c[0] + c[1]) + (c[2] + c[3])) + ((d[0] + d[1]) + (d[2] + d[3])));
    return 1.0f / sqrtf(s * (1.0f / 1024.0f) + EPS);
}
struct EpiZ {
    static constexpr bool PERM = true, AFTER_DRAIN = false;
    bf16_t* Z; float* gates;
    __device__ __forceinline__ void operator()(const f32x4 (&acc)[2][2][4][2], const Unit& u, int wr, int wc, int fr, int fq) {
        const int row0 = u.pm * BM + wr * 64 + fr; const int col0 = u.pn * BM + wc * 32 + 8 * fq;
#pragma unroll
        for (int ai = 0; ai < 2; ++ai)
#pragma unroll
            for (int m = 0; m < 4; ++m) { const int row = row0 + ai * HALF + m * 16; bf16_t* rowp = Z + (size_t)row * NZ + col0;
#pragma unroll
                for (int bj = 0; bj < 2; ++bj) { const f32x4 v0 = acc[ai][bj][m][0], v1 = acc[ai][bj][m][1];
                    u32x4 w; w.x = cvt_pk_bf16(v0[0], v0[1]); w.y = cvt_pk_bf16(v0[2], v0[3]); w.z = cvt_pk_bf16(v1[0], v1[1]); w.w = cvt_pk_bf16(v1[2], v1[3]);
                    *(u32x4*)(rowp + bj * HALF) = w; }
                if (wc == 0) {
                    if ((u.pn == 8 && fq == 0) || (u.pn == 13 && fq >= 1)) {
                        float* gp = gates + (size_t)row * 32 + 8 * fq;
                        *(f32x4*)(gp) = acc[ai][0][m][0]; *(f32x4*)(gp + 4) = acc[ai][0][m][1];
                    }
                }
            }
    }
};
template <bool ROWSCALE> struct EpiBf {
    static constexpr bool PERM = true, AFTER_DRAIN = false;
    bf16_t* O; int ldc; const float* rs;
    __device__ __forceinline__ void operator()(const f32x4 (&acc)[2][2][4][2], const Unit& u, int wr, int wc, int fr, int fq) {
        const int row0 = u.pm * BM + wr * 64 + fr; const int col0 = u.pn * BM + wc * 32 + 8 * fq;
#pragma unroll
        for (int ai = 0; ai < 2; ++ai)
#pragma unroll
            for (int m = 0; m < 4; ++m) { const int row = row0 + ai * HALF + m * 16; bf16_t* rowp = O + (size_t)row * ldc + col0;
                float sc = 1.f;
                if (ROWSCALE) sc = row_rstd(rs, row);
#pragma unroll
                for (int bj = 0; bj < 2; ++bj) { const f32x4 v0 = acc[ai][bj][m][0] * sc, v1 = acc[ai][bj][m][1] * sc;
                    u32x4 w; w.x = cvt_pk_bf16(v0[0], v0[1]); w.y = cvt_pk_bf16(v0[2], v0[3]); w.z = cvt_pk_bf16(v1[0], v1[1]); w.w = cvt_pk_bf16(v1[2], v1[3]);
                    *(u32x4*)(rowp + bj * HALF) = w; }
            }
    }
};
template <bool BASE_F32> struct EpiRes {
    static constexpr bool PERM = true, AFTER_DRAIN = false;
    const float* basef; const bf16_t* baseb; bf16_t* xb; float* rs;
    __device__ __forceinline__ void operator()(const f32x4 (&acc)[2][2][4][2], const Unit& u, int wr, int wc, int fr, int fq) const {
        const int row0 = u.pm * BM + wr * 64 + fr, col0 = u.pn * BM + wc * 32 + 8 * fq;
#pragma unroll
        for (int ai = 0; ai < 2; ++ai)
#pragma unroll
            for (int m = 0; m < 4; ++m) { const int row = row0 + ai * HALF + m * 16; const size_t off = (size_t)row * DM + col0; float s = 0.f;
#pragma unroll
                for (int bj = 0; bj < 2; ++bj) { f32x4 b0, b1;
                    if (BASE_F32) { b0 = *(const f32x4*)(basef + off + bj * HALF); b1 = *(const f32x4*)(basef + off + bj * HALF + 4); }
                    else { const u32x4 w = *(const u32x4*)(baseb + off + bj * HALF); b0 = (f32x4){bflo(w.x), bfhi(w.x), bflo(w.y), bfhi(w.y)}; b1 = (f32x4){bflo(w.z), bfhi(w.z), bflo(w.w), bfhi(w.w)}; }
                    const f32x4 o0 = b0 + acc[ai][bj][m][0], o1 = b1 + acc[ai][bj][m][1];
                    u32x4 w; w.x = cvt_pk_bf16(o0[0], o0[1]); w.y = cvt_pk_bf16(o0[2], o0[3]); w.z = cvt_pk_bf16(o1[0], o1[1]); w.w = cvt_pk_bf16(o1[2], o1[3]);
                    *(u32x4*)(xb + off + bj * HALF) = w;
                    s += ((o0[0] * o0[0] + o0[1] * o0[1]) + (o0[2] * o0[2] + o0[3] * o0[3])) + ((o1[0] * o1[0] + o1[1] * o1[1]) + (o1[2] * o1[2] + o1[3] * o1[3])); }
                s += __shfl_xor(s, 16); s += __shfl_xor(s, 32);
                if (fq == 0) rs[(size_t)row * 16 + u.pn * 4 + wc] = s; }
    }
};
struct EpiPle {
    static constexpr bool PERM = true, AFTER_DRAIN = false;
    const bf16_t* x2b; const bf16_t* proj; const float* rstd; bf16_t* x3b; float* rs;
    __device__ __forceinline__ void operator()(const f32x4 (&acc)[2][2][4][2], const Unit& u, int wr, int wc, int fr, int fq) const {
        const int row0 = u.pm * BM + wr * 64 + fr, col0 = u.pn * BM + wc * 32 + 8 * fq;
#pragma unroll
        for (int ai = 0; ai < 2; ++ai)
#pragma unroll
            for (int m = 0; m < 4; ++m) { const int row = row0 + ai * HALF + m * 16; const size_t off = (size_t)row * DM + col0; float s = 0.f;
                const float sc = rstd[row];
#pragma unroll
                for (int bj = 0; bj < 2; ++bj) { const u32x4 xw = *(const u32x4*)(x2b + off + bj * HALF), pw = *(const u32x4*)(proj + off + bj * HALF);
                    const f32x4 a0 = acc[ai][bj][m][0] * sc, a1 = acc[ai][bj][m][1] * sc; f32x4 o0, o1;
                    o0[0] = bflo(xw.x) + sigmoidf_(a0[0]) * bflo(pw.x); o0[1] = bfhi(xw.x) + sigmoidf_(a0[1]) * bfhi(pw.x); o0[2] = bflo(xw.y) + sigmoidf_(a0[2]) * bflo(pw.y); o0[3] = bfhi(xw.y) + sigmoidf_(a0[3]) * bfhi(pw.y);
                    o1[0] = bflo(xw.z) + sigmoidf_(a1[0]) * bflo(pw.z); o1[1] = bfhi(xw.z) + sigmoidf_(a1[1]) * bfhi(pw.z); o1[2] = bflo(xw.w) + sigmoidf_(a1[2]) * bflo(pw.w); o1[3] = bfhi(xw.w) + sigmoidf_(a1[3]) * bfhi(pw.w);
                    u32x4 w; w.x = cvt_pk_bf16(o0[0], o0[1]); w.y = cvt_pk_bf16(o0[2], o0[3]); w.z = cvt_pk_bf16(o1[0], o1[1]); w.w = cvt_pk_bf16(o1[2], o1[3]);
                    *(u32x4*)(x3b + off + bj * HALF) = w;
                    s += ((o0[0] * o0[0] + o0[1] * o0[1]) + (o0[2] * o0[2] + o0[3] * o0[3])) + ((o1[0] * o1[0] + o1[1] * o1[1]) + (o1[2] * o1[2] + o1[3] * o1[3])); }
                s += __shfl_xor(s, 16); s += __shfl_xor(s, 32);
                if (fq == 0) rs[(size_t)row * 16 + u.pn * 4 + wc] = s; }
    }
};
struct PanelOrder {
    int nM, G, c, nN = 4;
    __host__ __device__ void init(int M, int G_, int c_, int nN_ = 4) { nM = M / BM; G = G_; c = c_; nN = nN_; }
    __host__ __device__ bool next(int i, Unit& u) const { const int p = c + G * (i / nN); if (p >= nM) return false; u.pm = p; u.pn = i % nN; return true; }
    __device__ __forceinline__ void a_ready(const Unit&) const {}
    __device__ __forceinline__ void done(const Unit&) const {}
    __device__ __forceinline__ const char* a_tile(const Gemm& g, const Unit& u, size_t tstepA) const { return (const char*)g.A + (size_t)u.pm * tstepA; }
    __device__ __forceinline__ const char* b_tile(const Gemm& g, const Unit& u, size_t tstepB) const { return (const char*)g.Bt + (size_t)u.pn * tstepB; }
};
struct ChainOrder {
    int c;
    __host__ __device__ bool next(int i, Unit& u) const { if (i >= 16) return false; u.pm = (c >> 4) * 16 + i; u.pn = c & 15; return true; }
    __device__ __forceinline__ void a_ready(const Unit&) const {}
    __device__ __forceinline__ void done(const Unit&) const {}
    __device__ __forceinline__ const char* a_tile(const Gemm& g, const Unit& u, size_t tstepA) const { return (const char*)g.A + (size_t)u.pm * tstepA; }
    __device__ __forceinline__ const char* b_tile(const Gemm& g, const Unit& u, size_t tstepB) const { return (const char*)g.Bt + (size_t)u.pn * tstepB; }
};
__device__ __forceinline__ float dpp_ror1(float v) { return __builtin_bit_cast(float, __builtin_amdgcn_update_dpp(0, __builtin_bit_cast(int, v), 0x121, 0xf, 0xf, false)); }
__device__ __forceinline__ float dpp_ror2(float v) { return __builtin_bit_cast(float, __builtin_amdgcn_update_dpp(0, __builtin_bit_cast(int, v), 0x122, 0xf, 0xf, false)); }
struct EpiUpConv {
    static constexpr bool PERM = true, AFTER_DRAIN = false;
    bf16_t* ACT; const float* rs; const float* cw; const float* cb; PG8_LAS float* car;
    __device__ __forceinline__ void operator()(f32x4 (&acc)[2][2][4][2], const Unit& u, int wr, int wc, int fr, int fq) const {
        const int par = u.pm & 1; const bool first = (u.pm & 15) == 0;
        const int colg = 32 * wc + 8 * fq, gc = 128 * u.pn + colg;
#pragma unroll
        for (int ai = 0; ai < 2; ++ai)
#pragma unroll
            for (int m = 0; m < 4; ++m) { const float sc = rs[u.pm * BM + ai * HALF + wr * 64 + m * 16 + fr];
#pragma unroll
                for (int n = 0; n < 2; ++n) { acc[ai][0][m][n] *= sc; acc[ai][1][m][n] *= sc; } }
        if (fr >= 14) {
#pragma unroll
            for (int ai = 0; ai < 2; ++ai)
#pragma unroll
                for (int n = 0; n < 2; ++n) *(PG8_LAS f32x4*)(car + ((par * 4 + 2 * ai + wr) * 2 + (fr - 14)) * 128 + colg + 4 * n) = acc[ai][0][3][n]; }
        asm volatile("s_waitcnt lgkmcnt(0)" ::: "memory"); __builtin_amdgcn_s_barrier(); asm volatile("" ::: "memory");
#pragma unroll
        for (int ai = 0; ai < 2; ++ai) { const int sl = 2 * ai + wr;
            const PG8_LAS float* src = (sl == 0) ? car + ((par ^ 1) * 4 + 3) * 256 : car + (par * 4 + sl - 1) * 256;
            const bool zero_in = first && sl == 0;
#pragma unroll
            for (int n = 0; n < 2; ++n) {
                asm volatile("" ::: "memory");
                f32x4 c2 = *(const PG8_LAS f32x4*)(src + colg + 4 * n), c1 = *(const PG8_LAS f32x4*)(src + 128 + colg + 4 * n);
                if (zero_in) { c2 = (f32x4){0.f, 0.f, 0.f, 0.f}; c1 = c2; }
                const f32x4 w0 = *(const f32x4*)(cw + gc + 4 * n), w1 = *(const f32x4*)(cw + DFF + gc + 4 * n), w2 = *(const f32x4*)(cw + 2 * DFF + gc + 4 * n), bb = *(const f32x4*)(cb + gc + 4 * n);
#pragma unroll
                for (int e = 0; e < 4; ++e) { float tm1 = c1[e], tm2 = (fr == 1) ? c1[e] : c2[e];
#pragma unroll
                    for (int m = 0; m < 4; ++m) { const float x = acc[ai][0][m][n][e]; const float t1 = dpp_ror1(x), t2 = dpp_ror2(x);
                        const float p1 = fr >= 1 ? t1 : tm1, p2 = fr >= 2 ? t2 : tm2;
                        const float cv = w0[e] * p2 + w1[e] * p1 + w2[e] * x + bb[e];
                        acc[ai][1][m][n][e] = cv / (1.0f + __expf(-cv)) * acc[ai][1][m][n][e];
                        tm1 = t1; tm2 = t2; } } }
#pragma unroll
            for (int m = 0; m < 4; ++m) { const int row = u.pm * BM + ai * HALF + wr * 64 + m * 16 + fr; const f32x4 v0 = acc[ai][1][m][0], v1 = acc[ai][1][m][1];
                u32x4 w; w.x = cvt_pk_bf16(v0[0], v0[1]); w.y = cvt_pk_bf16(v0[2], v0[3]); w.z = cvt_pk_bf16(v1[0], v1[1]); w.w = cvt_pk_bf16(v1[2], v1[3]);
                *(u32x4*)(ACT + (size_t)row * DFF + gc) = w; } }
    }
};
struct CmpOrder {
    int c; const bf16_t* Z; const bf16_t* w1t;
    __host__ __device__ bool next(int i, Unit& u) const { if (i > 0 || c >= 64) return false; u.pm = c; u.pn = 0; return true; }
    __device__ __forceinline__ void a_ready(const Unit&) const {}
    __device__ __forceinline__ void done(const Unit&) const {}
    __device__ __forceinline__ const char* a_tile(const Gemm&, const Unit& u, size_t) const { const int kv = u.pm >> 5, b = (u.pm >> 1) & 15, gg = u.pm & 1; return (const char*)(Z + (size_t)b * SEQ * NZ + (kv ? ZC_AVC : ZC_AKC) + gg * 64); }
    __device__ __forceinline__ const char* b_tile(const Gemm&, const Unit& u, size_t) const { return (const char*)(w1t + (size_t)(u.pm >> 5) * 256 * 1024); }
};
struct EpiCmp {
    static constexpr bool PERM = false, AFTER_DRAIN = true;
    const float* c1; const bf16_t* w2t; bf16_t* kcb; bf16_t* vct;
    __device__ __forceinline__ void fused(f32x4 (&acc)[2][2][4][2], const Unit& u, int wr, int wc, int fr, int fq, PG8_LAS unsigned char* lds, int wid, int lane) const {
        const int kv = u.pm >> 5, bgi = u.pm & 31;
        const int cc0 = 32 * wc + 4 * fq;
#pragma unroll
        for (int ai = 0; ai < 2; ++ai)
#pragma unroll
            for (int m = 0; m < 4; ++m) { const int r = 128 * ai + 64 * wr + 16 * m + fr;
#pragma unroll
                for (int n = 0; n < 2; ++n) *(PG8_LAS f32x4*)(lds + (r * 128 + cc0 + 16 * n) * 4) = acc[ai][1][m][n]; }
        asm volatile("s_waitcnt lgkmcnt(0)" ::: "memory"); __builtin_amdgcn_s_barrier(); asm volatile("" ::: "memory");
#pragma unroll
        for (int ai = 0; ai < 2; ++ai)
#pragma unroll
            for (int m = 0; m < 4; ++m) { const int r = 128 * ai + 64 * wr + 16 * m + fr; const int rr = r < 255 ? r + 1 : 255;
#pragma unroll
                for (int n = 0; n < 2; ++n) { const f32x4 rv = *(const PG8_LAS f32x4*)(lds + (rr * 128 + cc0 + 16 * n) * 4); const f32x4 bv = *(const f32x4*)(c1 + kv * 128 + cc0 + 16 * n);
                    f32x4 x = acc[ai][0][m][n] + rv + bv;
#pragma unroll
                    for (int e = 0; e < 4; ++e) { const float y = 1.5957691216057308f * (x[e] + 0.044715f * x[e] * x[e] * x[e]); x[e] = x[e] / (1.0f + __expf(-y)); }
                    acc[ai][0][m][n] = x; } }
        asm volatile("s_waitcnt lgkmcnt(0)" ::: "memory"); __builtin_amdgcn_s_barrier(); asm volatile("" ::: "memory");
#pragma unroll
        for (int ai = 0; ai < 2; ++ai)
#pragma unroll
            for (int m = 0; m < 4; ++m) { const int r = 128 * ai + 64 * wr + 16 * m + fr;
#pragma unroll
                for (int n = 0; n < 2; ++n) { const f32x4 x = acc[ai][0][m][n]; u32x2 w; w.x = cvt_pk_bf16(x[0], x[1]); w.y = cvt_pk_bf16(x[2], x[3]); *(PG8_LAS u32x2*)(lds + r * 272 + (cc0 + 16 * n) * 2) = w; } }
        { const int t = wid * 64 + lane, d = t >> 3, ch = t & 7; const u32x4* src = (const u32x4*)(w2t + (size_t)kv * 64 * 128 + d * 128 + ch * 16);
          *(PG8_LAS u32x4*)(lds + 69632 + d * 272 + ch * 32) = src[0]; *(PG8_LAS u32x4*)(lds + 69632 + d * 272 + ch * 32 + 16) = src[1]; }
        asm volatile("s_waitcnt vmcnt(0) lgkmcnt(0)" ::: "memory"); __builtin_amdgcn_s_barrier(); asm volatile("" ::: "memory");
        typedef float f32x16_ __attribute__((ext_vector_type(16)));
        const int tq = lane & 31, hi = lane >> 5;
        f32x16_ O0, O1;
#pragma unroll
        for (int i = 0; i < 16; ++i) { O0[i] = 0.f; O1[i] = 0.f; }
#pragma unroll
        for (int kk = 0; kk < 8; ++kk) { const bf16x8 a = *(const PG8_LAS bf16x8*)(lds + (32 * wid + tq) * 272 + (16 * kk + 8 * hi) * 2);
            const bf16x8 b0 = *(const PG8_LAS bf16x8*)(lds + 69632 + tq * 272 + (16 * kk + 8 * hi) * 2), b1 = *(const PG8_LAS bf16x8*)(lds + 69632 + (32 + tq) * 272 + (16 * kk + 8 * hi) * 2);
            O0 = __builtin_amdgcn_mfma_f32_32x32x16_bf16(a, b0, O0, 0, 0, 0); O1 = __builtin_amdgcn_mfma_f32_32x32x16_bf16(a, b1, O1, 0, 0, 0); }
#pragma unroll
        for (int i = 0; i < 16; ++i) { const int nrow = 32 * wid + (i & 3) + 8 * (i >> 2) + 4 * hi; const bool ok = nrow < NCMP;
            const unsigned v0 = ok ? (cvt_pk_bf16(O0[i], 0.f) & 0xffffu) : 0u, v1 = ok ? (cvt_pk_bf16(O1[i], 0.f) & 0xffffu) : 0u;
            if (kv == 0) { bf16_t* p = kcb + ((size_t)bgi * 256 + nrow) * 64 + tq; p[0] = (bf16_t)v0; p[32] = (bf16_t)v1; }
            else { const int n16 = nrow & 15; const int np = (nrow & ~15) + 8 * ((n16 >> 2) & 1) + (n16 & 3) + 4 * (n16 >> 3); bf16_t* p = vct + ((size_t)bgi * 64 + tq) * 256 + np; p[0] = (bf16_t)v0; p[32 * 256] = (bf16_t)v1; } }
    }
};
}

template <bool UPMAP = false>
__device__ __forceinline__ void p0_transpose_item(const float* W, const float* gk, int K, int N, bf16_t* WT, float* scr, int item, int lane) {
    const int nblk = N / 32, kb = item / nblk, nb = item % nblk, k0 = 64 * kb, n0 = 32 * nb;
    const int r0 = UPMAP ? (((n0 & 2047) >> 7) * 256 + (n0 >> 11) * 128 + (n0 & 127)) : n0;
#pragma unroll 8
    for (int i = 0; i < 32; ++i) { const int kk = 2 * i + (lane >> 5); float w = W[(size_t)(k0 + kk) * N + n0 + (lane & 31)]; if (gk) w *= gk[k0 + kk]; scr[kk * 33 + (lane & 31)] = w; }
    WAVE_LDS_SYNC();
    const int c = lane & 7;
#pragma unroll
    for (int j = 0; j < 4; ++j) { const int n = (lane >> 3) + 8 * j; const float* s = scr + (8 * c) * 33 + n;
        u32x4 o; o.x = pk2(s[0 * 33], s[1 * 33]); o.y = pk2(s[2 * 33], s[3 * 33]); o.z = pk2(s[4 * 33], s[5 * 33]); o.w = pk2(s[6 * 33], s[7 * 33]);
        *(u32x4*)(WT + (size_t)(r0 + n) * K + k0 + 8 * c) = o; }
    WAVE_LDS_SYNC();
}

__device__ __forceinline__ float dot64_bf(const float* qv, const bf16_t* krow) {
    const u32x4* kp = (const u32x4*)krow; float acc = 0.f;
#pragma unroll
    for (int i = 0; i < 8; ++i) { const u32x4 w = kp[i]; const f32x4 q0 = *(const f32x4*)(qv + 8 * i), q1 = *(const f32x4*)(qv + 8 * i + 4);
        acc += q0[0] * bflo(w.x) + q0[1] * bfhi(w.x) + q0[2] * bflo(w.y) + q0[3] * bfhi(w.y) + q1[0] * bflo(w.z) + q1[1] * bfhi(w.z) + q1[2] * bflo(w.w) + q1[3] * bfhi(w.w); }
    return acc;
}
__device__ __forceinline__ float dot64_f(const float* qv, const float* krow) {
    float acc = 0.f;
#pragma unroll
    for (int i = 0; i < 16; ++i) { const f32x4 w = *(const f32x4*)(krow + 4 * i), q = *(const f32x4*)(qv + 4 * i); acc += q[0] * w[0] + q[1] * w[1] + q[2] * w[2] + q[3] * w[3]; }
    return acc;
}

__device__ __forceinline__ void compress_unit_simple(const bf16_t* Z, int zcol, const float* pe, const float* w1, const float* w2, float* outc, bf16_t* kcb, bf16_t* vct, int b, int g, int ng, float* lds_f, int tid) {
    float* tok = lds_f;
    float* pes = lds_f + 144 * 64;
    float* hid = pes + 32 * 64;
    const int n0 = 8 * ng, t0 = 16 * n0;
    for (int i = tid; i < 144 * 64; i += NTHREADS) { const int tt = i >> 6, d = i & 63; const int t = t0 + tt;
        tok[i] = (t < SEQ) ? bf2f(Z[((size_t)b * SEQ + t) * NZ + zcol + g * 64 + d]) : 0.f; }
    for (int i = tid; i < 32 * 64; i += NTHREADS) pes[i] = pe[i];
    __syncthreads();
    const int j = tid & 127, sub = tid >> 7;
    float a0 = 0.f, a1 = 0.f;
    const float* tk0 = tok + (2 * sub) * 16 * 64; const float* tk1 = tk0 + 16 * 64;
    for (int ld = 0; ld < 2048; ++ld) { const float w = w1[(size_t)ld * 128 + j]; const float pv = pes[ld]; a0 += (tk0[ld] + pv) * w; a1 += (tk1[ld] + pv) * w; }
    { const float x0 = a0, x1 = a1;
      hid[(2 * sub) * 128 + j] = 0.5f * x0 * (1.0f + tanhf(0.7978845608028654f * (x0 + 0.044715f * x0 * x0 * x0)));
      hid[(2 * sub + 1) * 128 + j] = 0.5f * x1 * (1.0f + tanhf(0.7978845608028654f * (x1 + 0.044715f * x1 * x1 * x1))); }
    __syncthreads();
    { const int nl = tid >> 6, d = tid & 63; float o = 0.f;
      for (int jj = 0; jj < 128; ++jj) o += hid[nl * 128 + jj] * w2[jj * 64 + d];
      const int n = n0 + nl; if (n < NCMP) outc[(((size_t)b * 2 + g) * 256 + n) * 64 + d] = o;
      const unsigned ob = (n < NCMP) ? f2bf(o) : 0u;
      if (kcb) kcb[(((size_t)b * 2 + g) * 256 + n) * 64 + d] = (bf16_t)ob;
      if (vct) { const int n16 = n & 15; vct[(((size_t)b * 2 + g) * 64 + d) * 256 + (n & ~15) + 8 * ((n16 >> 2) & 1) + (n16 & 3) + 4 * (n16 >> 3)] = (bf16_t)ob; } }
    __syncthreads();
}

struct MixPtrs { const bf16_t* Z; const float* gates; const float* KC; const float* VC; bf16_t* MIX; const float* gate_bias; const float* mnorm_g; };

__device__ __forceinline__ void nsa_token_simple(const MixPtrs& P, int b, int g, int t, float* qs, float* pc, float* pb, int lane) {
    const size_t row = (size_t)b * SEQ + t;
    const bf16_t* zrow = P.Z + row * NZ;
    const bf16_t* zb = P.Z + (size_t)b * SEQ * NZ;
#pragma unroll
    for (int r = 0; r < 4; ++r) qs[r * 64 + lane] = bf2f(zrow[ZC_AQ + (g * 4 + r) * 64 + lane]) * 0.125f;
    WAVE_LDS_SYNC();
    const int nv = (t >= 31) ? min((t - 31) / 16 + 1, NCMP) : 0;
    const float* kc = P.KC + ((size_t)b * 2 + g) * 256 * 64; const float* vc = P.VC + ((size_t)b * 2 + g) * 256 * 64;
    float oc[4], os[4], ow[4];
#pragma unroll 1
    for (int r = 0; r < 4; ++r) {
        const float slope = exp2f(-(float)(g * 4 + r + 1));
        float sv[4]; float mx = -3.0e38f;
#pragma unroll
        for (int i = 0; i < 4; ++i) { const int n = lane + 64 * i; sv[i] = -3.0e38f;
            if (n < nv) { const float s = dot64_f(qs + r * 64, kc + (size_t)n * 64) - slope * (float)(t - (16 * n + 31)); sv[i] = s; mx = fmaxf(mx, s); } }
        mx = wave_max(mx);
        float sum = 0.f;
#pragma unroll
        for (int i = 0; i < 4; ++i) { const int n = lane + 64 * i; float e = 0.f; if (n < nv) e = __expf(sv[i] - mx); sv[i] = e; sum += e; }
        sum = wave_sum(sum);
        const float inv = (nv > 0) ? 1.0f / sum : 0.f;
#pragma unroll
        for (int i = 0; i < 4; ++i) pc[r * 256 + lane + 64 * i] = sv[i] * inv;
        WAVE_LDS_SYNC();
        float a = 0.f;
        for (int n = 0; n < nv; ++n) a += pc[r * 256 + n] * vc[(size_t)n * 64 + lane];
        oc[r] = a;
    }
    unsigned long long selmask;
    {
        float imp = 0.f;
        for (int n = 4 * lane - 1; n <= 4 * lane + 3; ++n) if (n >= 0 && n < NCMP) imp += (pc[n] + pc[256 + n]) + (pc[512 + n] + pc[768 + n]);
        const int cur = t >> 6;
        const bool causal = lane <= cur; const bool forced = (lane == 0) || (lane == cur) || (lane == cur - 1);
        const float score = causal ? (forced ? 1.0e30f : imp) : -1.0e30f;
        int rank = 0;
        for (int i = 0; i < 64; ++i) { const float si = __shfl(score, i); rank += ((si > score) || (si == score && i < lane)) ? 1 : 0; }
        selmask = __ballot(rank < 16);
    }
#pragma unroll 1
    for (int r = 0; r < 4; ++r) {
        const float slope = exp2f(-(float)(g * 4 + r + 1));
        float mx = -3.0e38f; int idx = 0;
        for (unsigned long long mm = selmask; mm; mm &= mm - 1, ++idx) { const int j = __builtin_ctzll(mm); const int pos = 64 * j + lane;
            float s = -1.0e30f;
            if (pos <= t) s = dot64_bf(qs + r * 64, zb + (size_t)pos * NZ + ZC_AKS + g * 64) - slope * (float)(t - pos);
            pb[idx * 64 + lane] = s; mx = fmaxf(mx, s); }
        mx = wave_max(mx);
        float sum = 0.f;
        for (int i = 0; i < 16; ++i) { const float e = __expf(pb[i * 64 + lane] - mx); pb[i * 64 + lane] = e; sum += e; }
        sum = wave_sum(sum);
        WAVE_LDS_SYNC();
        float a = 0.f; idx = 0;
        for (unsigned long long mm = selmask; mm; mm &= mm - 1, ++idx) { const int j = __builtin_ctzll(mm);
            if (64 * j > t) continue;
            const bf16_t* vp = zb + (size_t)(64 * j) * NZ + ZC_AVS + g * 64 + lane;
            for (int l = 0; l < 64; ++l) a += pb[idx * 64 + l] * bf2f(vp[(size_t)l * NZ]); }
        os[r] = a / sum;
        WAVE_LDS_SYNC();
    }
    const int lo = max(0, t - 511);
#pragma unroll 1
    for (int r = 0; r < 4; ++r) {
        const float slope = exp2f(-(float)(g * 4 + r + 1));
        float mx = -3.0e38f;
        for (int i = 0; i < 8; ++i) { const int pos = lo + 64 * i + lane; float s = -1.0e30f;
            if (pos <= t) s = dot64_bf(qs + r * 64, zb + (size_t)pos * NZ + ZC_AKW + g * 64) - slope * (float)(t - pos);
            pb[i * 64 + lane] = s; mx = fmaxf(mx, s); }
        mx = wave_max(mx);
        float sum = 0.f;
        for (int i = 0; i < 8; ++i) { const float e = __expf(pb[i * 64 + lane] - mx); pb[i * 64 + lane] = e; sum += e; }
        sum = wave_sum(sum);
        WAVE_LDS_SYNC();
        float a = 0.f; const int cnt = t - lo + 1;
        const bf16_t* vp = zb + (size_t)lo * NZ + ZC_AVW + g * 64 + lane;
        for (int l = 0; l < cnt; ++l) a += pb[l] * bf2f(vp[(size_t)l * NZ]);
        ow[r] = a / sum;
        WAVE_LDS_SYNC();
    }
    const float* gp = P.gates + row * 32 + 8;
#pragma unroll
    for (int r = 0; r < 4; ++r) { const int hh = g * 4 + r;
        const float o = sigmoidf_(gp[hh * 3 + 0]) * oc[r] + sigmoidf_(gp[hh * 3 + 1]) * os[r] + sigmoidf_(gp[hh * 3 + 2]) * ow[r];
        P.MIX[row * DM + 512 + hh * 64 + lane] = (bf16_t)f2bf(o); }
}

__device__ __forceinline__ void mlstm_unit_simple(const MixPtrs& P, int b, int h, float* lds_f, int tid) {
    float* qs = lds_f;
    float* ks = qs + 64 * 128;
    float* vs = ks + 64 * 128;
    float* hraw = vs + 64 * 128;
    float* red = hraw + 64 * 128;
    float* redn = red + 2 * 4 * 128;
    float* igs = redn + 8;
    float* lfs = igs + 64;
    const int dv = tid & 127, kg = tid >> 7, lane = tid & 63, wave = tid >> 6;
    float C[32], nn[32];
#pragma unroll
    for (int i = 0; i < 32; ++i) { C[i] = 0.f; nn[i] = 0.f; }
    float mst = 0.f;
    const float bi = P.gate_bias[h], bff = P.gate_bias[4 + h];
    const float qscale = 0.08838834764831845f;
#pragma unroll 1
    for (int c = 0; c < SEQ / 64; ++c) {
        const size_t row0 = (size_t)b * SEQ + c * 64;
        for (int i = tid; i < 64 * 128; i += NTHREADS) { const int tt = i >> 7, d = i & 127; const bf16_t* zr = P.Z + (row0 + tt) * NZ + h * 128 + d;
            qs[i] = bf2f(zr[ZC_MQ]) * qscale; ks[i] = bf2f(zr[ZC_MK]); vs[i] = bf2f(zr[ZC_MV]); }
        if (tid < 64) { const float* gr = P.gates + (row0 + tid) * 32; igs[tid] = gr[h] + bi; lfs[tid] = log_sigmoidf_(gr[4 + h] + bff); }
        __syncthreads();
#pragma unroll 1
        for (int t = 0; t < 64; ++t) {
            const float lf = lfs[t], ig = igs[t];
            const float mnew = fmaxf(lf + mst, ig);
            const float fs = __expf(lf + mst - mnew), is = __expf(ig - mnew);
            mst = mnew;
            const float v = vs[t * 128 + dv] * is;
            float pn = 0.f, pd = 0.f;
            const float* kr = ks + t * 128 + kg * 32; const float* qr = qs + t * 128 + kg * 32;
#pragma unroll
            for (int i = 0; i < 32; ++i) { const float kk = kr[i], qq = qr[i];
                C[i] = fs * C[i] + kk * v; nn[i] = fs * nn[i] + is * kk; pn += qq * C[i]; pd += qq * nn[i]; }
            float* rb = red + (t & 1) * 512; float* rn = redn + (t & 1) * 4;
            rb[kg * 128 + dv] = pn; if (dv == 0) rn[kg] = pd;
            __syncthreads();
            if (tid < 128) { const float num = (rb[tid] + rb[128 + tid]) + (rb[256 + tid] + rb[384 + tid]); const float den = (rn[0] + rn[1]) + (rn[2] + rn[3]);
                hraw[t * 128 + tid] = num / fmaxf(fabsf(den), __expf(-mnew)); }
        }
        __syncthreads();
        for (int k = 0; k < 8; ++k) { const int tt = wave * 8 + k; const float h0 = hraw[tt * 128 + lane], h1 = hraw[tt * 128 + 64 + lane];
            const float ss = wave_sum(h0 * h0 + h1 * h1); const float rstd = 1.0f / sqrtf(ss * (1.0f / 128.0f) + EPS);
            const bf16_t* zo = P.Z + (row0 + tt) * NZ + ZC_MO + h * 128;
            const float o0 = h0 * rstd * P.mnorm_g[h * 128 + lane] * sigmoidf_(bf2f(zo[lane])), o1 = h1 * rstd * P.mnorm_g[h * 128 + 64 + lane] * sigmoidf_(bf2f(zo[64 + lane]));
            bf16_t* mo = P.MIX + (row0 + tt) * DM + h * 128;
            mo[lane] = (bf16_t)f2bf(o0); mo[64 + lane] = (bf16_t)f2bf(o1); }
        __syncthreads();
    }
}


#define LAS3 __attribute__((address_space(3)))
typedef short bf16x8 __attribute__((ext_vector_type(8)));
typedef float f32x16 __attribute__((ext_vector_type(16)));
typedef float f32x2_t __attribute__((ext_vector_type(2)));
typedef __bf16 bf16x2_t __attribute__((ext_vector_type(2)));
__device__ __forceinline__ unsigned cvtpk(float lo, float hi) { f32x2_t v = {lo, hi}; bf16x2_t b = __builtin_convertvector(v, bf16x2_t); return __builtin_bit_cast(unsigned, b); }
#define MFMA32(a, b, c) __builtin_amdgcn_mfma_f32_32x32x16_bf16((a), (b), (c), 0, 0, 0)
__device__ __forceinline__ bf16x8 pack8(const f32x16& x, int s) {
    u32x4 p; p.x = cvtpk(x[8 * s], x[8 * s + 1]); p.y = cvtpk(x[8 * s + 2], x[8 * s + 3]); p.z = cvtpk(x[8 * s + 4], x[8 * s + 5]); p.w = cvtpk(x[8 * s + 6], x[8 * s + 7]);
    return __builtin_bit_cast(bf16x8, p);
}
#define NEG_INF (-__builtin_inff())
constexpr float LOG2E = 1.4426950408889634f;
__device__ __forceinline__ unsigned other_half_u(unsigned v, int hi) { auto rr = __builtin_amdgcn_permlane32_swap(v, v, false, false); return hi ? rr[0] : rr[1]; }
__device__ __forceinline__ float other_half_f(float v, int hi) { return __uint_as_float(other_half_u(__float_as_uint(v), hi)); }
__device__ __forceinline__ float max16(const f32x16& u) {
    float a = fmaxf(fmaxf(u[0], u[1]), fmaxf(u[2], u[3])), b = fmaxf(fmaxf(u[4], u[5]), fmaxf(u[6], u[7]));
    float c = fmaxf(fmaxf(u[8], u[9]), fmaxf(u[10], u[11])), d = fmaxf(fmaxf(u[12], u[13]), fmaxf(u[14], u[15]));
    return fmaxf(fmaxf(a, b), fmaxf(c, d));
}
__device__ __forceinline__ unsigned long long spread_even(unsigned x) {
    unsigned long long s = x;
    s = (s | (s << 16)) & 0x0000FFFF0000FFFFull; s = (s | (s << 8)) & 0x00FF00FF00FF00FFull; s = (s | (s << 4)) & 0x0F0F0F0F0F0F0F0Full;
    s = (s | (s << 2)) & 0x3333333333333333ull; s = (s | (s << 1)) & 0x5555555555555555ull; return s;
}
struct NsaF { const bf16_t* Z; const float* gates; const bf16_t* KCB; const bf16_t* VCT; const bf16_t* VST; const bf16_t* VWT; bf16_t* MIX; };

__device__ __forceinline__ void nsa_load_q(bf16x8 (&qf)[4], const bf16_t* qp) {
    const float QSC = 0.125f * LOG2E;
#pragma unroll
    for (int s = 0; s < 4; ++s) { const u32x4 w = *(const u32x4*)(qp + 16 * s); u32x4 o;
        o.x = cvtpk(bflo(w.x) * QSC, bfhi(w.x) * QSC); o.y = cvtpk(bflo(w.y) * QSC, bfhi(w.y) * QSC); o.z = cvtpk(bflo(w.z) * QSC, bfhi(w.z) * QSC); o.w = cvtpk(bflo(w.w) * QSC, bfhi(w.w) * QSC);
        qf[s] = __builtin_bit_cast(bf16x8, o); }
}
__device__ __forceinline__ f32x16 nsa_st(const bf16_t* kp, const bf16x8 (&qf)[4], const f32x16& cinit) {
    f32x16 acc = MFMA32(*(const bf16x8*)(kp), qf[0], cinit);
    acc = MFMA32(*(const bf16x8*)(kp + 16), qf[1], acc); acc = MFMA32(*(const bf16x8*)(kp + 32), qf[2], acc); acc = MFMA32(*(const bf16x8*)(kp + 48), qf[3], acc);
    return acc;
}
struct NsaK { bf16x8 k[4]; };
struct NsaV { bf16x8 v0[2]; bf16x8 v1[2]; };
__device__ __forceinline__ void nsa_ldk(NsaK& R, const bf16_t* ku, unsigned ko) {
    R.k[0] = *(const bf16x8*)(ku + ko); R.k[1] = *(const bf16x8*)(ku + ko + 16); R.k[2] = *(const bf16x8*)(ku + ko + 32); R.k[3] = *(const bf16x8*)(ku + ko + 48);
}
__device__ __forceinline__ void nsa_ldv(NsaV& R, const bf16_t* vu, const bf16_t* vu2, unsigned vo) {
    R.v0[0] = *(const bf16x8*)(vu + vo); R.v0[1] = *(const bf16x8*)(vu + vo + 16); R.v1[0] = *(const bf16x8*)(vu2 + vo); R.v1[1] = *(const bf16x8*)(vu2 + vo + 16);
}
__device__ __forceinline__ f32x16 nsa_st_r(const NsaK& R, const bf16x8 (&qf)[4], const f32x16& cinit) {
    f32x16 acc = MFMA32(R.k[0], qf[0], cinit); acc = MFMA32(R.k[1], qf[1], acc); acc = MFMA32(R.k[2], qf[2], acc); acc = MFMA32(R.k[3], qf[3], acc); return acc;
}
__device__ __forceinline__ void nsa_soft_pv(f32x16& u, float tb, float& M, float& l, f32x16& O0, f32x16& O1, const NsaV& R, int hi) {
    float tm = max16(u); tm = fmaxf(tm, other_half_f(tm, hi));
    const float cand = tm + tb;
    if (__any(cand > M)) { const float mn = fmaxf(M, cand); const float al = __builtin_amdgcn_exp2f(M - mn); l *= al; O0 *= al; O1 *= al; M = mn; }
    const float ms = M - tb; float sum = 0.f;
#pragma unroll
    for (int i = 0; i < 16; ++i) { const float p = __builtin_amdgcn_exp2f(u[i] - ms); u[i] = p; sum += p; }
    l += sum;
    u32x4 a, b2;
    a.x = cvtpk(u[0], u[1]); a.y = cvtpk(u[2], u[3]); a.z = cvtpk(u[4], u[5]); a.w = cvtpk(u[6], u[7]);
    b2.x = cvtpk(u[8], u[9]); b2.y = cvtpk(u[10], u[11]); b2.z = cvtpk(u[12], u[13]); b2.w = cvtpk(u[14], u[15]);
    const bf16x8 p0 = __builtin_bit_cast(bf16x8, a), p1 = __builtin_bit_cast(bf16x8, b2);
    O0 = MFMA32(R.v0[0], p0, O0); O0 = MFMA32(R.v0[1], p1, O0);
    O1 = MFMA32(R.v1[0], p0, O1); O1 = MFMA32(R.v1[1], p1, O1);
}
__device__ __forceinline__ void nsa_mask_lt(f32x16& u, int limh) {
    asm volatile("" : "+v"(limh));
#pragma unroll
    for (int i = 0; i < 16; ++i) { const int c = (i & 3) + 8 * (i >> 2); if (!(c < limh)) u[i] = NEG_INF; }
}
__device__ __forceinline__ void nsa_mask_gt(f32x16& u, int limh) {
    asm volatile("" : "+v"(limh));
#pragma unroll
    for (int i = 0; i < 16; ++i) { const int c = (i & 3) + 8 * (i >> 2); if (!(c > limh)) u[i] = NEG_INF; }
}

__device__ __forceinline__ void nsa_unit_fast(const NsaF& P, int b, int g, int tb, int lane, float* acc_lds) {
    const int tq = lane & 31, hi = lane >> 5, t0 = tb * 32, cur = tb >> 1;
    const size_t rowq = (size_t)b * SEQ + t0 + tq;
    const bf16_t* zq = P.Z + rowq * NZ + ZC_AQ + (g * 4) * 64 + 8 * hi;
    const size_t bg = (size_t)b * 2 + g;
    const bf16_t* kcb_u = P.KCB + bg * 256 * 64; const unsigned koff = (unsigned)(tq * 64 + 8 * hi);
    const bf16_t* vct_u = P.VCT + bg * 64 * 256; const unsigned vcoff = (unsigned)(tq * 256 + 8 * hi);
    const bf16_t* zb_u = P.Z + (size_t)b * SEQ * NZ + g * 64;   const unsigned zoff = (unsigned)(tq * NZ + 8 * hi);
    const bf16_t* vst_u = P.VST + bg * 64 * SEQ; const bf16_t* vwt_u = P.VWT + bg * 64 * SEQ; const unsigned voff = (unsigned)(tq * SEQ + 8 * hi);
    const int nval = max(0, 2 * tb + 1 - (tq < 31 ? 1 : 0) - (tq < 15 ? 1 : 0));
    const int ntc = (2 * tb + 1 + 31) >> 5;
    const int tqh = tq - 4 * hi;
    const float hif = (float)(4 * hi);

    unsigned long long selmask;
    if (cur < 16) selmask = (2ull << cur) - 1ull;
    else {
        float* il = acc_lds + lane;
#pragma unroll
        for (int q = 0; q < 32; ++q) il[64 * q] = 0.f;
#pragma unroll 1
        for (int r = 0; r < 4; ++r) {
            bf16x8 qf[4]; nsa_load_q(qf, zq + r * 64);
            const float slope2 = __builtin_amdgcn_exp2f(-(float)(g * 4 + r + 1)) * LOG2E;
            f32x16 cb;
            { float hf = hif; asm volatile("" : "+v"(hf));
#pragma unroll
              for (int i = 0; i < 16; ++i) cb[i] = slope2 * 16.0f * ((float)((i & 3) + 8 * (i >> 2)) + hf); }
            float M = -1.0e30f, l = 0.f;
#pragma unroll 1
            for (int nt = ntc - 1; nt >= 0; --nt) {
                f32x16 u = nsa_st(kcb_u + nt * 32 * 64 + koff, qf, cb); nsa_mask_lt(u, nval - 32 * nt - 4 * hi);
                const float tbs = slope2 * 512.0f * (float)nt;
                float tm = max16(u); tm = fmaxf(tm, other_half_f(tm, hi));
                const float mn = fmaxf(M, tm + tbs); float sum = 0.f; const float ms = mn - tbs;
#pragma unroll
                for (int i = 0; i < 16; ++i) sum += __builtin_amdgcn_exp2f(u[i] - ms);
                l = l * __builtin_amdgcn_exp2f(M - mn) + sum; M = mn;
            }
            const float lt = l + other_half_f(l, hi); const float linv = lt > 0.f ? 1.0f / lt : 0.f;
            float carry = 0.f;
#pragma unroll 1
            for (int nt = 0; nt < ntc; ++nt) {
                f32x16 u = nsa_st(kcb_u + nt * 32 * 64 + koff, qf, cb); nsa_mask_lt(u, nval - 32 * nt - 4 * hi);
                const float ms = M - slope2 * 512.0f * (float)nt;
#pragma unroll
                for (int i = 0; i < 16; ++i) u[i] = __builtin_amdgcn_exp2f(u[i] - ms) * linv;
                float x[4], qs[4];
#pragma unroll
                for (int gq = 0; gq < 4; ++gq) { qs[gq] = (u[4 * gq] + u[4 * gq + 1]) + (u[4 * gq + 2] + u[4 * gq + 3]); x[gq] = other_half_f(u[4 * gq + 3], hi); }
                float* ip = il + 256 * nt;
                ip[0] += qs[0] + (hi ? x[0] : carry); ip[64] += qs[1] + (hi ? x[1] : x[0]); ip[128] += qs[2] + (hi ? x[2] : x[1]); ip[192] += qs[3] + (hi ? x[3] : x[2]);
                carry = x[3];
            }
        }
        unsigned uu[32];
        const int qlo = hi ? 0 : 1, qhi = (cur - 2 - hi) >> 1;
        const unsigned candm = (unsigned)((2ull << qhi) - 1ull) & ~((1u << qlo) - 1u);
#pragma unroll
        for (int q = 0; q < 32; ++q) uu[q] = __float_as_uint(il[64 * q]) & (unsigned)(-(int)((candm >> q) & 1u));
        unsigned T = 0u;
#pragma unroll 1
        for (int bit = 30; bit >= 0; --bit) { const unsigned c = T | (1u << bit); unsigned cnt = 0;
#pragma unroll
            for (int q = 0; q < 32; ++q) cnt += (uu[q] >= c) ? 1u : 0u;
            cnt += other_half_u(cnt, hi);
            if (cnt >= 13u) T = c; }
        unsigned gtm = 0u, eqm = 0u;
#pragma unroll
        for (int q = 0; q < 32; ++q) { gtm |= (uu[q] > T ? 1u : 0u) << q; eqm |= (uu[q] == T ? 1u : 0u) << q; }
        eqm &= candm;
        const unsigned ogt = other_half_u(gtm, hi), oeq = other_half_u(eqm, hi);
        const unsigned long long fgt = spread_even(hi ? ogt : gtm) | (spread_even(hi ? gtm : ogt) << 1);
        const unsigned long long feq = spread_even(hi ? oeq : eqm) | (spread_even(hi ? eqm : oeq) << 1);
        const int need = 13 - __builtin_popcountll(fgt);
        unsigned long long rem = feq;
#pragma unroll 1
        for (int i = 0; i < 13; ++i) if (i < need) rem &= rem - 1ull;
        selmask = fgt | (feq & ~rem) | 1ull | (3ull << (cur - 1));
    }
    unsigned ulo = (unsigned)selmask, uhi = (unsigned)(selmask >> 32);
#pragma unroll
    for (int o = 1; o < 32; o <<= 1) { ulo |= __shfl_xor(ulo, o); uhi |= __shfl_xor(uhi, o); }
    const unsigned long long U = ((unsigned long long)__builtin_amdgcn_readfirstlane(uhi) << 32) | (unsigned long long)__builtin_amdgcn_readfirstlane(ulo);

    float* al = acc_lds + lane;
#pragma unroll 1
    for (int r = 0; r < 4; ++r) {
        const int hh = g * 4 + r;
        bf16x8 qf[4]; nsa_load_q(qf, zq + r * 64);
        const float slope2 = __builtin_amdgcn_exp2f(-(float)(hh + 1)) * LOG2E;
        f32x16 cb;
        { float hf = hif; asm volatile("" : "+v"(hf));
#pragma unroll
          for (int i = 0; i < 16; ++i) cb[i] = slope2 * ((float)((i & 3) + 8 * (i >> 2)) + hf); }
        const float* gp = P.gates + rowq * 32 + 8 + hh * 3;
#define NSA_PINGPONG(NEXT, LOADK, LOADV, PROC) do { int kbA = 0, kbB = 0; NsaK KA, KB; NsaV VV; \
            if (NEXT(kbA)) { LOADK(KA, kbA); \
                for (;;) { const bool hB = NEXT(kbB); if (hB) { LOADK(KB, kbB); } LOADV(VV, kbA); PROC(KA, VV, kbA); if (!hB) break; \
                           const bool hA = NEXT(kbA); if (hA) { LOADK(KA, kbA); } LOADV(VV, kbB); PROC(KB, VV, kbB); if (!hA) break; } } } while (0)
        {
            const f32x16 cb16 = cb * 16.0f;
            float M = -1.0e30f, l = 0.f; f32x16 O0, O1;
#pragma unroll
            for (int i = 0; i < 16; ++i) { O0[i] = 0.f; O1[i] = 0.f; }
            int ncur = ntc - 1;
#define C_NEXT(kb) (ncur >= 0 ? (kb = ncur--, true) : false)
#define C_LOADK(R, kb) nsa_ldk(R, kcb_u + (kb) * 2048, koff)
#define C_LOADV(R, kb) nsa_ldv(R, vct_u + 32 * (kb), vct_u + 32 * (kb) + 32 * 256, vcoff)
#define C_PROC(RK, RV, kb) do { f32x16 u = nsa_st_r(RK, qf, cb16); nsa_mask_lt(u, nval - 32 * (kb) - 4 * hi); nsa_soft_pv(u, slope2 * 512.0f * (float)(kb), M, l, O0, O1, RV, hi); } while (0)
            NSA_PINGPONG(C_NEXT, C_LOADK, C_LOADV, C_PROC);
#undef C_NEXT
#undef C_LOADK
#undef C_LOADV
#undef C_PROC
            const float lt = l + other_half_f(l, hi); const float sc = lt > 0.f ? sigmoidf_(gp[0]) / lt : 0.f;
#pragma unroll
            for (int i = 0; i < 16; ++i) { al[64 * i] = O0[i] * sc; al[64 * (16 + i)] = O1[i] * sc; }
        }
        asm volatile("" ::: "memory");
        {
            float M = -1.0e30f, l = 0.f; f32x16 O0, O1;
#pragma unroll
            for (int i = 0; i < 16; ++i) { O0[i] = 0.f; O1[i] = 0.f; }
            int cj = cur, chalf = 1;
            auto snext = [&](int& kb) -> bool {
                while (cj >= 0) {
                    if (!((U >> cj) & 1ull)) { --cj; chalf = 1; continue; }
                    const int k = 64 * cj + 32 * chalf;
                    if (chalf == 1) chalf = 0; else { chalf = 1; --cj; }
                    if (k > t0) continue;
                    kb = k; return true; }
                return false; };
#define S_NEXT(kb) snext(kb)
#define S_LOADK(R, kb) nsa_ldk(R, zb_u + (size_t)(kb) * NZ + ZC_AKS, zoff)
#define S_LOADV(R, kb) nsa_ldv(R, vst_u + (kb), vst_u + (kb) + 32 * SEQ, voff)
#define S_PROC(RK, RV, kb) do { f32x16 u = nsa_st_r(RK, qf, cb); if ((kb) == t0) nsa_mask_lt(u, tqh + 1); \
                if (!((selmask >> ((kb) >> 6)) & 1ull)) { _Pragma("unroll") for (int i = 0; i < 16; ++i) u[i] = NEG_INF; } \
                nsa_soft_pv(u, slope2 * (float)((kb) - t0), M, l, O0, O1, RV, hi); } while (0)
            NSA_PINGPONG(S_NEXT, S_LOADK, S_LOADV, S_PROC);
#undef S_NEXT
#undef S_LOADK
#undef S_LOADV
#undef S_PROC
            const float lt = l + other_half_f(l, hi); const float sc = lt > 0.f ? sigmoidf_(gp[1]) / lt : 0.f;
#pragma unroll
            for (int i = 0; i < 16; ++i) { al[64 * i] += O0[i] * sc; al[64 * (16 + i)] += O1[i] * sc; }
        }
        asm volatile("" ::: "memory");
        {
            float M = -1.0e30f, l = 0.f; f32x16 O0, O1;
#pragma unroll
            for (int i = 0; i < 16; ++i) { O0[i] = 0.f; O1[i] = 0.f; }
            int wk = t0;
#define W_NEXT(kb) ((wk >= 0 && wk >= t0 - 512) ? (kb = wk, wk -= 32, true) : false)
#define W_LOADK(R, kb) nsa_ldk(R, zb_u + (size_t)(kb) * NZ + ZC_AKW, zoff)
#define W_LOADV(R, kb) nsa_ldv(R, vwt_u + (kb), vwt_u + (kb) + 32 * SEQ, voff)
#define W_PROC(RK, RV, kb) do { f32x16 u = nsa_st_r(RK, qf, cb); if ((kb) == t0) nsa_mask_lt(u, tqh + 1); if ((kb) == t0 - 512) nsa_mask_gt(u, tqh); \
                nsa_soft_pv(u, slope2 * (float)((kb) - t0), M, l, O0, O1, RV, hi); } while (0)
            NSA_PINGPONG(W_NEXT, W_LOADK, W_LOADV, W_PROC);
#undef W_NEXT
#undef W_LOADK
#undef W_LOADV
#undef W_PROC
            const float lt = l + other_half_f(l, hi); const float sc = lt > 0.f ? sigmoidf_(gp[2]) / lt : 0.f;
            bf16_t* op = P.MIX + rowq * DM + 512 + hh * 64 + 4 * hi;
#pragma unroll
            for (int q4 = 0; q4 < 4; ++q4) {
                float a[4], c[4];
#pragma unroll
                for (int e = 0; e < 4; ++e) { a[e] = al[64 * (4 * q4 + e)] + O0[4 * q4 + e] * sc; c[e] = al[64 * (16 + 4 * q4 + e)] + O1[4 * q4 + e] * sc; }
                u32x2 w0; w0.x = cvtpk(a[0], a[1]); w0.y = cvtpk(a[2], a[3]); *(u32x2*)(op + 8 * q4) = w0;
                u32x2 w1; w1.x = cvtpk(c[0], c[1]); w1.y = cvtpk(c[2], c[3]); *(u32x2*)(op + 32 + 8 * q4) = w1; }
        }
    }
}

__device__ __forceinline__ void vt_unit(const bf16_t* Z, int zcol, bf16_t* VT, int b, int g, int ch, unsigned short* tile  , int tid) {
    { const int pos = tid >> 3, c8 = (tid & 7) * 8;
      const u32x4 w = *(const u32x4*)(Z + ((size_t)b * SEQ + ch * 64 + pos) * NZ + zcol + g * 64 + c8);
      *(u32x4*)(tile + pos * 72 + c8) = w; }
    __syncthreads();
    { const int d = tid >> 3, chunk = tid & 7, gi = chunk >> 1, h = chunk & 1; unsigned short e[8];
#pragma unroll
      for (int j = 0; j < 8; ++j) { const int pos = 16 * gi + 8 * (j >> 2) + 4 * h + (j & 3); e[j] = tile[pos * 72 + d]; }
      u32x4 o; o.x = e[0] | ((unsigned)e[1] << 16); o.y = e[2] | ((unsigned)e[3] << 16); o.z = e[4] | ((unsigned)e[5] << 16); o.w = e[6] | ((unsigned)e[7] << 16);
      *(u32x4*)(VT + (((size_t)b * 2 + g) * 64 + d) * SEQ + ch * 64 + chunk * 8) = o; }
    __syncthreads();
}

constexpr int NC_KC = 0, NC_RING = 32768, NC_IMP = 81920, NC_LIST = 147456, NC_UEX = 148480, NC_QSLOT = 148512;
#define NC_WAITBAR(N) asm volatile("s_waitcnt vmcnt(" #N ") lgkmcnt(0)\n\ts_barrier" ::: "memory")

__device__ __forceinline__ void nsa_unit_coop(const NsaF& P, int b, int g, int tp, LAS3 unsigned char* L, int tid, const int dry = 0) {
    const int lane = tid & 63, wave = __builtin_amdgcn_readfirstlane(tid >> 6), tbsel = wave >> 2, r = wave & 3, tq = lane & 31, hi = lane >> 5;
    const int tb = 2 * tp + tbsel, t0 = 32 * tb, t0u = 64 * tp, cur = tp, hh = g * 4 + r;
    const size_t rowq = (size_t)b * SEQ + t0 + tq;
    const size_t bg = (size_t)b * 2 + g;
    const int nval = max(0, 2 * tb + 1 - (tq < 31 ? 1 : 0) - (tq < 15 ? 1 : 0));
    const int ntc = (2 * tb + 1 + 31) >> 5, ntc_u = (2 * (2 * tp + 1) + 1 + 31) >> 5;
    const int tqh = tq - 4 * hi;
    const float hif = (float)(4 * hi);
    const float slope2 = __builtin_amdgcn_exp2f(-(float)(hh + 1)) * LOG2E;
    bf16x8 qf[4]; nsa_load_q(qf, P.Z + rowq * NZ + ZC_AQ + hh * 64 + 8 * hi);
    const float* gp = P.gates + rowq * 32 + 8 + hh * 3;
    const float gt0 = sigmoidf_(gp[0]), gt1 = sigmoidf_(gp[1]), gt2 = sigmoidf_(gp[2]);
    asm volatile("s_waitcnt vmcnt(0)" ::: "memory");
    const int ks = wave & 3, vdt = (wave & 3) >> 1, vs = wave & 1;
    const bool isK = wave < 4;
    const bf16_t* srcC = isK ? P.KCB + (bg * 256 + tq) * 64 + 16 * ks + 8 * hi : P.VCT + (bg * 64 + 32 * vdt + tq) * 256 + 16 * vs + 8 * hi;
    const bf16_t* srcW = isK ? P.Z + ((size_t)b * SEQ + tq) * NZ + ZC_AKW + g * 64 + 16 * ks + 8 * hi : P.VWT + (bg * 64 + 32 * vdt + tq) * SEQ + 16 * vs + 8 * hi;
    const bf16_t* srcS = isK ? P.Z + ((size_t)b * SEQ + tq) * NZ + ZC_AKS + g * 64 + 16 * ks + 8 * hi : P.VST + (bg * 64 + 32 * vdt + tq) * SEQ + 16 * vs + 8 * hi;
    const size_t stepC = isK ? 32 * 64 : 32, stepP = isK ? (size_t)NZ : 1;
    volatile LAS3 int* list = (volatile LAS3 int*)(L + NC_LIST);
#define NC_DMA_E(i, ent) do { const int e_ = (ent); const int tag_ = e_ >> 16, val_ = ((e_ & 0xffff) == 0xffff) ? 0 : (e_ & 0xffff); \
        const bf16_t* s_ = (tag_ == 0) ? srcC + (size_t)val_ * stepC : ((tag_ == 1) ? srcW : srcS) + (size_t)val_ * stepP; \
        __builtin_amdgcn_global_load_lds((const unsigned*)s_, (LAS3 unsigned*)(L + NC_RING + (((i) >> 1) % 3) * 16384 + ((i) & 1) * 8192 + wave * 1024), 16, 0, 0); } while (0)
#define NC_DMA(i) NC_DMA_E(i, __builtin_amdgcn_readfirstlane(list[1 + (i)]))
    const bool topk = cur >= 16 && !(dry & 1);
    if (topk && wave < ntc_u) {
#pragma unroll
        for (int s = 0; s < 4; ++s) __builtin_amdgcn_global_load_lds((const unsigned*)(P.KCB + (bg * 256 + 32 * wave + tq) * 64 + 16 * s + 8 * hi), (LAS3 unsigned*)(L + NC_KC + wave * 4096 + s * 1024), 16, 0, 0);
    }
    if (tid == 0) { int n = 0;
        for (int nt = ntc_u - 1; nt >= 0; --nt) list[1 + n++] = nt;
        if (n & 1) list[1 + n++] = 0xffff;
        for (int kb = t0u + 32; kb >= t0u - 512 && kb >= 0; kb -= 32) list[1 + n++] = (1 << 16) | kb;
        if (n & 1) list[1 + n++] = (1 << 16) | 0xffff;
        list[0] = n; }
    asm volatile("s_waitcnt lgkmcnt(0)\n\ts_barrier" ::: "memory");
    int nlist = __builtin_amdgcn_readfirstlane(list[0]);
    NC_DMA(0); NC_DMA(1); NC_DMA(2); NC_DMA(3);
    unsigned long long selmask, Utb;
    if (!topk) { selmask = (2ull << cur) - 1ull; Utb = selmask; }
    else {
        NC_WAITBAR(4);
        float* il = (float*)0; (void)il;
        LAS3 float* ip0 = (LAS3 float*)(L + NC_IMP + (wave * 32) * 256) + lane;
#pragma unroll
        for (int q = 0; q < 32; ++q) ip0[64 * q] = 0.f;
        {
            f32x16 cb;
            { float hf = hif; asm volatile("" : "+v"(hf));
#pragma unroll
              for (int i = 0; i < 16; ++i) cb[i] = slope2 * 16.0f * ((float)((i & 3) + 8 * (i >> 2)) + hf); }
            float M = -1.0e30f, l = 0.f;
#pragma unroll 1
            for (int nt = ntc - 1; nt >= 0; --nt) {
                const LAS3 unsigned char* kp = L + NC_KC + nt * 4096 + lane * 16;
                f32x16 u = MFMA32(*(const LAS3 bf16x8*)(kp), qf[0], cb); u = MFMA32(*(const LAS3 bf16x8*)(kp + 1024), qf[1], u); u = MFMA32(*(const LAS3 bf16x8*)(kp + 2048), qf[2], u); u = MFMA32(*(const LAS3 bf16x8*)(kp + 3072), qf[3], u);
                nsa_mask_lt(u, nval - 32 * nt - 4 * hi);
                const float tbs = slope2 * 512.0f * (float)nt;
                float tm = max16(u); tm = fmaxf(tm, other_half_f(tm, hi));
                const float mn = fmaxf(M, tm + tbs); float sum = 0.f; const float ms = mn - tbs;
#pragma unroll
                for (int i = 0; i < 16; ++i) sum += __builtin_amdgcn_exp2f(u[i] - ms);
                l = l * __builtin_amdgcn_exp2f(M - mn) + sum; M = mn;
            }
            const float lt = l + other_half_f(l, hi); const float linv = lt > 0.f ? 1.0f / lt : 0.f;
            float carry = 0.f;
#pragma unroll 1
            for (int nt = 0; nt < ntc; ++nt) {
                const LAS3 unsigned char* kp = L + NC_KC + nt * 4096 + lane * 16;
                f32x16 u = MFMA32(*(const LAS3 bf16x8*)(kp), qf[0], cb); u = MFMA32(*(const LAS3 bf16x8*)(kp + 1024), qf[1], u); u = MFMA32(*(const LAS3 bf16x8*)(kp + 2048), qf[2], u); u = MFMA32(*(const LAS3 bf16x8*)(kp + 3072), qf[3], u);
                nsa_mask_lt(u, nval - 32 * nt - 4 * hi);
                const float ms = M - slope2 * 512.0f * (float)nt;
#pragma unroll
                for (int i = 0; i < 16; ++i) u[i] = __builtin_amdgcn_exp2f(u[i] - ms) * linv;
                float x[4], qs[4];
#pragma unroll
                for (int gq = 0; gq < 4; ++gq) { qs[gq] = (u[4 * gq] + u[4 * gq + 1]) + (u[4 * gq + 2] + u[4 * gq + 3]); x[gq] = other_half_f(u[4 * gq + 3], hi); }
                LAS3 float* ip = ip0 + 256 * nt;
                ip[0] += qs[0] + (hi ? x[0] : carry); ip[64] += qs[1] + (hi ? x[1] : x[0]); ip[128] += qs[2] + (hi ? x[2] : x[1]); ip[192] += qs[3] + (hi ? x[3] : x[2]);
                carry = x[3];
            }
        }
        asm volatile("s_waitcnt lgkmcnt(0)\n\ts_barrier" ::: "memory");
        unsigned uu[32];
        const int qlo = hi ? 0 : 1, qhi = (cur - 2 - hi) >> 1;
        const unsigned candm = (unsigned)((2ull << qhi) - 1ull) & ~((1u << qlo) - 1u);
        { const LAS3 float* pp = (const LAS3 float*)(L + NC_IMP + (tbsel * 4 * 32) * 256) + lane;
#pragma unroll
          for (int q = 0; q < 32; ++q) { const float v = (pp[64 * q] + pp[64 * (32 + q)]) + (pp[64 * (64 + q)] + pp[64 * (96 + q)]); uu[q] = __float_as_uint(v) & (unsigned)(-(int)((candm >> q) & 1u)); } }
        unsigned T = 0u;
#pragma unroll 1
        for (int bit = 30; bit >= 0; --bit) { const unsigned c = T | (1u << bit); unsigned cnt = 0;
#pragma unroll
            for (int q = 0; q < 32; ++q) cnt += (uu[q] >= c) ? 1u : 0u;
            cnt += other_half_u(cnt, hi);
            if (cnt >= 13u) T = c; }
        unsigned gtm = 0u, eqm = 0u;
#pragma unroll
        for (int q = 0; q < 32; ++q) { gtm |= (uu[q] > T ? 1u : 0u) << q; eqm |= (uu[q] == T ? 1u : 0u) << q; }
        eqm &= candm;
        const unsigned ogt = other_half_u(gtm, hi), oeq = other_half_u(eqm, hi);
        const unsigned long long fgt = spread_even(hi ? ogt : gtm) | (spread_even(hi ? gtm : ogt) << 1);
        const unsigned long long feq = spread_even(hi ? oeq : eqm) | (spread_even(hi ? eqm : oeq) << 1);
        const int need = 13 - __builtin_popcountll(fgt);
        unsigned long long rem = feq;
#pragma unroll 1
        for (int i = 0; i < 13; ++i) if (i < need) rem &= rem - 1ull;
        selmask = fgt | (feq & ~rem) | 1ull | (3ull << (cur - 1));
        unsigned ulo = (unsigned)selmask, uhi = (unsigned)(selmask >> 32);
#pragma unroll
        for (int o = 1; o < 32; o <<= 1) { ulo |= __shfl_xor(ulo, o); uhi |= __shfl_xor(uhi, o); }
        Utb = ((unsigned long long)__builtin_amdgcn_readfirstlane(uhi) << 32) | (unsigned long long)__builtin_amdgcn_readfirstlane(ulo);
        if (r == 0 && lane == 0) { ((volatile LAS3 unsigned*)(L + NC_UEX))[2 * tbsel] = (unsigned)Utb; ((volatile LAS3 unsigned*)(L + NC_UEX))[2 * tbsel + 1] = (unsigned)(Utb >> 32); }
        asm volatile("s_waitcnt lgkmcnt(0)\n\ts_barrier" ::: "memory");
    }
    if (tid == 0) {
        unsigned long long U;
        if (topk) { volatile LAS3 unsigned* ux = (volatile LAS3 unsigned*)(L + NC_UEX); U = ((unsigned long long)(ux[1] | ux[3]) << 32) | (unsigned long long)(ux[0] | ux[2]); } else U = (2ull << cur) - 1ull;
        int n = list[0];
        for (int j = cur; j >= 0; --j) if ((U >> j) & 1ull) { list[1 + n++] = (2 << 16) | (64 * j + 32); list[1 + n++] = (2 << 16) | (64 * j); }
        list[0] = n; }
    asm volatile("s_waitcnt lgkmcnt(0)\n\ts_barrier" ::: "memory");
    nlist = __builtin_amdgcn_readfirstlane(list[0]);
    const int lv0 = list[1 + lane], lv1 = list[65 + lane], lv2 = list[129 + lane];
#define NC_ENT(i) (((i) < 64) ? __builtin_amdgcn_readlane(lv0, (i)) : (((i) < 128) ? __builtin_amdgcn_readlane(lv1, (i) - 64) : __builtin_amdgcn_readlane(lv2, (i) - 128)))
    LAS3 float* al = (LAS3 float*)(L + NC_IMP + wave * 8192) + lane;
    f32x16 O0, O1, cb;
#pragma unroll
    for (int i = 0; i < 16; ++i) { al[64 * i] = 0.f; al[64 * (16 + i)] = 0.f; O0[i] = 0.f; O1[i] = 0.f; cb[i] = 0.f; }
    float M = -1.0e30f, l = 0.f; int curtag = -1;
#define NC_FINAL() do { const float lt_ = l + other_half_f(l, hi); const float g_ = (curtag == 0) ? gt0 : ((curtag == 1) ? gt2 : gt1); const float sc_ = lt_ > 0.f ? g_ / lt_ : 0.f; \
        _Pragma("unroll") for (int k_ = 0; k_ < 16; ++k_) { al[64 * k_] += O0[k_] * sc_; al[64 * (16 + k_)] += O1[k_] * sc_; } } while (0)
#define NC_SWITCH(tag) do { if ((tag) != curtag) { if (curtag >= 0) NC_FINAL(); curtag = (tag); M = -1.0e30f; l = 0.f; \
            float hf_ = hif; asm volatile("" : "+v"(hf_)); const float cs_ = ((tag) == 0) ? slope2 * 16.0f : slope2; \
            _Pragma("unroll") for (int k_ = 0; k_ < 16; ++k_) { O0[k_] = 0.f; O1[k_] = 0.f; cb[k_] = cs_ * ((float)((k_ & 3) + 8 * (k_ >> 2)) + hf_); } } } while (0)
#define NC_NEED(tag, val) (((tag) == 0) ? ((val) < ntc) : (((tag) == 1) ? (((val) <= t0) && ((val) >= t0 - 512)) : ((((Utb >> ((val) >> 6)) & 1ull) != 0ull) && ((val) <= t0))))
#define NC_TBIAS(tag, val) (((tag) == 0) ? slope2 * 512.0f * (float)(val) : slope2 * (float)((val) - t0))
#define NC_ST(u, sp) do { u = MFMA32(*(const LAS3 bf16x8*)(sp), qf[0], cb); u = MFMA32(*(const LAS3 bf16x8*)((sp) + 1024), qf[1], u); u = MFMA32(*(const LAS3 bf16x8*)((sp) + 2048), qf[2], u); u = MFMA32(*(const LAS3 bf16x8*)((sp) + 3072), qf[3], u); } while (0)
#define NC_MASK(u, tag, val) do { if ((tag) == 0) nsa_mask_lt(u, nval - 32 * (val) - 4 * hi); else { if ((val) == t0) nsa_mask_lt(u, tqh + 1); if ((tag) == 1 && (val) == t0 - 512) nsa_mask_gt(u, tqh); \
            if ((tag) == 2 && !((selmask >> ((val) >> 6)) & 1ull)) { _Pragma("unroll") for (int k_ = 0; k_ < 16; ++k_) u[k_] = NEG_INF; } } } while (0)
#define NC_LDV(V, sp) do { V.v0[0] = *(const LAS3 bf16x8*)((sp) + 4096); V.v0[1] = *(const LAS3 bf16x8*)((sp) + 5120); V.v1[0] = *(const LAS3 bf16x8*)((sp) + 6144); V.v1[1] = *(const LAS3 bf16x8*)((sp) + 7168); } while (0)
    const int npair = nlist >> 1;
    const int cfull = (2 * tb - 1) >> 5;
#pragma unroll 1
    for (int p = 0; p < npair; ++p) {
        if (p + 1 < npair) NC_WAITBAR(2); else NC_WAITBAR(0);
        if (p + 2 < npair) { const int i2 = 2 * (p + 2); NC_DMA_E(i2, NC_ENT(i2)); NC_DMA_E(i2 + 1, NC_ENT(i2 + 1)); }
        const int e0 = NC_ENT(2 * p), e1 = NC_ENT(2 * p + 1);
        const int tag = e0 >> 16, val0 = e0 & 0xffff, val1 = e1 & 0xffff;
        if (tag != curtag) { asm volatile("" ::: "memory"); NC_SWITCH(tag); }
        const bool need0 = !(dry & 2) && (val0 != 0xffff) && NC_NEED(tag, val0), need1 = !(dry & 2) && (val1 != 0xffff) && NC_NEED(tag, val1);
        if (need0 || need1) {
            const LAS3 unsigned char* sp0 = L + NC_RING + (p % 3) * 16384 + lane * 16; const LAS3 unsigned char* sp1 = sp0 + 8192;
            f32x16 u0, u1; NC_ST(u0, sp0); NC_ST(u1, sp1);
            const bool sp_0 = !need0 || ((tag == 0) ? (val0 >= cfull) : ((val0 == t0) || (tag == 1 && val0 == t0 - 512) || (tag == 2 && !__all((int)((selmask >> (val0 >> 6)) & 1ull)))));
            const bool sp_1 = !need1 || ((tag == 0) ? (val1 >= cfull) : ((val1 == t0) || (tag == 1 && val1 == t0 - 512) || (tag == 2 && !__all((int)((selmask >> (val1 >> 6)) & 1ull)))));
            if (sp_0) { asm volatile("" ::: "memory");
                if (!need0) { _Pragma("unroll") for (int k_ = 0; k_ < 16; ++k_) u0[k_] = NEG_INF; } else NC_MASK(u0, tag, val0); }
            if (sp_1) { asm volatile("" ::: "memory");
                if (!need1) { _Pragma("unroll") for (int k_ = 0; k_ < 16; ++k_) u1[k_] = NEG_INF; } else NC_MASK(u1, tag, val1); }
            const float tb0 = NC_TBIAS(tag, val0), tb1 = NC_TBIAS(tag, val1);
            const float tm0 = max16(u0), tm1 = max16(u1);
            float cand = fmaxf(tm0 + tb0, tm1 + tb1); cand = fmaxf(cand, other_half_f(cand, hi));
            if (__any(cand > M)) { asm volatile("" ::: "memory"); const float mn = fmaxf(M, cand); const float al_ = __builtin_amdgcn_exp2f(M - mn); l *= al_; O0 *= al_; O1 *= al_; M = mn; }
            const float ms0 = M - tb0, ms1 = M - tb1; float sum0 = 0.f, sum1 = 0.f;
#pragma unroll
            for (int i = 0; i < 16; ++i) { const float p0 = __builtin_amdgcn_exp2f(u0[i] - ms0), p1 = __builtin_amdgcn_exp2f(u1[i] - ms1); u0[i] = p0; u1[i] = p1; sum0 += p0; sum1 += p1; }
            l += sum0 + sum1;
            asm volatile("" ::: "memory");
            NsaV Va, Vb; NC_LDV(Va, sp0); NC_LDV(Vb, sp1);
            const bf16x8 pa0 = pack8(u0, 0), pa1 = pack8(u0, 1), pb0 = pack8(u1, 0), pb1 = pack8(u1, 1);
            O0 = MFMA32(Va.v0[0], pa0, O0); O1 = MFMA32(Va.v1[0], pa0, O1); O0 = MFMA32(Va.v0[1], pa1, O0); O1 = MFMA32(Va.v1[1], pa1, O1);
            O0 = MFMA32(Vb.v0[0], pb0, O0); O1 = MFMA32(Vb.v1[0], pb0, O1); O0 = MFMA32(Vb.v0[1], pb1, O0); O1 = MFMA32(Vb.v1[1], pb1, O1);
        }
    }
    if (curtag >= 0) NC_FINAL();
#undef NC_FINAL
#undef NC_SWITCH
#undef NC_NEED
#undef NC_TBIAS
#undef NC_ST
#undef NC_MASK
#undef NC_LDV
#undef NC_DMA
#undef NC_DMA_E
#undef NC_ENT
    bf16_t* op = P.MIX + rowq * DM + 512 + hh * 64 + 4 * hi;
    if (!(dry & 4))
#pragma unroll
    for (int q4 = 0; q4 < 4; ++q4) {
        u32x2 w0; w0.x = cvtpk(al[64 * (4 * q4)], al[64 * (4 * q4 + 1)]); w0.y = cvtpk(al[64 * (4 * q4 + 2)], al[64 * (4 * q4 + 3)]); *(u32x2*)(op + 8 * q4) = w0;
        u32x2 w1; w1.x = cvtpk(al[64 * (16 + 4 * q4)], al[64 * (16 + 4 * q4 + 1)]); w1.y = cvtpk(al[64 * (16 + 4 * q4 + 2)], al[64 * (16 + 4 * q4 + 3)]); *(u32x2*)(op + 32 + 8 * q4) = w1; }
}

#define LAS3 __attribute__((address_space(3)))
constexpr int ML_QC = 0, ML_KC = 17408, ML_KT = 34816, ML_VT = 53248, ML_EG = 71680, ML_N = 71936, ML_SSQ = 72960, ML_CF = 73984, ML_END = 106752;
constexpr int ML_RS = 272, ML_TS = 144;
struct MlF { const bf16_t* Z; const float* gates; bf16_t* MIX; const float* gate_bias; const float* mnorm_g; };

__device__ __forceinline__ float scan_add64(float v, int lane) {
#pragma unroll
    for (int o = 1; o < 64; o <<= 1) { const float t = __shfl_up(v, o); if (lane >= o) v += t; }
    return v;
}
__device__ __forceinline__ float scan_max64(float v, int lane) {
#pragma unroll
    for (int o = 1; o < 64; o <<= 1) { const float t = __shfl_up(v, o); if (lane >= o) v = fmaxf(v, t); }
    return v;
}
struct MlScal { float eg, inter_s, rowf_s, floorv, decay, cfac, mnew; };
__device__ __forceinline__ MlScal ml_scalars(float ipre, float fpre, float m, int lane) {
    const float lf = log_sigmoidf_(fpre);
    const float bcs = scan_add64(lf, lane);
    const float bL = __shfl(bcs, 63);
    const float g = ipre - bcs;
    const float pm = scan_max64(g, lane);
    const float gmax = __shfl(pm, 63);
    const float mm = fmaxf(m, pm), mg = fmaxf(m, gmax);
    MlScal s; const float scale = 0.08838834764831845f;
    s.eg = __expf(g - gmax); s.inter_s = __expf(m - mm) * scale; s.rowf_s = __expf(gmax - mm) * scale; s.floorv = __expf(-bcs - mm);
    s.decay = __expf(m - mg); s.cfac = __expf(gmax - mg); s.mnew = bL + mg;
    return s;
}

__device__ __forceinline__ void mlstm_unit_fast(const MlF& P, int b, int h, LAS3 unsigned char* L, int tid) {
    const int lane = tid & 63, wave = __builtin_amdgcn_readfirstlane(tid >> 6), lt = wave >> 2, dvt = wave & 3, tq = lane & 31, hi = lane >> 5;
    const float bi = P.gate_bias[h], bff = P.gate_bias[4 + h];
    const size_t row0 = (size_t)b * SEQ;
    const int ss = tid >> 3, d0 = 8 * (tid & 7);
    const bf16_t* zst = P.Z + (row0 + ss) * NZ + h * 128 + d0;
    const int s16 = ss & 15; const int sperm = (ss & ~15) + 8 * ((s16 >> 2) & 1) + (s16 & 3) + 4 * (s16 >> 3);
    const int offlo = (d0 & ~15) + ((d0 & 8) ? 4 : 0), offhi = (d0 & ~15) + ((d0 & 8) ? 12 : 8);
    const int wv_ = tid >> 6, ltv = wv_ >> 2, dvtv = wv_ & 3;
    const int lrow = 32 * ltv + tq;
    const unsigned a_qc = ML_QC + lrow * ML_RS + 16 * hi, a_kc = ML_KC + tq * ML_RS + 16 * hi, a_cf = ML_CF + (dvtv * 512 + lane) * 16;
    const unsigned a_vt = ML_VT + (32 * dvtv + tq) * ML_TS + 16 * hi, a_kt = ML_KT + (64 * ltv + tq) * ML_TS + 16 * hi, a_eg = ML_EG + 16 * hi, a_n = ML_N + 256 * hi;
    f32x16 C0, C1;
#pragma unroll
    for (int i = 0; i < 16; ++i) { C0[i] = 0.f; C1[i] = 0.f; }
    for (int i = tid; i < 256; i += NTHREADS) ((LAS3 float*)(L + ML_N))[i] = 0.f;
    for (int i = tid; i < 32768 / 16; i += NTHREADS) ((LAS3 u32x4*)(L + ML_CF))[i] = (u32x4){0u, 0u, 0u, 0u};
    float mst = 0.f;
    u32x4 rq[2], rk[2], rv[2]; float gi_, gf_;
#pragma unroll
    for (int p = 0; p < 2; ++p) { rq[p] = *(const u32x4*)(zst + ZC_MQ + 64 * p); rk[p] = *(const u32x4*)(zst + ZC_MK + 64 * p); rv[p] = *(const u32x4*)(zst + ZC_MV + 64 * p); }
    { const float* gr = P.gates + (row0 + lane) * 32; gi_ = gr[h] + bi; gf_ = gr[4 + h] + bff; }
    MlScal sc = ml_scalars(gi_, gf_, mst, lane);
#define ML_STAGE() do { \
        const float egs = __shfl(sc.eg, ss); const float cf = sc.cfac; \
        _Pragma("unroll") for (int p = 0; p < 2; ++p) { \
            *(LAS3 u32x2*)(L + ML_QC + ss * ML_RS + (offlo + 64 * p) * 2) = (u32x2){rq[p].x, rq[p].y}; *(LAS3 u32x2*)(L + ML_QC + ss * ML_RS + (offhi + 64 * p) * 2) = (u32x2){rq[p].z, rq[p].w}; \
            *(LAS3 u32x2*)(L + ML_KC + ss * ML_RS + (offlo + 64 * p) * 2) = (u32x2){rk[p].x, rk[p].y}; *(LAS3 u32x2*)(L + ML_KC + ss * ML_RS + (offhi + 64 * p) * 2) = (u32x2){rk[p].z, rk[p].w}; \
            const unsigned kw[4] = {rk[p].x, rk[p].y, rk[p].z, rk[p].w}; const unsigned vw[4] = {rv[p].x, rv[p].y, rv[p].z, rv[p].w}; \
            _Pragma("unroll") for (int e = 0; e < 4; ++e) { const int d = d0 + 64 * p + 2 * e; \
                *(LAS3 unsigned short*)(L + ML_KT + d * ML_TS + sperm * 2) = (unsigned short)f2bf(bflo(kw[e]) * cf); *(LAS3 unsigned short*)(L + ML_KT + (d + 1) * ML_TS + sperm * 2) = (unsigned short)f2bf(bfhi(kw[e]) * cf); \
                *(LAS3 unsigned short*)(L + ML_VT + d * ML_TS + sperm * 2) = (unsigned short)f2bf(bflo(vw[e]) * egs); *(LAS3 unsigned short*)(L + ML_VT + (d + 1) * ML_TS + sperm * 2) = (unsigned short)f2bf(bfhi(vw[e]) * egs); } } \
        if (wave == 0) ((LAS3 float*)(L + ML_EG))[lane] = sc.eg; } while (0)
    __syncthreads();
    ML_STAGE();
    float inter_s = __shfl(sc.inter_s, lrow), rowf_s = __shfl(sc.rowf_s, lrow), floorv = __shfl(sc.floorv, lrow), decay = sc.decay, cfac_n = sc.cfac;
    mst = sc.mnew;
#pragma unroll 1
    for (int c = 0; c < SEQ / 64; ++c) {
        __syncthreads();
        const bool more = (c + 1 < SEQ / 64);
        if (more) { const bf16_t* zn = zst + (size_t)(c + 1) * 64 * NZ;
#pragma unroll
            for (int p = 0; p < 2; ++p) { rq[p] = *(const u32x4*)(zn + ZC_MQ + 64 * p); rk[p] = *(const u32x4*)(zn + ZC_MK + 64 * p); rv[p] = *(const u32x4*)(zn + ZC_MV + 64 * p); }
            const float* gr = P.gates + (row0 + (size_t)(c + 1) * 64 + lane) * 32; gi_ = gr[h] + bi; gf_ = gr[4 + h] + bff; }
        const size_t orow = row0 + (size_t)c * 64 + lrow;
        u32x2 mo[4];
#pragma unroll
        for (int q = 0; q < 4; ++q) mo[q] = *(const u32x2*)(P.Z + orow * NZ + ZC_MO + h * 128 + 32 * dvtv + 8 * q + 4 * hi);
        bf16x8 qf[8];
#pragma unroll
        for (int kk = 0; kk < 8; ++kk) qf[kk] = *(const LAS3 bf16x8*)(L + a_qc + 32 * kk);
        float den = 0.f;
        bf16x8 xf[4];
        f32x16 z16;
#pragma unroll
        for (int i = 0; i < 16; ++i) z16[i] = 0.f;
#pragma unroll
        for (int st = 0; st < 2; ++st) {
            if (st <= lt) {
                f32x16 X = z16;
#pragma unroll
                for (int kk = 0; kk < 8; ++kk) X = MFMA32(*(const LAS3 bf16x8*)(L + a_kc + 32 * st * ML_RS + 32 * kk), qf[kk], X);
                const bool diag = (st == lt);
                int tqo = tq - 4 * hi; asm volatile("" : "+v"(tqo));
                float dsum = 0.f;
#pragma unroll
                for (int q = 0; q < 4; ++q) { const f32x4 e4 = *(const LAS3 f32x4*)(L + a_eg + (32 * st + 8 * q) * 4);
#pragma unroll
                    for (int e = 0; e < 4; ++e) { const int i = 4 * q + e; float x = X[i] * rowf_s; if (diag && (8 * q + e > tqo)) x = 0.f; X[i] = x; dsum += x * e4[e]; } }
                den += dsum;
                xf[2 * st] = pack8(X, 0); xf[2 * st + 1] = pack8(X, 1);
            }
        }
        den += other_half_f(den, hi);
        f32x16 acc = z16;
#pragma unroll
        for (int kk = 0; kk < 8; ++kk) acc = MFMA32(*(const LAS3 bf16x8*)(L + a_cf + kk * 1024), qf[kk], acc);
        float qn = 0.f;
        { const unsigned an = a_n + (c & 1) * 512; const unsigned aq = a_qc + 112 * hi;
#pragma unroll
          for (int k8 = 0; k8 < 8; ++k8) { const u32x4 w = *(const LAS3 u32x4*)(L + aq + 16 * k8); const f32x4 n0 = *(const LAS3 f32x4*)(L + an + 32 * k8), n1 = *(const LAS3 f32x4*)(L + an + 32 * k8 + 16);
              qn += bflo(w.x) * n0[0] + bfhi(w.x) * n0[1] + bflo(w.y) * n0[2] + bfhi(w.y) * n0[3] + bflo(w.z) * n1[0] + bfhi(w.z) * n1[1] + bflo(w.w) * n1[2] + bfhi(w.w) * n1[3]; } }
        qn += other_half_f(qn, hi);
        acc *= inter_s;
        bf16x8 vf[4];
#pragma unroll
        for (int s4 = 0; s4 < 4; ++s4) vf[s4] = *(const LAS3 bf16x8*)(L + a_vt + 32 * s4);
#pragma unroll
        for (int s4 = 0; s4 < 4; ++s4) if ((s4 >> 1) <= lt) acc = MFMA32(vf[s4], xf[s4], acc);
        den = inter_s * qn + den;
        const float inv = 1.0f / fmaxf(fabsf(den), floorv);
        float ssq = 0.f;
#pragma unroll
        for (int i = 0; i < 16; ++i) { acc[i] *= inv; ssq += acc[i] * acc[i]; }
        ssq += other_half_f(ssq, hi);
        if (hi == 0) *(LAS3 float*)(L + ML_SSQ + (dvtv * 64 + lrow) * 4) = ssq;
        C0 *= decay; C1 *= decay;
#pragma unroll
        for (int s4 = 0; s4 < 4; ++s4) {
            C0 = MFMA32(*(const LAS3 bf16x8*)(L + a_kt + 32 * s4), vf[s4], C0);
            C1 = MFMA32(*(const LAS3 bf16x8*)(L + a_kt + 32 * ML_TS + 32 * s4), vf[s4], C1); }
        if (tid < 128) { const int d16 = tid & 15; const int dperm = (tid & ~15) + 8 * ((d16 >> 2) & 1) + (d16 & 3) + 4 * (d16 >> 3);
            float a = 0.f;
            for (int s = 0; s < 64; ++s) a += ((const LAS3 float*)(L + ML_EG))[s] * bf2f(*(const LAS3 unsigned short*)(L + ML_KC + s * ML_RS + dperm * 2));
            LAS3 float* nn = (LAS3 float*)(L + ML_N);
            nn[((c + 1) & 1) * 128 + dperm] = decay * nn[(c & 1) * 128 + dperm] + cfac_n * a; }
        __syncthreads();
        { const LAS3 float* sq = (const LAS3 float*)(L + ML_SSQ + lrow * 4); const float ss4 = (sq[0] + sq[64]) + (sq[128] + sq[192]);
          const float rstd = 1.0f / sqrtf(ss4 * (1.0f / 128.0f) + EPS);
          bf16_t* op = P.MIX + orow * DM + h * 128 + 32 * dvtv + 4 * hi;
#pragma unroll
          for (int q = 0; q < 4; ++q) { const f32x4 gg = *(const f32x4*)(P.mnorm_g + h * 128 + 32 * dvtv + 8 * q + 4 * hi);
              const float o0 = acc[4 * q] * rstd * gg[0] * sigmoidf_(bflo(mo[q].x)), o1 = acc[4 * q + 1] * rstd * gg[1] * sigmoidf_(bfhi(mo[q].x));
              const float o2 = acc[4 * q + 2] * rstd * gg[2] * sigmoidf_(bflo(mo[q].y)), o3 = acc[4 * q + 3] * rstd * gg[3] * sigmoidf_(bfhi(mo[q].y));
              u32x2 w; w.x = cvtpk(o0, o1); w.y = cvtpk(o2, o3); *(u32x2*)(op + 8 * q) = w; } }
        { const unsigned aw = a_cf + ltv * 4096;
          *(LAS3 bf16x8*)(L + aw) = pack8(C0, 0); *(LAS3 bf16x8*)(L + aw + 1024) = pack8(C0, 1); *(LAS3 bf16x8*)(L + aw + 2048) = pack8(C1, 0); *(LAS3 bf16x8*)(L + aw + 3072) = pack8(C1, 1); }
        if (more) {
            sc = ml_scalars(gi_, gf_, mst, lane);
            ML_STAGE();
            inter_s = __shfl(sc.inter_s, lrow); rowf_s = __shfl(sc.rowf_s, lrow); floorv = __shfl(sc.floorv, lrow); decay = sc.decay; cfac_n = sc.cfac; mst = sc.mnew;
        }
    }
#undef ML_STAGE
    __syncthreads();
}


constexpr int M2_QC = 0, M2_KC = 17408, M2_K2 = 34816, M2_VC = 55296, M2_EG = 75776, M2_N = 76032, M2_SSQ = 77056, M2_CF = 78080, M2_G = 110848, M2_END = 111360;
constexpr int M2_RS = 272, M2_TS = 320;
typedef short v4i16_t __attribute__((ext_vector_type(4)));
__device__ __forceinline__ v4i16_t ml_tr(const LAS3 unsigned char* p) { return __builtin_amdgcn_ds_read_tr16_b64_v4i16((LAS3 v4i16_t*)p); }
__device__ __forceinline__ bf16x8 ml_cat(v4i16_t a, v4i16_t b) { return (bf16x8){a[0], a[1], a[2], a[3], b[0], b[1], b[2], b[3]}; }
__device__ __forceinline__ float dpp_f(float ident, float v, const int ctrl_dummy) { return v; }
#define ML_DPP(ident, v, ctrl, rmask) __builtin_bit_cast(float, __builtin_amdgcn_update_dpp(__builtin_bit_cast(int, (float)(ident)), __builtin_bit_cast(int, (float)(v)), (ctrl), (rmask), 0xf, false))
__device__ __forceinline__ float scan_add64_dpp(float v) {
    v += ML_DPP(0.f, v, 0x111, 0xf); v += ML_DPP(0.f, v, 0x112, 0xf); v += ML_DPP(0.f, v, 0x114, 0xf); v += ML_DPP(0.f, v, 0x118, 0xf);
    v += ML_DPP(0.f, v, 0x142, 0xa); v += ML_DPP(0.f, v, 0x143, 0xc); return v;
}
__device__ __forceinline__ float scan_max64_dpp(float v) {
    const float NI = -__builtin_inff();
    v = fmaxf(v, ML_DPP(NI, v, 0x111, 0xf)); v = fmaxf(v, ML_DPP(NI, v, 0x112, 0xf)); v = fmaxf(v, ML_DPP(NI, v, 0x114, 0xf)); v = fmaxf(v, ML_DPP(NI, v, 0x118, 0xf));
    v = fmaxf(v, ML_DPP(NI, v, 0x142, 0xa)); v = fmaxf(v, ML_DPP(NI, v, 0x143, 0xc)); return v;
}
struct Ml2Scal { float w, inter_s, rowf_s, floorv, decay, mnew; };
__device__ __forceinline__ Ml2Scal ml2_scalars(float ipre, float fpre, float m) {
    const float lf = log_sigmoidf_(fpre);
    const float bcs = scan_add64_dpp(lf);
    const float bL = __builtin_bit_cast(float, __builtin_amdgcn_readlane(__builtin_bit_cast(int, bcs), 63));
    const float g = ipre - bcs;
    const float pm = scan_max64_dpp(g);
    const float gmax = __builtin_bit_cast(float, __builtin_amdgcn_readlane(__builtin_bit_cast(int, pm), 63));
    const float mm = fmaxf(m, pm), mg = fmaxf(m, gmax);
    Ml2Scal s; const float scale = 0.08838834764831845f;
    s.w = __expf(g - mg); s.inter_s = __expf(m - mm) * scale; s.rowf_s = __expf(mg - mm) * scale; s.floorv = __expf(-bcs - mm);
    s.decay = __expf(m - mg); s.mnew = bL + mg;
    return s;
}

__device__ __forceinline__ void mlstm_unit_v2(const MlF& P, int b, int h, LAS3 unsigned char* L, int tid) {
    const int lane = tid & 63, wave = __builtin_amdgcn_readfirstlane(tid >> 6), lt = wave >> 2, tq = lane & 31, hi = lane >> 5;
    const float bi = P.gate_bias[h], bff = P.gate_bias[4 + h];
    const size_t row0 = (size_t)b * SEQ;
    const int ss = tid >> 3, d0 = 8 * (tid & 7);
    const bf16_t* zst = P.Z + (row0 + ss) * NZ + h * 128 + d0;
    const int wv_ = tid >> 6, ltv = wv_ >> 2, dvtv = wv_ & 3;
    const int lrow = 32 * ltv + tq;
    const int i16 = lane & 15, g16 = lane >> 4;
    const unsigned tr_lane = (unsigned)((4 * hi + (i16 >> 2)) * M2_TS + (16 * (g16 & 1) + 4 * (i16 & 3)) * 2);
    const unsigned a_qc = M2_QC + lrow * M2_RS + 16 * hi, a_qp = M2_QC + lrow * M2_RS + 8 * hi, a_kc = M2_KC + tq * M2_RS + 16 * hi, a_cf = M2_CF + (dvtv * 512 + lane) * 16;
    const unsigned a_vt = M2_VC + tr_lane + (32 * dvtv) * 2, a_kt = M2_K2 + tr_lane + (64 * ltv) * 2, a_eg = M2_EG + 16 * hi, a_n = M2_N + 256 * hi;
    f32x16 C0, C1;
#pragma unroll
    for (int i = 0; i < 16; ++i) { C0[i] = 0.f; C1[i] = 0.f; }
    for (int i = tid; i < 256; i += NTHREADS) ((LAS3 float*)(L + M2_N))[i] = 0.f;
    if (tid < 128) ((LAS3 float*)(L + M2_G))[tid] = P.mnorm_g[h * 128 + tid];
    for (int i = tid; i < 32768 / 16; i += NTHREADS) ((LAS3 u32x4*)(L + M2_CF))[i] = (u32x4){0u, 0u, 0u, 0u};
    float mst = 0.f;
    u32x4 rq[2], rk[2], rv[2]; float gi_, gf_;
#pragma unroll
    for (int p = 0; p < 2; ++p) { rq[p] = *(const u32x4*)(zst + ZC_MQ + 64 * p); rk[p] = *(const u32x4*)(zst + ZC_MK + 64 * p); rv[p] = *(const u32x4*)(zst + ZC_MV + 64 * p); }
    { const float* gr = P.gates + (row0 + lane) * 32; gi_ = gr[h] + bi; gf_ = gr[4 + h] + bff; }
    Ml2Scal sc = ml2_scalars(gi_, gf_, mst);
#define ML2_STAGE() do { \
        const float ws_ = __shfl(sc.w, ss); \
        _Pragma("unroll") for (int p = 0; p < 2; ++p) { \
            *(LAS3 u32x4*)(L + M2_QC + ss * M2_RS + (d0 + 64 * p) * 2) = rq[p]; \
            *(LAS3 u32x4*)(L + M2_KC + ss * M2_RS + (d0 + 64 * p) * 2) = rk[p]; *(LAS3 u32x4*)(L + M2_K2 + ss * M2_TS + (d0 + 64 * p) * 2) = rk[p]; \
            u32x4 o_; o_.x = cvtpk(bflo(rv[p].x) * ws_, bfhi(rv[p].x) * ws_); o_.y = cvtpk(bflo(rv[p].y) * ws_, bfhi(rv[p].y) * ws_); o_.z = cvtpk(bflo(rv[p].z) * ws_, bfhi(rv[p].z) * ws_); o_.w = cvtpk(bflo(rv[p].w) * ws_, bfhi(rv[p].w) * ws_); \
            *(LAS3 u32x4*)(L + M2_VC + ss * M2_TS + (d0 + 64 * p) * 2) = o_; } \
        if (wave == 0) ((LAS3 float*)(L + M2_EG))[lane] = sc.w; } while (0)
    __syncthreads();
    ML2_STAGE();
    float inter_s = __shfl(sc.inter_s, lrow), rowf_s = __shfl(sc.rowf_s, lrow), floorv = __shfl(sc.floorv, lrow), decay = sc.decay;
    mst = sc.mnew;
    u32x2 mo[4];
#define ML2_PREFETCH(cn) do { \
        if ((cn) < SEQ / 64) { const bf16_t* zn = zst + (size_t)(cn) * 64 * NZ; \
            _Pragma("unroll") for (int p = 0; p < 2; ++p) { rq[p] = *(const u32x4*)(zn + ZC_MQ + 64 * p); rk[p] = *(const u32x4*)(zn + ZC_MK + 64 * p); rv[p] = *(const u32x4*)(zn + ZC_MV + 64 * p); } \
            const float* gr = P.gates + (row0 + (size_t)(cn) * 64 + lane) * 32; gi_ = gr[h] + bi; gf_ = gr[4 + h] + bff; } \
        { const size_t orow_ = row0 + (size_t)((cn) - 1) * 64 + lrow; \
          _Pragma("unroll") for (int q = 0; q < 4; ++q) mo[q] = *(const u32x2*)(P.Z + orow_ * NZ + ZC_MO + h * 128 + 32 * dvtv + 8 * q + 4 * hi); } } while (0)
    ML2_PREFETCH(1);
#pragma unroll 1
    for (int c = 0; c < SEQ / 64; ++c) {
        __syncthreads();
        const bool more = (c + 1 < SEQ / 64);
        const size_t orow = row0 + (size_t)c * 64 + lrow;
        float den = 0.f;
        bf16x8 xf[4];
        {
            bf16x8 qf[8];
#pragma unroll
            for (int kk = 0; kk < 8; ++kk) qf[kk] = *(const LAS3 bf16x8*)(L + a_qc + 32 * kk);
#pragma unroll
            for (int st = 0; st < 2; ++st) {
                if (st <= lt) {
                    f32x16 X;
#pragma unroll
                    for (int i = 0; i < 16; ++i) X[i] = 0.f;
#pragma unroll
                    for (int kk = 0; kk < 8; ++kk) X = MFMA32(*(const LAS3 bf16x8*)(L + a_kc + 32 * st * M2_RS + 32 * kk), qf[kk], X);
                    const bool diag = (st == lt);
                    int tqo = tq - 4 * hi; asm volatile("" : "+v"(tqo));
                    float dsum = 0.f;
#pragma unroll
                    for (int q = 0; q < 4; ++q) { const f32x4 e4 = *(const LAS3 f32x4*)(L + a_eg + (32 * st + 8 * q) * 4);
#pragma unroll
                        for (int e = 0; e < 4; ++e) { const int i = 4 * q + e; float x = X[i] * rowf_s; if (diag && (8 * q + e > tqo)) x = 0.f; X[i] = x; dsum += x * e4[e]; } }
                    den += dsum;
                    xf[2 * st] = pack8(X, 0); xf[2 * st + 1] = pack8(X, 1);
                }
            }
        }
        den += other_half_f(den, hi);
        asm volatile("" ::: "memory");
        f32x16 acc;
#pragma unroll
        for (int i = 0; i < 16; ++i) acc[i] = 0.f;
#pragma unroll
        for (int kk = 0; kk < 8; ++kk) { const u32x2 qa = *(const LAS3 u32x2*)(L + a_qp + 32 * kk), qb = *(const LAS3 u32x2*)(L + a_qp + 32 * kk + 16);
            const u32x4 qq = (u32x4){qa.x, qa.y, qb.x, qb.y};
            acc = MFMA32(*(const LAS3 bf16x8*)(L + a_cf + kk * 1024), __builtin_bit_cast(bf16x8, qq), acc); }
        asm volatile("" ::: "memory");
        float qn = 0.f;
        { const unsigned an = a_n + (c & 1) * 512; const unsigned aq = M2_QC + lrow * M2_RS + 128 * hi;
#pragma unroll
          for (int k8 = 0; k8 < 8; ++k8) { const u32x4 w = *(const LAS3 u32x4*)(L + aq + 16 * k8); const f32x4 n0 = *(const LAS3 f32x4*)(L + an + 32 * k8), n1 = *(const LAS3 f32x4*)(L + an + 32 * k8 + 16);
              qn += bflo(w.x) * n0[0] + bfhi(w.x) * n0[1] + bflo(w.y) * n0[2] + bfhi(w.y) * n0[3] + bflo(w.z) * n1[0] + bfhi(w.z) * n1[1] + bflo(w.w) * n1[2] + bfhi(w.w) * n1[3]; } }
        qn += other_half_f(qn, hi);
        acc *= inter_s;
        bf16x8 vf[4];
#pragma unroll
        for (int s4 = 0; s4 < 4; ++s4) vf[s4] = ml_cat(ml_tr(L + a_vt + 16 * s4 * M2_TS), ml_tr(L + a_vt + (16 * s4 + 8) * M2_TS));
#pragma unroll
        for (int s4 = 0; s4 < 4; ++s4) if ((s4 >> 1) <= lt) acc = MFMA32(vf[s4], xf[s4], acc);
        den = inter_s * qn + den;
        const float inv = 1.0f / fmaxf(fabsf(den), floorv);
        float ssq = 0.f;
#pragma unroll
        for (int i = 0; i < 16; ++i) { acc[i] *= inv; ssq += acc[i] * acc[i]; }
        ssq += other_half_f(ssq, hi);
        if (hi == 0) *(LAS3 float*)(L + M2_SSQ + (dvtv * 64 + lrow) * 4) = ssq;
        asm volatile("" ::: "memory");
        C0 *= decay; C1 *= decay;
#pragma unroll
        for (int s4 = 0; s4 < 4; ++s4) {
            C0 = MFMA32(ml_cat(ml_tr(L + a_kt + 16 * s4 * M2_TS), ml_tr(L + a_kt + (16 * s4 + 8) * M2_TS)), vf[s4], C0);
            C1 = MFMA32(ml_cat(ml_tr(L + a_kt + 64 + 16 * s4 * M2_TS), ml_tr(L + a_kt + 64 + (16 * s4 + 8) * M2_TS)), vf[s4], C1); }
        if (tid < 128) { float a = 0.f;
#pragma unroll 16
            for (int s = 0; s < 64; ++s) a += ((const LAS3 float*)(L + M2_EG))[s] * bf2f(*(const LAS3 unsigned short*)(L + M2_KC + s * M2_RS + tid * 2));
            LAS3 float* nn = (LAS3 float*)(L + M2_N);
            nn[((c + 1) & 1) * 128 + tid] = decay * nn[(c & 1) * 128 + tid] + a; }
        __syncthreads();
        { const LAS3 float* sq = (const LAS3 float*)(L + M2_SSQ + lrow * 4); const float ss4 = (sq[0] + sq[64]) + (sq[128] + sq[192]);
          const float rstd = 1.0f / sqrtf(ss4 * (1.0f / 128.0f) + EPS);
          bf16_t* op = P.MIX + orow * DM + h * 128 + 32 * dvtv + 4 * hi;
#pragma unroll
          for (int q = 0; q < 4; ++q) { const f32x4 gg = *(const LAS3 f32x4*)(L + M2_G + (32 * dvtv + 8 * q + 4 * hi) * 4);
              const float o0 = acc[4 * q] * rstd * gg[0] * sigmoidf_(bflo(mo[q].x)), o1 = acc[4 * q + 1] * rstd * gg[1] * sigmoidf_(bfhi(mo[q].x));
              const float o2 = acc[4 * q + 2] * rstd * gg[2] * sigmoidf_(bflo(mo[q].y)), o3 = acc[4 * q + 3] * rstd * gg[3] * sigmoidf_(bfhi(mo[q].y));
              u32x2 w; w.x = cvtpk(o0, o1); w.y = cvtpk(o2, o3); *(u32x2*)(op + 8 * q) = w; } }
        { const unsigned aw = a_cf + ltv * 4096;
          *(LAS3 bf16x8*)(L + aw) = pack8(C0, 0); *(LAS3 bf16x8*)(L + aw + 1024) = pack8(C0, 1); *(LAS3 bf16x8*)(L + aw + 2048) = pack8(C1, 0); *(LAS3 bf16x8*)(L + aw + 3072) = pack8(C1, 1); }
        if (more) {
            sc = ml2_scalars(gi_, gf_, mst);
            ML2_STAGE();
            inter_s = __shfl(sc.inter_s, lrow); rowf_s = __shfl(sc.rowf_s, lrow); floorv = __shfl(sc.floorv, lrow); decay = sc.decay; mst = sc.mnew;
            ML2_PREFETCH(c + 2);
        }
    }
#undef ML2_PREFETCH
#undef ML2_STAGE
    __syncthreads();
}

#define LAS __attribute__((address_space(3)))
#define XB_TMO      128
#define XB_XCNT(j)  (256  + 64 * (j))
#define XB_XSUB(j)  (1280 + 64 * (j))
#define XB_XGEN(j)  (2304 + 64 * (j))
#define XB_TOP      3328
#define XB_TOPGEN   3392
#define XCD_BAR_WORDS 3456
#define XB_SPIN_CAP (1u << 18)

__device__ __forceinline__ unsigned xb_ld(unsigned* p)              { return __hip_atomic_load(p, __ATOMIC_RELAXED, __HIP_MEMORY_SCOPE_AGENT); }
__device__ __forceinline__ unsigned xb_add(unsigned* p, unsigned v) { return __hip_atomic_fetch_add(p, v, __ATOMIC_RELAXED, __HIP_MEMORY_SCOPE_AGENT); }
__device__ __forceinline__ unsigned xb_xcc_id() { return (unsigned)__builtin_amdgcn_s_getreg((3 << 11) | 20) & 0xFu; }
#define XB_SPIN(cond, bar) do { unsigned _sp = 0; while (cond) { __builtin_amdgcn_s_sleep(1); \
    if ((++_sp & 255u) == 0u) { if (xb_ld(&(bar)[XB_TMO])) break; if (_sp > XB_SPIN_CAP) { atomicAdd(&(bar)[XB_TMO], 1u); break; } } } } while (0)

struct XcdBarrier {
    unsigned* bar; unsigned x;
    volatile LAS unsigned* st;
};

__device__ __forceinline__ XcdBarrier xcd_barrier_post(unsigned* bar, volatile LAS unsigned* st) {
    XcdBarrier b; b.bar = bar; b.x = xb_xcc_id(); b.st = st;
    if (threadIdx.x == 0) (void)xb_add(&bar[XB_XCNT(b.x)], 1u);
    return b;
}
__device__ __forceinline__ void xcd_barrier_complete(unsigned* bar, unsigned x, unsigned& nloc, unsigned& nx) {
    const unsigned G = gridDim.x * gridDim.y * gridDim.z;
    unsigned sum, cnt, mine, sp = 0u;
    for (;;) {
        sum = 0u; cnt = 0u; mine = 0u;
#pragma unroll
        for (unsigned j = 0; j < 16; ++j) { const unsigned c = xb_ld(&bar[XB_XCNT(j)]); sum += c; cnt += (c > 0u) ? 1u : 0u; mine = (j == x) ? c : mine; }
        if (sum == G) break;
        __builtin_amdgcn_s_sleep(1);
        if ((++sp & 255u) == 0u) { if (xb_ld(&bar[XB_TMO])) break; if (sp > XB_SPIN_CAP) { atomicAdd(&bar[XB_TMO], 1u); break; } }
    }
    nloc = mine > 0u ? mine : 1u; nx = cnt > 0u ? cnt : 1u;
}

__device__ __forceinline__ void xcd_barrier(const XcdBarrier& b) {
    asm volatile("s_waitcnt vmcnt(0)" ::: "memory");
    __syncthreads();
    if (threadIdx.x == 0) {
        unsigned* bar = b.bar;
        __builtin_amdgcn_s_waitcnt(0);
        unsigned nloc = b.st[0], nx = b.st[1];
        if (nloc == 0u) { xcd_barrier_complete(bar, b.x, nloc, nx); b.st[0] = nloc; b.st[1] = nx; }
        const unsigned old = xb_add(&bar[XB_XSUB(b.x)], 1u);
        const unsigned gen = old / nloc;
        if (old + 1u == (gen + 1u) * nloc) {
            __builtin_amdgcn_fence(__ATOMIC_RELEASE, "agent");
            asm volatile("s_waitcnt vmcnt(0)" ::: "memory");
            const unsigned og = xb_add(&bar[XB_TOP], 1u);
            const unsigned tg = og / nx;
            if (og + 1u == (tg + 1u) * nx) xb_add(&bar[XB_TOPGEN], 1u);
            else XB_SPIN(xb_ld(&bar[XB_TOPGEN]) == tg, bar);
            __builtin_amdgcn_fence(__ATOMIC_ACQUIRE, "agent");
            xb_add(&bar[XB_XGEN(b.x)], 1u);
            asm volatile("s_waitcnt vmcnt(0)" ::: "memory");
        } else {
            XB_SPIN(xb_ld(&bar[XB_XGEN(b.x)]) == gen, bar);
            __builtin_amdgcn_fence(__ATOMIC_ACQUIRE, "agent");
            asm volatile("s_waitcnt vmcnt(0)" ::: "memory");
        }
    }
    __syncthreads();
}

__global__ void __launch_bounds__(NTHREADS, 2) fwd_kernel(Params prm) {
    extern __shared__ __attribute__((aligned(16))) unsigned char lds[];
    cg::grid_group grid = cg::this_grid();
    PG8_LAS unsigned char* ldsl = (PG8_LAS unsigned char*)lds;
    float* lds_f = (float*)lds;
#define TID ((int)threadIdx.x)
#define LANE ((int)(threadIdx.x & 63))
#define WAVE (__builtin_amdgcn_readfirstlane((int)(threadIdx.x >> 6)))
#define GRIDN ((int)gridDim.x)
#define BX ((int)blockIdx.x)
#define WSP(T, name, off) T* name; { unsigned char* w_ = prm.ws; asm volatile("" : "+s"(w_)); name = (T*)(w_ + (off)); }
    { volatile LAS unsigned* st0 = (volatile LAS unsigned*)((LAS unsigned char*)lds + XBAR_LDS); if (threadIdx.x < 2) st0[threadIdx.x] = 0u; }
    __syncthreads();
    XcdBarrier xbar; { unsigned char* w_ = prm.ws; asm volatile("" : "+s"(w_)); xbar = xcd_barrier_post((unsigned*)(w_ + WS_CTL) + 4096, (volatile LAS unsigned*)((LAS unsigned char*)lds + XBAR_LDS)); }
#ifndef DUP_PHASE
#define DUPREPS(k) 1
#else
#define DUPREPS(k) ((k) == DUP_PHASE ? 2 : 1)
#endif
#ifdef PROBE_A
#define STAMP(k) do { if (BX == 0 && TID == 0) { unsigned char* w_ = prm.ws; asm volatile("" : "+s"(w_)); ((unsigned long long*)w_)[k] = __builtin_amdgcn_s_memrealtime(); } } while (0)
#else
#define STAMP(k) do { } while (0)
#endif
    STAMP(0);

    _Pragma("unroll 1") for (int rep_ = 0; rep_ < DUPREPS(0); ++rep_)
    {
        const int lane = LANE, wave = WAVE, G = GRIDN, bx = BX, tid = TID; const int gw = bx * NWAVES + wave, NGW = G * NWAVES;
        WSP(bf16_t, Win_t, WS_WIN) WSP(bf16_t, Wout_t, WS_WOUT) WSP(bf16_t, Wup_t, WS_WUP) WSP(bf16_t, Wdn_t, WS_WDN) WSP(bf16_t, Wpg_t, WS_WPG) WSP(bf16_t, Wpp_t, WS_WPP)
        WSP(bf16_t, XB, WS_XB) WSP(bf16_t, PB, WS_PB) WSP(bf16_t, W1T, WS_W1T) WSP(bf16_t, W2T, WS_W2T) WSP(float, C1, WS_C1)
        const float* x = prm.in[0]; const float* pin = prm.in[1];
        float* scr = lds_f + wave * 4096;
        constexpr int I_IN = (DM / 64) * (3360 / 32), I_OUT = (DM / 64) * (DM / 32), I_UP = (DM / 64) * (4096 / 32), I_DN = (DFF / 64) * (DM / 32), I_PG = I_OUT, I_PP = (PLE / 64) * (DM / 32);
        constexpr int I_W1 = 4 * 64, I_W2 = 2 * 4;
        constexpr int NITEMS = I_IN + I_OUT + I_UP + I_DN + I_PG + I_PP + I_W1 + I_W2;
        for (int it = gw; it < NITEMS; it += NGW) {
            int r = it;
            if (r < I_IN) { p0_transpose_item(prm.in[3], nullptr, DM, 3360, Win_t, scr, r, lane); continue; } r -= I_IN;
            if (r < I_OUT) { p0_transpose_item(prm.in[12], nullptr, DM, DM, Wout_t, scr, r, lane); continue; } r -= I_OUT;
            if (r < I_UP) { p0_transpose_item<true>(prm.in[14], prm.in[13], DM, 4096, Wup_t, scr, r, lane); continue; } r -= I_UP;
            if (r < I_DN) { p0_transpose_item(prm.in[17], nullptr, DFF, DM, Wdn_t, scr, r, lane); continue; } r -= I_DN;
            if (r < I_PG) { p0_transpose_item(prm.in[19], prm.in[18], DM, DM, Wpg_t, scr, r, lane); continue; } r -= I_PG;
            if (r < I_PP) { p0_transpose_item(prm.in[20], nullptr, PLE, DM, Wpp_t, scr, r, lane); continue; } r -= I_PP;
            if (r < I_W1) { const int q = r >> 6, kv = q >> 1, half = q & 1;
                p0_transpose_item(prm.in[kv ? 10 : 8] + (size_t)half * 1024 * 128, nullptr, 1024, 128, W1T + (size_t)kv * 256 * 1024 + (size_t)half * 128 * 1024, scr, r & 63, lane); continue; } r -= I_W1;
            { const int kv = r >> 2; p0_transpose_item(prm.in[kv ? 11 : 9], nullptr, 128, 64, W2T + (size_t)kv * 64 * 128, scr, r & 3, lane); }
        }
        if (tid < 256) { const int kv = tid >> 7, j = tid & 127; const float* pe = prm.in[kv ? 7 : 6]; const float* w1 = prm.in[kv ? 10 : 8]; float a = 0.f;
            const int per = (2048 + G - 1) / G; const int l0 = bx * per, l1 = min(2048, l0 + per);
            for (int ld = l0; ld < l1; ++ld) a += pe[ld] * w1[(size_t)ld * 128 + j];
            if (l0 < l1) atomicAdd(C1 + kv * 128 + j, a); }
        for (int i = bx * NTHREADS + tid; i < (NZ - 3360) * DM / 8; i += G * NTHREADS) ((u32x4*)(Win_t + (size_t)3360 * DM))[i] = (u32x4){0u, 0u, 0u, 0u};
        const float* g1 = prm.in[2];
        f32x4 gv[4];
#pragma unroll
        for (int j = 0; j < 4; ++j) gv[j] = ((const f32x4*)g1)[lane + 64 * j];
        for (int m = 2 * gw; m < MTOK; m += 2 * NGW) {
            f32x4 v[2][4]; float sq[2];
#pragma unroll
            for (int k = 0; k < 2; ++k) { const f32x4* xr = (const f32x4*)(x + (size_t)(m + k) * DM) + lane;
#pragma unroll
                for (int j = 0; j < 4; ++j) v[k][j] = xr[64 * j]; }
#pragma unroll
            for (int k = 0; k < 2; ++k) { float s = 0.f;
#pragma unroll
                for (int j = 0; j < 4; ++j) s += (v[k][j][0] * v[k][j][0] + v[k][j][1] * v[k][j][1]) + (v[k][j][2] * v[k][j][2] + v[k][j][3] * v[k][j][3]);
                sq[k] = s; }
#pragma unroll
            for (int o = 1; o < 64; o <<= 1) { sq[0] += __shfl_xor(sq[0], o); sq[1] += __shfl_xor(sq[1], o); }
#pragma unroll
            for (int k = 0; k < 2; ++k) { const float rstd = 1.0f / sqrtf(sq[k] * (1.0f / DM) + EPS);
                u32x2* o8 = (u32x2*)(XB + (size_t)(m + k) * DM) + lane;
#pragma unroll
                for (int j = 0; j < 4; ++j) { u32x2 w; w.x = pk2(v[k][j][0] * rstd * gv[j][0], v[k][j][1] * rstd * gv[j][1]); w.y = pk2(v[k][j][2] * rstd * gv[j][2], v[k][j][3] * rstd * gv[j][3]); o8[64 * j] = w; } }
        }
        for (size_t i = (size_t)bx * NTHREADS + tid; i < (size_t)MTOK * PLE / 8; i += (size_t)G * NTHREADS) {
            const f32x4 a = ((const f32x4*)pin)[2 * i], c = ((const f32x4*)pin)[2 * i + 1];
            u32x4 w; w.x = pk2(a[0], a[1]); w.y = pk2(a[2], a[3]); w.z = pk2(c[0], c[1]); w.w = pk2(c[2], c[3]); ((u32x4*)PB)[i] = w; }
    }
    grid.sync();
    STAMP(1);

    _Pragma("unroll 1") for (int rep_ = 0; rep_ < DUPREPS(1); ++rep_)
    {
        WSP(bf16_t, XB, WS_XB) WSP(bf16_t, Win_t, WS_WIN) WSP(bf16_t, Z, WS_Z) WSP(float, GATES, WS_GATES)
        pg8::Gemm g{XB, Win_t, MTOK, NZ, DM}; pg8::StaticOrder S; S.init(MTOK, NZ, GRIDN, BX);
#ifdef P1_PLAIN_DUP
        if (rep_ > 0) { pg8::EpiBf<false> E2{Z, NZ, nullptr}; pg8::gemm_phase<pg8::EpiBf<false>, pg8::StaticOrder, true, true>(ldsl, g, S, E2); } else
#endif
        { pg8::EpiZ E{Z, GATES};
        pg8::gemm_phase<pg8::EpiZ, pg8::StaticOrder, true, true>(ldsl, g, S, E); }
    }
    xcd_barrier(xbar);
    STAMP(2);

    _Pragma("unroll 1") for (int rep_ = 0; rep_ < DUPREPS(2); ++rep_)
    {
        WSP(bf16_t, Z, WS_Z) WSP(bf16_t, KCB, WS_KCB) WSP(bf16_t, VCT, WS_VCT) WSP(bf16_t, VST, WS_VST) WSP(bf16_t, VWT, WS_VWT)
        const bool split = GRIDN > 128;
        if (!split || BX < 64) {
            WSP(bf16_t, W1T, WS_W1T) WSP(bf16_t, W2T, WS_W2T) WSP(float, C1, WS_C1)
            for (int un = BX; un < 64; un += (split ? 64 : GRIDN)) {
                pg8::Gemm g{nullptr, nullptr, 256, 256, 1024, 16 * NZ, NZ * 2}; pg8::CmpOrder S{un, Z, W1T};
                pg8::EpiCmp E{C1, W2T, KCB, VCT};
                pg8::gemm_phase<pg8::EpiCmp, pg8::CmpOrder, true, true>(ldsl, g, S, E);
                __syncthreads();
            }
        }
        if (!split || BX >= 64)
        for (int un = split ? BX - 64 : BX; un < BATCH * 2 * 2 * 64; un += (split ? GRIDN - 64 : GRIDN)) {
            const int ch = un & 63, br = (un >> 6) & 1, g = (un >> 7) & 1, b = un >> 8;
            vt_unit(Z, br ? ZC_AVW : ZC_AVS, br ? VWT : VST, b, g, ch, (unsigned short*)lds, TID);
        }
    }
    xcd_barrier(xbar);
    STAMP(3);

    _Pragma("unroll 1") for (int rep_ = 0; rep_ < DUPREPS(3); ++rep_)
    {
        WSP(bf16_t, Z, WS_Z) WSP(float, GATES, WS_GATES) WSP(bf16_t, MIX, WS_MIX)
        {
            MlF MP{Z, GATES, MIX, prm.in[4], prm.in[5]};
            _Pragma("unroll 1") for (int rep2_ = 0; rep2_ < DUPREPS(30); ++rep2_)
            for (int un = BX; un < BATCH * 4; un += GRIDN) mlstm_unit_v2(MP, un >> 2, un & 3, (LAS3 unsigned char*)lds, TID);
        }
        __syncthreads();
        {
            WSP(bf16_t, KCB, WS_KCB) WSP(bf16_t, VCT, WS_VCT) WSP(bf16_t, VST, WS_VST) WSP(bf16_t, VWT, WS_VWT)
            NsaF NP{Z, GATES, KCB, VCT, VST, VWT, MIX};
            unsigned* qctr; { unsigned char* w_ = prm.ws; asm volatile("" : "+s"(w_)); qctr = (unsigned*)(w_ + WS_CTL) + 64; }
            volatile LAS3 int* slot = (volatile LAS3 int*)((LAS3 unsigned char*)lds + NC_QSLOT);
            _Pragma("unroll 1") for (int rep2_ = 0; rep2_ < DUPREPS(31); ++rep2_)
            for (;;) {
                if (TID == 0) *slot = (int)atomicAdd(qctr + 64 * rep2_, 1u);
                __syncthreads();
                const int grp = *slot;
                __syncthreads();
                if (grp >= BATCH * 2 * 64) break;
#ifdef NSA_DRY
                nsa_unit_coop(NP, (grp >> 1) & 15, grp & 1, 63 - (grp >> 5), (LAS3 unsigned char*)lds, TID, rep2_ ? NSA_DRY : 0);
#else
                nsa_unit_coop(NP, (grp >> 1) & 15, grp & 1, 63 - (grp >> 5), (LAS3 unsigned char*)lds, TID);
#endif
            }
        }
    }
    xcd_barrier(xbar);
    STAMP(4);

    _Pragma("unroll 1") for (int rep_ = 0; rep_ < DUPREPS(4); ++rep_)
    {
        WSP(bf16_t, MIX, WS_MIX) WSP(bf16_t, Wout_t, WS_WOUT) WSP(bf16_t, XB, WS_XB) WSP(float, RS2, WS_RS2)
        pg8::Gemm g{MIX, Wout_t, MTOK, DM, DM}; pg8::PanelOrder S; S.init(MTOK, GRIDN, BX);
        pg8::EpiRes<true> E{prm.in[0], nullptr, XB, RS2};
        pg8::gemm_phase<pg8::EpiRes<true>, pg8::PanelOrder, true, true>(ldsl, g, S, E);
        WSP(float, RSTD2, WS_RSTD2)
        asm volatile("s_waitcnt vmcnt(0)" ::: "memory"); __syncthreads();
        for (int p = BX; p < MTOK / 256; p += GRIDN) if (TID < 256) { const int row = p * 256 + TID; RSTD2[row] = pg8::row_rstd(RS2, row); }
    }
    xcd_barrier(xbar);
    STAMP(5);

    _Pragma("unroll 1") for (int rep_ = 0; rep_ < DUPREPS(5); ++rep_)
    {
        WSP(bf16_t, XB, WS_XB) WSP(bf16_t, Wup_t, WS_WUP) WSP(bf16_t, ACT, WS_ACT) WSP(float, RS2, WS_RSTD2)
        PG8_LAS float* car = (PG8_LAS float*)(ldsl + 131072 + 1024);
        pg8::Gemm g{XB, Wup_t, MTOK, 4096, DM, 0, 0}; pg8::ChainOrder S{BX};
        pg8::EpiUpConv E{ACT, RS2, prm.in[15], prm.in[16], car};
        pg8::gemm_phase<pg8::EpiUpConv, pg8::ChainOrder, true, true>(ldsl, g, S, E);
    }
    xcd_barrier(xbar);
    STAMP(6);

    _Pragma("unroll 1") for (int rep_ = 0; rep_ < DUPREPS(7); ++rep_)
    {
        WSP(bf16_t, ACT, WS_ACT) WSP(bf16_t, Wdn_t, WS_WDN) WSP(bf16_t, XB, WS_XB) WSP(float, RS3, WS_RS3)
        pg8::Gemm g{ACT, Wdn_t, MTOK, DM, DFF}; pg8::PanelOrder S; S.init(MTOK, GRIDN, BX);
        pg8::EpiRes<false> E{nullptr, XB, XB, RS3};
        pg8::gemm_phase<pg8::EpiRes<false>, pg8::PanelOrder, true, true>(ldsl, g, S, E);
        WSP(float, RSTD3, WS_RSTD3)
        asm volatile("s_waitcnt vmcnt(0)" ::: "memory"); __syncthreads();
        for (int p = BX; p < MTOK / 256; p += GRIDN) if (TID < 256) { const int row = p * 256 + TID; RSTD3[row] = pg8::row_rstd(RS3, row); }
    }
    _Pragma("unroll 1") for (int rep_ = 0; rep_ < DUPREPS(8); ++rep_)
    {
        WSP(bf16_t, PB, WS_PB) WSP(bf16_t, Wpp_t, WS_WPP) WSP(bf16_t, PROJ, WS_PROJ)
        pg8::Gemm g{PB, Wpp_t, MTOK, DM, PLE}; pg8::StaticOrder S; S.init(MTOK, DM, GRIDN, BX);
        pg8::EpiBf<false> E{PROJ, DM, nullptr};
        pg8::gemm_phase<pg8::EpiBf<false>, pg8::StaticOrder, true, true>(ldsl, g, S, E);
    }
    xcd_barrier(xbar);
    STAMP(8);

    _Pragma("unroll 1") for (int rep_ = 0; rep_ < DUPREPS(9); ++rep_)
    {
        WSP(bf16_t, XB, WS_XB) WSP(bf16_t, Wpg_t, WS_WPG) WSP(bf16_t, PROJ, WS_PROJ) WSP(float, RS3, WS_RSTD3)
        pg8::Gemm g{XB, Wpg_t, MTOK, DM, DM}; pg8::PanelOrder S; S.init(MTOK, GRIDN, BX);
        WSP(bf16_t, X3B, WS_ACT) WSP(float, RS4, WS_RS2)
        pg8::EpiPle E{XB, PROJ, RS3, X3B, RS4};
        pg8::gemm_phase<pg8::EpiPle, pg8::PanelOrder, true, true>(ldsl, g, S, E);
    }
    xcd_barrier(xbar);
    STAMP(9);

    _Pragma("unroll 1") for (int rep_ = 0; rep_ < DUPREPS(10); ++rep_)
    {
        WSP(bf16_t, X3B, WS_ACT) WSP(float, RS4, WS_RS2)
        const int lane = LANE; const int gw = BX * NWAVES + WAVE, NGW = GRIDN * NWAVES;
        const float* fg = prm.in[21]; float* out = prm.out;
        f32x4 gv[4];
#pragma unroll
        for (int j = 0; j < 4; ++j) gv[j] = ((const f32x4*)fg)[4 * lane + j];
        for (int m = 2 * gw; m < MTOK; m += 2 * NGW) {
            u32x4 xa[2][2]; float ss[2];
#pragma unroll
            for (int k = 0; k < 2; ++k) { const u32x4* xr = (const u32x4*)(X3B + (size_t)(m + k) * DM) + 2 * lane; xa[k][0] = xr[0]; xa[k][1] = xr[1];
                ss[k] = (lane < 16) ? RS4[(size_t)(m + k) * 16 + lane] : 0.f; }
#pragma unroll
            for (int k = 0; k < 2; ++k) { float s = ss[k]; s += __shfl_xor(s, 1); s += __shfl_xor(s, 2); s += __shfl_xor(s, 4); s += __shfl_xor(s, 8); s = __shfl(s, 0);
                const float rstd = 1.0f / sqrtf(s * (1.0f / DM) + EPS);
                f32x4* o = (f32x4*)(out + (size_t)(m + k) * DM) + 4 * lane;
                const u32x4 w0 = xa[k][0], w1 = xa[k][1];
                o[0] = (f32x4){bflo(w0.x), bfhi(w0.x), bflo(w0.y), bfhi(w0.y)} * rstd * gv[0]; o[1] = (f32x4){bflo(w0.z), bfhi(w0.z), bflo(w0.w), bfhi(w0.w)} * rstd * gv[1];
                o[2] = (f32x4){bflo(w1.x), bfhi(w1.x), bflo(w1.y), bfhi(w1.y)} * rstd * gv[2]; o[3] = (f32x4){bflo(w1.z), bfhi(w1.z), bflo(w1.w), bfhi(w1.w)} * rstd * gv[3]; }
        }
    }
#ifdef PROBE_A
    xcd_barrier(xbar);
    {
        unsigned char* w_ = prm.ws; asm volatile("" : "+s"(w_)); const unsigned long long* ts = (const unsigned long long*)w_;
        const float ta = (float)(ts[PROBE_A + 1] - ts[PROBE_A]) * 0.01f, tb = (float)(ts[PROBE_B + 1] - ts[PROBE_B]) * 0.01f;
        float* out = prm.out;
        if (BX == 0 && TID == 0) out[0] += ta;
        for (size_t i = (size_t)BX * NTHREADS + TID; i < (size_t)1024 * 1024; i += (size_t)GRIDN * NTHREADS) out[1024 + i] += tb * 0.01f;
    }
#endif

}

extern "C" void kernel_launch(void* const* d_in, const int* in_sizes, int n_in, void* d_out, int out_size, void* d_ws, size_t ws_size, hipStream_t stream) {
    static int grid = 0;
    if (grid == 0) {
        if (n_in != 22 || out_size != MTOK * DM || ws_size < WS_END) { fprintf(stderr, "kernel_launch: unexpected problem (n_in %d, out %d, ws %zu)\n", n_in, out_size, ws_size); grid = -1; return; }
        int dev = 0, cus = 0, per_cu = 0;
        if (hipGetDevice(&dev) != hipSuccess || hipDeviceGetAttribute(&cus, hipDeviceAttributeMultiprocessorCount, dev) != hipSuccess) { grid = -1; return; }
        if (hipFuncSetAttribute((const void*)fwd_kernel, hipFuncAttributeMaxDynamicSharedMemorySize, LDS_BYTES) != hipSuccess) { fprintf(stderr, "kernel_launch: hipFuncSetAttribute failed\n"); grid = -1; return; }
        if (hipOccupancyMaxActiveBlocksPerMultiprocessor(&per_cu, (const void*)fwd_kernel, NTHREADS, LDS_BYTES) != hipSuccess || per_cu < 1) { fprintf(stderr, "kernel_launch: occupancy query says %d\n", per_cu); (void)hipGetLastError(); per_cu = 1; }
        grid = cus * 1;
    }
    if (grid < 0) return;
    if (hipMemsetAsync((char*)d_ws + WS_CTL, 0, 65536, stream) != hipSuccess) { fprintf(stderr, "kernel_launch: hipMemsetAsync failed\n"); return; }
    Params p{};
    for (int i = 0; i < 22; ++i) p.in[i] = (const float*)d_in[i];
    p.out = (float*)d_out; p.ws = (unsigned char*)d_ws;
    void* args[] = {&p};
    hipError_t e = hipLaunchCooperativeKernel((const void*)fwd_kernel, dim3(grid), dim3(NTHREADS), args, LDS_BYTES, stream);
    if (e != hipSuccess) fprintf(stderr, "kernel_launch: cooperative launch failed: %s (grid %d)\n", hipGetErrorString(e), grid);
}
```

```cpp
#include <hip/hip_runtime.h>
#include <hip/hip_cooperative_groups.h>
#include <cstdio>
#include <cstdint>
namespace cg = cooperative_groups;
namespace pg8 {
#define PG8_LAS __attribute__((address_space(3)))
typedef unsigned short bf16_t;
typedef short bf16x8 __attribute__((ext_vector_type(8)));
typedef float f32x4 __attribute__((ext_vector_type(4)));
typedef unsigned u32x4 __attribute__((ext_vector_type(4)));
constexpr int BM = 256, BK = 64, HALF = 128, HTB = HALF * BK * 2  , STAGE_BYTES = 8 * HTB, NXCD = 8, WGM = 8;

__host__ __device__ __forceinline__ int lds_byte(int r, int c) { const int st = (r >> 4) * 2 + (c >> 5), rr = r & 15, cc = c & 31, ob = rr * 64 + cc * 2; return st * 1024 + (ob ^ (((ob >> 9) & 1) << 5)); }
__host__ __device__ __forceinline__ void stage_rc(int b, int& R, int& C) { const int st = b / 1024, sb = b % 1024, swz = sb ^ (((sb >> 9) & 1) << 5); R = (st >> 1) * 16 + swz / 64; C = (st & 1) * 32 + (swz % 64) / 2; }
__host__ __device__ __forceinline__ int perm32(int rho) { const int n = rho >> 4, i = rho & 15; return 8 * (i >> 2) + 4 * n + (i & 3); }

struct Unit { int pm, pn; };
struct Gemm { const bf16_t* A; const bf16_t* Bt; int M, N, K; int lda, kstepA; };

struct StaticOrder {
    int nM, nN, nwg, G, c;
    __host__ __device__ void init(int M, int N, int G_, int c_) { nM = M / BM; nN = N / BM; nwg = nM * nN; G = G_; c = c_; }
    __host__ __device__ bool next(int i, Unit& u) const {
        const long L = (long)i * G + c; if (L >= nwg) return false;
        int wgid = (int)L; { const int q = nwg / NXCD, r = nwg % NXCD, xcd = wgid % NXCD, off = wgid / NXCD; wgid = (xcd < r ? xcd * (q + 1) : r * (q + 1) + (xcd - r) * q) + off; }
        const int nig = WGM * nN, gid = wgid / nig, fm = gid * WGM, gsz = (nM - fm) < WGM ? (nM - fm) : WGM;
        u.pm = fm + ((wgid % nig) % gsz); u.pn = (wgid % nig) / gsz; return true;
    }
    __device__ __forceinline__ void a_ready(const Unit&) const {}
    __device__ __forceinline__ void done(const Unit&) const {}
    __device__ __forceinline__ const char* a_tile(const Gemm& g, const Unit& u, size_t tstepA) const { return (const char*)g.A + (size_t)u.pm * tstepA; }
    __device__ __forceinline__ const char* b_tile(const Gemm& g, const Unit& u, size_t tstepB) const { return (const char*)g.Bt + (size_t)u.pn * tstepB; }
};

__device__ __forceinline__ unsigned cvt_pk_bf16(float lo, float hi) { unsigned r; asm volatile("v_cvt_pk_bf16_f32 %0, %1, %2" : "=v"(r) : "v"(lo), "v"(hi)); return r; }
typedef float f32x2 __attribute__((ext_vector_type(2)));
__device__ __forceinline__ f32x2 gelu_pk(f32x2 v) {
    const f32x2 av = __builtin_elementwise_abs(v), d = av * 0.2316418882f + 1.0f;
    f32x2 t; t.x = __builtin_amdgcn_rcpf(d.x); t.y = __builtin_amdgcn_rcpf(d.y);
    f32x2 q = t * 0.5307027145f + (-0.7265760135f); q = q * t + 0.7107068705f; q = q * t + (-0.142248368f); q = q * t + 0.127414796f; q = q * t;
    const f32x2 s = (v * v) * (-0.72134752044f);
    f32x2 e; e.x = __builtin_amdgcn_exp2f(s.x); e.y = __builtin_amdgcn_exp2f(s.y);
    const f32x2 m = v * (q * e), r = v - m;
    f32x2 o; o.x = v.x < 0.f ? m.x : r.x; o.y = v.y < 0.f ? m.y : r.y; return o;
}

template <int ACT  > struct EpiBf16 {
    static constexpr bool PERM = true, AFTER_DRAIN = false; static_assert(ACT == 0 || ACT == 1, "EpiBf16: ACT is 0 (none) or 1 (gelu_pk)");
    bf16_t* O; int ldc; const float* bias; int split_cols; size_t split_stride; float scale0;
    __device__ __forceinline__ void operator()(const f32x4 (&acc)[2][2][4][2], const Unit& u, int wr, int wc, int fr, int fq) const {
        const int row0 = u.pm * BM + wr * 64 + fr; int colt = u.pn * BM; bf16_t* base = O;
        float sc = 1.f; if (split_cols) { const int t = colt / split_cols; base += (size_t)t * split_stride; colt -= t * split_cols; if (t == 0) sc = scale0; }
        const int col0 = colt + wc * 32 + 8 * fq, bcol0 = u.pn * BM + wc * 32 + 8 * fq;
        f32x4 bv[2][2];
#pragma unroll
        for (int bj = 0; bj < 2; ++bj)
#pragma unroll
            for (int n = 0; n < 2; ++n) bv[bj][n] = bias ? *(const f32x4*)(bias + bcol0 + bj * HALF + 4 * n) : (f32x4){0.f, 0.f, 0.f, 0.f};
#pragma unroll
        for (int ai = 0; ai < 2; ++ai)
#pragma unroll
            for (int m = 0; m < 4; ++m) { bf16_t* rowp = base + (size_t)(row0 + ai * HALF + m * 16) * ldc + col0;
#pragma unroll
                for (int bj = 0; bj < 2; ++bj) { f32x4 v0 = acc[ai][bj][m][0] + bv[bj][0], v1 = acc[ai][bj][m][1] + bv[bj][1];
                    if (ACT == 1) { f32x2 a = gelu_pk((f32x2){v0[0], v0[1]}), b = gelu_pk((f32x2){v0[2], v0[3]}), c = gelu_pk((f32x2){v1[0], v1[1]}), d = gelu_pk((f32x2){v1[2], v1[3]});
                        v0 = (f32x4){a.x, a.y, b.x, b.y}; v1 = (f32x4){c.x, c.y, d.x, d.y}; }
                    v0 = v0 * sc; v1 = v1 * sc; u32x4 w; w.x = cvt_pk_bf16(v0[0], v0[1]); w.y = cvt_pk_bf16(v0[2], v0[3]); w.z = cvt_pk_bf16(v1[0], v1[1]); w.w = cvt_pk_bf16(v1[2], v1[3]);
                    *(u32x4*)(rowp + bj * HALF) = w; } }
    }
};
template <class Epi, class Sched, bool ALIGN_EPI = false, bool SP2 = false>
__device__ __forceinline__ void gemm_phase(PG8_LAS unsigned char* lds, const Gemm g, const Sched& S, Epi& E) {
    int tid_ = threadIdx.x; asm volatile("" : "+v"(tid_));
    const int tid = tid_, wid = __builtin_amdgcn_readfirstlane(tid >> 6), lane = tid & 63, wr = wid >> 2, wc = wid & 3, fr = lane & 15, fq = lane >> 4;
    int K_ = g.K; asm volatile("" : "+s"(K_)); const int K = K_, nt = K / BK;
    const int lda = g.lda ? g.lda : K;
    unsigned voffA[2], voffB[2];
#pragma unroll
    for (int i = 0; i < 2; ++i) { int R, C; stage_rc(tid * 16 + i * 8192, R, C); const int Rb = Epi::PERM ? ((R & ~31) + perm32(R & 31)) : R;
        voffA[i] = (unsigned)(R * lda + C) * 2u; voffB[i] = (unsigned)(Rb * K + C) * 2u; }
    const size_t kstepB = (size_t)(BK * 2), kstepA = g.kstepA ? (size_t)g.kstepA : kstepB;
    const size_t hstepB = (size_t)HALF * K * 2, hstepA = (size_t)HALF * lda * 2;
    const size_t tstepB = 2 * hstepB, tstepA = 2 * hstepA;
    const unsigned ldsw = (unsigned)wid * 1024u;
    const int aoff = lds_byte(wr * 64 + fr, fq * 8), boff = lds_byte(wc * 32 + fr, fq * 8);
#define PG8_SA(b, h) (((b) * 2 + (h)) * HTB)
#define PG8_SB(b, h) ((4 + (b) * 2 + (h)) * HTB)
#define PG8_STAGE(bufoff, gbase, voff) do { _Pragma("unroll") for (int _i = 0; _i < 2; ++_i) \
        __builtin_amdgcn_global_load_lds((const unsigned*)((const char*)(gbase) + (voff)[_i]), (PG8_LAS unsigned*)(lds + (bufoff) + ldsw + _i * 8192), 16, 0, 0); } while (0)
#define PG8_LDA(dst, b, h) do { _Pragma("unroll") for (int m = 0; m < 4; ++m) _Pragma("unroll") for (int k = 0; k < 2; ++k) dst[m][k] = *(const PG8_LAS bf16x8*)(lds + PG8_SA(b, h) + aoff + m * 2048 + k * 1024); } while (0)
#define PG8_LDB(dst, b, h) do { _Pragma("unroll") for (int n = 0; n < 2; ++n) _Pragma("unroll") for (int k = 0; k < 2; ++k) dst[n][k] = *(const PG8_LAS bf16x8*)(lds + PG8_SB(b, h) + boff + n * 2048 + k * 1024); } while (0)
#define PG8_MMA(ai, bj, At, Bt) do { __builtin_amdgcn_s_setprio(1); _Pragma("unroll") for (int m = 0; m < 4; ++m) _Pragma("unroll") for (int n = 0; n < 2; ++n) _Pragma("unroll") for (int k = 0; k < 2; ++k) \
        acc[ai][bj][m][n] = __builtin_amdgcn_mfma_f32_16x16x32_bf16(Bt[n][k], At[m][k], acc[ai][bj][m][n], 0, 0, 0); __builtin_amdgcn_s_setprio(0); } while (0)
#define PG8_WAIT_V(n) asm volatile("s_waitcnt vmcnt(" #n ")" ::: "memory")
#define PG8_WAIT_L(n) asm volatile("s_waitcnt lgkmcnt(" #n ")" ::: "memory")
#define PG8_BAR __builtin_amdgcn_s_barrier()
#define PG8_SCHED __builtin_amdgcn_sched_barrier(0)
    Unit cur, nxt; int ui = 0;
    if (!S.next(0, cur)) return;
    f32x4 acc[2][2][4][2];
#pragma unroll
    for (int a = 0; a < 2; ++a)
#pragma unroll
        for (int b = 0; b < 2; ++b)
#pragma unroll
            for (int m = 0; m < 4; ++m)
#pragma unroll
                for (int n = 0; n < 2; ++n) acc[a][b][m][n] = (f32x4){0.f, 0.f, 0.f, 0.f};
    bf16x8 At[4][2], B0[2][2], B1[2][2];
    const char* cA = S.a_tile(g, cur, tstepA); const char* cB = S.b_tile(g, cur, tstepB);
    S.a_ready(cur);
    if constexpr (SP2) {
        PG8_STAGE(PG8_SB(0, 0), cB, voffB); PG8_STAGE(PG8_SB(0, 1), cB + hstepB, voffB); PG8_STAGE(PG8_SA(0, 0), cA, voffA); PG8_STAGE(PG8_SA(0, 1), cA + hstepA, voffA);
        if (wr == 1) PG8_BAR;
        PG8_WAIT_V(2); PG8_BAR;
        PG8_STAGE(PG8_SB(1, 0), cB + kstepB, voffB); PG8_STAGE(PG8_SA(1, 0), cA + kstepA, voffA); PG8_STAGE(PG8_SB(1, 1), cB + hstepB + kstepB, voffB);
        PG8_WAIT_V(6); PG8_BAR;
    } else {
        PG8_STAGE(PG8_SB(0, 0), cB, voffB); PG8_STAGE(PG8_SA(0, 0), cA, voffA); PG8_STAGE(PG8_SB(0, 1), cB + hstepB, voffB); PG8_STAGE(PG8_SA(0, 1), cA + hstepA, voffA);
        if (wr == 1) PG8_BAR;
        PG8_WAIT_V(4); PG8_BAR;
        PG8_STAGE(PG8_SB(1, 0), cB + kstepB, voffB); PG8_STAGE(PG8_SA(1, 0), cA + kstepA, voffA); PG8_STAGE(PG8_SB(1, 1), cB + hstepB + kstepB, voffB);
        PG8_WAIT_V(6); PG8_BAR;
    }
    for (;;) {
        const bool has_next = S.next(ui + 1, nxt);
        const char* nA = has_next ? S.a_tile(g, nxt, tstepA) : cA; const char* nB = has_next ? S.b_tile(g, nxt, tstepB) : cB;
        for (int t = 0; t < nt; t += 2) {
            const bool last = (t == nt - 2);
            const char* a1 = cA + (size_t)(t + 1) * kstepA;
            const char* a2 = last ? nA : cA + (size_t)(t + 2) * kstepA; const char* b2 = last ? nB : cB + (size_t)(t + 2) * kstepB;
            const char* a3 = a2 + kstepA; const char* b3 = b2 + kstepB;
            if (last && has_next) S.a_ready(nxt);
            if constexpr (SP2) {
            PG8_LDB(B0, 0, 0); PG8_LDB(B1, 0, 1); PG8_SCHED; PG8_LDA(At, 0, 0); PG8_STAGE(PG8_SA(1, 1), a1 + hstepA, voffA);
            PG8_WAIT_V(8); PG8_WAIT_L(0); PG8_BAR; PG8_MMA(0, 0, At, B0); PG8_MMA(0, 1, At, B1); PG8_BAR; PG8_SCHED;
            PG8_LDA(At, 0, 1); PG8_STAGE(PG8_SB(0, 0), b2, voffB); PG8_STAGE(PG8_SB(0, 1), b2 + hstepB, voffB); PG8_STAGE(PG8_SA(0, 0), a2, voffA);
            PG8_WAIT_V(8); PG8_WAIT_L(0); PG8_BAR; PG8_MMA(1, 0, At, B0); PG8_MMA(1, 1, At, B1); PG8_BAR; PG8_SCHED;
            PG8_LDB(B0, 1, 0); PG8_LDB(B1, 1, 1); PG8_SCHED; PG8_LDA(At, 1, 0); PG8_STAGE(PG8_SA(0, 1), a2 + hstepA, voffA);
            PG8_WAIT_V(8); PG8_WAIT_L(0); PG8_BAR; PG8_MMA(0, 0, At, B0); PG8_MMA(0, 1, At, B1); PG8_BAR; PG8_SCHED;
            PG8_LDA(At, 1, 1); PG8_STAGE(PG8_SB(1, 0), b3, voffB); PG8_STAGE(PG8_SB(1, 1), b3 + hstepB, voffB); PG8_STAGE(PG8_SA(1, 0), a3, voffA);
            PG8_WAIT_V(8); PG8_WAIT_L(0); PG8_BAR; PG8_MMA(1, 0, At, B0); PG8_MMA(1, 1, At, B1); PG8_BAR; PG8_SCHED;
            } else {
            PG8_LDB(B0, 0, 0); PG8_SCHED; PG8_LDA(At, 0, 0); PG8_STAGE(PG8_SA(1, 1), a1 + hstepA, voffA);
            PG8_WAIT_L(8); PG8_BAR; PG8_WAIT_L(0); PG8_MMA(0, 0, At, B0); PG8_BAR; PG8_SCHED;
            PG8_LDB(B1, 0, 1); PG8_STAGE(PG8_SB(0, 0), b2, voffB);
            PG8_BAR; PG8_WAIT_L(0); PG8_MMA(0, 1, At, B1); PG8_BAR;
            PG8_LDA(At, 0, 1); PG8_STAGE(PG8_SA(0, 0), a2, voffA);
            PG8_BAR; PG8_WAIT_L(0); PG8_MMA(1, 0, At, B0); PG8_BAR; PG8_SCHED;
            PG8_STAGE(PG8_SB(0, 1), b2 + hstepB, voffB);
            PG8_WAIT_V(6); PG8_BAR; PG8_MMA(1, 1, At, B1); PG8_BAR;
            PG8_LDB(B0, 1, 0); PG8_SCHED; PG8_LDA(At, 1, 0); PG8_STAGE(PG8_SA(0, 1), a2 + hstepA, voffA);
            PG8_WAIT_L(8); PG8_BAR; PG8_WAIT_L(0); PG8_MMA(0, 0, At, B0); PG8_BAR; PG8_SCHED;
            PG8_LDB(B1, 1, 1); PG8_STAGE(PG8_SB(1, 0), b3, voffB);
            PG8_BAR; PG8_WAIT_L(0); PG8_MMA(0, 1, At, B1); PG8_BAR;
            PG8_LDA(At, 1, 1); PG8_STAGE(PG8_SA(1, 0), a3, voffA);
            PG8_BAR; PG8_WAIT_L(0); PG8_MMA(1, 0, At, B0); PG8_BAR; PG8_SCHED;
            PG8_STAGE(PG8_SB(1, 1), b3 + hstepB, voffB);
            PG8_WAIT_V(6); PG8_BAR; PG8_MMA(1, 1, At, B1); PG8_BAR;
            }
        }
        if constexpr (ALIGN_EPI) { if (wr == 0) PG8_BAR; }
        if constexpr (!Epi::AFTER_DRAIN) { E(acc, cur, wr, wc, fr, fq); S.done(cur); }
        if (!has_next) break;
#pragma unroll
        for (int a = 0; a < 2; ++a)
#pragma unroll
            for (int b = 0; b < 2; ++b)
#pragma unroll
                for (int m = 0; m < 4; ++m)
#pragma unroll
                    for (int n = 0; n < 2; ++n) acc[a][b][m][n] = (f32x4){0.f, 0.f, 0.f, 0.f};
        cur = nxt; cA = nA; cB = nB; ++ui;
        if constexpr (ALIGN_EPI) { if (wr == 1) PG8_BAR; }
    }
    PG8_WAIT_V(0);
    if constexpr (!ALIGN_EPI) { if (wr == 0) PG8_BAR; }
    PG8_BAR;
    if constexpr (Epi::AFTER_DRAIN) { E.fused(acc, cur, wr, wc, fr, fq, lds, wid, lane); S.done(cur); }
#undef PG8_SA
#undef PG8_SB
#undef PG8_STAGE
#undef PG8_LDA
#undef PG8_LDB
#undef PG8_MMA
#undef PG8_WAIT_V
#undef PG8_WAIT_L
#undef PG8_BAR
#undef PG8_SCHED
}
}

constexpr int BATCH = 16, SEQ = 4096, DM = 1024, MTOK = BATCH * SEQ;
constexpr int NZ = 3584;
constexpr int ZC_MQ = 0, ZC_MK = 512, ZC_MV = 1024, ZC_MO = 1536, ZC_AQ = 2056, ZC_AKC = 2568, ZC_AVC = 2696, ZC_AKS = 2824, ZC_AVS = 2952, ZC_AKW = 3080, ZC_AVW = 3208;
constexpr int DFF = 2048, PLE = 256, NCMP = 255;
constexpr float EPS = 1e-6f;
constexpr int NWAVES = 8, NTHREADS = 512;
constexpr int LDS_BYTES = 163840;
constexpr int XBAR_LDS = 163840 - 256;

typedef unsigned short bf16_t;
typedef float f32x4 __attribute__((ext_vector_type(4)));
typedef unsigned u32x4 __attribute__((ext_vector_type(4)));
typedef unsigned u32x2 __attribute__((ext_vector_type(2)));

constexpr size_t MiB = 1u << 20;
constexpr size_t WS_CTL = 0;
constexpr size_t WS_WIN = 1 * MiB, WS_WOUT = 8 * MiB, WS_WUP = 10 * MiB, WS_WDN = 18 * MiB, WS_WPG = 22 * MiB, WS_WPP = 24 * MiB;
constexpr size_t WS_W1T = 25 * MiB, WS_W2T = 26 * MiB, WS_C1 = WS_CTL + 32768, WS_KCB = 29 * MiB, WS_VCT = 30 * MiB;
constexpr size_t WS_GATES = 32 * MiB, WS_PB = 40 * MiB, WS_XB = 72 * MiB;
constexpr size_t WS_MIX = 200 * MiB, WS_ACT = 200 * MiB;
constexpr size_t WS_Z = 456 * MiB, WS_U = 456 * MiB, WS_PROJ = 456 * MiB;
constexpr size_t WS_RS2 = 968 * MiB, WS_RS3 = 972 * MiB;
constexpr size_t WS_RSTD2 = 31 * MiB, WS_RSTD3 = 31 * MiB + 512 * 1024;
constexpr size_t WS_VST = 976 * MiB, WS_VWT = 992 * MiB;
constexpr size_t WS_END = 1008 * MiB;

struct Params { const float* in[22]; float* out; unsigned char* ws; };

__device__ __forceinline__ float bf2f(unsigned u16) { return __uint_as_float(u16 << 16); }
__device__ __forceinline__ float bflo(unsigned w) { return __uint_as_float(w << 16); }
__device__ __forceinline__ float bfhi(unsigned w) { return __uint_as_float(w & 0xffff0000u); }
__device__ __forceinline__ unsigned f2bf(float f) { unsigned u = __float_as_uint(f); return (u + 0x7fffu + ((u >> 16) & 1u)) >> 16; }
__device__ __forceinline__ unsigned pk2(float lo, float hi) { return f2bf(lo) | (f2bf(hi) << 16); }
__device__ __forceinline__ float wave_sum(float v) {
#pragma unroll
    for (int o = 1; o < 64; o <<= 1) v += __shfl_xor(v, o);
    return v;
}
__device__ __forceinline__ float wave_max(float v) {
#pragma unroll
    for (int o = 1; o < 64; o <<= 1) v = fmaxf(v, __shfl_xor(v, o));
    return v;
}
__device__ __forceinline__ float sigmoidf_(float x) { return __builtin_amdgcn_rcpf(1.0f + __expf(-x)); }
__device__ __forceinline__ float log_sigmoidf_(float x) { return fminf(x, 0.f) - __logf(1.0f + __expf(-fabsf(x))); }
#define WAVE_LDS_SYNC() asm volatile("s_waitcnt lgkmcnt(0)" ::: "memory")

namespace pg8 {
__device__ __forceinline__ float row_rstd(const float* rs, int row) {
    const f32x4* p = (const f32x4*)(rs + (size_t)row * 16); const f32x4 a = p[0], b = p[1], c = p[2], d = p[3];
    const float s = (((a[0] + a[1]) + (a[2] + a[3])) + ((b[0] + b[1]) + (b[2] + b[3]))) + (((c[0] + c[1]) + (c[2] + c[3])) + ((d[0] + d[1]) + (d[2] + d[3])));
    return 1.0f / sqrtf(s * (1.0f / 1024.0f) + EPS);
}
struct EpiZ {
    static constexpr bool PERM = true, AFTER_DRAIN = false;
    bf16_t* Z; float* gates;
    __device__ __forceinline__ void operator()(const f32x4 (&acc)[2][2][4][2], const Unit& u, int wr, int wc, int fr, int fq) {
        const int row0 = u.pm * BM + wr * 64 + fr; const int col0 = u.pn * BM + wc * 32 + 8 * fq;
#pragma unroll
        for (int ai = 0; ai < 2; ++ai)
#pragma unroll
            for (int m = 0; m < 4; ++m) { const int row = row0 + ai * HALF + m * 16; bf16_t* rowp = Z + (size_t)row * NZ + col0;
#pragma unroll
                for (int bj = 0; bj < 2; ++bj) { const f32x4 v0 = acc[ai][bj][m][0], v1 = acc[ai][bj][m][1];
                    u32x4 w; w.x = cvt_pk_bf16(v0[0], v0[1]); w.y = cvt_pk_bf16(v0[2], v0[3]); w.z = cvt_pk_bf16(v1[0], v1[1]); w.w = cvt_pk_bf16(v1[2], v1[3]);
                    *(u32x4*)(rowp + bj * HALF) = w; }
                if (wc == 0) {
                    if ((u.pn == 8 && fq == 0) || (u.pn == 13 && fq >= 1)) {
                        float* gp = gates + (size_t)row * 32 + 8 * fq;
                        *(f32x4*)(gp) = acc[ai][0][m][0]; *(f32x4*)(gp + 4) = acc[ai][0][m][1];
                    }
                }
            }
    }
};
template <bool ROWSCALE> struct EpiBf {
    static constexpr bool PERM = true, AFTER_DRAIN = false;
    bf16_t* O; int ldc; const float* rs;
    __device__ __forceinline__ void operator()(const f32x4 (&acc)[2][2][4][2], const Unit& u, int wr, int wc, int fr, int fq) {
        const int row0 = u.pm * BM + wr * 64 + fr; const int col0 = u.pn * BM + wc * 32 + 8 * fq;
#pragma unroll
        for (int ai = 0; ai < 2; ++ai)
#pragma unroll
            for (int m = 0; m < 4; ++m) { const int row = row0 + ai * HALF + m * 16; bf16_t* rowp = O + (size_t)row * ldc + col0;
                float sc = 1.f;
                if (ROWSCALE) sc = row_rstd(rs, row);
#pragma unroll
                for (int bj = 0; bj < 2; ++bj) { const f32x4 v0 = acc[ai][bj][m][0] * sc, v1 = acc[ai][bj][m][1] * sc;
                    u32x4 w; w.x = cvt_pk_bf16(v0[0], v0[1]); w.y = cvt_pk_bf16(v0[2], v0[3]); w.z = cvt_pk_bf16(v1[0], v1[1]); w.w = cvt_pk_bf16(v1[2], v1[3]);
                    *(u32x4*)(rowp + bj * HALF) = w; }
            }
    }
};
template <bool BASE_F32> struct EpiRes {
    static constexpr bool PERM = true, AFTER_DRAIN = false;
    const float* basef; const bf16_t* baseb; bf16_t* xb; float* rs;
    __device__ __forceinline__ void operator()(const f32x4 (&acc)[2][2][4][2], const Unit& u, int wr, int wc, int fr, int fq) const {
        const int row0 = u.pm * BM + wr * 64 + fr, col0 = u.pn * BM + wc * 32 + 8 * fq;
#pragma unroll
        for (int ai = 0; ai < 2; ++ai)
#pragma unroll
            for (int m = 0; m < 4; ++m) { const int row = row0 + ai * HALF + m * 16; const size_t off = (size_t)row * DM + col0; float s = 0.f;
#pragma unroll
                for (int bj = 0; bj < 2; ++bj) { f32x4 b0, b1;
                    if (BASE_F32) { b0 = *(const f32x4*)(basef + off + bj * HALF); b1 = *(const f32x4*)(basef + off + bj * HALF + 4); }
                    else { const u32x4 w = *(const u32x4*)(baseb + off + bj * HALF); b0 = (f32x4){bflo(w.x), bfhi(w.x), bflo(w.y), bfhi(w.y)}; b1 = (f32x4){bflo(w.z), bfhi(w.z), bflo(w.w), bfhi(w.w)}; }
                    const f32x4 o0 = b0 + acc[ai][bj][m][0], o1 = b1 + acc[ai][bj][m][1];
                    u32x4 w; w.x = cvt_pk_bf16(o0[0], o0[1]); w.y = cvt_pk_bf16(o0[2], o0[3]); w.z = cvt_pk_bf16(o1[0], o1[1]); w.w = cvt_pk_bf16(o1[2], o1[3]);
                    *(u32x4*)(xb + off + bj * HALF) = w;
                    s += ((o0[0] * o0[0] + o0[1] * o0[1]) + (o0[2] * o0[2] + o0[3] * o0[3])) + ((o1[0] * o1[0] + o1[1] * o1[1]) + (o1[2] * o1[2] + o1[3] * o1[3])); }
                s += __shfl_xor(s, 16); s += __shfl_xor(s, 32);
                if (fq == 0) rs[(size_t)row * 16 + u.pn * 4 + wc] = s; }
    }
};
struct EpiPle {
    static constexpr bool PERM = true, AFTER_DRAIN = false;
    const bf16_t* x2b; const bf16_t* proj; const float* rstd; bf16_t* x3b; float* rs;
    __device__ __forceinline__ void operator()(const f32x4 (&acc)[2][2][4][2], const Unit& u, int wr, int wc, int fr, int fq) const {
        const int row0 = u.pm * BM + wr * 64 + fr, col0 = u.pn * BM + wc * 32 + 8 * fq;
#pragma unroll
        for (int ai = 0; ai < 2; ++ai)
#pragma unroll
            for (int m = 0; m < 4; ++m) { const int row = row0 + ai * HALF + m * 16; const size_t off = (size_t)row * DM + col0; float s = 0.f;
                const float sc = rstd[row];
#pragma unroll
                for (int bj = 0; bj < 2; ++bj) { const u32x4 xw = *(const u32x4*)(x2b + off + bj * HALF), pw = *(const u32x4*)(proj + off + bj * HALF);
                    const f32x4 a0 = acc[ai][bj][m][0] * sc, a1 = acc[ai][bj][m][1] * sc; f32x4 o0, o1;
                    o0[0] = bflo(xw.x) + sigmoidf_(a0[0]) * bflo(pw.x); o0[1] = bfhi(xw.x) + sigmoidf_(a0[1]) * bfhi(pw.x); o0[2] = bflo(xw.y) + sigmoidf_(a0[2]) * bflo(pw.y); o0[3] = bfhi(xw.y) + sigmoidf_(a0[3]) * bfhi(pw.y);
                    o1[0] = bflo(xw.z) + sigmoidf_(a1[0]) * bflo(pw.z); o1[1] = bfhi(xw.z) + sigmoidf_(a1[1]) * bfhi(pw.z); o1[2] = bflo(xw.w) + sigmoidf_(a1[2]) * bflo(pw.w); o1[3] = bfhi(xw.w) + sigmoidf_(a1[3]) * bfhi(pw.w);
                    u32x4 w; w.x = cvt_pk_bf16(o0[0], o0[1]); w.y = cvt_pk_bf16(o0[2], o0[3]); w.z = cvt_pk_bf16(o1[0], o1[1]); w.w = cvt_pk_bf16(o1[2], o1[3]);
                    *(u32x4*)(x3b + off + bj * HALF) = w;
                    s += ((o0[0] * o0[0] + o0[1] * o0[1]) + (o0[2] * o0[2] + o0[3] * o0[3])) + ((o1[0] * o1[0] + o1[1] * o1[1]) + (o1[2] * o1[2] + o1[3] * o1[3])); }
                s += __shfl_xor(s, 16); s += __shfl_xor(s, 32);
                if (fq == 0) rs[(size_t)row * 16 + u.pn * 4 + wc] = s; }
    }
};
struct PanelOrder {
    int nM, G, c, nN = 4;
    __host__ __device__ void init(int M, int G_, int c_, int nN_ = 4) { nM = M / BM; G = G_; c = c_; nN = nN_; }
    __host__ __device__ bool next(int i, Unit& u) const { const int p = c + G * (i / nN); if (p >= nM) return false; u.pm = p; u.pn = i % nN; return true; }
    __device__ __forceinline__ void a_ready(const Unit&) const {}
    __device__ __forceinline__ void done(const Unit&) const {}
    __device__ __forceinline__ const char* a_tile(const Gemm& g, const Unit& u, size_t tstepA) const { return (const char*)g.A + (size_t)u.pm * tstepA; }
    __device__ __forceinline__ const char* b_tile(const Gemm& g, const Unit& u, size_t tstepB) const { return (const char*)g.Bt + (size_t)u.pn * tstepB; }
};
struct ChainOrder {
    int c;
    __host__ __device__ bool next(int i, Unit& u) const { if (i >= 16) return false; u.pm = (c >> 4) * 16 + i; u.pn = c & 15; return true; }
    __device__ __forceinline__ void a_ready(const Unit&) const {}
    __device__ __forceinline__ void done(const Unit&) const {}
    __device__ __forceinline__ const char* a_tile(const Gemm& g, const Unit& u, size_t tstepA) const { return (const char*)g.A + (size_t)u.pm * tstepA; }
    __device__ __forceinline__ const char* b_tile(const Gemm& g, const Unit& u, size_t tstepB) const { return (const char*)g.Bt + (size_t)u.pn * tstepB; }
};
__device__ __forceinline__ float dpp_ror1(float v) { return __builtin_bit_cast(float, __builtin_amdgcn_update_dpp(0, __builtin_bit_cast(int, v), 0x121, 0xf, 0xf, false)); }
__device__ __forceinline__ float dpp_ror2(float v) { return __builtin_bit_cast(float, __builtin_amdgcn_update_dpp(0, __builtin_bit_cast(int, v), 0x122, 0xf, 0xf, false)); }
struct EpiUpConv {
    static constexpr bool PERM = true, AFTER_DRAIN = false;
    bf16_t* ACT; const float* rs; const float* cw; const float* cb; PG8_LAS float* car;
    __device__ __forceinline__ void operator()(f32x4 (&acc)[2][2][4][2], const Unit& u, int wr, int wc, int fr, int fq) const {
        const int par = u.pm & 1; const bool first = (u.pm & 15) == 0;
        const int colg = 32 * wc + 8 * fq, gc = 128 * u.pn + colg;
#pragma unroll
        for (int ai = 0; ai < 2; ++ai)
#pragma unroll
            for (int m = 0; m < 4; ++m) { const float sc = rs[u.pm * BM + ai * HALF + wr * 64 + m * 16 + fr];
#pragma unroll
                for (int n = 0; n < 2; ++n) { acc[ai][0][m][n] *= sc; acc[ai][1][m][n] *= sc; } }
        if (fr >= 14) {
#pragma unroll
            for (int ai = 0; ai < 2; ++ai)
#pragma unroll
                for (int n = 0; n < 2; ++n) *(PG8_LAS f32x4*)(car + ((par * 4 + 2 * ai + wr) * 2 + (fr - 14)) * 128 + colg + 4 * n) = acc[ai][0][3][n]; }
        asm volatile("s_waitcnt lgkmcnt(0)" ::: "memory"); __builtin_amdgcn_s_barrier(); asm volatile("" ::: "memory");
#pragma unroll
        for (int ai = 0; ai < 2; ++ai) { const int sl = 2 * ai + wr;
            const PG8_LAS float* src = (sl == 0) ? car + ((par ^ 1) * 4 + 3) * 256 : car + (par * 4 + sl - 1) * 256;
            const bool zero_in = first && sl == 0;
#pragma unroll
            for (int n = 0; n < 2; ++n) {
                asm volatile("" ::: "memory");
                f32x4 c2 = *(const PG8_LAS f32x4*)(src + colg + 4 * n), c1 = *(const PG8_LAS f32x4*)(src + 128 + colg + 4 * n);
                if (zero_in) { c2 = (f32x4){0.f, 0.f, 0.f, 0.f}; c1 = c2; }
                const f32x4 w0 = *(const f32x4*)(cw + gc + 4 * n), w1 = *(const f32x4*)(cw + DFF + gc + 4 * n), w2 = *(const f32x4*)(cw + 2 * DFF + gc + 4 * n), bb = *(const f32x4*)(cb + gc + 4 * n);
#pragma unroll
                for (int e = 0; e < 4; ++e) { float tm1 = c1[e], tm2 = (fr == 1) ? c1[e] : c2[e];
#pragma unroll
                    for (int m = 0; m < 4; ++m) { const float x = acc[ai][0][m][n][e]; const float t1 = dpp_ror1(x), t2 = dpp_ror2(x);
                        const float p1 = fr >= 1 ? t1 : tm1, p2 = fr >= 2 ? t2 : tm2;
                        const float cv = w0[e] * p2 + w1[e] * p1 + w2[e] * x + bb[e];
                        acc[ai][1][m][n][e] = cv * __builtin_amdgcn_rcpf(1.0f + __expf(-cv)) * acc[ai][1][m][n][e];
                        tm1 = t1; tm2 = t2; } } }
#pragma unroll
            for (int m = 0; m < 4; ++m) { const int row = u.pm * BM + ai * HALF + wr * 64 + m * 16 + fr; const f32x4 v0 = acc[ai][1][m][0], v1 = acc[ai][1][m][1];
                u32x4 w; w.x = cvt_pk_bf16(v0[0], v0[1]); w.y = cvt_pk_bf16(v0[2], v0[3]); w.z = cvt_pk_bf16(v1[0], v1[1]); w.w = cvt_pk_bf16(v1[2], v1[3]);
                *(u32x4*)(ACT + (size_t)row * DFF + gc) = w; } }
    }
};
struct CmpOrder {
    int c; const bf16_t* Z; const bf16_t* w1t;
    __host__ __device__ bool next(int i, Unit& u) const { if (i > 0 || c >= 64) return false; u.pm = c; u.pn = 0; return true; }
    __device__ __forceinline__ void a_ready(const Unit&) const {}
    __device__ __forceinline__ void done(const Unit&) const {}
    __device__ __forceinline__ const char* a_tile(const Gemm&, const Unit& u, size_t) const { const int kv = u.pm >> 5, b = (u.pm >> 1) & 15, gg = u.pm & 1; return (const char*)(Z + (size_t)b * SEQ * NZ + (kv ? ZC_AVC : ZC_AKC) + gg * 64); }
    __device__ __forceinline__ const char* b_tile(const Gemm&, const Unit& u, size_t) const { return (const char*)(w1t + (size_t)(u.pm >> 5) * 256 * 1024); }
};
struct EpiCmp {
    static constexpr bool PERM = false, AFTER_DRAIN = true;
    const float* c1; const bf16_t* w2t; bf16_t* kcb; bf16_t* vct;
    __device__ __forceinline__ void fused(f32x4 (&acc)[2][2][4][2], const Unit& u, int wr, int wc, int fr, int fq, PG8_LAS unsigned char* lds, int wid, int lane) const {
        const int kv = u.pm >> 5, bgi = u.pm & 31;
        const int cc0 = 32 * wc + 4 * fq;
#pragma unroll
        for (int ai = 0; ai < 2; ++ai)
#pragma unroll
            for (int m = 0; m < 4; ++m) { const int r = 128 * ai + 64 * wr + 16 * m + fr;
#pragma unroll
                for (int n = 0; n < 2; ++n) *(PG8_LAS f32x4*)(lds + (r * 128 + cc0 + 16 * n) * 4) = acc[ai][1][m][n]; }
        asm volatile("s_waitcnt lgkmcnt(0)" ::: "memory"); __builtin_amdgcn_s_barrier(); asm volatile("" ::: "memory");
#pragma unroll
        for (int ai = 0; ai < 2; ++ai)
#pragma unroll
            for (int m = 0; m < 4; ++m) { const int r = 128 * ai + 64 * wr + 16 * m + fr; const int rr = r < 255 ? r + 1 : 255;
#pragma unroll
                for (int n = 0; n < 2; ++n) { const f32x4 rv = *(const PG8_LAS f32x4*)(lds + (rr * 128 + cc0 + 16 * n) * 4); const f32x4 bv = *(const f32x4*)(c1 + kv * 128 + cc0 + 16 * n);
                    f32x4 x = acc[ai][0][m][n] + rv + bv;
#pragma unroll
                    for (int e = 0; e < 4; ++e) { const float y = 1.5957691216057308f * (x[e] + 0.044715f * x[e] * x[e] * x[e]); x[e] = x[e] * __builtin_amdgcn_rcpf(1.0f + __expf(-y)); }
                    acc[ai][0][m][n] = x; } }
        asm volatile("s_waitcnt lgkmcnt(0)" ::: "memory"); __builtin_amdgcn_s_barrier(); asm volatile("" ::: "memory");
#pragma unroll
        for (int ai = 0; ai < 2; ++ai)
#pragma unroll
            for (int m = 0; m < 4; ++m) { const int r = 128 * ai + 64 * wr + 16 * m + fr;
#pragma unroll
                for (int n = 0; n < 2; ++n) { const f32x4 x = acc[ai][0][m][n]; u32x2 w; w.x = cvt_pk_bf16(x[0], x[1]); w.y = cvt_pk_bf16(x[2], x[3]); *(PG8_LAS u32x2*)(lds + r * 272 + (cc0 + 16 * n) * 2) = w; } }
        { const int t = wid * 64 + lane, d = t >> 3, ch = t & 7; const u32x4* src = (const u32x4*)(w2t + (size_t)kv * 64 * 128 + d * 128 + ch * 16);
          *(PG8_LAS u32x4*)(lds + 69632 + d * 272 + ch * 32) = src[0]; *(PG8_LAS u32x4*)(lds + 69632 + d * 272 + ch * 32 + 16) = src[1]; }
        asm volatile("s_waitcnt vmcnt(0) lgkmcnt(0)" ::: "memory"); __builtin_amdgcn_s_barrier(); asm volatile("" ::: "memory");
        typedef float f32x16_ __attribute__((ext_vector_type(16)));
        const int tq = lane & 31, hi = lane >> 5;
        f32x16_ O0, O1;
#pragma unroll
        for (int i = 0; i < 16; ++i) { O0[i] = 0.f; O1[i] = 0.f; }
#pragma unroll
        for (int kk = 0; kk < 8; ++kk) { const bf16x8 a = *(const PG8_LAS bf16x8*)(lds + (32 * wid + tq) * 272 + (16 * kk + 8 * hi) * 2);
            const bf16x8 b0 = *(const PG8_LAS bf16x8*)(lds + 69632 + tq * 272 + (16 * kk + 8 * hi) * 2), b1 = *(const PG8_LAS bf16x8*)(lds + 69632 + (32 + tq) * 272 + (16 * kk + 8 * hi) * 2);
            O0 = __builtin_amdgcn_mfma_f32_32x32x16_bf16(a, b0, O0, 0, 0, 0); O1 = __builtin_amdgcn_mfma_f32_32x32x16_bf16(a, b1, O1, 0, 0, 0); }
#pragma unroll
        for (int i = 0; i < 16; ++i) { const int nrow = 32 * wid + (i & 3) + 8 * (i >> 2) + 4 * hi; const bool ok = nrow < NCMP;
            const unsigned v0 = ok ? (cvt_pk_bf16(O0[i], 0.f) & 0xffffu) : 0u, v1 = ok ? (cvt_pk_bf16(O1[i], 0.f) & 0xffffu) : 0u;
            if (kv == 0) { bf16_t* p = kcb + ((size_t)bgi * 256 + nrow) * 64 + tq; p[0] = (bf16_t)v0; p[32] = (bf16_t)v1; }
            else { const int n16 = nrow & 15; const int np = (nrow & ~15) + 8 * ((n16 >> 2) & 1) + (n16 & 3) + 4 * (n16 >> 3); bf16_t* p = vct + ((size_t)bgi * 64 + tq) * 256 + np; p[0] = (bf16_t)v0; p[32 * 256] = (bf16_t)v1; } }
    }
};
}

template <bool UPMAP = false>
__device__ __forceinline__ void p0_transpose_item(const float* W, const float* gk, int K, int N, bf16_t* WT, float* scr, int item, int lane) {
    const int nblk = N / 32, kb = item / nblk, nb = item % nblk, k0 = 64 * kb, n0 = 32 * nb;
    const int r0 = UPMAP ? (((n0 & 2047) >> 7) * 256 + (n0 >> 11) * 128 + (n0 & 127)) : n0;
#pragma unroll 8
    for (int i = 0; i < 32; ++i) { const int kk = 2 * i + (lane >> 5); float w = W[(size_t)(k0 + kk) * N + n0 + (lane & 31)]; if (gk) w *= gk[k0 + kk]; scr[kk * 33 + (lane & 31)] = w; }
    WAVE_LDS_SYNC();
    const int c = lane & 7;
#pragma unroll
    for (int j = 0; j < 4; ++j) { const int n = (lane >> 3) + 8 * j; const float* s = scr + (8 * c) * 33 + n;
        u32x4 o; o.x = pk2(s[0 * 33], s[1 * 33]); o.y = pk2(s[2 * 33], s[3 * 33]); o.z = pk2(s[4 * 33], s[5 * 33]); o.w = pk2(s[6 * 33], s[7 * 33]);
        *(u32x4*)(WT + (size_t)(r0 + n) * K + k0 + 8 * c) = o; }
    WAVE_LDS_SYNC();
}

#define LAS3 __attribute__((address_space(3)))
typedef short bf16x8 __attribute__((ext_vector_type(8)));
typedef float f32x16 __attribute__((ext_vector_type(16)));
typedef float f32x2_t __attribute__((ext_vector_type(2)));
typedef __bf16 bf16x2_t __attribute__((ext_vector_type(2)));
__device__ __forceinline__ unsigned cvtpk(float lo, float hi) { f32x2_t v = {lo, hi}; bf16x2_t b = __builtin_convertvector(v, bf16x2_t); return __builtin_bit_cast(unsigned, b); }
#define MFMA32(a, b, c) __builtin_amdgcn_mfma_f32_32x32x16_bf16((a), (b), (c), 0, 0, 0)
__device__ __forceinline__ bf16x8 pack8(const f32x16& x, int s) {
    u32x4 p; p.x = cvtpk(x[8 * s], x[8 * s + 1]); p.y = cvtpk(x[8 * s + 2], x[8 * s + 3]); p.z = cvtpk(x[8 * s + 4], x[8 * s + 5]); p.w = cvtpk(x[8 * s + 6], x[8 * s + 7]);
    return __builtin_bit_cast(bf16x8, p);
}
#define NEG_INF (-__builtin_inff())
constexpr float LOG2E = 1.4426950408889634f;
__device__ __forceinline__ unsigned other_half_u(unsigned v, int hi) { auto rr = __builtin_amdgcn_permlane32_swap(v, v, false, false); return hi ? rr[0] : rr[1]; }
__device__ __forceinline__ float other_half_f(float v, int hi) { return __uint_as_float(other_half_u(__float_as_uint(v), hi)); }
__device__ __forceinline__ float max16(const f32x16& u) {
    float a = fmaxf(fmaxf(u[0], u[1]), fmaxf(u[2], u[3])), b = fmaxf(fmaxf(u[4], u[5]), fmaxf(u[6], u[7]));
    float c = fmaxf(fmaxf(u[8], u[9]), fmaxf(u[10], u[11])), d = fmaxf(fmaxf(u[12], u[13]), fmaxf(u[14], u[15]));
    return fmaxf(fmaxf(a, b), fmaxf(c, d));
}
__device__ __forceinline__ unsigned long long spread_even(unsigned x) {
    unsigned long long s = x;
    s = (s | (s << 16)) & 0x0000FFFF0000FFFFull; s = (s | (s << 8)) & 0x00FF00FF00FF00FFull; s = (s | (s << 4)) & 0x0F0F0F0F0F0F0F0Full;
    s = (s | (s << 2)) & 0x3333333333333333ull; s = (s | (s << 1)) & 0x5555555555555555ull; return s;
}
struct NsaF { const bf16_t* Z; const float* gates; const bf16_t* KCB; const bf16_t* VCT; const bf16_t* VST; const bf16_t* VWT; bf16_t* MIX; };

__device__ __forceinline__ void nsa_load_q(bf16x8 (&qf)[4], const bf16_t* qp) {
    const float QSC = 0.125f * LOG2E;
#pragma unroll
    for (int s = 0; s < 4; ++s) { const u32x4 w = *(const u32x4*)(qp + 16 * s); u32x4 o;
        o.x = cvtpk(bflo(w.x) * QSC, bfhi(w.x) * QSC); o.y = cvtpk(bflo(w.y) * QSC, bfhi(w.y) * QSC); o.z = cvtpk(bflo(w.z) * QSC, bfhi(w.z) * QSC); o.w = cvtpk(bflo(w.w) * QSC, bfhi(w.w) * QSC);
        qf[s] = __builtin_bit_cast(bf16x8, o); }
}
__device__ __forceinline__ f32x16 nsa_st(const bf16_t* kp, const bf16x8 (&qf)[4], const f32x16& cinit) {
    f32x16 acc = MFMA32(*(const bf16x8*)(kp), qf[0], cinit);
    acc = MFMA32(*(const bf16x8*)(kp + 16), qf[1], acc); acc = MFMA32(*(const bf16x8*)(kp + 32), qf[2], acc); acc = MFMA32(*(const bf16x8*)(kp + 48), qf[3], acc);
    return acc;
}
struct NsaK { bf16x8 k[4]; };
struct NsaV { bf16x8 v0[2]; bf16x8 v1[2]; };
__device__ __forceinline__ void nsa_ldk(NsaK& R, const bf16_t* ku, unsigned ko) {
    R.k[0] = *(const bf16x8*)(ku + ko); R.k[1] = *(const bf16x8*)(ku + ko + 16); R.k[2] = *(const bf16x8*)(ku + ko + 32); R.k[3] = *(const bf16x8*)(ku + ko + 48);
}
__device__ __forceinline__ void nsa_ldv(NsaV& R, const bf16_t* vu, const bf16_t* vu2, unsigned vo) {
    R.v0[0] = *(const bf16x8*)(vu + vo); R.v0[1] = *(const bf16x8*)(vu + vo + 16); R.v1[0] = *(const bf16x8*)(vu2 + vo); R.v1[1] = *(const bf16x8*)(vu2 + vo + 16);
}
__device__ __forceinline__ f32x16 nsa_st_r(const NsaK& R, const bf16x8 (&qf)[4], const f32x16& cinit) {
    f32x16 acc = MFMA32(R.k[0], qf[0], cinit); acc = MFMA32(R.k[1], qf[1], acc); acc = MFMA32(R.k[2], qf[2], acc); acc = MFMA32(R.k[3], qf[3], acc); return acc;
}
__device__ __forceinline__ void nsa_soft_pv(f32x16& u, float tb, float& M, float& l, f32x16& O0, f32x16& O1, const NsaV& R, int hi) {
    float tm = max16(u); tm = fmaxf(tm, other_half_f(tm, hi));
    const float cand = tm + tb;
    if (__any(cand > M)) { const float mn = fmaxf(M, cand); const float al = __builtin_amdgcn_exp2f(M - mn); l *= al; O0 *= al; O1 *= al; M = mn; }
    const float ms = M - tb; float sum = 0.f;
#pragma unroll
    for (int i = 0; i < 16; ++i) { const float p = __builtin_amdgcn_exp2f(u[i] - ms); u[i] = p; sum += p; }
    l += sum;
    u32x4 a, b2;
    a.x = cvtpk(u[0], u[1]); a.y = cvtpk(u[2], u[3]); a.z = cvtpk(u[4], u[5]); a.w = cvtpk(u[6], u[7]);
    b2.x = cvtpk(u[8], u[9]); b2.y = cvtpk(u[10], u[11]); b2.z = cvtpk(u[12], u[13]); b2.w = cvtpk(u[14], u[15]);
    const bf16x8 p0 = __builtin_bit_cast(bf16x8, a), p1 = __builtin_bit_cast(bf16x8, b2);
    O0 = MFMA32(R.v0[0], p0, O0); O0 = MFMA32(R.v0[1], p1, O0);
    O1 = MFMA32(R.v1[0], p0, O1); O1 = MFMA32(R.v1[1], p1, O1);
}
__device__ __forceinline__ void nsa_mask_lt(f32x16& u, int limh) {
    asm volatile("" : "+v"(limh));
#pragma unroll
    for (int i = 0; i < 16; ++i) { const int c = (i & 3) + 8 * (i >> 2); if (!(c < limh)) u[i] = NEG_INF; }
}
__device__ __forceinline__ void nsa_mask_gt(f32x16& u, int limh) {
    asm volatile("" : "+v"(limh));
#pragma unroll
    for (int i = 0; i < 16; ++i) { const int c = (i & 3) + 8 * (i >> 2); if (!(c > limh)) u[i] = NEG_INF; }
}

__device__ __forceinline__ void vt_unit(const bf16_t* Z, int zcol, bf16_t* VT, int b, int g, int ch, unsigned short* tile  , int tid) {
    { const int pos = tid >> 3, c8 = (tid & 7) * 8;
      const u32x4 w = *(const u32x4*)(Z + ((size_t)b * SEQ + ch * 64 + pos) * NZ + zcol + g * 64 + c8);
      *(u32x4*)(tile + pos * 72 + c8) = w; }
    __syncthreads();
    { const int d = tid >> 3, chunk = tid & 7, gi = chunk >> 1, h = chunk & 1; unsigned short e[8];
#pragma unroll
      for (int j = 0; j < 8; ++j) { const int pos = 16 * gi + 8 * (j >> 2) + 4 * h + (j & 3); e[j] = tile[pos * 72 + d]; }
      u32x4 o; o.x = e[0] | ((unsigned)e[1] << 16); o.y = e[2] | ((unsigned)e[3] << 16); o.z = e[4] | ((unsigned)e[5] << 16); o.w = e[6] | ((unsigned)e[7] << 16);
      *(u32x4*)(VT + (((size_t)b * 2 + g) * 64 + d) * SEQ + ch * 64 + chunk * 8) = o; }
    __syncthreads();
}

constexpr int NC_KC = 0, NC_RING = 32768, NC_IMP = 81920, NC_LIST = 147456, NC_UEX = 148480, NC_QSLOT = 148512;
#define NC_WAITBAR(N) asm volatile("s_waitcnt vmcnt(" #N ") lgkmcnt(0)\n\ts_barrier" ::: "memory")

__device__ __forceinline__ void nsa_unit_coop(const NsaF& P, int b, int g, int tp, LAS3 unsigned char* L, int tid, const int dry = 0) {
    if (dry & 2048) return;
    const int lane = tid & 63, wave = __builtin_amdgcn_readfirstlane(tid >> 6), tbsel = wave >> 2, r = wave & 3, tq = lane & 31, hi = lane >> 5;
    const int tb = 2 * tp + tbsel, t0 = 32 * tb, t0u = 64 * tp, cur = tp, hh = g * 4 + r;
    const size_t rowq = (size_t)b * SEQ + t0 + tq;
    const size_t bg = (size_t)b * 2 + g;
    const int nval = max(0, 2 * tb + 1 - (tq < 31 ? 1 : 0) - (tq < 15 ? 1 : 0));
    const int ntc = (2 * tb + 1 + 31) >> 5, ntc_u = (2 * (2 * tp + 1) + 1 + 31) >> 5;
    const int tqh = tq - 4 * hi;
    const float hif = (float)(4 * hi);
    const float slope2 = __builtin_amdgcn_exp2f(-(float)(hh + 1)) * LOG2E;
    bf16x8 qf[4]; if (!(dry & 1024)) nsa_load_q(qf, P.Z + rowq * NZ + ZC_AQ + hh * 64 + 8 * hi); else { qf[0] = qf[1] = qf[2] = qf[3] = (bf16x8){0, 0, 0, 0, 0, 0, 0, 0}; }
    const float* gp = (dry & 1024) ? P.gates : P.gates + rowq * 32 + 8 + hh * 3;
    const float gt0 = sigmoidf_(gp[0]), gt1 = sigmoidf_(gp[1]), gt2 = sigmoidf_(gp[2]);
    asm volatile("s_waitcnt vmcnt(0)" ::: "memory");
    if (dry & 16384) return;
    const int ks = wave & 3, vdt = (wave & 3) >> 1, vs = wave & 1;
    const bool isK = wave < 4;
    const bf16_t* srcC = isK ? P.KCB + (bg * 256 + tq) * 64 + 16 * ks + 8 * hi : P.VCT + (bg * 64 + 32 * vdt + tq) * 256 + 16 * vs + 8 * hi;
    const bf16_t* srcW = isK ? P.Z + ((size_t)b * SEQ + tq) * NZ + ZC_AKW + g * 64 + 16 * ks + 8 * hi : P.VWT + (bg * 64 + 32 * vdt + tq) * SEQ + 16 * vs + 8 * hi;
    const bf16_t* srcS = isK ? P.Z + ((size_t)b * SEQ + tq) * NZ + ZC_AKS + g * 64 + 16 * ks + 8 * hi : P.VST + (bg * 64 + 32 * vdt + tq) * SEQ + 16 * vs + 8 * hi;
    const size_t stepC = isK ? 32 * 64 : 32, stepP = isK ? (size_t)NZ : 1;
    volatile LAS3 int* list = (volatile LAS3 int*)(L + NC_LIST);
#define NC_DMA_E(i, ent) do { const int e_ = (ent); const int tag_ = (e_ >> 16) & 3, val_ = ((e_ & 0xffff) == 0xffff) ? 0 : (e_ & 0xffff); \
        const bf16_t* s_ = (tag_ == 0) ? srcC + (size_t)val_ * stepC : ((tag_ == 1) ? srcW : srcS) + (size_t)val_ * stepP; \
        __builtin_amdgcn_global_load_lds((const unsigned*)s_, (LAS3 unsigned*)(L + NC_RING + (((i) >> 1) % 3) * 16384 + ((i) & 1) * 8192 + wave * 1024), 16, 0, 0); } while (0)
#define NC_DMA(i) NC_DMA_E(i, __builtin_amdgcn_readfirstlane(list[1 + (i)]))
    const bool topk = cur >= 16 && !(dry & 1);
    if (topk && wave < ntc_u) {
#pragma unroll
        for (int s = 0; s < 4; ++s) __builtin_amdgcn_global_load_lds((const unsigned*)(P.KCB + (bg * 256 + 32 * wave + tq) * 64 + 16 * s + 8 * hi), (LAS3 unsigned*)(L + NC_KC + wave * 4096 + s * 1024), 16, 0, 0);
    }
#define NC_FLAGS(tag_, val_, t0_, ntc_, cf_) (((tag_) == 0) ? (((val_) < (ntc_) ? 1 : 0) | ((val_) >= (cf_) ? 8 : 0)) : (((tag_) == 1) ? ((((val_) <= (t0_) && (val_) >= (t0_) - 512) ? 1 : 0) | ((val_) == (t0_) ? 2 : 0) | ((val_) == (t0_) - 512 ? 4 : 0)) : ((((val_) <= (t0_)) ? 1 : 0) | ((val_) == (t0_) ? 2 : 0))))
#define NC_ENTRY(tag_, val_) ((val_) | ((tag_) << 16) | (NC_FLAGS(tag_, val_, t0u, ntcA, cfA) << 18) | (NC_FLAGS(tag_, val_, t0u + 32, ntcB, cfB) << 22))
    const int ntcA = (2 * (2 * tp) + 1 + 31) >> 5, ntcB = ntc_u, cfA = (2 * (2 * tp) - 1) >> 5, cfB = (2 * (2 * tp + 1) - 1) >> 5;
    const int ncmp = ntc_u + (ntc_u & 1);
    const int nsl0 = min(18, 2 * tp + 2), nsl = nsl0 + (nsl0 & 1);
    if (wave == 0) {
        if (lane < ncmp) list[1 + lane] = (lane < ntc_u) ? NC_ENTRY(0, ntc_u - 1 - lane) : 0xffff;
        else if (lane < ncmp + nsl) { const int k = lane - ncmp; list[1 + lane] = (k < nsl0) ? NC_ENTRY(1, t0u + 32 - 32 * k) : ((1 << 16) | 0xffff); }
        if (lane == 0) list[0] = ncmp + nsl; }
    asm volatile("s_waitcnt lgkmcnt(0)\n\ts_barrier" ::: "memory");
    if (dry & 8192) return;
    int nlist = __builtin_amdgcn_readfirstlane(list[0]);
    if (!(dry & 4096)) { NC_DMA(0); NC_DMA(1); NC_DMA(2); NC_DMA(3); }
    unsigned long long selmask, Utb;
    if (!topk) { selmask = (2ull << cur) - 1ull; Utb = selmask; }
    else {
        NC_WAITBAR(4);
        float* il = (float*)0; (void)il;
        LAS3 float* ip0 = (LAS3 float*)(L + NC_IMP + (wave * 32) * 256) + lane;
#pragma unroll
        for (int q = 0; q < 32; ++q) ip0[64 * q] = 0.f;
        {
            f32x16 cb;
            { float hf = hif; asm volatile("" : "+v"(hf));
#pragma unroll
              for (int i = 0; i < 16; ++i) cb[i] = slope2 * 16.0f * ((float)((i & 3) + 8 * (i >> 2)) + hf); }
            float M = -1.0e30f, l = 0.f;
#pragma unroll 1
            for (int nt = ntc - 1; nt >= 0; --nt) {
                const LAS3 unsigned char* kp = L + NC_KC + nt * 4096 + lane * 16;
                f32x16 u = MFMA32(*(const LAS3 bf16x8*)(kp), qf[0], cb); u = MFMA32(*(const LAS3 bf16x8*)(kp + 1024), qf[1], u); u = MFMA32(*(const LAS3 bf16x8*)(kp + 2048), qf[2], u); u = MFMA32(*(const LAS3 bf16x8*)(kp + 3072), qf[3], u);
                nsa_mask_lt(u, nval - 32 * nt - 4 * hi);
                const float tbs = slope2 * 512.0f * (float)nt;
                float tm = max16(u); tm = fmaxf(tm, other_half_f(tm, hi));
                const float mn = fmaxf(M, tm + tbs); float sum = 0.f; const float ms = mn - tbs;
#pragma unroll
                for (int i = 0; i < 16; ++i) sum += __builtin_amdgcn_exp2f(u[i] - ms);
                l = l * __builtin_amdgcn_exp2f(M - mn) + sum; M = mn;
            }
            const float lt = l + other_half_f(l, hi); const float linv = lt > 0.f ? 1.0f / lt : 0.f;
            float carry = 0.f;
#pragma unroll 1
            for (int nt = 0; nt < ntc; ++nt) {
                const LAS3 unsigned char* kp = L + NC_KC + nt * 4096 + lane * 16;
                f32x16 u = MFMA32(*(const LAS3 bf16x8*)(kp), qf[0], cb); u = MFMA32(*(const LAS3 bf16x8*)(kp + 1024), qf[1], u); u = MFMA32(*(const LAS3 bf16x8*)(kp + 2048), qf[2], u); u = MFMA32(*(const LAS3 bf16x8*)(kp + 3072), qf[3], u);
                nsa_mask_lt(u, nval - 32 * nt - 4 * hi);
                const float ms = M - slope2 * 512.0f * (float)nt;
#pragma unroll
                for (int i = 0; i < 16; ++i) u[i] = __builtin_amdgcn_exp2f(u[i] - ms) * linv;
                float x[4], qs[4];
#pragma unroll
                for (int gq = 0; gq < 4; ++gq) { qs[gq] = (u[4 * gq] + u[4 * gq + 1]) + (u[4 * gq + 2] + u[4 * gq + 3]); x[gq] = other_half_f(u[4 * gq + 3], hi); }
                LAS3 float* ip = ip0 + 256 * nt;
                ip[0] += qs[0] + (hi ? x[0] : carry); ip[64] += qs[1] + (hi ? x[1] : x[0]); ip[128] += qs[2] + (hi ? x[2] : x[1]); ip[192] += qs[3] + (hi ? x[3] : x[2]);
                carry = x[3];
            }
        }
        asm volatile("s_waitcnt lgkmcnt(0)\n\ts_barrier" ::: "memory");
        unsigned uu[32];
        const int qlo = hi ? 0 : 1, qhi = (cur - 2 - hi) >> 1;
        const unsigned candm = (unsigned)((2ull << qhi) - 1ull) & ~((1u << qlo) - 1u);
        { const LAS3 float* pp = (const LAS3 float*)(L + NC_IMP + (tbsel * 4 * 32) * 256) + lane;
#pragma unroll
          for (int q = 0; q < 32; ++q) { const float v = (pp[64 * q] + pp[64 * (32 + q)]) + (pp[64 * (64 + q)] + pp[64 * (96 + q)]); uu[q] = __float_as_uint(v) & (unsigned)(-(int)((candm >> q) & 1u)); } }
        unsigned T = 0u;
#pragma unroll 1
        for (int bit = 30; bit >= 0; --bit) { const unsigned c = T | (1u << bit); unsigned cnt = 0;
#pragma unroll
            for (int q = 0; q < 32; ++q) cnt += (uu[q] >= c) ? 1u : 0u;
            cnt += other_half_u(cnt, hi);
            if (cnt >= 13u) T = c; }
        unsigned gtm = 0u, eqm = 0u;
#pragma unroll
        for (int q = 0; q < 32; ++q) { gtm |= (uu[q] > T ? 1u : 0u) << q; eqm |= (uu[q] == T ? 1u : 0u) << q; }
        eqm &= candm;
        const unsigned ogt = other_half_u(gtm, hi), oeq = other_half_u(eqm, hi);
        const unsigned long long fgt = spread_even(hi ? ogt : gtm) | (spread_even(hi ? gtm : ogt) << 1);
        const unsigned long long feq = spread_even(hi ? oeq : eqm) | (spread_even(hi ? eqm : oeq) << 1);
        const int need = 13 - __builtin_popcountll(fgt);
        unsigned long long rem = feq;
#pragma unroll 1
        for (int i = 0; i < 13; ++i) if (i < need) rem &= rem - 1ull;
        selmask = fgt | (feq & ~rem) | 1ull | (3ull << (cur - 1));
        unsigned ulo = (unsigned)selmask, uhi = (unsigned)(selmask >> 32);
#pragma unroll
        for (int o = 1; o < 32; o <<= 1) { ulo |= __shfl_xor(ulo, o); uhi |= __shfl_xor(uhi, o); }
        Utb = ((unsigned long long)__builtin_amdgcn_readfirstlane(uhi) << 32) | (unsigned long long)__builtin_amdgcn_readfirstlane(ulo);
        if (r == 0 && lane == 0) { ((volatile LAS3 unsigned*)(L + NC_UEX))[2 * tbsel] = (unsigned)Utb; ((volatile LAS3 unsigned*)(L + NC_UEX))[2 * tbsel + 1] = (unsigned)(Utb >> 32); }
        asm volatile("s_waitcnt lgkmcnt(0)\n\ts_barrier" ::: "memory");
    }
    if (dry & 32768) return;
    if (wave == 0) {
        unsigned long long U;
        if (topk) { volatile LAS3 unsigned* ux = (volatile LAS3 unsigned*)(L + NC_UEX); U = ((unsigned long long)(ux[1] | ux[3]) << 32) | (unsigned long long)(ux[0] | ux[2]); } else U = (2ull << cur) - 1ull;
        const int n0 = ncmp + nsl;
        if ((U >> lane) & 1ull) { const int pos = n0 + 2 * __builtin_popcountll(lane == 63 ? 0ull : (U >> (lane + 1))); list[1 + pos] = NC_ENTRY(2, 64 * lane + 32); list[2 + pos] = NC_ENTRY(2, 64 * lane); }
        if (lane == 0) list[0] = n0 + 2 * __builtin_popcountll(U); }
    asm volatile("s_waitcnt lgkmcnt(0)\n\ts_barrier" ::: "memory");
    if (dry & 65536) return;
    nlist = __builtin_amdgcn_readfirstlane(list[0]);
    const int lv0 = list[1 + lane], lv1 = list[65 + lane], lv2 = list[129 + lane];
#define NC_ENT(i) (((i) < 64) ? __builtin_amdgcn_readlane(lv0, (i)) : (((i) < 128) ? __builtin_amdgcn_readlane(lv1, (i) - 64) : __builtin_amdgcn_readlane(lv2, (i) - 128)))
    LAS3 float* al = (LAS3 float*)(L + NC_IMP + wave * 8192) + lane;
    f32x16 O0, O1, O2, cb;
#pragma unroll
    for (int i = 0; i < 16; ++i) { al[64 * i] = 0.f; al[64 * (16 + i)] = 0.f; O0[i] = 0.f; O1[i] = 0.f; O2[i] = 0.f; cb[i] = 0.f; }
    const unsigned onesw = (tq == 0) ? 0x3f803f80u : 0u;
    const bf16x8 onesf = __builtin_bit_cast(bf16x8, (u32x4){onesw, onesw, onesw, onesw});
    float M = -1.0e30f, l = 0.f; int curtag = -1;
#define NC_FINAL() do { const float l0_ = O2[0]; const float lt_ = l0_ + other_half_f(l0_, hi);     const float g_ = (curtag == 0) ? gt0 : ((curtag == 1) ? gt2 : gt1); const float sc_ = lt_ > 0.f ? g_ / lt_ : 0.f; \
        _Pragma("unroll") for (int k_ = 0; k_ < 16; ++k_) { al[64 * k_] += O0[k_] * sc_; al[64 * (16 + k_)] += O1[k_] * sc_; } } while (0)
#define NC_SWITCH(tag) do { if ((tag) != curtag) { if (curtag >= 0) NC_FINAL(); curtag = (tag); M = -1.0e30f; l = 0.f; \
            float hf_ = hif; asm volatile("" : "+v"(hf_)); const float cs_ = ((tag) == 0) ? slope2 * 16.0f : slope2; \
            _Pragma("unroll") for (int k_ = 0; k_ < 16; ++k_) { O0[k_] = 0.f; O1[k_] = 0.f; O2[k_] = 0.f; cb[k_] = cs_ * ((float)((k_ & 3) + 8 * (k_ >> 2)) + hf_); } } } while (0)
#define NC_NEED(tag, val) (((tag) == 0) ? ((val) < ntc) : (((tag) == 1) ? (((val) <= t0) && ((val) >= t0 - 512)) : ((((Utb >> ((val) >> 6)) & 1ull) != 0ull) && ((val) <= t0))))
#define NC_TBIAS(tag, val) (((tag) == 0) ? slope2 * 512.0f * (float)(val) : slope2 * (float)((val) - t0))
#define NC_ST(u, sp) do { u = MFMA32(*(const LAS3 bf16x8*)(sp), qf[0], cb); u = MFMA32(*(const LAS3 bf16x8*)((sp) + 1024), qf[1], u); u = MFMA32(*(const LAS3 bf16x8*)((sp) + 2048), qf[2], u); u = MFMA32(*(const LAS3 bf16x8*)((sp) + 3072), qf[3], u); } while (0)
#define NC_MASK(u, tag, val) do { if ((tag) == 0) nsa_mask_lt(u, nval - 32 * (val) - 4 * hi); else { if ((val) == t0) nsa_mask_lt(u, tqh + 1); if ((tag) == 1 && (val) == t0 - 512) nsa_mask_gt(u, tqh); \
            if ((tag) == 2 && !((selmask >> ((val) >> 6)) & 1ull)) { _Pragma("unroll") for (int k_ = 0; k_ < 16; ++k_) u[k_] = NEG_INF; } } } while (0)
#define NC_LDV(V, sp) do { V.v0[0] = *(const LAS3 bf16x8*)((sp) + 4096); V.v0[1] = *(const LAS3 bf16x8*)((sp) + 5120); V.v1[0] = *(const LAS3 bf16x8*)((sp) + 6144); V.v1[1] = *(const LAS3 bf16x8*)((sp) + 7168); } while (0)
    const int npair = (dry & 8) ? 0 : (nlist >> 1);
    const int cfull = (2 * tb - 1) >> 5;
#pragma unroll 1
    for (int p = 0; p < npair; ++p) {
        if (dry & 256) { asm volatile("s_waitcnt lgkmcnt(0)\n\ts_barrier" ::: "memory"); } else { if (p + 1 < npair) NC_WAITBAR(2); else NC_WAITBAR(0); }
        if (!(dry & 512) && p + 2 < npair) { const int i2 = 2 * (p + 2); NC_DMA_E(i2, NC_ENT(i2)); NC_DMA_E(i2 + 1, NC_ENT(i2 + 1)); }
        const int e0 = NC_ENT(2 * p), e1 = NC_ENT(2 * p + 1);
        const int tag = (e0 >> 16) & 3, val0 = e0 & 0xffff, val1 = e1 & 0xffff;
        const int f0 = (e0 >> (18 + 4 * tbsel)) & 15, f1 = (e1 >> (18 + 4 * tbsel)) & 15;
        if (tag != curtag) { asm volatile("" ::: "memory"); NC_SWITCH(tag); }
        const bool sel = (tag == 2);
        const bool need0 = !(dry & 2) && (f0 & 1) && (!sel || ((Utb >> (val0 >> 6)) & 1ull)), need1 = !(dry & 2) && (f1 & 1) && (!sel || ((Utb >> (val1 >> 6)) & 1ull));
        if (need0 || need1) {
            const LAS3 unsigned char* sp0 = L + NC_RING + (p % 3) * 16384 + lane * 16; const LAS3 unsigned char* sp1 = sp0 + 8192;
            f32x16 u0, u1; if (dry & 128) { u0 = cb; u1 = cb; } else { NC_ST(u0, sp0); NC_ST(u1, sp1); }
            const bool nm0 = sel && !__all((int)((selmask >> (val0 >> 6)) & 1ull)), nm1 = sel && !__all((int)((selmask >> (val1 >> 6)) & 1ull));
            if (!need0 || (f0 & 14) || nm0) { asm volatile("" ::: "memory");
                if (!need0) { _Pragma("unroll") for (int k_ = 0; k_ < 16; ++k_) u0[k_] = NEG_INF; } else NC_MASK(u0, tag, val0); }
            if (!need1 || (f1 & 14) || nm1) { asm volatile("" ::: "memory");
                if (!need1) { _Pragma("unroll") for (int k_ = 0; k_ < 16; ++k_) u1[k_] = NEG_INF; } else NC_MASK(u1, tag, val1); }
            const float tb0 = NC_TBIAS(tag, val0), tb1 = NC_TBIAS(tag, val1);
            const float tm0 = (dry & 16) ? 0.f : max16(u0), tm1 = (dry & 16) ? 0.f : max16(u1);
            float cand = fmaxf(tm0 + tb0, tm1 + tb1); if (!(dry & 16)) cand = fmaxf(cand, other_half_f(cand, hi));
            if (!(dry & 16) && __any(cand > M)) { asm volatile("" ::: "memory"); const float mn = fmaxf(M, cand); const float al_ = __builtin_amdgcn_exp2f(M - mn); O0 *= al_; O1 *= al_; O2 *= al_; M = mn; }
            const float ms0 = M - tb0, ms1 = M - tb1;
#pragma unroll
            for (int i = 0; i < 16; ++i) { if (dry & 32) { u0[i] = u0[i] - ms0; u1[i] = u1[i] - ms1; } else { u0[i] = __builtin_amdgcn_exp2f(u0[i] - ms0); u1[i] = __builtin_amdgcn_exp2f(u1[i] - ms1); } }
            asm volatile("" ::: "memory");
            NsaV Va, Vb; NC_LDV(Va, sp0); NC_LDV(Vb, sp1);
            const bf16x8 pa0 = pack8(u0, 0), pa1 = pack8(u0, 1), pb0 = pack8(u1, 0), pb1 = pack8(u1, 1);
            if (dry & 64) { O0[0] += __builtin_bit_cast(float, pa0[0] ^ pa1[1] ^ pb0[2] ^ pb1[3]) + __builtin_bit_cast(float, (int)(Va.v0[0][0] ^ Va.v1[1][1] ^ Vb.v0[0][2] ^ Vb.v1[1][3])); } else {
            O0 = MFMA32(Va.v0[0], pa0, O0); O1 = MFMA32(Va.v1[0], pa0, O1); O0 = MFMA32(Va.v0[1], pa1, O0); O1 = MFMA32(Va.v1[1], pa1, O1);
            O0 = MFMA32(Vb.v0[0], pb0, O0); O1 = MFMA32(Vb.v1[0], pb0, O1); O0 = MFMA32(Vb.v0[1], pb1, O0); O1 = MFMA32(Vb.v1[1], pb1, O1);
            O2 = MFMA32(onesf, pa0, O2); O2 = MFMA32(onesf, pa1, O2); O2 = MFMA32(onesf, pb0, O2); O2 = MFMA32(onesf, pb1, O2); }
        }
    }
    if (curtag >= 0) NC_FINAL();
#undef NC_FINAL
#undef NC_SWITCH
#undef NC_NEED
#undef NC_TBIAS
#undef NC_ST
#undef NC_MASK
#undef NC_LDV
#undef NC_DMA
#undef NC_DMA_E
#undef NC_ENT
#undef NC_FLAGS
#undef NC_ENTRY
    bf16_t* op = P.MIX + rowq * DM + 512 + hh * 64 + 4 * hi;
    if (!(dry & 4))
#pragma unroll
    for (int q4 = 0; q4 < 4; ++q4) {
        u32x2 w0; w0.x = cvtpk(al[64 * (4 * q4)], al[64 * (4 * q4 + 1)]); w0.y = cvtpk(al[64 * (4 * q4 + 2)], al[64 * (4 * q4 + 3)]); *(u32x2*)(op + 8 * q4) = w0;
        u32x2 w1; w1.x = cvtpk(al[64 * (16 + 4 * q4)], al[64 * (16 + 4 * q4 + 1)]); w1.y = cvtpk(al[64 * (16 + 4 * q4 + 2)], al[64 * (16 + 4 * q4 + 3)]); *(u32x2*)(op + 32 + 8 * q4) = w1; }
}

struct MlF { const bf16_t* Z; const float* gates; bf16_t* MIX; const float* gate_bias; const float* mnorm_g; };
constexpr int M2_QC = 0, M2_KC = 17408, M2_K2 = 34816, M2_VC = 55296, M2_EG = 75776, M2_N = 76032, M2_SSQ = 77056, M2_CF = 78080, M2_G = 110848, M2_END = 111360;
constexpr int M2_RS = 272, M2_TS = 320;
typedef short v4i16_t __attribute__((ext_vector_type(4)));
__device__ __forceinline__ v4i16_t ml_tr(const LAS3 unsigned char* p) { return __builtin_amdgcn_ds_read_tr16_b64_v4i16((LAS3 v4i16_t*)p); }
__device__ __forceinline__ bf16x8 ml_cat(v4i16_t a, v4i16_t b) { return (bf16x8){a[0], a[1], a[2], a[3], b[0], b[1], b[2], b[3]}; }
__device__ __forceinline__ float dpp_f(float ident, float v, const int ctrl_dummy) { return v; }
#define ML_DPP(ident, v, ctrl, rmask) __builtin_bit_cast(float, __builtin_amdgcn_update_dpp(__builtin_bit_cast(int, (float)(ident)), __builtin_bit_cast(int, (float)(v)), (ctrl), (rmask), 0xf, false))
__device__ __forceinline__ float scan_add64_dpp(float v) {
    v += ML_DPP(0.f, v, 0x111, 0xf); v += ML_DPP(0.f, v, 0x112, 0xf); v += ML_DPP(0.f, v, 0x114, 0xf); v += ML_DPP(0.f, v, 0x118, 0xf);
    v += ML_DPP(0.f, v, 0x142, 0xa); v += ML_DPP(0.f, v, 0x143, 0xc); return v;
}
__device__ __forceinline__ float scan_max64_dpp(float v) {
    const float NI = -__builtin_inff();
    v = fmaxf(v, ML_DPP(NI, v, 0x111, 0xf)); v = fmaxf(v, ML_DPP(NI, v, 0x112, 0xf)); v = fmaxf(v, ML_DPP(NI, v, 0x114, 0xf)); v = fmaxf(v, ML_DPP(NI, v, 0x118, 0xf));
    v = fmaxf(v, ML_DPP(NI, v, 0x142, 0xa)); v = fmaxf(v, ML_DPP(NI, v, 0x143, 0xc)); return v;
}
struct Ml2Scal { float w, inter_s, rowf_s, floorv, decay, mnew; };
__device__ __forceinline__ Ml2Scal ml2_scalars(float ipre, float fpre, float m) {
    const float lf = log_sigmoidf_(fpre);
    const float bcs = scan_add64_dpp(lf);
    const float bL = __builtin_bit_cast(float, __builtin_amdgcn_readlane(__builtin_bit_cast(int, bcs), 63));
    const float g = ipre - bcs;
    const float pm = scan_max64_dpp(g);
    const float gmax = __builtin_bit_cast(float, __builtin_amdgcn_readlane(__builtin_bit_cast(int, pm), 63));
    const float mm = fmaxf(m, pm), mg = fmaxf(m, gmax);
    Ml2Scal s; const float scale = 0.08838834764831845f;
    s.w = __expf(g - mg); s.inter_s = __expf(m - mm) * scale; s.rowf_s = __expf(mg - mm) * scale; s.floorv = __expf(-bcs - mm);
    s.decay = __expf(m - mg); s.mnew = bL + mg;
    return s;
}

__device__ __forceinline__ void mlstm_unit_v2(const MlF& P, int b, int h, LAS3 unsigned char* L, int tid) {
    const int lane = tid & 63, wave = __builtin_amdgcn_readfirstlane(tid >> 6), lt = wave >> 2, tq = lane & 31, hi = lane >> 5;
    const float bi = P.gate_bias[h], bff = P.gate_bias[4 + h];
    const size_t row0 = (size_t)b * SEQ;
    const int ss = tid >> 3, d0 = 8 * (tid & 7);
    const bf16_t* zst = P.Z + (row0 + ss) * NZ + h * 128 + d0;
    const int wv_ = tid >> 6, ltv = wv_ >> 2, dvtv = wv_ & 3;
    const int lrow = 32 * ltv + tq;
    const int i16 = lane & 15, g16 = lane >> 4;
    const unsigned tr_lane = (unsigned)((4 * hi + (i16 >> 2)) * M2_TS + (16 * (g16 & 1) + 4 * (i16 & 3)) * 2);
    const unsigned a_qc = M2_QC + lrow * M2_RS + 16 * hi, a_qp = M2_QC + lrow * M2_RS + 8 * hi, a_kc = M2_KC + tq * M2_RS + 16 * hi, a_cf = M2_CF + (dvtv * 512 + lane) * 16;
    const unsigned a_vt = M2_VC + tr_lane + (32 * dvtv) * 2, a_kt = M2_K2 + tr_lane + (64 * ltv) * 2, a_eg = M2_EG + 16 * hi, a_n = M2_N + 256 * hi;
    f32x16 C0, C1;
#pragma unroll
    for (int i = 0; i < 16; ++i) { C0[i] = 0.f; C1[i] = 0.f; }
    for (int i = tid; i < 256; i += NTHREADS) ((LAS3 float*)(L + M2_N))[i] = 0.f;
    if (tid < 128) ((LAS3 float*)(L + M2_G))[tid] = P.mnorm_g[h * 128 + tid];
    for (int i = tid; i < 32768 / 16; i += NTHREADS) ((LAS3 u32x4*)(L + M2_CF))[i] = (u32x4){0u, 0u, 0u, 0u};
    float mst = 0.f;
    u32x4 rq[2], rk[2], rv[2]; float gi_, gf_;
#pragma unroll
    for (int p = 0; p < 2; ++p) { rq[p] = *(const u32x4*)(zst + ZC_MQ + 64 * p); rk[p] = *(const u32x4*)(zst + ZC_MK + 64 * p); rv[p] = *(const u32x4*)(zst + ZC_MV + 64 * p); }
    { const float* gr = P.gates + (row0 + lane) * 32; gi_ = gr[h] + bi; gf_ = gr[4 + h] + bff; }
    Ml2Scal sc = ml2_scalars(gi_, gf_, mst);
#define ML2_STAGE() do { \
        const float ws_ = __shfl(sc.w, ss); \
        _Pragma("unroll") for (int p = 0; p < 2; ++p) { \
            *(LAS3 u32x4*)(L + M2_QC + ss * M2_RS + (d0 + 64 * p) * 2) = rq[p]; \
            *(LAS3 u32x4*)(L + M2_KC + ss * M2_RS + (d0 + 64 * p) * 2) = rk[p]; *(LAS3 u32x4*)(L + M2_K2 + ss * M2_TS + (d0 + 64 * p) * 2) = rk[p]; \
            u32x4 o_; o_.x = cvtpk(bflo(rv[p].x) * ws_, bfhi(rv[p].x) * ws_); o_.y = cvtpk(bflo(rv[p].y) * ws_, bfhi(rv[p].y) * ws_); o_.z = cvtpk(bflo(rv[p].z) * ws_, bfhi(rv[p].z) * ws_); o_.w = cvtpk(bflo(rv[p].w) * ws_, bfhi(rv[p].w) * ws_); \
            *(LAS3 u32x4*)(L + M2_VC + ss * M2_TS + (d0 + 64 * p) * 2) = o_; } \
        if (wave == 0) ((LAS3 float*)(L + M2_EG))[lane] = sc.w; } while (0)
    __syncthreads();
    ML2_STAGE();
    float inter_s = __shfl(sc.inter_s, lrow), rowf_s = __shfl(sc.rowf_s, lrow), floorv = __shfl(sc.floorv, lrow), decay = sc.decay;
    mst = sc.mnew;
    u32x2 mo[4];
#define ML2_PREFETCH(cn) do { \
        if ((cn) < SEQ / 64) { const bf16_t* zn = zst + (size_t)(cn) * 64 * NZ; \
            _Pragma("unroll") for (int p = 0; p < 2; ++p) { rq[p] = *(const u32x4*)(zn + ZC_MQ + 64 * p); rk[p] = *(const u32x4*)(zn + ZC_MK + 64 * p); rv[p] = *(const u32x4*)(zn + ZC_MV + 64 * p); } \
            const float* gr = P.gates + (row0 + (size_t)(cn) * 64 + lane) * 32; gi_ = gr[h] + bi; gf_ = gr[4 + h] + bff; } \
        { const size_t orow_ = row0 + (size_t)((cn) - 1) * 64 + lrow; \
          _Pragma("unroll") for (int q = 0; q < 4; ++q) mo[q] = *(const u32x2*)(P.Z + orow_ * NZ + ZC_MO + h * 128 + 32 * dvtv + 8 * q + 4 * hi); } } while (0)
    ML2_PREFETCH(1);
#pragma unroll 1
    for (int c = 0; c < SEQ / 64; ++c) {
        __syncthreads();
        const bool more = (c + 1 < SEQ / 64);
        const size_t orow = row0 + (size_t)c * 64 + lrow;
        float den = 0.f;
        bf16x8 xf[4];
        {
            bf16x8 qf[8];
#pragma unroll
            for (int kk = 0; kk < 8; ++kk) qf[kk] = *(const LAS3 bf16x8*)(L + a_qc + 32 * kk);
#pragma unroll
            for (int st = 0; st < 2; ++st) {
                if (st <= lt) {
                    f32x16 X;
#pragma unroll
                    for (int i = 0; i < 16; ++i) X[i] = 0.f;
#pragma unroll
                    for (int kk = 0; kk < 8; ++kk) X = MFMA32(*(const LAS3 bf16x8*)(L + a_kc + 32 * st * M2_RS + 32 * kk), qf[kk], X);
                    const bool diag = (st == lt);
                    int tqo = tq - 4 * hi; asm volatile("" : "+v"(tqo));
                    float dsum = 0.f;
#pragma unroll
                    for (int q = 0; q < 4; ++q) { const f32x4 e4 = *(const LAS3 f32x4*)(L + a_eg + (32 * st + 8 * q) * 4);
#pragma unroll
                        for (int e = 0; e < 4; ++e) { const int i = 4 * q + e; float x = X[i] * rowf_s; if (diag && (8 * q + e > tqo)) x = 0.f; X[i] = x; dsum += x * e4[e]; } }
                    den += dsum;
                    xf[2 * st] = pack8(X, 0); xf[2 * st + 1] = pack8(X, 1);
                }
            }
        }
        den += other_half_f(den, hi);
        asm volatile("" ::: "memory");
        f32x16 acc;
#pragma unroll
        for (int i = 0; i < 16; ++i) acc[i] = 0.f;
#pragma unroll
        for (int kk = 0; kk < 8; ++kk) { const u32x2 qa = *(const LAS3 u32x2*)(L + a_qp + 32 * kk), qb = *(const LAS3 u32x2*)(L + a_qp + 32 * kk + 16);
            const u32x4 qq = (u32x4){qa.x, qa.y, qb.x, qb.y};
            acc = MFMA32(*(const LAS3 bf16x8*)(L + a_cf + kk * 1024), __builtin_bit_cast(bf16x8, qq), acc); }
        asm volatile("" ::: "memory");
        float qn = 0.f;
        { const unsigned an = a_n + (c & 1) * 512; const unsigned aq = M2_QC + lrow * M2_RS + 128 * hi;
#pragma unroll
          for (int k8 = 0; k8 < 8; ++k8) { const u32x4 w = *(const LAS3 u32x4*)(L + aq + 16 * k8); const f32x4 n0 = *(const LAS3 f32x4*)(L + an + 32 * k8), n1 = *(const LAS3 f32x4*)(L + an + 32 * k8 + 16);
              qn += bflo(w.x) * n0[0] + bfhi(w.x) * n0[1] + bflo(w.y) * n0[2] + bfhi(w.y) * n0[3] + bflo(w.z) * n1[0] + bfhi(w.z) * n1[1] + bflo(w.w) * n1[2] + bfhi(w.w) * n1[3]; } }
        qn += other_half_f(qn, hi);
        acc *= inter_s;
        bf16x8 vf[4];
#pragma unroll
        for (int s4 = 0; s4 < 4; ++s4) vf[s4] = ml_cat(ml_tr(L + a_vt + 16 * s4 * M2_TS), ml_tr(L + a_vt + (16 * s4 + 8) * M2_TS));
#pragma unroll
        for (int s4 = 0; s4 < 4; ++s4) if ((s4 >> 1) <= lt) acc = MFMA32(vf[s4], xf[s4], acc);
        den = inter_s * qn + den;
        const float inv = __builtin_amdgcn_rcpf(fmaxf(fabsf(den), floorv));
        float ssq = 0.f;
#pragma unroll
        for (int i = 0; i < 16; ++i) { acc[i] *= inv; ssq += acc[i] * acc[i]; }
        ssq += other_half_f(ssq, hi);
        if (hi == 0) *(LAS3 float*)(L + M2_SSQ + (dvtv * 64 + lrow) * 4) = ssq;
        asm volatile("" ::: "memory");
        C0 *= decay; C1 *= decay;
#pragma unroll
        for (int s4 = 0; s4 < 4; ++s4) {
            C0 = MFMA32(ml_cat(ml_tr(L + a_kt + 16 * s4 * M2_TS), ml_tr(L + a_kt + (16 * s4 + 8) * M2_TS)), vf[s4], C0);
            C1 = MFMA32(ml_cat(ml_tr(L + a_kt + 64 + 16 * s4 * M2_TS), ml_tr(L + a_kt + 64 + (16 * s4 + 8) * M2_TS)), vf[s4], C1); }
        if (tid < 128) { float a = 0.f;
#pragma unroll 16
            for (int s = 0; s < 64; ++s) a += ((const LAS3 float*)(L + M2_EG))[s] * bf2f(*(const LAS3 unsigned short*)(L + M2_KC + s * M2_RS + tid * 2));
            LAS3 float* nn = (LAS3 float*)(L + M2_N);
            nn[((c + 1) & 1) * 128 + tid] = decay * nn[(c & 1) * 128 + tid] + a; }
        __syncthreads();
        { const LAS3 float* sq = (const LAS3 float*)(L + M2_SSQ + lrow * 4); const float ss4 = (sq[0] + sq[64]) + (sq[128] + sq[192]);
          const float rstd = __builtin_amdgcn_rsqf(ss4 * (1.0f / 128.0f) + EPS);
          bf16_t* op = P.MIX + orow * DM + h * 128 + 32 * dvtv + 4 * hi;
#pragma unroll
          for (int q = 0; q < 4; ++q) { const f32x4 gg = *(const LAS3 f32x4*)(L + M2_G + (32 * dvtv + 8 * q + 4 * hi) * 4);
              const float o0 = acc[4 * q] * rstd * gg[0] * sigmoidf_(bflo(mo[q].x)), o1 = acc[4 * q + 1] * rstd * gg[1] * sigmoidf_(bfhi(mo[q].x));
              const float o2 = acc[4 * q + 2] * rstd * gg[2] * sigmoidf_(bflo(mo[q].y)), o3 = acc[4 * q + 3] * rstd * gg[3] * sigmoidf_(bfhi(mo[q].y));
              u32x2 w; w.x = cvtpk(o0, o1); w.y = cvtpk(o2, o3); *(u32x2*)(op + 8 * q) = w; } }
        { const unsigned aw = a_cf + ltv * 4096;
          *(LAS3 bf16x8*)(L + aw) = pack8(C0, 0); *(LAS3 bf16x8*)(L + aw + 1024) = pack8(C0, 1); *(LAS3 bf16x8*)(L + aw + 2048) = pack8(C1, 0); *(LAS3 bf16x8*)(L + aw + 3072) = pack8(C1, 1); }
        if (more) {
            sc = ml2_scalars(gi_, gf_, mst);
            ML2_STAGE();
            inter_s = __shfl(sc.inter_s, lrow); rowf_s = __shfl(sc.rowf_s, lrow); floorv = __shfl(sc.floorv, lrow); decay = sc.decay; mst = sc.mnew;
            ML2_PREFETCH(c + 2);
        }
    }
#undef ML2_PREFETCH
#undef ML2_STAGE
    __syncthreads();
}

#define LAS __attribute__((address_space(3)))
#define XB_TMO      128
#define XB_XCNT(j)  (256  + 64 * (j))
#define XB_XSUB(j)  (1280 + 64 * (j))
#define XB_XGEN(j)  (2304 + 64 * (j))
#define XB_TOP      3328
#define XB_TOPGEN   3392
#define XCD_BAR_WORDS 3456
#define XB_SPIN_CAP (1u << 18)

__device__ __forceinline__ unsigned xb_ld(unsigned* p)              { return __hip_atomic_load(p, __ATOMIC_RELAXED, __HIP_MEMORY_SCOPE_AGENT); }
__device__ __forceinline__ unsigned xb_add(unsigned* p, unsigned v) { return __hip_atomic_fetch_add(p, v, __ATOMIC_RELAXED, __HIP_MEMORY_SCOPE_AGENT); }
__device__ __forceinline__ unsigned xb_xcc_id() { return (unsigned)__builtin_amdgcn_s_getreg((3 << 11) | 20) & 0xFu; }
#define XB_SPIN(cond, bar) do { unsigned _sp = 0; while (cond) { __builtin_amdgcn_s_sleep(1); \
    if ((++_sp & 255u) == 0u) { if (xb_ld(&(bar)[XB_TMO])) break; if (_sp > XB_SPIN_CAP) { atomicAdd(&(bar)[XB_TMO], 1u); break; } } } } while (0)

struct XcdBarrier {
    unsigned* bar; unsigned x;
    volatile LAS unsigned* st;
};

__device__ __forceinline__ XcdBarrier xcd_barrier_post(unsigned* bar, volatile LAS unsigned* st) {
    XcdBarrier b; b.bar = bar; b.x = xb_xcc_id(); b.st = st;
    if (threadIdx.x == 0) (void)xb_add(&bar[XB_XCNT(b.x)], 1u);
    return b;
}
__device__ __forceinline__ void xcd_barrier_complete(unsigned* bar, unsigned x, unsigned& nloc, unsigned& nx) {
    const unsigned G = gridDim.x * gridDim.y * gridDim.z;
    unsigned sum, cnt, mine, sp = 0u;
    for (;;) {
        sum = 0u; cnt = 0u; mine = 0u;
#pragma unroll
        for (unsigned j = 0; j < 16; ++j) { const unsigned c = xb_ld(&bar[XB_XCNT(j)]); sum += c; cnt += (c > 0u) ? 1u : 0u; mine = (j == x) ? c : mine; }
        if (sum == G) break;
        __builtin_amdgcn_s_sleep(1);
        if ((++sp & 255u) == 0u) { if (xb_ld(&bar[XB_TMO])) break; if (sp > XB_SPIN_CAP) { atomicAdd(&bar[XB_TMO], 1u); break; } }
    }
    nloc = mine > 0u ? mine : 1u; nx = cnt > 0u ? cnt : 1u;
}

__device__ __forceinline__ void xcd_barrier(const XcdBarrier& b) {
    asm volatile("s_waitcnt vmcnt(0)" ::: "memory");
    __syncthreads();
    if (threadIdx.x == 0) {
        unsigned* bar = b.bar;
        __builtin_amdgcn_s_waitcnt(0);
        unsigned nloc = b.st[0], nx = b.st[1];
        if (nloc == 0u) { xcd_barrier_complete(bar, b.x, nloc, nx); b.st[0] = nloc; b.st[1] = nx; }
        const unsigned old = xb_add(&bar[XB_XSUB(b.x)], 1u);
        const unsigned gen = old / nloc;
        if (old + 1u == (gen + 1u) * nloc) {
            __builtin_amdgcn_fence(__ATOMIC_RELEASE, "agent");
            asm volatile("s_waitcnt vmcnt(0)" ::: "memory");
            const unsigned og = xb_add(&bar[XB_TOP], 1u);
            const unsigned tg = og / nx;
            if (og + 1u == (tg + 1u) * nx) xb_add(&bar[XB_TOPGEN], 1u);
            else XB_SPIN(xb_ld(&bar[XB_TOPGEN]) == tg, bar);
            __builtin_amdgcn_fence(__ATOMIC_ACQUIRE, "agent");
            xb_add(&bar[XB_XGEN(b.x)], 1u);
            asm volatile("s_waitcnt vmcnt(0)" ::: "memory");
        } else {
            XB_SPIN(xb_ld(&bar[XB_XGEN(b.x)]) == gen, bar);
            __builtin_amdgcn_fence(__ATOMIC_ACQUIRE, "agent");
            asm volatile("s_waitcnt vmcnt(0)" ::: "memory");
        }
    }
    __syncthreads();
}

__global__ void __launch_bounds__(NTHREADS, 2) fwd_kernel(Params prm) {
    extern __shared__ __attribute__((aligned(16))) unsigned char lds[];
    cg::grid_group grid = cg::this_grid();
    PG8_LAS unsigned char* ldsl = (PG8_LAS unsigned char*)lds;
    float* lds_f = (float*)lds;
#define TID ((int)threadIdx.x)
#define LANE ((int)(threadIdx.x & 63))
#define WAVE (__builtin_amdgcn_readfirstlane((int)(threadIdx.x >> 6)))
#define GRIDN ((int)gridDim.x)
#define BX ((int)blockIdx.x)
#define WSP(T, name, off) T* name; { unsigned char* w_ = prm.ws; asm volatile("" : "+s"(w_)); name = (T*)(w_ + (off)); }
    { volatile LAS unsigned* st0 = (volatile LAS unsigned*)((LAS unsigned char*)lds + XBAR_LDS); if (threadIdx.x < 2) st0[threadIdx.x] = 0u; }
    __syncthreads();
    XcdBarrier xbar; { unsigned char* w_ = prm.ws; asm volatile("" : "+s"(w_)); xbar = xcd_barrier_post((unsigned*)(w_ + WS_CTL) + 4096, (volatile LAS unsigned*)((LAS unsigned char*)lds + XBAR_LDS)); }
#ifndef DUP_PHASE
#define DUPREPS(k) 1
#else
#define DUPREPS(k) ((k) == DUP_PHASE ? 2 : 1)
#endif
#ifdef PROBE_A
#define STAMP(k) do { if (BX == 0 && TID == 0) { unsigned char* w_ = prm.ws; asm volatile("" : "+s"(w_)); ((unsigned long long*)w_)[k] = __builtin_amdgcn_s_memrealtime(); } } while (0)
#else
#define STAMP(k) do { } while (0)
#endif
    STAMP(0);

    _Pragma("unroll 1") for (int rep_ = 0; rep_ < DUPREPS(0); ++rep_)
    {
        const int lane = LANE, wave = WAVE, G = GRIDN, bx = BX, tid = TID; const int gw = bx * NWAVES + wave, NGW = G * NWAVES;
        WSP(bf16_t, Win_t, WS_WIN) WSP(bf16_t, Wout_t, WS_WOUT) WSP(bf16_t, Wup_t, WS_WUP) WSP(bf16_t, Wdn_t, WS_WDN) WSP(bf16_t, Wpg_t, WS_WPG) WSP(bf16_t, Wpp_t, WS_WPP)
        WSP(bf16_t, XB, WS_XB) WSP(bf16_t, PB, WS_PB) WSP(bf16_t, W1T, WS_W1T) WSP(bf16_t, W2T, WS_W2T) WSP(float, C1, WS_C1)
        const float* x = prm.in[0]; const float* pin = prm.in[1];
        float* scr = lds_f + wave * 4096;
        constexpr int I_IN = (DM / 64) * (3360 / 32), I_OUT = (DM / 64) * (DM / 32), I_UP = (DM / 64) * (4096 / 32), I_DN = (DFF / 64) * (DM / 32), I_PG = I_OUT, I_PP = (PLE / 64) * (DM / 32);
        constexpr int I_W1 = 4 * 64, I_W2 = 2 * 4;
        constexpr int NITEMS = I_IN + I_OUT + I_UP + I_DN + I_PG + I_PP + I_W1 + I_W2;
        for (int it = gw; it < NITEMS; it += NGW) {
            int r = it;
            if (r < I_IN) { p0_transpose_item(prm.in[3], nullptr, DM, 3360, Win_t, scr, r, lane); continue; } r -= I_IN;
            if (r < I_OUT) { p0_transpose_item(prm.in[12], nullptr, DM, DM, Wout_t, scr, r, lane); continue; } r -= I_OUT;
            if (r < I_UP) { p0_transpose_item<true>(prm.in[14], prm.in[13], DM, 4096, Wup_t, scr, r, lane); continue; } r -= I_UP;
            if (r < I_DN) { p0_transpose_item(prm.in[17], nullptr, DFF, DM, Wdn_t, scr, r, lane); continue; } r -= I_DN;
            if (r < I_PG) { p0_transpose_item(prm.in[19], prm.in[18], DM, DM, Wpg_t, scr, r, lane); continue; } r -= I_PG;
            if (r < I_PP) { p0_transpose_item(prm.in[20], nullptr, PLE, DM, Wpp_t, scr, r, lane); continue; } r -= I_PP;
            if (r < I_W1) { const int q = r >> 6, kv = q >> 1, half = q & 1;
                p0_transpose_item(prm.in[kv ? 10 : 8] + (size_t)half * 1024 * 128, nullptr, 1024, 128, W1T + (size_t)kv * 256 * 1024 + (size_t)half * 128 * 1024, scr, r & 63, lane); continue; } r -= I_W1;
            { const int kv = r >> 2; p0_transpose_item(prm.in[kv ? 11 : 9], nullptr, 128, 64, W2T + (size_t)kv * 64 * 128, scr, r & 3, lane); }
        }
        if (tid < 256) { const int kv = tid >> 7, j = tid & 127; const float* pe = prm.in[kv ? 7 : 6]; const float* w1 = prm.in[kv ? 10 : 8]; float a = 0.f;
            const int per = (2048 + G - 1) / G; const int l0 = bx * per, l1 = min(2048, l0 + per);
            for (int ld = l0; ld < l1; ++ld) a += pe[ld] * w1[(size_t)ld * 128 + j];
            if (l0 < l1) atomicAdd(C1 + kv * 128 + j, a); }
        for (int i = bx * NTHREADS + tid; i < (NZ - 3360) * DM / 8; i += G * NTHREADS) ((u32x4*)(Win_t + (size_t)3360 * DM))[i] = (u32x4){0u, 0u, 0u, 0u};
        const float* g1 = prm.in[2];
        f32x4 gv[4];
#pragma unroll
        for (int j = 0; j < 4; ++j) gv[j] = ((const f32x4*)g1)[lane + 64 * j];
        for (int m = 2 * gw; m < MTOK; m += 2 * NGW) {
            f32x4 v[2][4]; float sq[2];
#pragma unroll
            for (int k = 0; k < 2; ++k) { const f32x4* xr = (const f32x4*)(x + (size_t)(m + k) * DM) + lane;
#pragma unroll
                for (int j = 0; j < 4; ++j) v[k][j] = xr[64 * j]; }
#pragma unroll
            for (int k = 0; k < 2; ++k) { float s = 0.f;
#pragma unroll
                for (int j = 0; j < 4; ++j) s += (v[k][j][0] * v[k][j][0] + v[k][j][1] * v[k][j][1]) + (v[k][j][2] * v[k][j][2] + v[k][j][3] * v[k][j][3]);
                sq[k] = s; }
#pragma unroll
            for (int o = 1; o < 64; o <<= 1) { sq[0] += __shfl_xor(sq[0], o); sq[1] += __shfl_xor(sq[1], o); }
#pragma unroll
            for (int k = 0; k < 2; ++k) { const float rstd = 1.0f / sqrtf(sq[k] * (1.0f / DM) + EPS);
                u32x2* o8 = (u32x2*)(XB + (size_t)(m + k) * DM) + lane;
#pragma unroll
                for (int j = 0; j < 4; ++j) { u32x2 w; w.x = pk2(v[k][j][0] * rstd * gv[j][0], v[k][j][1] * rstd * gv[j][1]); w.y = pk2(v[k][j][2] * rstd * gv[j][2], v[k][j][3] * rstd * gv[j][3]); o8[64 * j] = w; } }
        }
        for (size_t i = (size_t)bx * NTHREADS + tid; i < (size_t)MTOK * PLE / 8; i += (size_t)G * NTHREADS) {
            const f32x4 a = ((const f32x4*)pin)[2 * i], c = ((const f32x4*)pin)[2 * i + 1];
            u32x4 w; w.x = pk2(a[0], a[1]); w.y = pk2(a[2], a[3]); w.z = pk2(c[0], c[1]); w.w = pk2(c[2], c[3]); ((u32x4*)PB)[i] = w; }
    }
    grid.sync();
    STAMP(1);

    _Pragma("unroll 1") for (int rep_ = 0; rep_ < DUPREPS(1); ++rep_)
    {
        WSP(bf16_t, XB, WS_XB) WSP(bf16_t, Win_t, WS_WIN) WSP(bf16_t, Z, WS_Z) WSP(float, GATES, WS_GATES)
        pg8::Gemm g{XB, Win_t, MTOK, NZ, DM}; pg8::StaticOrder S; S.init(MTOK, NZ, GRIDN, BX);
#ifdef P1_PLAIN_DUP
        if (rep_ > 0) { pg8::EpiBf<false> E2{Z, NZ, nullptr}; pg8::gemm_phase<pg8::EpiBf<false>, pg8::StaticOrder, true, true>(ldsl, g, S, E2); } else
#endif
        { pg8::EpiZ E{Z, GATES};
        pg8::gemm_phase<pg8::EpiZ, pg8::StaticOrder, true, true>(ldsl, g, S, E); }
    }
    xcd_barrier(xbar);
    STAMP(2);

    _Pragma("unroll 1") for (int rep_ = 0; rep_ < DUPREPS(2); ++rep_)
    {
        WSP(bf16_t, Z, WS_Z) WSP(bf16_t, KCB, WS_KCB) WSP(bf16_t, VCT, WS_VCT) WSP(bf16_t, VST, WS_VST) WSP(bf16_t, VWT, WS_VWT)
        const bool split = GRIDN > 128;
        if (!split || BX < 64) {
            WSP(bf16_t, W1T, WS_W1T) WSP(bf16_t, W2T, WS_W2T) WSP(float, C1, WS_C1)
            for (int un = BX; un < 64; un += (split ? 64 : GRIDN)) {
                pg8::Gemm g{nullptr, nullptr, 256, 256, 1024, 16 * NZ, NZ * 2}; pg8::CmpOrder S{un, Z, W1T};
                pg8::EpiCmp E{C1, W2T, KCB, VCT};
                pg8::gemm_phase<pg8::EpiCmp, pg8::CmpOrder, true, true>(ldsl, g, S, E);
                __syncthreads();
            }
        }
        if (!split || BX >= 64)
        for (int un = split ? BX - 64 : BX; un < BATCH * 2 * 2 * 64; un += (split ? GRIDN - 64 : GRIDN)) {
            const int ch = un & 63, br = (un >> 6) & 1, g = (un >> 7) & 1, b = un >> 8;
            vt_unit(Z, br ? ZC_AVW : ZC_AVS, br ? VWT : VST, b, g, ch, (unsigned short*)lds, TID);
        }
    }
    xcd_barrier(xbar);
    STAMP(3);

    _Pragma("unroll 1") for (int rep_ = 0; rep_ < DUPREPS(3); ++rep_)
    {
        WSP(bf16_t, Z, WS_Z) WSP(float, GATES, WS_GATES) WSP(bf16_t, MIX, WS_MIX)
        {
            MlF MP{Z, GATES, MIX, prm.in[4], prm.in[5]};
            _Pragma("unroll 1") for (int rep2_ = 0; rep2_ < DUPREPS(30); ++rep2_)
            for (int un = BX; un < BATCH * 4; un += GRIDN) mlstm_unit_v2(MP, un >> 2, un & 3, (LAS3 unsigned char*)lds, TID);
        }
        __syncthreads();
        {
            WSP(bf16_t, KCB, WS_KCB) WSP(bf16_t, VCT, WS_VCT) WSP(bf16_t, VST, WS_VST) WSP(bf16_t, VWT, WS_VWT)
            NsaF NP{Z, GATES, KCB, VCT, VST, VWT, MIX};
            unsigned* qctr; { unsigned char* w_ = prm.ws; asm volatile("" : "+s"(w_)); qctr = (unsigned*)(w_ + WS_CTL) + 64; }
            volatile LAS3 int* slot = (volatile LAS3 int*)((LAS3 unsigned char*)lds + NC_QSLOT);
            _Pragma("unroll 1") for (int rep2_ = 0; rep2_ < DUPREPS(31); ++rep2_) {
            int tk = 0;
            if (TID == 0) tk = (int)atomicAdd(qctr + 64 * rep2_, 1u);
            for (;;) {
                if (TID == 0) { *slot = tk; if (tk < BATCH * 2 * 64) tk = (int)atomicAdd(qctr + 64 * rep2_, 1u); }
                __syncthreads();
                const int grp = *slot;
                __syncthreads();
                if (grp >= BATCH * 2 * 64) break;
#ifdef NSA_DRY
                nsa_unit_coop(NP, (grp >> 1) & 15, grp & 1, 63 - (grp >> 5), (LAS3 unsigned char*)lds, TID, rep2_ ? NSA_DRY : 0);
#else
                nsa_unit_coop(NP, (grp >> 1) & 15, grp & 1, 63 - (grp >> 5), (LAS3 unsigned char*)lds, TID);
#endif
            } }
        }
    }
    xcd_barrier(xbar);
    STAMP(4);

    _Pragma("unroll 1") for (int rep_ = 0; rep_ < DUPREPS(4); ++rep_)
    {
        WSP(bf16_t, MIX, WS_MIX) WSP(bf16_t, Wout_t, WS_WOUT) WSP(bf16_t, XB, WS_XB) WSP(float, RS2, WS_RS2)
        pg8::Gemm g{MIX, Wout_t, MTOK, DM, DM}; pg8::PanelOrder S; S.init(MTOK, GRIDN, BX);
        pg8::EpiRes<true> E{prm.in[0], nullptr, XB, RS2};
        pg8::gemm_phase<pg8::EpiRes<true>, pg8::PanelOrder, true, true>(ldsl, g, S, E);
        WSP(float, RSTD2, WS_RSTD2)
        asm volatile("s_waitcnt vmcnt(0)" ::: "memory"); __syncthreads();
        for (int p = BX; p < MTOK / 256; p += GRIDN) if (TID < 256) { const int row = p * 256 + TID; RSTD2[row] = pg8::row_rstd(RS2, row); }
    }
    xcd_barrier(xbar);
    STAMP(5);

    _Pragma("unroll 1") for (int rep_ = 0; rep_ < DUPREPS(5); ++rep_)
    {
        WSP(bf16_t, XB, WS_XB) WSP(bf16_t, Wup_t, WS_WUP) WSP(bf16_t, ACT, WS_ACT) WSP(float, RS2, WS_RSTD2)
        PG8_LAS float* car = (PG8_LAS float*)(ldsl + 131072 + 1024);
        pg8::Gemm g{XB, Wup_t, MTOK, 4096, DM, 0, 0}; pg8::ChainOrder S{BX};
        pg8::EpiUpConv E{ACT, RS2, prm.in[15], prm.in[16], car};
        pg8::gemm_phase<pg8::EpiUpConv, pg8::ChainOrder, true, true>(ldsl, g, S, E);
    }
    xcd_barrier(xbar);
    STAMP(6);

    _Pragma("unroll 1") for (int rep_ = 0; rep_ < DUPREPS(7); ++rep_)
    {
        WSP(bf16_t, ACT, WS_ACT) WSP(bf16_t, Wdn_t, WS_WDN) WSP(bf16_t, XB, WS_XB) WSP(float, RS3, WS_RS3)
        pg8::Gemm g{ACT, Wdn_t, MTOK, DM, DFF}; pg8::PanelOrder S; S.init(MTOK, GRIDN, BX);
        pg8::EpiRes<false> E{nullptr, XB, XB, RS3};
        pg8::gemm_phase<pg8::EpiRes<false>, pg8::PanelOrder, true, true>(ldsl, g, S, E);
        WSP(float, RSTD3, WS_RSTD3)
        asm volatile("s_waitcnt vmcnt(0)" ::: "memory"); __syncthreads();
        for (int p = BX; p < MTOK / 256; p += GRIDN) if (TID < 256) { const int row = p * 256 + TID; RSTD3[row] = pg8::row_rstd(RS3, row); }
    }
    _Pragma("unroll 1") for (int rep_ = 0; rep_ < DUPREPS(8); ++rep_)
    {
        WSP(bf16_t, PB, WS_PB) WSP(bf16_t, Wpp_t, WS_WPP) WSP(bf16_t, PROJ, WS_PROJ)
        pg8::Gemm g{PB, Wpp_t, MTOK, DM, PLE}; pg8::StaticOrder S; S.init(MTOK, DM, GRIDN, BX);
        pg8::EpiBf<false> E{PROJ, DM, nullptr};
        pg8::gemm_phase<pg8::EpiBf<false>, pg8::StaticOrder, true, true>(ldsl, g, S, E);
    }
    xcd_barrier(xbar);
    STAMP(8);

    _Pragma("unroll 1") for (int rep_ = 0; rep_ < DUPREPS(9); ++rep_)
    {
        WSP(bf16_t, XB, WS_XB) WSP(bf16_t, Wpg_t, WS_WPG) WSP(bf16_t, PROJ, WS_PROJ) WSP(float, RS3, WS_RSTD3)
        pg8::Gemm g{XB, Wpg_t, MTOK, DM, DM}; pg8::PanelOrder S; S.init(MTOK, GRIDN, BX);
        WSP(bf16_t, X3B, WS_ACT) WSP(float, RS4, WS_RS2)
        pg8::EpiPle E{XB, PROJ, RS3, X3B, RS4};
        pg8::gemm_phase<pg8::EpiPle, pg8::PanelOrder, true, true>(ldsl, g, S, E);
    }
    xcd_barrier(xbar);
    STAMP(9);

    _Pragma("unroll 1") for (int rep_ = 0; rep_ < DUPREPS(10); ++rep_)
    {
        WSP(bf16_t, X3B, WS_ACT) WSP(float, RS4, WS_RS2)
        const int lane = LANE; const int gw = BX * NWAVES + WAVE, NGW = GRIDN * NWAVES;
        const float* fg = prm.in[21]; float* out = prm.out;
        f32x4 gv[4];
#pragma unroll
        for (int j = 0; j < 4; ++j) gv[j] = ((const f32x4*)fg)[4 * lane + j];
        for (int m = 2 * gw; m < MTOK; m += 2 * NGW) {
            u32x4 xa[2][2]; float ss[2];
#pragma unroll
            for (int k = 0; k < 2; ++k) { const u32x4* xr = (const u32x4*)(X3B + (size_t)(m + k) * DM) + 2 * lane; xa[k][0] = xr[0]; xa[k][1] = xr[1];
                ss[k] = (lane < 16) ? RS4[(size_t)(m + k) * 16 + lane] : 0.f; }
#pragma unroll
            for (int k = 0; k < 2; ++k) { float s = ss[k]; s += __shfl_xor(s, 1); s += __shfl_xor(s, 2); s += __shfl_xor(s, 4); s += __shfl_xor(s, 8); s = __shfl(s, 0);
                const float rstd = 1.0f / sqrtf(s * (1.0f / DM) + EPS);
                f32x4* o = (f32x4*)(out + (size_t)(m + k) * DM) + 4 * lane;
                const u32x4 w0 = xa[k][0], w1 = xa[k][1];
                o[0] = (f32x4){bflo(w0.x), bfhi(w0.x), bflo(w0.y), bfhi(w0.y)} * rstd * gv[0]; o[1] = (f32x4){bflo(w0.z), bfhi(w0.z), bflo(w0.w), bfhi(w0.w)} * rstd * gv[1];
                o[2] = (f32x4){bflo(w1.x), bfhi(w1.x), bflo(w1.y), bfhi(w1.y)} * rstd * gv[2]; o[3] = (f32x4){bflo(w1.z), bfhi(w1.z), bflo(w1.w), bfhi(w1.w)} * rstd * gv[3]; }
        }
    }
#ifdef PROBE_A
    xcd_barrier(xbar);
    {
        unsigned char* w_ = prm.ws; asm volatile("" : "+s"(w_)); const unsigned long long* ts = (const unsigned long long*)w_;
        const float ta = (float)(ts[PROBE_A + 1] - ts[PROBE_A]) * 0.01f, tb = (float)(ts[PROBE_B + 1] - ts[PROBE_B]) * 0.01f;
        float* out = prm.out;
        if (BX == 0 && TID == 0) out[0] += ta;
        for (size_t i = (size_t)BX * NTHREADS + TID; i < (size_t)1024 * 1024; i += (size_t)GRIDN * NTHREADS) out[1024 + i] += tb * 0.01f;
    }
#endif

}

extern "C" void kernel_launch(void* const* d_in, const int* in_sizes, int n_in, void* d_out, int out_size, void* d_ws, size_t ws_size, hipStream_t stream) {
    static int grid = 0;
    if (grid == 0) {
        if (n_in != 22 || out_size != MTOK * DM || ws_size < WS_END) { fprintf(stderr, "kernel_launch: unexpected problem (n_in %d, out %d, ws %zu)\n", n_in, out_size, ws_size); grid = -1; return; }
        int dev = 0, cus = 0, per_cu = 0;
        if (hipGetDevice(&dev) != hipSuccess || hipDeviceGetAttribute(&cus, hipDeviceAttributeMultiprocessorCount, dev) != hipSuccess) { grid = -1; return; }
        if (hipFuncSetAttribute((const void*)fwd_kernel, hipFuncAttributeMaxDynamicSharedMemorySize, LDS_BYTES) != hipSuccess) { fprintf(stderr, "kernel_launch: hipFuncSetAttribute failed\n"); grid = -1; return; }
        if (hipOccupancyMaxActiveBlocksPerMultiprocessor(&per_cu, (const void*)fwd_kernel, NTHREADS, LDS_BYTES) != hipSuccess || per_cu < 1) { fprintf(stderr, "kernel_launch: occupancy query says %d\n", per_cu); (void)hipGetLastError(); per_cu = 1; }
        grid = cus * 1;
    }
    if (grid < 0) return;
    if (hipMemsetAsync((char*)d_ws + WS_CTL, 0, 65536, stream) != hipSuccess) { fprintf(stderr, "kernel_launch: hipMemsetAsync failed\n"); return; }
    Params p{};
    for (int i = 0; i < 22; ++i) p.in[i] = (const float*)d_in[i];
    p.out = (float*)d_out; p.ws = (unsigned char*)d_ws;
    void* args[] = {&p};
    hipError_t e = hipLaunchCooperativeKernel((const void*)fwd_kernel, dim3(grid), dim3(NTHREADS), args, LDS_BYTES, stream);
    if (e != hipSuccess) fprintf(stderr, "kernel_launch: cooperative launch failed: %s (grid %d)\n", hipGetErrorString(e), grid);
}
```

```cpp
#include <hip/hip_runtime.h>
#include <hip/hip_cooperative_groups.h>
#include <cstdio>
#include <cstdint>
namespace cg = cooperative_groups;
namespace pg8 {
#define PG8_LAS __attribute__((address_space(3)))
typedef unsigned short bf16_t;
typedef short bf16x8 __attribute__((ext_vector_type(8)));
typedef float f32x4 __attribute__((ext_vector_type(4)));
typedef unsigned u32x4 __attribute__((ext_vector_type(4)));
constexpr int BM = 256, BK = 64, HALF = 128, HTB = HALF * BK * 2  , STAGE_BYTES = 8 * HTB, NXCD = 8, WGM = 8;

__host__ __device__ __forceinline__ int lds_byte(int r, int c) { const int st = (r >> 4) * 2 + (c >> 5), rr = r & 15, cc = c & 31, ob = rr * 64 + cc * 2; return st * 1024 + (ob ^ (((ob >> 9) & 1) << 5)); }
__host__ __device__ __forceinline__ void stage_rc(int b, int& R, int& C) { const int st = b / 1024, sb = b % 1024, swz = sb ^ (((sb >> 9) & 1) << 5); R = (st >> 1) * 16 + swz / 64; C = (st & 1) * 32 + (swz % 64) / 2; }
__host__ __device__ __forceinline__ int perm32(int rho) { const int n = rho >> 4, i = rho & 15; return 8 * (i >> 2) + 4 * n + (i & 3); }

struct Unit { int pm, pn; };
struct Gemm { const bf16_t* A; const bf16_t* Bt; int M, N, K; int lda, kstepA; };

struct StaticOrder {
    int nM, nN, nwg, G, c;
    __host__ __device__ void init(int M, int N, int G_, int c_) { nM = M / BM; nN = N / BM; nwg = nM * nN; G = G_; c = c_; }
    __host__ __device__ bool next(int i, Unit& u) const {
        const long L = (long)i * G + c; if (L >= nwg) return false;
        int wgid = (int)L; { const int q = nwg / NXCD, r = nwg % NXCD, xcd = wgid % NXCD, off = wgid / NXCD; wgid = (xcd < r ? xcd * (q + 1) : r * (q + 1) + (xcd - r) * q) + off; }
        const int nig = WGM * nN, gid = wgid / nig, fm = gid * WGM, gsz = (nM - fm) < WGM ? (nM - fm) : WGM;
        u.pm = fm + ((wgid % nig) % gsz); u.pn = (wgid % nig) / gsz; return true;
    }
    __device__ __forceinline__ void a_ready(const Unit&) const {}
    __device__ __forceinline__ void done(const Unit&) const {}
    __device__ __forceinline__ const char* a_tile(const Gemm& g, const Unit& u, size_t tstepA) const { return (const char*)g.A + (size_t)u.pm * tstepA; }
    __device__ __forceinline__ const char* b_tile(const Gemm& g, const Unit& u, size_t tstepB) const { return (const char*)g.Bt + (size_t)u.pn * tstepB; }
};

__device__ __forceinline__ unsigned cvt_pk_bf16(float lo, float hi) { unsigned r; asm volatile("v_cvt_pk_bf16_f32 %0, %1, %2" : "=v"(r) : "v"(lo), "v"(hi)); return r; }
typedef float f32x2 __attribute__((ext_vector_type(2)));
__device__ __forceinline__ f32x2 gelu_pk(f32x2 v) {
    const f32x2 av = __builtin_elementwise_abs(v), d = av * 0.2316418882f + 1.0f;
    f32x2 t; t.x = __builtin_amdgcn_rcpf(d.x); t.y = __builtin_amdgcn_rcpf(d.y);
    f32x2 q = t * 0.5307027145f + (-0.7265760135f); q = q * t + 0.7107068705f; q = q * t + (-0.142248368f); q = q * t + 0.127414796f; q = q * t;
    const f32x2 s = (v * v) * (-0.72134752044f);
    f32x2 e; e.x = __builtin_amdgcn_exp2f(s.x); e.y = __builtin_amdgcn_exp2f(s.y);
    const f32x2 m = v * (q * e), r = v - m;
    f32x2 o; o.x = v.x < 0.f ? m.x : r.x; o.y = v.y < 0.f ? m.y : r.y; return o;
}

template <int ACT  > struct EpiBf16 {
    static constexpr bool PERM = true, AFTER_DRAIN = false; static_assert(ACT == 0 || ACT == 1, "EpiBf16: ACT is 0 (none) or 1 (gelu_pk)");
    bf16_t* O; int ldc; const float* bias; int split_cols; size_t split_stride; float scale0;
    __device__ __forceinline__ void operator()(const f32x4 (&acc)[2][2][4][2], const Unit& u, int wr, int wc, int fr, int fq) const {
        const int row0 = u.pm * BM + wr * 64 + fr; int colt = u.pn * BM; bf16_t* base = O;
        float sc = 1.f; if (split_cols) { const int t = colt / split_cols; base += (size_t)t * split_stride; colt -= t * split_cols; if (t == 0) sc = scale0; }
        const int col0 = colt + wc * 32 + 8 * fq, bcol0 = u.pn * BM + wc * 32 + 8 * fq;
        f32x4 bv[2][2];
#pragma unroll
        for (int bj = 0; bj < 2; ++bj)
#pragma unroll
            for (int n = 0; n < 2; ++n) bv[bj][n] = bias ? *(const f32x4*)(bias + bcol0 + bj * HALF + 4 * n) : (f32x4){0.f, 0.f, 0.f, 0.f};
#pragma unroll
        for (int ai = 0; ai < 2; ++ai)
#pragma unroll
            for (int m = 0; m < 4; ++m) { bf16_t* rowp = base + (size_t)(row0 + ai * HALF + m * 16) * ldc + col0;
#pragma unroll
                for (int bj = 0; bj < 2; ++bj) { f32x4 v0 = acc[ai][bj][m][0] + bv[bj][0], v1 = acc[ai][bj][m][1] + bv[bj][1];
                    if (ACT == 1) { f32x2 a = gelu_pk((f32x2){v0[0], v0[1]}), b = gelu_pk((f32x2){v0[2], v0[3]}), c = gelu_pk((f32x2){v1[0], v1[1]}), d = gelu_pk((f32x2){v1[2], v1[3]});
                        v0 = (f32x4){a.x, a.y, b.x, b.y}; v1 = (f32x4){c.x, c.y, d.x, d.y}; }
                    v0 = v0 * sc; v1 = v1 * sc; u32x4 w; w.x = cvt_pk_bf16(v0[0], v0[1]); w.y = cvt_pk_bf16(v0[2], v0[3]); w.z = cvt_pk_bf16(v1[0], v1[1]); w.w = cvt_pk_bf16(v1[2], v1[3]);
                    *(u32x4*)(rowp + bj * HALF) = w; } }
    }
};
template <class Epi, class Sched, bool ALIGN_EPI = false, bool SP2 = false>
__device__ __forceinline__ void gemm_phase(PG8_LAS unsigned char* lds, const Gemm g, const Sched& S, Epi& E) {
    int tid_ = threadIdx.x; asm volatile("" : "+v"(tid_));
    const int tid = tid_, wid = __builtin_amdgcn_readfirstlane(tid >> 6), lane = tid & 63, wr = wid >> 2, wc = wid & 3, fr = lane & 15, fq = lane >> 4;
    int K_ = g.K; asm volatile("" : "+s"(K_)); const int K = K_, nt = K / BK;
    const int lda = g.lda ? g.lda : K;
    unsigned voffA[2], voffB[2];
#pragma unroll
    for (int i = 0; i < 2; ++i) { int R, C; stage_rc(tid * 16 + i * 8192, R, C); const int Rb = Epi::PERM ? ((R & ~31) + perm32(R & 31)) : R;
        voffA[i] = (unsigned)(R * lda + C) * 2u; voffB[i] = (unsigned)(Rb * K + C) * 2u; }
    const size_t kstepB = (size_t)(BK * 2), kstepA = g.kstepA ? (size_t)g.kstepA : kstepB;
    const size_t hstepB = (size_t)HALF * K * 2, hstepA = (size_t)HALF * lda * 2;
    const size_t tstepB = 2 * hstepB, tstepA = 2 * hstepA;
    const unsigned ldsw = (unsigned)wid * 1024u;
    const int aoff = lds_byte(wr * 64 + fr, fq * 8), boff = lds_byte(wc * 32 + fr, fq * 8);
#define PG8_SA(b, h) (((b) * 2 + (h)) * HTB)
#define PG8_SB(b, h) ((4 + (b) * 2 + (h)) * HTB)
#define PG8_STAGE(bufoff, gbase, voff) do { _Pragma("unroll") for (int _i = 0; _i < 2; ++_i) \
        __builtin_amdgcn_global_load_lds((const unsigned*)((const char*)(gbase) + (voff)[_i]), (PG8_LAS unsigned*)(lds + (bufoff) + ldsw + _i * 8192), 16, 0, 0); } while (0)
#define PG8_LDA(dst, b, h) do { _Pragma("unroll") for (int m = 0; m < 4; ++m) _Pragma("unroll") for (int k = 0; k < 2; ++k) dst[m][k] = *(const PG8_LAS bf16x8*)(lds + PG8_SA(b, h) + aoff + m * 2048 + k * 1024); } while (0)
#define PG8_LDB(dst, b, h) do { _Pragma("unroll") for (int n = 0; n < 2; ++n) _Pragma("unroll") for (int k = 0; k < 2; ++k) dst[n][k] = *(const PG8_LAS bf16x8*)(lds + PG8_SB(b, h) + boff + n * 2048 + k * 1024); } while (0)
#define PG8_MMA(ai, bj, At, Bt) do { __builtin_amdgcn_s_setprio(1); _Pragma("unroll") for (int m = 0; m < 4; ++m) _Pragma("unroll") for (int n = 0; n < 2; ++n) _Pragma("unroll") for (int k = 0; k < 2; ++k) \
        acc[ai][bj][m][n] = __builtin_amdgcn_mfma_f32_16x16x32_bf16(Bt[n][k], At[m][k], acc[ai][bj][m][n], 0, 0, 0); __builtin_amdgcn_s_setprio(0); } while (0)
#define PG8_WAIT_V(n) asm volatile("s_waitcnt vmcnt(" #n ")" ::: "memory")
#define PG8_WAIT_L(n) asm volatile("s_waitcnt lgkmcnt(" #n ")" ::: "memory")
#define PG8_BAR __builtin_amdgcn_s_barrier()
#define PG8_SCHED __builtin_amdgcn_sched_barrier(0)
    Unit cur, nxt; int ui = 0;
    if (!S.next(0, cur)) return;
    f32x4 acc[2][2][4][2];
#pragma unroll
    for (int a = 0; a < 2; ++a)
#pragma unroll
        for (int b = 0; b < 2; ++b)
#pragma unroll
            for (int m = 0; m < 4; ++m)
#pragma unroll
                for (int n = 0; n < 2; ++n) acc[a][b][m][n] = (f32x4){0.f, 0.f, 0.f, 0.f};
    bf16x8 At[4][2], B0[2][2], B1[2][2];
    const char* cA = S.a_tile(g, cur, tstepA); const char* cB = S.b_tile(g, cur, tstepB);
    S.a_ready(cur);
    if constexpr (SP2) {
        PG8_STAGE(PG8_SB(0, 0), cB, voffB); PG8_STAGE(PG8_SB(0, 1), cB + hstepB, voffB); PG8_STAGE(PG8_SA(0, 0), cA, voffA); PG8_STAGE(PG8_SA(0, 1), cA + hstepA, voffA);
        if (wr == 1) PG8_BAR;
        PG8_WAIT_V(2); PG8_BAR;
        PG8_STAGE(PG8_SB(1, 0), cB + kstepB, voffB); PG8_STAGE(PG8_SA(1, 0), cA + kstepA, voffA); PG8_STAGE(PG8_SB(1, 1), cB + hstepB + kstepB, voffB);
        PG8_WAIT_V(6); PG8_BAR;
    } else {
        PG8_STAGE(PG8_SB(0, 0), cB, voffB); PG8_STAGE(PG8_SA(0, 0), cA, voffA); PG8_STAGE(PG8_SB(0, 1), cB + hstepB, voffB); PG8_STAGE(PG8_SA(0, 1), cA + hstepA, voffA);
        if (wr == 1) PG8_BAR;
        PG8_WAIT_V(4); PG8_BAR;
        PG8_STAGE(PG8_SB(1, 0), cB + kstepB, voffB); PG8_STAGE(PG8_SA(1, 0), cA + kstepA, voffA); PG8_STAGE(PG8_SB(1, 1), cB + hstepB + kstepB, voffB);
        PG8_WAIT_V(6); PG8_BAR;
    }
    for (;;) {
        const bool has_next = S.next(ui + 1, nxt);
        const char* nA = has_next ? S.a_tile(g, nxt, tstepA) : cA; const char* nB = has_next ? S.b_tile(g, nxt, tstepB) : cB;
        for (int t = 0; t < nt; t += 2) {
            const bool last = (t == nt - 2);
            const char* a1 = cA + (size_t)(t + 1) * kstepA;
            const char* a2 = last ? nA : cA + (size_t)(t + 2) * kstepA; const char* b2 = last ? nB : cB + (size_t)(t + 2) * kstepB;
            const char* a3 = a2 + kstepA; const char* b3 = b2 + kstepB;
            if (last && has_next) S.a_ready(nxt);
            if constexpr (SP2) {
            PG8_LDB(B0, 0, 0); PG8_LDB(B1, 0, 1); PG8_SCHED; PG8_LDA(At, 0, 0); PG8_STAGE(PG8_SA(1, 1), a1 + hstepA, voffA);
            PG8_WAIT_V(8); PG8_WAIT_L(0); PG8_BAR; PG8_MMA(0, 0, At, B0); PG8_MMA(0, 1, At, B1); PG8_BAR; PG8_SCHED;
            PG8_LDA(At, 0, 1); PG8_STAGE(PG8_SB(0, 0), b2, voffB); PG8_STAGE(PG8_SB(0, 1), b2 + hstepB, voffB); PG8_STAGE(PG8_SA(0, 0), a2, voffA);
            PG8_WAIT_V(8); PG8_WAIT_L(0); PG8_BAR; PG8_MMA(1, 0, At, B0); PG8_MMA(1, 1, At, B1); PG8_BAR; PG8_SCHED;
            PG8_LDB(B0, 1, 0); PG8_LDB(B1, 1, 1); PG8_SCHED; PG8_LDA(At, 1, 0); PG8_STAGE(PG8_SA(0, 1), a2 + hstepA, voffA);
            PG8_WAIT_V(8); PG8_WAIT_L(0); PG8_BAR; PG8_MMA(0, 0, At, B0); PG8_MMA(0, 1, At, B1); PG8_BAR; PG8_SCHED;
            PG8_LDA(At, 1, 1); PG8_STAGE(PG8_SB(1, 0), b3, voffB); PG8_STAGE(PG8_SB(1, 1), b3 + hstepB, voffB); PG8_STAGE(PG8_SA(1, 0), a3, voffA);
            PG8_WAIT_V(8); PG8_WAIT_L(0); PG8_BAR; PG8_MMA(1, 0, At, B0); PG8_MMA(1, 1, At, B1); PG8_BAR; PG8_SCHED;
            } else {
            PG8_LDB(B0, 0, 0); PG8_SCHED; PG8_LDA(At, 0, 0); PG8_STAGE(PG8_SA(1, 1), a1 + hstepA, voffA);
            PG8_WAIT_L(8); PG8_BAR; PG8_WAIT_L(0); PG8_MMA(0, 0, At, B0); PG8_BAR; PG8_SCHED;
            PG8_LDB(B1, 0, 1); PG8_STAGE(PG8_SB(0, 0), b2, voffB);
            PG8_BAR; PG8_WAIT_L(0); PG8_MMA(0, 1, At, B1); PG8_BAR;
            PG8_LDA(At, 0, 1); PG8_STAGE(PG8_SA(0, 0), a2, voffA);
            PG8_BAR; PG8_WAIT_L(0); PG8_MMA(1, 0, At, B0); PG8_BAR; PG8_SCHED;
            PG8_STAGE(PG8_SB(0, 1), b2 + hstepB, voffB);
            PG8_WAIT_V(6); PG8_BAR; PG8_MMA(1, 1, At, B1); PG8_BAR;
            PG8_LDB(B0, 1, 0); PG8_SCHED; PG8_LDA(At, 1, 0); PG8_STAGE(PG8_SA(0, 1), a2 + hstepA, voffA);
            PG8_WAIT_L(8); PG8_BAR; PG8_WAIT_L(0); PG8_MMA(0, 0, At, B0); PG8_BAR; PG8_SCHED;
            PG8_LDB(B1, 1, 1); PG8_STAGE(PG8_SB(1, 0), b3, voffB);
            PG8_BAR; PG8_WAIT_L(0); PG8_MMA(0, 1, At, B1); PG8_BAR;
            PG8_LDA(At, 1, 1); PG8_STAGE(PG8_SA(1, 0), a3, voffA);
            PG8_BAR; PG8_WAIT_L(0); PG8_MMA(1, 0, At, B0); PG8_BAR; PG8_SCHED;
            PG8_STAGE(PG8_SB(1, 1), b3 + hstepB, voffB);
            PG8_WAIT_V(6); PG8_BAR; PG8_MMA(1, 1, At, B1); PG8_BAR;
            }
        }
        if constexpr (ALIGN_EPI) { if (wr == 0) PG8_BAR; }
        if constexpr (!Epi::AFTER_DRAIN) { E(acc, cur, wr, wc, fr, fq); S.done(cur); }
        if (!has_next) break;
#pragma unroll
        for (int a = 0; a < 2; ++a)
#pragma unroll
            for (int b = 0; b < 2; ++b)
#pragma unroll
                for (int m = 0; m < 4; ++m)
#pragma unroll
                    for (int n = 0; n < 2; ++n) acc[a][b][m][n] = (f32x4){0.f, 0.f, 0.f, 0.f};
        cur = nxt; cA = nA; cB = nB; ++ui;
        if constexpr (ALIGN_EPI) { if (wr == 1) PG8_BAR; }
    }
    PG8_WAIT_V(0);
    if constexpr (!ALIGN_EPI) { if (wr == 0) PG8_BAR; }
    PG8_BAR;
    if constexpr (Epi::AFTER_DRAIN) { E.fused(acc, cur, wr, wc, fr, fq, lds, wid, lane); S.done(cur); }
#undef PG8_SA
#undef PG8_SB
#undef PG8_STAGE
#undef PG8_LDA
#undef PG8_LDB
#undef PG8_MMA
#undef PG8_WAIT_V
#undef PG8_WAIT_L
#undef PG8_BAR
#undef PG8_SCHED
}
}

constexpr int BATCH = 16, SEQ = 4096, DM = 1024, MTOK = BATCH * SEQ;
constexpr int NZ = 3584;
constexpr int ZC_MQ = 0, ZC_MK = 512, ZC_MV = 1024, ZC_MO = 1536, ZC_AQ = 2056, ZC_AKC = 2568, ZC_AVC = 2696, ZC_AKS = 2824, ZC_AVS = 2952, ZC_AKW = 3080, ZC_AVW = 3208;
constexpr int DFF = 2048, PLE = 256, NCMP = 255;
constexpr float EPS = 1e-6f;
constexpr int NWAVES = 8, NTHREADS = 512;
constexpr int LDS_BYTES = 163840;
constexpr int XBAR_LDS = 163840 - 256;

typedef unsigned short bf16_t;
typedef float f32x4 __attribute__((ext_vector_type(4)));
typedef unsigned u32x4 __attribute__((ext_vector_type(4)));
typedef unsigned u32x2 __attribute__((ext_vector_type(2)));

constexpr size_t MiB = 1u << 20;
constexpr size_t WS_CTL = 0;
constexpr size_t WS_WIN = 1 * MiB, WS_WOUT = 8 * MiB, WS_WUP = 10 * MiB, WS_WDN = 18 * MiB, WS_WPG = 22 * MiB, WS_WPP = 24 * MiB;
constexpr size_t WS_W1T = 25 * MiB, WS_W2T = 26 * MiB, WS_C1 = WS_CTL + 32768, WS_KCB = 29 * MiB, WS_VCT = 30 * MiB;
constexpr size_t WS_GATES = 32 * MiB, WS_PB = 40 * MiB, WS_XB = 72 * MiB;
constexpr size_t WS_MIX = 200 * MiB, WS_ACT = 200 * MiB;
constexpr size_t WS_Z = 456 * MiB, WS_U = 456 * MiB, WS_PROJ = 456 * MiB;
constexpr size_t WS_RS2 = 968 * MiB, WS_RS3 = 972 * MiB;
constexpr size_t WS_RSTD2 = 31 * MiB, WS_RSTD3 = 31 * MiB + 512 * 1024;
constexpr size_t WS_VST = 976 * MiB, WS_VWT = 992 * MiB;
constexpr size_t WS_END = 1008 * MiB;

struct Params { const float* in[22]; float* out; unsigned char* ws; };

__device__ __forceinline__ float bf2f(unsigned u16) { return __uint_as_float(u16 << 16); }
__device__ __forceinline__ float bflo(unsigned w) { return __uint_as_float(w << 16); }
__device__ __forceinline__ float bfhi(unsigned w) { return __uint_as_float(w & 0xffff0000u); }
__device__ __forceinline__ unsigned f2bf(float f) { unsigned u = __float_as_uint(f); return (u + 0x7fffu + ((u >> 16) & 1u)) >> 16; }
__device__ __forceinline__ unsigned pk2(float lo, float hi) { return f2bf(lo) | (f2bf(hi) << 16); }
__device__ __forceinline__ float wave_sum(float v) {
#pragma unroll
    for (int o = 1; o < 64; o <<= 1) v += __shfl_xor(v, o);
    return v;
}
__device__ __forceinline__ float wave_max(float v) {
#pragma unroll
    for (int o = 1; o < 64; o <<= 1) v = fmaxf(v, __shfl_xor(v, o));
    return v;
}
__device__ __forceinline__ float sigmoidf_(float x) { return __builtin_amdgcn_rcpf(1.0f + __expf(-x)); }
__device__ __forceinline__ float log_sigmoidf_(float x) { return fminf(x, 0.f) - __logf(1.0f + __expf(-fabsf(x))); }
#define WAVE_LDS_SYNC() asm volatile("s_waitcnt lgkmcnt(0)" ::: "memory")

namespace pg8 {
__device__ __forceinline__ float row_rstd(const float* rs, int row) {
    const f32x4* p = (const f32x4*)(rs + (size_t)row * 16); const f32x4 a = p[0], b = p[1], c = p[2], d = p[3];
    const float s = (((a[0] + a[1]) + (a[2] + a[3])) + ((b[0] + b[1]) + (b[2] + b[3]))) + (((c[0] + c[1]) + (c[2] + c[3])) + ((d[0] + d[1]) + (d[2] + d[3])));
    return 1.0f / sqrtf(s * (1.0f / 1024.0f) + EPS);
}
struct EpiZ {
    static constexpr bool PERM = true, AFTER_DRAIN = false;
    bf16_t* Z; float* gates;
    __device__ __forceinline__ void operator()(const f32x4 (&acc)[2][2][4][2], const Unit& u, int wr, int wc, int fr, int fq) {
        const int row0 = u.pm * BM + wr * 64 + fr; const int col0 = u.pn * BM + wc * 32 + 8 * fq;
#pragma unroll
        for (int ai = 0; ai < 2; ++ai)
#pragma unroll
            for (int m = 0; m < 4; ++m) { const int row = row0 + ai * HALF + m * 16; bf16_t* rowp = Z + (size_t)row * NZ + col0;
#pragma unroll
                for (int bj = 0; bj < 2; ++bj) { const f32x4 v0 = acc[ai][bj][m][0], v1 = acc[ai][bj][m][1];
                    u32x4 w; w.x = cvt_pk_bf16(v0[0], v0[1]); w.y = cvt_pk_bf16(v0[2], v0[3]); w.z = cvt_pk_bf16(v1[0], v1[1]); w.w = cvt_pk_bf16(v1[2], v1[3]);
                    *(u32x4*)(rowp + bj * HALF) = w; }
                if (wc == 0) {
                    if ((u.pn == 8 && fq == 0) || (u.pn == 13 && fq >= 1)) {
                        float* gp = gates + (size_t)row * 32 + 8 * fq;
                        *(f32x4*)(gp) = acc[ai][0][m][0]; *(f32x4*)(gp + 4) = acc[ai][0][m][1];
                    }
                }
            }
    }
};
template <bool ROWSCALE> struct EpiBf {
    static constexpr bool PERM = true, AFTER_DRAIN = false;
    bf16_t* O; int ldc; const float* rs;
    __device__ __forceinline__ void operator()(const f32x4 (&acc)[2][2][4][2], const Unit& u, int wr, int wc, int fr, int fq) {
        const int row0 = u.pm * BM + wr * 64 + fr; const int col0 = u.pn * BM + wc * 32 + 8 * fq;
#pragma unroll
        for (int ai = 0; ai < 2; ++ai)
#pragma unroll
            for (int m = 0; m < 4; ++m) { const int row = row0 + ai * HALF + m * 16; bf16_t* rowp = O + (size_t)row * ldc + col0;
                float sc = 1.f;
                if (ROWSCALE) sc = row_rstd(rs, row);
#pragma unroll
                for (int bj = 0; bj < 2; ++bj) { const f32x4 v0 = acc[ai][bj][m][0] * sc, v1 = acc[ai][bj][m][1] * sc;
                    u32x4 w; w.x = cvt_pk_bf16(v0[0], v0[1]); w.y = cvt_pk_bf16(v0[2], v0[3]); w.z = cvt_pk_bf16(v1[0], v1[1]); w.w = cvt_pk_bf16(v1[2], v1[3]);
                    *(u32x4*)(rowp + bj * HALF) = w; }
            }
    }
};
template <bool BASE_F32> struct EpiRes {
    static constexpr bool PERM = true, AFTER_DRAIN = false;
    const float* basef; const bf16_t* baseb; bf16_t* xb; float* rs;
    __device__ __forceinline__ void operator()(const f32x4 (&acc)[2][2][4][2], const Unit& u, int wr, int wc, int fr, int fq) const {
        const int row0 = u.pm * BM + wr * 64 + fr, col0 = u.pn * BM + wc * 32 + 8 * fq;
#pragma unroll
        for (int ai = 0; ai < 2; ++ai)
#pragma unroll
            for (int m = 0; m < 4; ++m) { const int row = row0 + ai * HALF + m * 16; const size_t off = (size_t)row * DM + col0; float s = 0.f;
#pragma unroll
                for (int bj = 0; bj < 2; ++bj) { f32x4 b0, b1;
                    if (BASE_F32) { b0 = *(const f32x4*)(basef + off + bj * HALF); b1 = *(const f32x4*)(basef + off + bj * HALF + 4); }
                    else { const u32x4 w = *(const u32x4*)(baseb + off + bj * HALF); b0 = (f32x4){bflo(w.x), bfhi(w.x), bflo(w.y), bfhi(w.y)}; b1 = (f32x4){bflo(w.z), bfhi(w.z), bflo(w.w), bfhi(w.w)}; }
                    const f32x4 o0 = b0 + acc[ai][bj][m][0], o1 = b1 + acc[ai][bj][m][1];
                    u32x4 w; w.x = cvt_pk_bf16(o0[0], o0[1]); w.y = cvt_pk_bf16(o0[2], o0[3]); w.z = cvt_pk_bf16(o1[0], o1[1]); w.w = cvt_pk_bf16(o1[2], o1[3]);
                    *(u32x4*)(xb + off + bj * HALF) = w;
                    s += ((o0[0] * o0[0] + o0[1] * o0[1]) + (o0[2] * o0[2] + o0[3] * o0[3])) + ((o1[0] * o1[0] + o1[1] * o1[1]) + (o1[2] * o1[2] + o1[3] * o1[3])); }
                s += __shfl_xor(s, 16); s += __shfl_xor(s, 32);
                if (fq == 0) rs[(size_t)row * 16 + u.pn * 4 + wc] = s; }
    }
};
struct EpiPle {
    static constexpr bool PERM = true, AFTER_DRAIN = false;
    const bf16_t* x2b; const bf16_t* proj; const float* rstd; bf16_t* x3b; float* rs;
    __device__ __forceinline__ void operator()(const f32x4 (&acc)[2][2][4][2], const Unit& u, int wr, int wc, int fr, int fq) const {
        const int row0 = u.pm * BM + wr * 64 + fr, col0 = u.pn * BM + wc * 32 + 8 * fq;
#pragma unroll
        for (int ai = 0; ai < 2; ++ai)
#pragma unroll
            for (int m = 0; m < 4; ++m) { const int row = row0 + ai * HALF + m * 16; const size_t off = (size_t)row * DM + col0; float s = 0.f;
                const float sc = rstd[row];
#pragma unroll
                for (int bj = 0; bj < 2; ++bj) { const u32x4 xw = *(const u32x4*)(x2b + off + bj * HALF), pw = *(const u32x4*)(proj + off + bj * HALF);
                    const f32x4 a0 = acc[ai][bj][m][0] * sc, a1 = acc[ai][bj][m][1] * sc; f32x4 o0, o1;
                    o0[0] = bflo(xw.x) + sigmoidf_(a0[0]) * bflo(pw.x); o0[1] = bfhi(xw.x) + sigmoidf_(a0[1]) * bfhi(pw.x); o0[2] = bflo(xw.y) + sigmoidf_(a0[2]) * bflo(pw.y); o0[3] = bfhi(xw.y) + sigmoidf_(a0[3]) * bfhi(pw.y);
                    o1[0] = bflo(xw.z) + sigmoidf_(a1[0]) * bflo(pw.z); o1[1] = bfhi(xw.z) + sigmoidf_(a1[1]) * bfhi(pw.z); o1[2] = bflo(xw.w) + sigmoidf_(a1[2]) * bflo(pw.w); o1[3] = bfhi(xw.w) + sigmoidf_(a1[3]) * bfhi(pw.w);
                    u32x4 w; w.x = cvt_pk_bf16(o0[0], o0[1]); w.y = cvt_pk_bf16(o0[2], o0[3]); w.z = cvt_pk_bf16(o1[0], o1[1]); w.w = cvt_pk_bf16(o1[2], o1[3]);
                    *(u32x4*)(x3b + off + bj * HALF) = w;
                    s += ((o0[0] * o0[0] + o0[1] * o0[1]) + (o0[2] * o0[2] + o0[3] * o0[3])) + ((o1[0] * o1[0] + o1[1] * o1[1]) + (o1[2] * o1[2] + o1[3] * o1[3])); }
                s += __shfl_xor(s, 16); s += __shfl_xor(s, 32);
                if (fq == 0) rs[(size_t)row * 16 + u.pn * 4 + wc] = s; }
    }
};
struct PanelOrder {
    int nM, G, c, nN = 4;
    __host__ __device__ void init(int M, int G_, int c_, int nN_ = 4) { nM = M / BM; G = G_; c = c_; nN = nN_; }
    __host__ __device__ bool next(int i, Unit& u) const { const int p = c + G * (i / nN); if (p >= nM) return false; u.pm = p; u.pn = i % nN; return true; }
    __device__ __forceinline__ void a_ready(const Unit&) const {}
    __device__ __forceinline__ void done(const Unit&) const {}
    __device__ __forceinline__ const char* a_tile(const Gemm& g, const Unit& u, size_t tstepA) const { return (const char*)g.A + (size_t)u.pm * tstepA; }
    __device__ __forceinline__ const char* b_tile(const Gemm& g, const Unit& u, size_t tstepB) const { return (const char*)g.Bt + (size_t)u.pn * tstepB; }
};
struct ChainOrder {
    int c;
    __host__ __device__ bool next(int i, Unit& u) const { if (i >= 16) return false; u.pm = (c >> 4) * 16 + i; u.pn = c & 15; return true; }
    __device__ __forceinline__ void a_ready(const Unit&) const {}
    __device__ __forceinline__ void done(const Unit&) const {}
    __device__ __forceinline__ const char* a_tile(const Gemm& g, const Unit& u, size_t tstepA) const { return (const char*)g.A + (size_t)u.pm * tstepA; }
    __device__ __forceinline__ const char* b_tile(const Gemm& g, const Unit& u, size_t tstepB) const { return (const char*)g.Bt + (size_t)u.pn * tstepB; }
};
__device__ __forceinline__ float dpp_ror1(float v) { return __builtin_bit_cast(float, __builtin_amdgcn_update_dpp(0, __builtin_bit_cast(int, v), 0x121, 0xf, 0xf, false)); }
__device__ __forceinline__ float dpp_ror2(float v) { return __builtin_bit_cast(float, __builtin_amdgcn_update_dpp(0, __builtin_bit_cast(int, v), 0x122, 0xf, 0xf, false)); }
struct EpiUpConv {
    static constexpr bool PERM = true, AFTER_DRAIN = false;
    bf16_t* ACT; const float* rs; const float* cw; const float* cb; PG8_LAS float* car;
    __device__ __forceinline__ void operator()(f32x4 (&acc)[2][2][4][2], const Unit& u, int wr, int wc, int fr, int fq) const {
        const int par = u.pm & 1; const bool first = (u.pm & 15) == 0;
        const int colg = 32 * wc + 8 * fq, gc = 128 * u.pn + colg;
#pragma unroll
        for (int ai = 0; ai < 2; ++ai)
#pragma unroll
            for (int m = 0; m < 4; ++m) { const float sc = rs[u.pm * BM + ai * HALF + wr * 64 + m * 16 + fr];
#pragma unroll
                for (int n = 0; n < 2; ++n) { acc[ai][0][m][n] *= sc; acc[ai][1][m][n] *= sc; } }
        if (fr >= 14) {
#pragma unroll
            for (int ai = 0; ai < 2; ++ai)
#pragma unroll
                for (int n = 0; n < 2; ++n) *(PG8_LAS f32x4*)(car + ((par * 4 + 2 * ai + wr) * 2 + (fr - 14)) * 128 + colg + 4 * n) = acc[ai][0][3][n]; }
        asm volatile("s_waitcnt lgkmcnt(0)" ::: "memory"); __builtin_amdgcn_s_barrier(); asm volatile("" ::: "memory");
#pragma unroll
        for (int ai = 0; ai < 2; ++ai) { const int sl = 2 * ai + wr;
            const PG8_LAS float* src = (sl == 0) ? car + ((par ^ 1) * 4 + 3) * 256 : car + (par * 4 + sl - 1) * 256;
            const bool zero_in = first && sl == 0;
#pragma unroll
            for (int n = 0; n < 2; ++n) {
                asm volatile("" ::: "memory");
                f32x4 c2 = *(const PG8_LAS f32x4*)(src + colg + 4 * n), c1 = *(const PG8_LAS f32x4*)(src + 128 + colg + 4 * n);
                if (zero_in) { c2 = (f32x4){0.f, 0.f, 0.f, 0.f}; c1 = c2; }
                const f32x4 w0 = *(const f32x4*)(cw + gc + 4 * n), w1 = *(const f32x4*)(cw + DFF + gc + 4 * n), w2 = *(const f32x4*)(cw + 2 * DFF + gc + 4 * n), bb = *(const f32x4*)(cb + gc + 4 * n);
#pragma unroll
                for (int e = 0; e < 4; ++e) { float tm1 = c1[e], tm2 = (fr == 1) ? c1[e] : c2[e];
#pragma unroll
                    for (int m = 0; m < 4; ++m) { const float x = acc[ai][0][m][n][e]; const float t1 = dpp_ror1(x), t2 = dpp_ror2(x);
                        const float p1 = fr >= 1 ? t1 : tm1, p2 = fr >= 2 ? t2 : tm2;
                        const float cv = w0[e] * p2 + w1[e] * p1 + w2[e] * x + bb[e];
                        acc[ai][1][m][n][e] = cv * __builtin_amdgcn_rcpf(1.0f + __expf(-cv)) * acc[ai][1][m][n][e];
                        tm1 = t1; tm2 = t2; } } }
#pragma unroll
            for (int m = 0; m < 4; ++m) { const int row = u.pm * BM + ai * HALF + wr * 64 + m * 16 + fr; const f32x4 v0 = acc[ai][1][m][0], v1 = acc[ai][1][m][1];
                u32x4 w; w.x = cvt_pk_bf16(v0[0], v0[1]); w.y = cvt_pk_bf16(v0[2], v0[3]); w.z = cvt_pk_bf16(v1[0], v1[1]); w.w = cvt_pk_bf16(v1[2], v1[3]);
                *(u32x4*)(ACT + (size_t)row * DFF + gc) = w; } }
    }
};
struct CmpOrder {
    int c; const bf16_t* Z; const bf16_t* w1t;
    __host__ __device__ bool next(int i, Unit& u) const { if (i > 0 || c >= 64) return false; u.pm = c; u.pn = 0; return true; }
    __device__ __forceinline__ void a_ready(const Unit&) const {}
    __device__ __forceinline__ void done(const Unit&) const {}
    __device__ __forceinline__ const char* a_tile(const Gemm&, const Unit& u, size_t) const { const int kv = u.pm >> 5, b = (u.pm >> 1) & 15, gg = u.pm & 1; return (const char*)(Z + (size_t)b * SEQ * NZ + (kv ? ZC_AVC : ZC_AKC) + gg * 64); }
    __device__ __forceinline__ const char* b_tile(const Gemm&, const Unit& u, size_t) const { return (const char*)(w1t + (size_t)(u.pm >> 5) * 256 * 1024); }
};
struct EpiCmp {
    static constexpr bool PERM = false, AFTER_DRAIN = true;
    const float* c1; const bf16_t* w2t; bf16_t* kcb; bf16_t* vct;
    __device__ __forceinline__ void fused(f32x4 (&acc)[2][2][4][2], const Unit& u, int wr, int wc, int fr, int fq, PG8_LAS unsigned char* lds, int wid, int lane) const {
        const int kv = u.pm >> 5, bgi = u.pm & 31;
        const int cc0 = 32 * wc + 4 * fq;
#pragma unroll
        for (int ai = 0; ai < 2; ++ai)
#pragma unroll
            for (int m = 0; m < 4; ++m) { const int r = 128 * ai + 64 * wr + 16 * m + fr;
#pragma unroll
                for (int n = 0; n < 2; ++n) *(PG8_LAS f32x4*)(lds + (r * 128 + cc0 + 16 * n) * 4) = acc[ai][1][m][n]; }
        asm volatile("s_waitcnt lgkmcnt(0)" ::: "memory"); __builtin_amdgcn_s_barrier(); asm volatile("" ::: "memory");
#pragma unroll
        for (int ai = 0; ai < 2; ++ai)
#pragma unroll
            for (int m = 0; m < 4; ++m) { const int r = 128 * ai + 64 * wr + 16 * m + fr; const int rr = r < 255 ? r + 1 : 255;
#pragma unroll
                for (int n = 0; n < 2; ++n) { const f32x4 rv = *(const PG8_LAS f32x4*)(lds + (rr * 128 + cc0 + 16 * n) * 4); const f32x4 bv = *(const f32x4*)(c1 + kv * 128 + cc0 + 16 * n);
                    f32x4 x = acc[ai][0][m][n] + rv + bv;
#pragma unroll
                    for (int e = 0; e < 4; ++e) { const float y = 1.5957691216057308f * (x[e] + 0.044715f * x[e] * x[e] * x[e]); x[e] = x[e] * __builtin_amdgcn_rcpf(1.0f + __expf(-y)); }
                    acc[ai][0][m][n] = x; } }
        asm volatile("s_waitcnt lgkmcnt(0)" ::: "memory"); __builtin_amdgcn_s_barrier(); asm volatile("" ::: "memory");
#pragma unroll
        for (int ai = 0; ai < 2; ++ai)
#pragma unroll
            for (int m = 0; m < 4; ++m) { const int r = 128 * ai + 64 * wr + 16 * m + fr;
#pragma unroll
                for (int n = 0; n < 2; ++n) { const f32x4 x = acc[ai][0][m][n]; u32x2 w; w.x = cvt_pk_bf16(x[0], x[1]); w.y = cvt_pk_bf16(x[2], x[3]); *(PG8_LAS u32x2*)(lds + r * 272 + (cc0 + 16 * n) * 2) = w; } }
        { const int t = wid * 64 + lane, d = t >> 3, ch = t & 7; const u32x4* src = (const u32x4*)(w2t + (size_t)kv * 64 * 128 + d * 128 + ch * 16);
          *(PG8_LAS u32x4*)(lds + 69632 + d * 272 + ch * 32) = src[0]; *(PG8_LAS u32x4*)(lds + 69632 + d * 272 + ch * 32 + 16) = src[1]; }
        asm volatile("s_waitcnt vmcnt(0) lgkmcnt(0)" ::: "memory"); __builtin_amdgcn_s_barrier(); asm volatile("" ::: "memory");
        typedef float f32x16_ __attribute__((ext_vector_type(16)));
        const int tq = lane & 31, hi = lane >> 5;
        f32x16_ O0, O1;
#pragma unroll
        for (int i = 0; i < 16; ++i) { O0[i] = 0.f; O1[i] = 0.f; }
#pragma unroll
        for (int kk = 0; kk < 8; ++kk) { const bf16x8 a = *(const PG8_LAS bf16x8*)(lds + (32 * wid + tq) * 272 + (16 * kk + 8 * hi) * 2);
            const bf16x8 b0 = *(const PG8_LAS bf16x8*)(lds + 69632 + tq * 272 + (16 * kk + 8 * hi) * 2), b1 = *(const PG8_LAS bf16x8*)(lds + 69632 + (32 + tq) * 272 + (16 * kk + 8 * hi) * 2);
            O0 = __builtin_amdgcn_mfma_f32_32x32x16_bf16(a, b0, O0, 0, 0, 0); O1 = __builtin_amdgcn_mfma_f32_32x32x16_bf16(a, b1, O1, 0, 0, 0); }
#pragma unroll
        for (int i = 0; i < 16; ++i) { const int nrow = 32 * wid + (i & 3) + 8 * (i >> 2) + 4 * hi; const bool ok = nrow < NCMP;
            const unsigned v0 = ok ? (cvt_pk_bf16(O0[i], 0.f) & 0xffffu) : 0u, v1 = ok ? (cvt_pk_bf16(O1[i], 0.f) & 0xffffu) : 0u;
            if (kv == 0) { bf16_t* p = kcb + ((size_t)bgi * 256 + nrow) * 64 + tq; p[0] = (bf16_t)v0; p[32] = (bf16_t)v1; }
            else { const int n16 = nrow & 15; const int np = (nrow & ~15) + 8 * ((n16 >> 2) & 1) + (n16 & 3) + 4 * (n16 >> 3); bf16_t* p = vct + ((size_t)bgi * 64 + tq) * 256 + np; p[0] = (bf16_t)v0; p[32 * 256] = (bf16_t)v1; } }
    }
};
}

template <bool UPMAP = false>
__device__ __forceinline__ void p0_transpose_item(const float* W, const float* gk, int K, int N, bf16_t* WT, float* scr, int item, int lane) {
    const int nblk = N / 32, kb = item / nblk, nb = item % nblk, k0 = 64 * kb, n0 = 32 * nb;
    const int r0 = UPMAP ? (((n0 & 2047) >> 7) * 256 + (n0 >> 11) * 128 + (n0 & 127)) : n0;
#pragma unroll 8
    for (int i = 0; i < 32; ++i) { const int kk = 2 * i + (lane >> 5); float w = W[(size_t)(k0 + kk) * N + n0 + (lane & 31)]; if (gk) w *= gk[k0 + kk]; scr[kk * 33 + (lane & 31)] = w; }
    WAVE_LDS_SYNC();
    const int c = lane & 7;
#pragma unroll
    for (int j = 0; j < 4; ++j) { const int n = (lane >> 3) + 8 * j; const float* s = scr + (8 * c) * 33 + n;
        u32x4 o; o.x = pk2(s[0 * 33], s[1 * 33]); o.y = pk2(s[2 * 33], s[3 * 33]); o.z = pk2(s[4 * 33], s[5 * 33]); o.w = pk2(s[6 * 33], s[7 * 33]);
        *(u32x4*)(WT + (size_t)(r0 + n) * K + k0 + 8 * c) = o; }
    WAVE_LDS_SYNC();
}

#define LAS3 __attribute__((address_space(3)))
typedef short bf16x8 __attribute__((ext_vector_type(8)));
typedef float f32x16 __attribute__((ext_vector_type(16)));
typedef float f32x2_t __attribute__((ext_vector_type(2)));
typedef __bf16 bf16x2_t __attribute__((ext_vector_type(2)));
__device__ __forceinline__ unsigned cvtpk(float lo, float hi) { f32x2_t v = {lo, hi}; bf16x2_t b = __builtin_convertvector(v, bf16x2_t); return __builtin_bit_cast(unsigned, b); }
#define MFMA32(a, b, c) __builtin_amdgcn_mfma_f32_32x32x16_bf16((a), (b), (c), 0, 0, 0)
__device__ __forceinline__ bf16x8 pack8(const f32x16& x, int s) {
    u32x4 p; p.x = cvtpk(x[8 * s], x[8 * s + 1]); p.y = cvtpk(x[8 * s + 2], x[8 * s + 3]); p.z = cvtpk(x[8 * s + 4], x[8 * s + 5]); p.w = cvtpk(x[8 * s + 6], x[8 * s + 7]);
    return __builtin_bit_cast(bf16x8, p);
}
#define NEG_INF (-__builtin_inff())
constexpr float LOG2E = 1.4426950408889634f;
__device__ __forceinline__ unsigned other_half_u(unsigned v, int hi) { auto rr = __builtin_amdgcn_permlane32_swap(v, v, false, false); return hi ? rr[0] : rr[1]; }
__device__ __forceinline__ float other_half_f(float v, int hi) { return __uint_as_float(other_half_u(__float_as_uint(v), hi)); }
__device__ __forceinline__ float max16(const f32x16& u) {
    float a = fmaxf(fmaxf(u[0], u[1]), fmaxf(u[2], u[3])), b = fmaxf(fmaxf(u[4], u[5]), fmaxf(u[6], u[7]));
    float c = fmaxf(fmaxf(u[8], u[9]), fmaxf(u[10], u[11])), d = fmaxf(fmaxf(u[12], u[13]), fmaxf(u[14], u[15]));
    return fmaxf(fmaxf(a, b), fmaxf(c, d));
}
__device__ __forceinline__ unsigned long long spread_even(unsigned x) {
    unsigned long long s = x;
    s = (s | (s << 16)) & 0x0000FFFF0000FFFFull; s = (s | (s << 8)) & 0x00FF00FF00FF00FFull; s = (s | (s << 4)) & 0x0F0F0F0F0F0F0F0Full;
    s = (s | (s << 2)) & 0x3333333333333333ull; s = (s | (s << 1)) & 0x5555555555555555ull; return s;
}
struct NsaF { const bf16_t* Z; const float* gates; const bf16_t* KCB; const bf16_t* VCT; const bf16_t* VST; const bf16_t* VWT; bf16_t* MIX; };

__device__ __forceinline__ void nsa_load_q(bf16x8 (&qf)[4], const bf16_t* qp) {
    const float QSC = 0.125f * LOG2E;
#pragma unroll
    for (int s = 0; s < 4; ++s) { const u32x4 w = *(const u32x4*)(qp + 16 * s); u32x4 o;
        o.x = cvtpk(bflo(w.x) * QSC, bfhi(w.x) * QSC); o.y = cvtpk(bflo(w.y) * QSC, bfhi(w.y) * QSC); o.z = cvtpk(bflo(w.z) * QSC, bfhi(w.z) * QSC); o.w = cvtpk(bflo(w.w) * QSC, bfhi(w.w) * QSC);
        qf[s] = __builtin_bit_cast(bf16x8, o); }
}
__device__ __forceinline__ f32x16 nsa_st(const bf16_t* kp, const bf16x8 (&qf)[4], const f32x16& cinit) {
    f32x16 acc = MFMA32(*(const bf16x8*)(kp), qf[0], cinit);
    acc = MFMA32(*(const bf16x8*)(kp + 16), qf[1], acc); acc = MFMA32(*(const bf16x8*)(kp + 32), qf[2], acc); acc = MFMA32(*(const bf16x8*)(kp + 48), qf[3], acc);
    return acc;
}
struct NsaK { bf16x8 k[4]; };
struct NsaV { bf16x8 v0[2]; bf16x8 v1[2]; };
__device__ __forceinline__ void nsa_ldk(NsaK& R, const bf16_t* ku, unsigned ko) {
    R.k[0] = *(const bf16x8*)(ku + ko); R.k[1] = *(const bf16x8*)(ku + ko + 16); R.k[2] = *(const bf16x8*)(ku + ko + 32); R.k[3] = *(const bf16x8*)(ku + ko + 48);
}
__device__ __forceinline__ void nsa_ldv(NsaV& R, const bf16_t* vu, const bf16_t* vu2, unsigned vo) {
    R.v0[0] = *(const bf16x8*)(vu + vo); R.v0[1] = *(const bf16x8*)(vu + vo + 16); R.v1[0] = *(const bf16x8*)(vu2 + vo); R.v1[1] = *(const bf16x8*)(vu2 + vo + 16);
}
__device__ __forceinline__ f32x16 nsa_st_r(const NsaK& R, const bf16x8 (&qf)[4], const f32x16& cinit) {
    f32x16 acc = MFMA32(R.k[0], qf[0], cinit); acc = MFMA32(R.k[1], qf[1], acc); acc = MFMA32(R.k[2], qf[2], acc); acc = MFMA32(R.k[3], qf[3], acc); return acc;
}
__device__ __forceinline__ void nsa_soft_pv(f32x16& u, float tb, float& M, float& l, f32x16& O0, f32x16& O1, const NsaV& R, int hi) {
    float tm = max16(u); tm = fmaxf(tm, other_half_f(tm, hi));
    const float cand = tm + tb;
    if (__any(cand > M)) { const float mn = fmaxf(M, cand); const float al = __builtin_amdgcn_exp2f(M - mn); l *= al; O0 *= al; O1 *= al; M = mn; }
    const float ms = M - tb; float sum = 0.f;
#pragma unroll
    for (int i = 0; i < 16; ++i) { const float p = __builtin_amdgcn_exp2f(u[i] - ms); u[i] = p; sum += p; }
    l += sum;
    u32x4 a, b2;
    a.x = cvtpk(u[0], u[1]); a.y = cvtpk(u[2], u[3]); a.z = cvtpk(u[4], u[5]); a.w = cvtpk(u[6], u[7]);
    b2.x = cvtpk(u[8], u[9]); b2.y = cvtpk(u[10], u[11]); b2.z = cvtpk(u[12], u[13]); b2.w = cvtpk(u[14], u[15]);
    const bf16x8 p0 = __builtin_bit_cast(bf16x8, a), p1 = __builtin_bit_cast(bf16x8, b2);
    O0 = MFMA32(R.v0[0], p0, O0); O0 = MFMA32(R.v0[1], p1, O0);
    O1 = MFMA32(R.v1[0], p0, O1); O1 = MFMA32(R.v1[1], p1, O1);
}
__device__ __forceinline__ void nsa_mask_lt(f32x16& u, int limh) {
    asm volatile("" : "+v"(limh));
#pragma unroll
    for (int i = 0; i < 16; ++i) { const int c = (i & 3) + 8 * (i >> 2); if (!(c < limh)) u[i] = NEG_INF; }
}
__device__ __forceinline__ void nsa_mask_gt(f32x16& u, int limh) {
    asm volatile("" : "+v"(limh));
#pragma unroll
    for (int i = 0; i < 16; ++i) { const int c = (i & 3) + 8 * (i >> 2); if (!(c > limh)) u[i] = NEG_INF; }
}

__device__ __forceinline__ void vt_unit(const bf16_t* Z, int zcol, bf16_t* VT, int b, int g, int ch, unsigned short* tile  , int tid) {
    { const int pos = tid >> 3, c8 = (tid & 7) * 8;
      const u32x4 w = *(const u32x4*)(Z + ((size_t)b * SEQ + ch * 64 + pos) * NZ + zcol + g * 64 + c8);
      *(u32x4*)(tile + pos * 72 + c8) = w; }
    __syncthreads();
    { const int d = tid >> 3, chunk = tid & 7, gi = chunk >> 1, h = chunk & 1; unsigned short e[8];
#pragma unroll
      for (int j = 0; j < 8; ++j) { const int pos = 16 * gi + 8 * (j >> 2) + 4 * h + (j & 3); e[j] = tile[pos * 72 + d]; }
      u32x4 o; o.x = e[0] | ((unsigned)e[1] << 16); o.y = e[2] | ((unsigned)e[3] << 16); o.z = e[4] | ((unsigned)e[5] << 16); o.w = e[6] | ((unsigned)e[7] << 16);
      *(u32x4*)(VT + (((size_t)b * 2 + g) * 64 + d) * SEQ + ch * 64 + chunk * 8) = o; }
    __syncthreads();
}

constexpr int NC_KC = 0, NC_RING = 32768, NC_IMP = 81920, NC_LIST = 147456, NC_UEX = 148480, NC_QSLOT = 148512;
#define NC_WAITBAR(N) asm volatile("s_waitcnt vmcnt(" #N ") lgkmcnt(0)\n\ts_barrier" ::: "memory")

__device__ __forceinline__ void nsa_unit_coop(const NsaF& P, int b, int g, int tp, LAS3 unsigned char* L, int tid, const int dry = 0) {
    if (dry & 2048) return;
    const int lane = tid & 63, wave = __builtin_amdgcn_readfirstlane(tid >> 6), tbsel = wave >> 2, r = wave & 3, tq = lane & 31, hi = lane >> 5;
    const int tb = 2 * tp + tbsel, t0 = 32 * tb, t0u = 64 * tp, cur = tp, hh = g * 4 + r;
    const size_t rowq = (size_t)b * SEQ + t0 + tq;
    const size_t bg = (size_t)b * 2 + g;
    const int nval = max(0, 2 * tb + 1 - (tq < 31 ? 1 : 0) - (tq < 15 ? 1 : 0));
    const int ntc = (2 * tb + 1 + 31) >> 5, ntc_u = (2 * (2 * tp + 1) + 1 + 31) >> 5;
    const int tqh = tq - 4 * hi;
    const float hif = (float)(4 * hi);
    const float slope2 = __builtin_amdgcn_exp2f(-(float)(hh + 1)) * LOG2E;
    bf16x8 qf[4]; if (!(dry & 1024)) nsa_load_q(qf, P.Z + rowq * NZ + ZC_AQ + hh * 64 + 8 * hi); else { qf[0] = qf[1] = qf[2] = qf[3] = (bf16x8){0, 0, 0, 0, 0, 0, 0, 0}; }
    const float* gp = (dry & 1024) ? P.gates : P.gates + rowq * 32 + 8 + hh * 3;
    const float gt0 = sigmoidf_(gp[0]), gt1 = sigmoidf_(gp[1]), gt2 = sigmoidf_(gp[2]);
    asm volatile("s_waitcnt vmcnt(0)" ::: "memory");
    if (dry & 16384) return;
    const int ks = wave & 3, vdt = (wave & 3) >> 1, vs = wave & 1;
    const bool isK = wave < 4;
    const bf16_t* srcC = isK ? P.KCB + (bg * 256 + tq) * 64 + 16 * ks + 8 * hi : P.VCT + (bg * 64 + 32 * vdt + tq) * 256 + 16 * vs + 8 * hi;
    const bf16_t* srcW = isK ? P.Z + ((size_t)b * SEQ + tq) * NZ + ZC_AKW + g * 64 + 16 * ks + 8 * hi : P.VWT + (bg * 64 + 32 * vdt + tq) * SEQ + 16 * vs + 8 * hi;
    const bf16_t* srcS = isK ? P.Z + ((size_t)b * SEQ + tq) * NZ + ZC_AKS + g * 64 + 16 * ks + 8 * hi : P.VST + (bg * 64 + 32 * vdt + tq) * SEQ + 16 * vs + 8 * hi;
    const size_t stepC = isK ? 32 * 64 : 32, stepP = isK ? (size_t)NZ : 1;
    volatile LAS3 int* list = (volatile LAS3 int*)(L + NC_LIST);
#define NC_DMA_E(i, ent) do { const int e_ = (ent); const int tag_ = (e_ >> 16) & 3, val_ = ((e_ & 0xffff) == 0xffff) ? 0 : (e_ & 0xffff); \
        const bf16_t* s_ = (tag_ == 0) ? srcC + (size_t)val_ * stepC : ((tag_ == 1) ? srcW : srcS) + (size_t)val_ * stepP; \
        __builtin_amdgcn_global_load_lds((const unsigned*)s_, (LAS3 unsigned*)(L + NC_RING + (((i) >> 1) % 3) * 16384 + ((i) & 1) * 8192 + wave * 1024), 16, 0, 0); } while (0)
#define NC_DMA(i) NC_DMA_E(i, __builtin_amdgcn_readfirstlane(list[1 + (i)]))
    const bool topk = cur >= 16 && !(dry & 1);
    if (topk && wave < ntc_u) {
#pragma unroll
        for (int s = 0; s < 4; ++s) __builtin_amdgcn_global_load_lds((const unsigned*)(P.KCB + (bg * 256 + 32 * wave + tq) * 64 + 16 * s + 8 * hi), (LAS3 unsigned*)(L + NC_KC + wave * 4096 + s * 1024), 16, 0, 0);
    }
#define NC_FLAGS(tag_, val_, t0_, ntc_, cf_) (((tag_) == 0) ? (((val_) < (ntc_) ? 1 : 0) | ((val_) >= (cf_) ? 8 : 0)) : (((tag_) == 1) ? ((((val_) <= (t0_) && (val_) >= (t0_) - 512) ? 1 : 0) | ((val_) == (t0_) ? 2 : 0) | ((val_) == (t0_) - 512 ? 4 : 0)) : ((((val_) <= (t0_)) ? 1 : 0) | ((val_) == (t0_) ? 2 : 0))))
#define NC_ENTRY(tag_, val_) ((val_) | ((tag_) << 16) | (NC_FLAGS(tag_, val_, t0u, ntcA, cfA) << 18) | (NC_FLAGS(tag_, val_, t0u + 32, ntcB, cfB) << 22))
    const int ntcA = (2 * (2 * tp) + 1 + 31) >> 5, ntcB = ntc_u, cfA = (2 * (2 * tp) - 1) >> 5, cfB = (2 * (2 * tp + 1) - 1) >> 5;
    const int ncmp = ntc_u + (ntc_u & 1);
    const int nsl0 = min(18, 2 * tp + 2), nsl = nsl0 + (nsl0 & 1);
    if (wave == 0) {
        if (lane < ncmp) list[1 + lane] = (lane < ntc_u) ? NC_ENTRY(0, ntc_u - 1 - lane) : 0xffff;
        else if (lane < ncmp + nsl) { const int k = lane - ncmp; list[1 + lane] = (k < nsl0) ? NC_ENTRY(1, t0u + 32 - 32 * k) : ((1 << 16) | 0xffff); }
        if (lane == 0) list[0] = ncmp + nsl; }
    asm volatile("s_waitcnt lgkmcnt(0)\n\ts_barrier" ::: "memory");
    if (dry & 8192) return;
    int nlist = __builtin_amdgcn_readfirstlane(list[0]);
    if (!(dry & 4096)) { NC_DMA(0); NC_DMA(1); NC_DMA(2); NC_DMA(3); }
    unsigned long long selmask, Utb;
    if (!topk) { selmask = (2ull << cur) - 1ull; Utb = selmask; }
    else {
        NC_WAITBAR(4);
        float* il = (float*)0; (void)il;
        LAS3 float* ip0 = (LAS3 float*)(L + NC_IMP + (wave * 32) * 256) + lane;
#pragma unroll
        for (int q = 0; q < 32; ++q) ip0[64 * q] = 0.f;
        {
            f32x16 cb;
            { float hf = hif; asm volatile("" : "+v"(hf));
#pragma unroll
              for (int i = 0; i < 16; ++i) cb[i] = slope2 * 16.0f * ((float)((i & 3) + 8 * (i >> 2)) + hf); }
            float M = -1.0e30f, l = 0.f;
#pragma unroll 1
            for (int nt = ntc - 1; nt >= 0; --nt) {
                const LAS3 unsigned char* kp = L + NC_KC + nt * 4096 + lane * 16;
                f32x16 u = MFMA32(*(const LAS3 bf16x8*)(kp), qf[0], cb); u = MFMA32(*(const LAS3 bf16x8*)(kp + 1024), qf[1], u); u = MFMA32(*(const LAS3 bf16x8*)(kp + 2048), qf[2], u); u = MFMA32(*(const LAS3 bf16x8*)(kp + 3072), qf[3], u);
                nsa_mask_lt(u, nval - 32 * nt - 4 * hi);
                const float tbs = slope2 * 512.0f * (float)nt;
                float tm = max16(u); tm = fmaxf(tm, other_half_f(tm, hi));
                const float mn = fmaxf(M, tm + tbs); float sum = 0.f; const float ms = mn - tbs;
#pragma unroll
                for (int i = 0; i < 16; ++i) sum += __builtin_amdgcn_exp2f(u[i] - ms);
                l = l * __builtin_amdgcn_exp2f(M - mn) + sum; M = mn;
            }
            const float lt = l + other_half_f(l, hi); const float linv = lt > 0.f ? 1.0f / lt : 0.f;
            float carry = 0.f;
#pragma unroll 1
            for (int nt = 0; nt < ntc; ++nt) {
                const LAS3 unsigned char* kp = L + NC_KC + nt * 4096 + lane * 16;
                f32x16 u = MFMA32(*(const LAS3 bf16x8*)(kp), qf[0], cb); u = MFMA32(*(const LAS3 bf16x8*)(kp + 1024), qf[1], u); u = MFMA32(*(const LAS3 bf16x8*)(kp + 2048), qf[2], u); u = MFMA32(*(const LAS3 bf16x8*)(kp + 3072), qf[3], u);
                nsa_mask_lt(u, nval - 32 * nt - 4 * hi);
                const float ms = M - slope2 * 512.0f * (float)nt;
#pragma unroll
                for (int i = 0; i < 16; ++i) u[i] = __builtin_amdgcn_exp2f(u[i] - ms) * linv;
                float x[4], qs[4];
#pragma unroll
                for (int gq = 0; gq < 4; ++gq) { qs[gq] = (u[4 * gq] + u[4 * gq + 1]) + (u[4 * gq + 2] + u[4 * gq + 3]); x[gq] = other_half_f(u[4 * gq + 3], hi); }
                LAS3 float* ip = ip0 + 256 * nt;
                ip[0] += qs[0] + (hi ? x[0] : carry); ip[64] += qs[1] + (hi ? x[1] : x[0]); ip[128] += qs[2] + (hi ? x[2] : x[1]); ip[192] += qs[3] + (hi ? x[3] : x[2]);
                carry = x[3];
            }
        }
        asm volatile("s_waitcnt lgkmcnt(0)\n\ts_barrier" ::: "memory");
        unsigned uu[32];
        const int qlo = hi ? 0 : 1, qhi = (cur - 2 - hi) >> 1;
        const unsigned candm = (unsigned)((2ull << qhi) - 1ull) & ~((1u << qlo) - 1u);
        { const LAS3 float* pp = (const LAS3 float*)(L + NC_IMP + (tbsel * 4 * 32) * 256) + lane;
#pragma unroll
          for (int q = 0; q < 32; ++q) { const float v = (pp[64 * q] + pp[64 * (32 + q)]) + (pp[64 * (64 + q)] + pp[64 * (96 + q)]); uu[q] = __float_as_uint(v) & (unsigned)(-(int)((candm >> q) & 1u)); } }
        unsigned T = 0u;
#pragma unroll 1
        for (int bit = 30; bit >= 0; --bit) { const unsigned c = T | (1u << bit); unsigned cnt = 0;
#pragma unroll
            for (int q = 0; q < 32; ++q) cnt += (uu[q] >= c) ? 1u : 0u;
            cnt += other_half_u(cnt, hi);
            if (cnt >= 13u) T = c; }
        unsigned gtm = 0u, eqm = 0u;
#pragma unroll
        for (int q = 0; q < 32; ++q) { gtm |= (uu[q] > T ? 1u : 0u) << q; eqm |= (uu[q] == T ? 1u : 0u) << q; }
        eqm &= candm;
        const unsigned ogt = other_half_u(gtm, hi), oeq = other_half_u(eqm, hi);
        const unsigned long long fgt = spread_even(hi ? ogt : gtm) | (spread_even(hi ? gtm : ogt) << 1);
        const unsigned long long feq = spread_even(hi ? oeq : eqm) | (spread_even(hi ? eqm : oeq) << 1);
        const int need = 13 - __builtin_popcountll(fgt);
        unsigned long long rem = feq;
#pragma unroll 1
        for (int i = 0; i < 13; ++i) if (i < need) rem &= rem - 1ull;
        selmask = fgt | (feq & ~rem) | 1ull | (3ull << (cur - 1));
        unsigned ulo = (unsigned)selmask, uhi = (unsigned)(selmask >> 32);
#pragma unroll
        for (int o = 1; o < 32; o <<= 1) { ulo |= __shfl_xor(ulo, o); uhi |= __shfl_xor(uhi, o); }
        Utb = ((unsigned long long)__builtin_amdgcn_readfirstlane(uhi) << 32) | (unsigned long long)__builtin_amdgcn_readfirstlane(ulo);
        if (r == 0 && lane == 0) { ((volatile LAS3 unsigned*)(L + NC_UEX))[2 * tbsel] = (unsigned)Utb; ((volatile LAS3 unsigned*)(L + NC_UEX))[2 * tbsel + 1] = (unsigned)(Utb >> 32); }
        asm volatile("s_waitcnt lgkmcnt(0)\n\ts_barrier" ::: "memory");
    }
    if (dry & 32768) return;
    if (wave == 0) {
        unsigned long long U;
        if (topk) { volatile LAS3 unsigned* ux = (volatile LAS3 unsigned*)(L + NC_UEX); U = ((unsigned long long)(ux[1] | ux[3]) << 32) | (unsigned long long)(ux[0] | ux[2]); } else U = (2ull << cur) - 1ull;
        const int n0 = ncmp + nsl;
        if ((U >> lane) & 1ull) { const int pos = n0 + 2 * __builtin_popcountll(lane == 63 ? 0ull : (U >> (lane + 1))); list[1 + pos] = NC_ENTRY(2, 64 * lane + 32); list[2 + pos] = NC_ENTRY(2, 64 * lane); }
        if (lane == 0) list[0] = n0 + 2 * __builtin_popcountll(U); }
    asm volatile("s_waitcnt lgkmcnt(0)\n\ts_barrier" ::: "memory");
    if (dry & 65536) return;
    nlist = __builtin_amdgcn_readfirstlane(list[0]);
    const int lv0 = list[1 + lane], lv1 = list[65 + lane], lv2 = list[129 + lane];
#define NC_ENT(i) (((i) < 64) ? __builtin_amdgcn_readlane(lv0, (i)) : (((i) < 128) ? __builtin_amdgcn_readlane(lv1, (i) - 64) : __builtin_amdgcn_readlane(lv2, (i) - 128)))
    LAS3 float* al = (LAS3 float*)(L + NC_IMP + wave * 8192) + lane;
    f32x16 O0, O1, O2, cb;
#pragma unroll
    for (int i = 0; i < 16; ++i) { al[64 * i] = 0.f; al[64 * (16 + i)] = 0.f; O0[i] = 0.f; O1[i] = 0.f; O2[i] = 0.f; cb[i] = 0.f; }
    const unsigned onesw = (tq == 0) ? 0x3f803f80u : 0u;
    const bf16x8 onesf = __builtin_bit_cast(bf16x8, (u32x4){onesw, onesw, onesw, onesw});
    float M = -1.0e30f, l = 0.f; int curtag = -1;
#define NC_FINAL() do { const float l0_ = O2[0]; const float lt_ = l0_ + other_half_f(l0_, hi);     const float g_ = (curtag == 0) ? gt0 : ((curtag == 1) ? gt2 : gt1); const float sc_ = lt_ > 0.f ? g_ / lt_ : 0.f; \
        _Pragma("unroll") for (int k_ = 0; k_ < 16; ++k_) { al[64 * k_] += O0[k_] * sc_; al[64 * (16 + k_)] += O1[k_] * sc_; } } while (0)
#define NC_SWITCH(tag) do { if ((tag) != curtag) { if (curtag >= 0) NC_FINAL(); curtag = (tag); M = -1.0e30f; l = 0.f; \
            float hf_ = hif; asm volatile("" : "+v"(hf_)); const float cs_ = ((tag) == 0) ? slope2 * 16.0f : slope2; \
            _Pragma("unroll") for (int k_ = 0; k_ < 16; ++k_) { O0[k_] = 0.f; O1[k_] = 0.f; O2[k_] = 0.f; cb[k_] = cs_ * ((float)((k_ & 3) + 8 * (k_ >> 2)) + hf_); } } } while (0)
#define NC_NEED(tag, val) (((tag) == 0) ? ((val) < ntc) : (((tag) == 1) ? (((val) <= t0) && ((val) >= t0 - 512)) : ((((Utb >> ((val) >> 6)) & 1ull) != 0ull) && ((val) <= t0))))
#define NC_TBIAS(tag, val) (((tag) == 0) ? slope2 * 512.0f * (float)(val) : slope2 * (float)((val) - t0))
#define NC_ST(u, sp) do { u = MFMA32(*(const LAS3 bf16x8*)(sp), qf[0], cb); u = MFMA32(*(const LAS3 bf16x8*)((sp) + 1024), qf[1], u); u = MFMA32(*(const LAS3 bf16x8*)((sp) + 2048), qf[2], u); u = MFMA32(*(const LAS3 bf16x8*)((sp) + 3072), qf[3], u); } while (0)
#define NC_MASK(u, tag, val) do { if ((tag) == 0) nsa_mask_lt(u, nval - 32 * (val) - 4 * hi); else { if ((val) == t0) nsa_mask_lt(u, tqh + 1); if ((tag) == 1 && (val) == t0 - 512) nsa_mask_gt(u, tqh); \
            if ((tag) == 2 && !((selmask >> ((val) >> 6)) & 1ull)) { _Pragma("unroll") for (int k_ = 0; k_ < 16; ++k_) u[k_] = NEG_INF; } } } while (0)
#define NC_LDV(V, sp) do { V.v0[0] = *(const LAS3 bf16x8*)((sp) + 4096); V.v0[1] = *(const LAS3 bf16x8*)((sp) + 5120); V.v1[0] = *(const LAS3 bf16x8*)((sp) + 6144); V.v1[1] = *(const LAS3 bf16x8*)((sp) + 7168); } while (0)
    const int npair = (dry & 8) ? 0 : (nlist >> 1);
    const int cfull = (2 * tb - 1) >> 5;
#pragma unroll 1
    for (int p = 0; p < npair; ++p) {
        if (dry & 256) { asm volatile("s_waitcnt lgkmcnt(0)\n\ts_barrier" ::: "memory"); } else { if (p + 1 < npair) NC_WAITBAR(2); else NC_WAITBAR(0); }
        if (!(dry & 512) && p + 2 < npair) { const int i2 = 2 * (p + 2); NC_DMA_E(i2, NC_ENT(i2)); NC_DMA_E(i2 + 1, NC_ENT(i2 + 1)); }
        const int e0 = NC_ENT(2 * p), e1 = NC_ENT(2 * p + 1);
        const int tag = (e0 >> 16) & 3, val0 = e0 & 0xffff, val1 = e1 & 0xffff;
        const int f0 = (e0 >> (18 + 4 * tbsel)) & 15, f1 = (e1 >> (18 + 4 * tbsel)) & 15;
        if (tag != curtag) { asm volatile("" ::: "memory"); NC_SWITCH(tag); }
        const bool sel = (tag == 2);
        const bool need0 = !(dry & 2) && (f0 & 1) && (!sel || ((Utb >> (val0 >> 6)) & 1ull)), need1 = !(dry & 2) && (f1 & 1) && (!sel || ((Utb >> (val1 >> 6)) & 1ull));
        if (need0 || need1) {
            const LAS3 unsigned char* sp0 = L + NC_RING + (p % 3) * 16384 + lane * 16; const LAS3 unsigned char* sp1 = sp0 + 8192;
            f32x16 u0, u1; if (dry & 128) { u0 = cb; u1 = cb; } else { NC_ST(u0, sp0); NC_ST(u1, sp1); }
            const bool nm0 = sel && !__all((int)((selmask >> (val0 >> 6)) & 1ull)), nm1 = sel && !__all((int)((selmask >> (val1 >> 6)) & 1ull));
            if (!need0 || (f0 & 14) || nm0) { asm volatile("" ::: "memory");
                if (!need0) { _Pragma("unroll") for (int k_ = 0; k_ < 16; ++k_) u0[k_] = NEG_INF; } else NC_MASK(u0, tag, val0); }
            if (!need1 || (f1 & 14) || nm1) { asm volatile("" ::: "memory");
                if (!need1) { _Pragma("unroll") for (int k_ = 0; k_ < 16; ++k_) u1[k_] = NEG_INF; } else NC_MASK(u1, tag, val1); }
            const float tb0 = NC_TBIAS(tag, val0), tb1 = NC_TBIAS(tag, val1);
            const float tm0 = (dry & 16) ? 0.f : max16(u0), tm1 = (dry & 16) ? 0.f : max16(u1);
            float cand = fmaxf(tm0 + tb0, tm1 + tb1); if (!(dry & 16)) cand = fmaxf(cand, other_half_f(cand, hi));
            if (!(dry & 16) && __any(cand > M)) { asm volatile("" ::: "memory"); const float mn = fmaxf(M, cand); const float al_ = __builtin_amdgcn_exp2f(M - mn); O0 *= al_; O1 *= al_; O2 *= al_; M = mn; }
            const float ms0 = M - tb0, ms1 = M - tb1;
#pragma unroll
            for (int i = 0; i < 16; ++i) { if (dry & 32) { u0[i] = u0[i] - ms0; u1[i] = u1[i] - ms1; } else { u0[i] = __builtin_amdgcn_exp2f(u0[i] - ms0); u1[i] = __builtin_amdgcn_exp2f(u1[i] - ms1); } }
            asm volatile("" ::: "memory");
            NsaV Va, Vb; NC_LDV(Va, sp0); NC_LDV(Vb, sp1);
            const bf16x8 pa0 = pack8(u0, 0), pa1 = pack8(u0, 1), pb0 = pack8(u1, 0), pb1 = pack8(u1, 1);
            if (dry & 64) { O0[0] += __builtin_bit_cast(float, pa0[0] ^ pa1[1] ^ pb0[2] ^ pb1[3]) + __builtin_bit_cast(float, (int)(Va.v0[0][0] ^ Va.v1[1][1] ^ Vb.v0[0][2] ^ Vb.v1[1][3])); } else {
            O0 = MFMA32(Va.v0[0], pa0, O0); O1 = MFMA32(Va.v1[0], pa0, O1); O0 = MFMA32(Va.v0[1], pa1, O0); O1 = MFMA32(Va.v1[1], pa1, O1);
            O0 = MFMA32(Vb.v0[0], pb0, O0); O1 = MFMA32(Vb.v1[0], pb0, O1); O0 = MFMA32(Vb.v0[1], pb1, O0); O1 = MFMA32(Vb.v1[1], pb1, O1);
            O2 = MFMA32(onesf, pa0, O2); O2 = MFMA32(onesf, pa1, O2); O2 = MFMA32(onesf, pb0, O2); O2 = MFMA32(onesf, pb1, O2); }
        }
    }
    if (curtag >= 0) NC_FINAL();
#undef NC_FINAL
#undef NC_SWITCH
#undef NC_NEED
#undef NC_TBIAS
#undef NC_ST
#undef NC_MASK
#undef NC_LDV
#undef NC_DMA
#undef NC_DMA_E
#undef NC_ENT
#undef NC_FLAGS
#undef NC_ENTRY
    bf16_t* op = P.MIX + rowq * DM + 512 + hh * 64 + 4 * hi;
    if (!(dry & 4))
#pragma unroll
    for (int q4 = 0; q4 < 4; ++q4) {
        u32x2 w0; w0.x = cvtpk(al[64 * (4 * q4)], al[64 * (4 * q4 + 1)]); w0.y = cvtpk(al[64 * (4 * q4 + 2)], al[64 * (4 * q4 + 3)]); *(u32x2*)(op + 8 * q4) = w0;
        u32x2 w1; w1.x = cvtpk(al[64 * (16 + 4 * q4)], al[64 * (16 + 4 * q4 + 1)]); w1.y = cvtpk(al[64 * (16 + 4 * q4 + 2)], al[64 * (16 + 4 * q4 + 3)]); *(u32x2*)(op + 32 + 8 * q4) = w1; }
}

struct MlF { const bf16_t* Z; const float* gates; bf16_t* MIX; const float* gate_bias; const float* mnorm_g; };
constexpr int M2_QC = 0, M2_KC = 17408, M2_K2 = 34816, M2_VC = 55296, M2_EG = 75776, M2_N = 76032, M2_SSQ = 77056, M2_CF = 78080, M2_G = 110848, M2_END = 111360;
constexpr int M2_RS = 272, M2_TS = 320;
typedef short v4i16_t __attribute__((ext_vector_type(4)));
__device__ __forceinline__ v4i16_t ml_tr(const LAS3 unsigned char* p) { return __builtin_amdgcn_ds_read_tr16_b64_v4i16((LAS3 v4i16_t*)p); }
__device__ __forceinline__ bf16x8 ml_cat(v4i16_t a, v4i16_t b) { return (bf16x8){a[0], a[1], a[2], a[3], b[0], b[1], b[2], b[3]}; }
__device__ __forceinline__ float dpp_f(float ident, float v, const int ctrl_dummy) { return v; }
#define ML_DPP(ident, v, ctrl, rmask) __builtin_bit_cast(float, __builtin_amdgcn_update_dpp(__builtin_bit_cast(int, (float)(ident)), __builtin_bit_cast(int, (float)(v)), (ctrl), (rmask), 0xf, false))
__device__ __forceinline__ float scan_add64_dpp(float v) {
    v += ML_DPP(0.f, v, 0x111, 0xf); v += ML_DPP(0.f, v, 0x112, 0xf); v += ML_DPP(0.f, v, 0x114, 0xf); v += ML_DPP(0.f, v, 0x118, 0xf);
    v += ML_DPP(0.f, v, 0x142, 0xa); v += ML_DPP(0.f, v, 0x143, 0xc); return v;
}
__device__ __forceinline__ float scan_max64_dpp(float v) {
    const float NI = -__builtin_inff();
    v = fmaxf(v, ML_DPP(NI, v, 0x111, 0xf)); v = fmaxf(v, ML_DPP(NI, v, 0x112, 0xf)); v = fmaxf(v, ML_DPP(NI, v, 0x114, 0xf)); v = fmaxf(v, ML_DPP(NI, v, 0x118, 0xf));
    v = fmaxf(v, ML_DPP(NI, v, 0x142, 0xa)); v = fmaxf(v, ML_DPP(NI, v, 0x143, 0xc)); return v;
}
struct Ml2Scal { float w, inter_s, rowf_s, floorv, decay, mnew; };
__device__ __forceinline__ Ml2Scal ml2_scalars(float ipre, float fpre, float m) {
    const float lf = log_sigmoidf_(fpre);
    const float bcs = scan_add64_dpp(lf);
    const float bL = __builtin_bit_cast(float, __builtin_amdgcn_readlane(__builtin_bit_cast(int, bcs), 63));
    const float g = ipre - bcs;
    const float pm = scan_max64_dpp(g);
    const float gmax = __builtin_bit_cast(float, __builtin_amdgcn_readlane(__builtin_bit_cast(int, pm), 63));
    const float mm = fmaxf(m, pm), mg = fmaxf(m, gmax);
    Ml2Scal s; const float scale = 0.08838834764831845f;
    s.w = __expf(g - mg); s.inter_s = __expf(m - mm) * scale; s.rowf_s = __expf(mg - mm) * scale; s.floorv = __expf(-bcs - mm);
    s.decay = __expf(m - mg); s.mnew = bL + mg;
    return s;
}

__device__ __forceinline__ void mlstm_unit_v2(const MlF& P, int b, int h, LAS3 unsigned char* L, int tid) {
    const int lane = tid & 63, wave = __builtin_amdgcn_readfirstlane(tid >> 6), lt = wave >> 2, tq = lane & 31, hi = lane >> 5;
    const float bi = P.gate_bias[h], bff = P.gate_bias[4 + h];
    const size_t row0 = (size_t)b * SEQ;
    const int ss = tid >> 3, d0 = 8 * (tid & 7);
    const bf16_t* zst = P.Z + (row0 + ss) * NZ + h * 128 + d0;
    const int wv_ = tid >> 6, ltv = wv_ >> 2, dvtv = wv_ & 3;
    const int lrow = 32 * ltv + tq;
    const int i16 = lane & 15, g16 = lane >> 4;
    const unsigned tr_lane = (unsigned)((4 * hi + (i16 >> 2)) * M2_TS + (16 * (g16 & 1) + 4 * (i16 & 3)) * 2);
    const unsigned a_qc = M2_QC + lrow * M2_RS + 16 * hi, a_qp = M2_QC + lrow * M2_RS + 8 * hi, a_kc = M2_KC + tq * M2_RS + 16 * hi, a_cf = M2_CF + (dvtv * 512 + lane) * 16;
    const unsigned a_vt = M2_VC + tr_lane + (32 * dvtv) * 2, a_kt = M2_K2 + tr_lane + (64 * ltv) * 2, a_eg = M2_EG + 16 * hi, a_n = M2_N + 256 * hi;
    f32x16 C0, C1;
#pragma unroll
    for (int i = 0; i < 16; ++i) { C0[i] = 0.f; C1[i] = 0.f; }
    for (int i = tid; i < 256; i += NTHREADS) ((LAS3 float*)(L + M2_N))[i] = 0.f;
    if (tid < 128) ((LAS3 float*)(L + M2_G))[tid] = P.mnorm_g[h * 128 + tid];
    for (int i = tid; i < 32768 / 16; i += NTHREADS) ((LAS3 u32x4*)(L + M2_CF))[i] = (u32x4){0u, 0u, 0u, 0u};
    float mst = 0.f;
    u32x4 rq[2], rk[2], rv[2]; float gi_, gf_;
#pragma unroll
    for (int p = 0; p < 2; ++p) { rq[p] = *(const u32x4*)(zst + ZC_MQ + 64 * p); rk[p] = *(const u32x4*)(zst + ZC_MK + 64 * p); rv[p] = *(const u32x4*)(zst + ZC_MV + 64 * p); }
    { const float* gr = P.gates + (row0 + lane) * 32; gi_ = gr[h] + bi; gf_ = gr[4 + h] + bff; }
    Ml2Scal sc = ml2_scalars(gi_, gf_, mst);
#define ML2_STAGE() do { \
        const float ws_ = __shfl(sc.w, ss); \
        _Pragma("unroll") for (int p = 0; p < 2; ++p) { \
            *(LAS3 u32x4*)(L + M2_QC + ss * M2_RS + (d0 + 64 * p) * 2) = rq[p]; \
            *(LAS3 u32x4*)(L + M2_KC + ss * M2_RS + (d0 + 64 * p) * 2) = rk[p]; *(LAS3 u32x4*)(L + M2_K2 + ss * M2_TS + (d0 + 64 * p) * 2) = rk[p]; \
            u32x4 o_; o_.x = cvtpk(bflo(rv[p].x) * ws_, bfhi(rv[p].x) * ws_); o_.y = cvtpk(bflo(rv[p].y) * ws_, bfhi(rv[p].y) * ws_); o_.z = cvtpk(bflo(rv[p].z) * ws_, bfhi(rv[p].z) * ws_); o_.w = cvtpk(bflo(rv[p].w) * ws_, bfhi(rv[p].w) * ws_); \
            *(LAS3 u32x4*)(L + M2_VC + ss * M2_TS + (d0 + 64 * p) * 2) = o_; } \
        if (wave == 0) ((LAS3 float*)(L + M2_EG))[lane] = sc.w; } while (0)
    __syncthreads();
    ML2_STAGE();
    float inter_s = __shfl(sc.inter_s, lrow), rowf_s = __shfl(sc.rowf_s, lrow), floorv = __shfl(sc.floorv, lrow), decay = sc.decay;
    mst = sc.mnew;
    u32x2 mo[4];
#define ML2_PREFETCH(cn) do { \
        if ((cn) < SEQ / 64) { const bf16_t* zn = zst + (size_t)(cn) * 64 * NZ; \
            _Pragma("unroll") for (int p = 0; p < 2; ++p) { rq[p] = *(const u32x4*)(zn + ZC_MQ + 64 * p); rk[p] = *(const u32x4*)(zn + ZC_MK + 64 * p); rv[p] = *(const u32x4*)(zn + ZC_MV + 64 * p); } \
            const float* gr = P.gates + (row0 + (size_t)(cn) * 64 + lane) * 32; gi_ = gr[h] + bi; gf_ = gr[4 + h] + bff; } \
        { const size_t orow_ = row0 + (size_t)((cn) - 1) * 64 + lrow; \
          _Pragma("unroll") for (int q = 0; q < 4; ++q) mo[q] = *(const u32x2*)(P.Z + orow_ * NZ + ZC_MO + h * 128 + 32 * dvtv + 8 * q + 4 * hi); } } while (0)
    ML2_PREFETCH(1);
#pragma unroll 1
    for (int c = 0; c < SEQ / 64; ++c) {
        __syncthreads();
        const bool more = (c + 1 < SEQ / 64);
        const size_t orow = row0 + (size_t)c * 64 + lrow;
        float den = 0.f;
        bf16x8 xf[4];
        {
            bf16x8 qf[8];
#pragma unroll
            for (int kk = 0; kk < 8; ++kk) qf[kk] = *(const LAS3 bf16x8*)(L + a_qc + 32 * kk);
#pragma unroll
            for (int st = 0; st < 2; ++st) {
                if (st <= lt) {
                    f32x16 X;
#pragma unroll
                    for (int i = 0; i < 16; ++i) X[i] = 0.f;
#pragma unroll
                    for (int kk = 0; kk < 8; ++kk) X = MFMA32(*(const LAS3 bf16x8*)(L + a_kc + 32 * st * M2_RS + 32 * kk), qf[kk], X);
                    const bool diag = (st == lt);
                    int tqo = tq - 4 * hi; asm volatile("" : "+v"(tqo));
                    float dsum = 0.f;
#pragma unroll
                    for (int q = 0; q < 4; ++q) { const f32x4 e4 = *(const LAS3 f32x4*)(L + a_eg + (32 * st + 8 * q) * 4);
#pragma unroll
                        for (int e = 0; e < 4; ++e) { const int i = 4 * q + e; float x = X[i] * rowf_s; if (diag && (8 * q + e > tqo)) x = 0.f; X[i] = x; dsum += x * e4[e]; } }
                    den += dsum;
                    xf[2 * st] = pack8(X, 0); xf[2 * st + 1] = pack8(X, 1);
                }
            }
        }
        den += other_half_f(den, hi);
        asm volatile("" ::: "memory");
        f32x16 acc;
#pragma unroll
        for (int i = 0; i < 16; ++i) acc[i] = 0.f;
#pragma unroll
        for (int kk = 0; kk < 8; ++kk) { const u32x2 qa = *(const LAS3 u32x2*)(L + a_qp + 32 * kk), qb = *(const LAS3 u32x2*)(L + a_qp + 32 * kk + 16);
            const u32x4 qq = (u32x4){qa.x, qa.y, qb.x, qb.y};
            acc = MFMA32(*(const LAS3 bf16x8*)(L + a_cf + kk * 1024), __builtin_bit_cast(bf16x8, qq), acc); }
        asm volatile("" ::: "memory");
        float qn = 0.f;
        { const unsigned an = a_n + (c & 1) * 512; const unsigned aq = M2_QC + lrow * M2_RS + 128 * hi;
#pragma unroll
          for (int k8 = 0; k8 < 8; ++k8) { const u32x4 w = *(const LAS3 u32x4*)(L + aq + 16 * k8); const f32x4 n0 = *(const LAS3 f32x4*)(L + an + 32 * k8), n1 = *(const LAS3 f32x4*)(L + an + 32 * k8 + 16);
              qn += bflo(w.x) * n0[0] + bfhi(w.x) * n0[1] + bflo(w.y) * n0[2] + bfhi(w.y) * n0[3] + bflo(w.z) * n1[0] + bfhi(w.z) * n1[1] + bflo(w.w) * n1[2] + bfhi(w.w) * n1[3]; } }
        qn += other_half_f(qn, hi);
        acc *= inter_s;
        bf16x8 vf[4];
#pragma unroll
        for (int s4 = 0; s4 < 4; ++s4) vf[s4] = ml_cat(ml_tr(L + a_vt + 16 * s4 * M2_TS), ml_tr(L + a_vt + (16 * s4 + 8) * M2_TS));
#pragma unroll
        for (int s4 = 0; s4 < 4; ++s4) if ((s4 >> 1) <= lt) acc = MFMA32(vf[s4], xf[s4], acc);
        den = inter_s * qn + den;
        const float inv = __builtin_amdgcn_rcpf(fmaxf(fabsf(den), floorv));
        float ssq = 0.f;
#pragma unroll
        for (int i = 0; i < 16; ++i) { acc[i] *= inv; ssq += acc[i] * acc[i]; }
        ssq += other_half_f(ssq, hi);
        if (hi == 0) *(LAS3 float*)(L + M2_SSQ + (dvtv * 64 + lrow) * 4) = ssq;
        asm volatile("" ::: "memory");
        C0 *= decay; C1 *= decay;
#pragma unroll
        for (int s4 = 0; s4 < 4; ++s4) {
            C0 = MFMA32(ml_cat(ml_tr(L + a_kt + 16 * s4 * M2_TS), ml_tr(L + a_kt + (16 * s4 + 8) * M2_TS)), vf[s4], C0);
            C1 = MFMA32(ml_cat(ml_tr(L + a_kt + 64 + 16 * s4 * M2_TS), ml_tr(L + a_kt + 64 + (16 * s4 + 8) * M2_TS)), vf[s4], C1); }
        if (tid < 128) { float a = 0.f;
#pragma unroll 16
            for (int s = 0; s < 64; ++s) a += ((const LAS3 float*)(L + M2_EG))[s] * bf2f(*(const LAS3 unsigned short*)(L + M2_KC + s * M2_RS + tid * 2));
            LAS3 float* nn = (LAS3 float*)(L + M2_N);
            nn[((c + 1) & 1) * 128 + tid] = decay * nn[(c & 1) * 128 + tid] + a; }
        __syncthreads();
        { const LAS3 float* sq = (const LAS3 float*)(L + M2_SSQ + lrow * 4); const float ss4 = (sq[0] + sq[64]) + (sq[128] + sq[192]);
          const float rstd = __builtin_amdgcn_rsqf(ss4 * (1.0f / 128.0f) + EPS);
          bf16_t* op = P.MIX + orow * DM + h * 128 + 32 * dvtv + 4 * hi;
#pragma unroll
          for (int q = 0; q < 4; ++q) { const f32x4 gg = *(const LAS3 f32x4*)(L + M2_G + (32 * dvtv + 8 * q + 4 * hi) * 4);
              const float o0 = acc[4 * q] * rstd * gg[0] * sigmoidf_(bflo(mo[q].x)), o1 = acc[4 * q + 1] * rstd * gg[1] * sigmoidf_(bfhi(mo[q].x));
              const float o2 = acc[4 * q + 2] * rstd * gg[2] * sigmoidf_(bflo(mo[q].y)), o3 = acc[4 * q + 3] * rstd * gg[3] * sigmoidf_(bfhi(mo[q].y));
              u32x2 w; w.x = cvtpk(o0, o1); w.y = cvtpk(o2, o3); *(u32x2*)(op + 8 * q) = w; } }
        { const unsigned aw = a_cf + ltv * 4096;
          *(LAS3 bf16x8*)(L + aw) = pack8(C0, 0); *(LAS3 bf16x8*)(L + aw + 1024) = pack8(C0, 1); *(LAS3 bf16x8*)(L + aw + 2048) = pack8(C1, 0); *(LAS3 bf16x8*)(L + aw + 3072) = pack8(C1, 1); }
        if (more) {
            sc = ml2_scalars(gi_, gf_, mst);
            ML2_STAGE();
            inter_s = __shfl(sc.inter_s, lrow); rowf_s = __shfl(sc.rowf_s, lrow); floorv = __shfl(sc.floorv, lrow); decay = sc.decay; mst = sc.mnew;
            ML2_PREFETCH(c + 2);
        }
    }
#undef ML2_PREFETCH
#undef ML2_STAGE
    __syncthreads();
}

#define LAS __attribute__((address_space(3)))
#define XB_TMO      128
#define XB_XCNT(j)  (256  + 64 * (j))
#define XB_XSUB(j)  (1280 + 64 * (j))
#define XB_XGEN(j)  (2304 + 64 * (j))
#define XB_TOP      3328
#define XB_TOPGEN   3392
#define XCD_BAR_WORDS 3456
#define XB_SPIN_CAP (1u << 18)

__device__ __forceinline__ unsigned xb_ld(unsigned* p)              { return __hip_atomic_load(p, __ATOMIC_RELAXED, __HIP_MEMORY_SCOPE_AGENT); }
__device__ __forceinline__ unsigned xb_add(unsigned* p, unsigned v) { return __hip_atomic_fetch_add(p, v, __ATOMIC_RELAXED, __HIP_MEMORY_SCOPE_AGENT); }
__device__ __forceinline__ unsigned xb_xcc_id() { return (unsigned)__builtin_amdgcn_s_getreg((3 << 11) | 20) & 0xFu; }
#define XB_SPIN(cond, bar) do { unsigned _sp = 0; while (cond) { __builtin_amdgcn_s_sleep(1); \
    if ((++_sp & 255u) == 0u) { if (xb_ld(&(bar)[XB_TMO])) break; if (_sp > XB_SPIN_CAP) { atomicAdd(&(bar)[XB_TMO], 1u); break; } } } } while (0)

struct XcdBarrier {
    unsigned* bar; unsigned x;
    volatile LAS unsigned* st;
};

__device__ __forceinline__ XcdBarrier xcd_barrier_post(unsigned* bar, volatile LAS unsigned* st) {
    XcdBarrier b; b.bar = bar; b.x = xb_xcc_id(); b.st = st;
    if (threadIdx.x == 0) (void)xb_add(&bar[XB_XCNT(b.x)], 1u);
    return b;
}
__device__ __forceinline__ void xcd_barrier_complete(unsigned* bar, unsigned x, unsigned& nloc, unsigned& nx) {
    const unsigned G = gridDim.x * gridDim.y * gridDim.z;
    unsigned sum, cnt, mine, sp = 0u;
    for (;;) {
        sum = 0u; cnt = 0u; mine = 0u;
#pragma unroll
        for (unsigned j = 0; j < 16; ++j) { const unsigned c = xb_ld(&bar[XB_XCNT(j)]); sum += c; cnt += (c > 0u) ? 1u : 0u; mine = (j == x) ? c : mine; }
        if (sum == G) break;
        __builtin_amdgcn_s_sleep(1);
        if ((++sp & 255u) == 0u) { if (xb_ld(&bar[XB_TMO])) break; if (sp > XB_SPIN_CAP) { atomicAdd(&bar[XB_TMO], 1u); break; } }
    }
    nloc = mine > 0u ? mine : 1u; nx = cnt > 0u ? cnt : 1u;
}

__device__ __forceinline__ void xcd_barrier(const XcdBarrier& b) {
    asm volatile("s_waitcnt vmcnt(0)" ::: "memory");
    __syncthreads();
    if (threadIdx.x == 0) {
        unsigned* bar = b.bar;
        __builtin_amdgcn_s_waitcnt(0);
        unsigned nloc = b.st[0], nx = b.st[1];
        if (nloc == 0u) { xcd_barrier_complete(bar, b.x, nloc, nx); b.st[0] = nloc; b.st[1] = nx; }
        const unsigned old = xb_add(&bar[XB_XSUB(b.x)], 1u);
        const unsigned gen = old / nloc;
        if (old + 1u == (gen + 1u) * nloc) {
            __builtin_amdgcn_fence(__ATOMIC_RELEASE, "agent");
            asm volatile("s_waitcnt vmcnt(0)" ::: "memory");
            const unsigned og = xb_add(&bar[XB_TOP], 1u);
            const unsigned tg = og / nx;
            if (og + 1u == (tg + 1u) * nx) xb_add(&bar[XB_TOPGEN], 1u);
            else XB_SPIN(xb_ld(&bar[XB_TOPGEN]) == tg, bar);
            __builtin_amdgcn_fence(__ATOMIC_ACQUIRE, "agent");
            xb_add(&bar[XB_XGEN(b.x)], 1u);
            asm volatile("s_waitcnt vmcnt(0)" ::: "memory");
        } else {
            XB_SPIN(xb_ld(&bar[XB_XGEN(b.x)]) == gen, bar);
            __builtin_amdgcn_fence(__ATOMIC_ACQUIRE, "agent");
            asm volatile("s_waitcnt vmcnt(0)" ::: "memory");
        }
    }
    __syncthreads();
}

__global__ void __launch_bounds__(NTHREADS, 2) fwd_kernel(Params prm) {
    extern __shared__ __attribute__((aligned(16))) unsigned char lds[];
    cg::grid_group grid = cg::this_grid();
    PG8_LAS unsigned char* ldsl = (PG8_LAS unsigned char*)lds;
    float* lds_f = (float*)lds;
#define TID ((int)threadIdx.x)
#define LANE ((int)(threadIdx.x & 63))
#define WAVE (__builtin_amdgcn_readfirstlane((int)(threadIdx.x >> 6)))
#define GRIDN ((int)gridDim.x)
#define BX ((int)blockIdx.x)
#define WSP(T, name, off) T* name; { unsigned char* w_ = prm.ws; asm volatile("" : "+s"(w_)); name = (T*)(w_ + (off)); }
    { volatile LAS unsigned* st0 = (volatile LAS unsigned*)((LAS unsigned char*)lds + XBAR_LDS); if (threadIdx.x < 2) st0[threadIdx.x] = 0u; }
    __syncthreads();
    XcdBarrier xbar; { unsigned char* w_ = prm.ws; asm volatile("" : "+s"(w_)); xbar = xcd_barrier_post((unsigned*)(w_ + WS_CTL) + 4096, (volatile LAS unsigned*)((LAS unsigned char*)lds + XBAR_LDS)); }
#ifndef DUP_PHASE
#define DUPREPS(k) 1
#else
#define DUPREPS(k) ((k) == DUP_PHASE ? 2 : 1)
#endif
#ifdef PROBE_A
#define STAMP(k) do { if (BX == 0 && TID == 0) { unsigned char* w_ = prm.ws; asm volatile("" : "+s"(w_)); ((unsigned long long*)w_)[k] = __builtin_amdgcn_s_memrealtime(); } } while (0)
#else
#define STAMP(k) do { } while (0)
#endif
    STAMP(0);

    _Pragma("unroll 1") for (int rep_ = 0; rep_ < DUPREPS(0); ++rep_)
    {
        const int lane = LANE, wave = WAVE, G = GRIDN, bx = BX, tid = TID; const int gw = bx * NWAVES + wave, NGW = G * NWAVES;
        WSP(bf16_t, Win_t, WS_WIN) WSP(bf16_t, Wout_t, WS_WOUT) WSP(bf16_t, Wup_t, WS_WUP) WSP(bf16_t, Wdn_t, WS_WDN) WSP(bf16_t, Wpg_t, WS_WPG) WSP(bf16_t, Wpp_t, WS_WPP)
        WSP(bf16_t, XB, WS_XB) WSP(bf16_t, PB, WS_PB) WSP(bf16_t, W1T, WS_W1T) WSP(bf16_t, W2T, WS_W2T) WSP(float, C1, WS_C1)
        const float* x = prm.in[0]; const float* pin = prm.in[1];
        float* scr = lds_f + wave * 4096;
        constexpr int I_IN = (DM / 64) * (3360 / 32), I_OUT = (DM / 64) * (DM / 32), I_UP = (DM / 64) * (4096 / 32), I_DN = (DFF / 64) * (DM / 32), I_PG = I_OUT, I_PP = (PLE / 64) * (DM / 32);
        constexpr int I_W1 = 4 * 64, I_W2 = 2 * 4;
        constexpr int NITEMS = I_IN + I_OUT + I_UP + I_DN + I_PG + I_PP + I_W1 + I_W2;
        for (int it = gw; it < NITEMS; it += NGW) {
            int r = it;
            if (r < I_IN) { p0_transpose_item(prm.in[3], nullptr, DM, 3360, Win_t, scr, r, lane); continue; } r -= I_IN;
            if (r < I_OUT) { p0_transpose_item(prm.in[12], nullptr, DM, DM, Wout_t, scr, r, lane); continue; } r -= I_OUT;
            if (r < I_UP) { p0_transpose_item<true>(prm.in[14], prm.in[13], DM, 4096, Wup_t, scr, r, lane); continue; } r -= I_UP;
            if (r < I_DN) { p0_transpose_item(prm.in[17], nullptr, DFF, DM, Wdn_t, scr, r, lane); continue; } r -= I_DN;
            if (r < I_PG) { p0_transpose_item(prm.in[19], prm.in[18], DM, DM, Wpg_t, scr, r, lane); continue; } r -= I_PG;
            if (r < I_PP) { p0_transpose_item(prm.in[20], nullptr, PLE, DM, Wpp_t, scr, r, lane); continue; } r -= I_PP;
            if (r < I_W1) { const int q = r >> 6, kv = q >> 1, half = q & 1;
                p0_transpose_item(prm.in[kv ? 10 : 8] + (size_t)half * 1024 * 128, nullptr, 1024, 128, W1T + (size_t)kv * 256 * 1024 + (size_t)half * 128 * 1024, scr, r & 63, lane); continue; } r -= I_W1;
            { const int kv = r >> 2; p0_transpose_item(prm.in[kv ? 11 : 9], nullptr, 128, 64, W2T + (size_t)kv * 64 * 128, scr, r & 3, lane); }
        }
        if (tid < 256) { const int kv = tid >> 7, j = tid & 127; const float* pe = prm.in[kv ? 7 : 6]; const float* w1 = prm.in[kv ? 10 : 8]; float a = 0.f;
            const int per = (2048 + G - 1) / G; const int l0 = bx * per, l1 = min(2048, l0 + per);
            for (int ld = l0; ld < l1; ++ld) a += pe[ld] * w1[(size_t)ld * 128 + j];
            if (l0 < l1) atomicAdd(C1 + kv * 128 + j, a); }
        for (int i = bx * NTHREADS + tid; i < (NZ - 3360) * DM / 8; i += G * NTHREADS) ((u32x4*)(Win_t + (size_t)3360 * DM))[i] = (u32x4){0u, 0u, 0u, 0u};
        const float* g1 = prm.in[2];
        f32x4 gv[4];
#pragma unroll
        for (int j = 0; j < 4; ++j) gv[j] = ((const f32x4*)g1)[lane + 64 * j];
        for (int m = 2 * gw; m < MTOK; m += 2 * NGW) {
            f32x4 v[2][4]; float sq[2];
#pragma unroll
            for (int k = 0; k < 2; ++k) { const f32x4* xr = (const f32x4*)(x + (size_t)(m + k) * DM) + lane;
#pragma unroll
                for (int j = 0; j < 4; ++j) v[k][j] = xr[64 * j]; }
#pragma unroll
            for (int k = 0; k < 2; ++k) { float s = 0.f;
#pragma unroll
                for (int j = 0; j < 4; ++j) s += (v[k][j][0] * v[k][j][0] + v[k][j][1] * v[k][j][1]) + (v[k][j][2] * v[k][j][2] + v[k][j][3] * v[k][j][3]);
                sq[k] = s; }
#pragma unroll
            for (int o = 1; o < 64; o <<= 1) { sq[0] += __shfl_xor(sq[0], o); sq[1] += __shfl_xor(sq[1], o); }
#pragma unroll
            for (int k = 0; k < 2; ++k) { const float rstd = 1.0f / sqrtf(sq[k] * (1.0f / DM) + EPS);
                u32x2* o8 = (u32x2*)(XB + (size_t)(m + k) * DM) + lane;
#pragma unroll
                for (int j = 0; j < 4; ++j) { u32x2 w; w.x = pk2(v[k][j][0] * rstd * gv[j][0], v[k][j][1] * rstd * gv[j][1]); w.y = pk2(v[k][j][2] * rstd * gv[j][2], v[k][j][3] * rstd * gv[j][3]); o8[64 * j] = w; } }
        }
        for (size_t i = (size_t)bx * NTHREADS + tid; i < (size_t)MTOK * PLE / 8; i += (size_t)G * NTHREADS) {
            const f32x4 a = ((const f32x4*)pin)[2 * i], c = ((const f32x4*)pin)[2 * i + 1];
            u32x4 w; w.x = pk2(a[0], a[1]); w.y = pk2(a[2], a[3]); w.z = pk2(c[0], c[1]); w.w = pk2(c[2], c[3]); ((u32x4*)PB)[i] = w; }
    }
    grid.sync();
    STAMP(1);

    _Pragma("unroll 1") for (int rep_ = 0; rep_ < DUPREPS(1); ++rep_)
    {
        WSP(bf16_t, XB, WS_XB) WSP(bf16_t, Win_t, WS_WIN) WSP(bf16_t, Z, WS_Z) WSP(float, GATES, WS_GATES)
        pg8::Gemm g{XB, Win_t, MTOK, NZ, DM}; pg8::StaticOrder S; S.init(MTOK, NZ, GRIDN, BX);
#ifdef P1_PLAIN_DUP
        if (rep_ > 0) { pg8::EpiBf<false> E2{Z, NZ, nullptr}; pg8::gemm_phase<pg8::EpiBf<false>, pg8::StaticOrder, true, true>(ldsl, g, S, E2); } else
#endif
        { pg8::EpiZ E{Z, GATES};
        pg8::gemm_phase<pg8::EpiZ, pg8::StaticOrder, true, true>(ldsl, g, S, E); }
    }
    xcd_barrier(xbar);
    STAMP(2);

    _Pragma("unroll 1") for (int rep_ = 0; rep_ < DUPREPS(2); ++rep_)
    {
        WSP(bf16_t, Z, WS_Z) WSP(bf16_t, KCB, WS_KCB) WSP(bf16_t, VCT, WS_VCT) WSP(bf16_t, VST, WS_VST) WSP(bf16_t, VWT, WS_VWT)
        const bool split = GRIDN > 128;
        if (!split || BX < 64) {
            WSP(bf16_t, W1T, WS_W1T) WSP(bf16_t, W2T, WS_W2T) WSP(float, C1, WS_C1)
            for (int un = BX; un < 64; un += (split ? 64 : GRIDN)) {
                pg8::Gemm g{nullptr, nullptr, 256, 256, 1024, 16 * NZ, NZ * 2}; pg8::CmpOrder S{un, Z, W1T};
                pg8::EpiCmp E{C1, W2T, KCB, VCT};
                pg8::gemm_phase<pg8::EpiCmp, pg8::CmpOrder, true, true>(ldsl, g, S, E);
                __syncthreads();
            }
        }
        if (!split || BX >= 64)
        for (int un = split ? BX - 64 : BX; un < BATCH * 2 * 2 * 64; un += (split ? GRIDN - 64 : GRIDN)) {
            const int ch = un & 63, br = (un >> 6) & 1, g = (un >> 7) & 1, b = un >> 8;
            vt_unit(Z, br ? ZC_AVW : ZC_AVS, br ? VWT : VST, b, g, ch, (unsigned short*)lds, TID);
        }
    }
    xcd_barrier(xbar);
    STAMP(3);

    _Pragma("unroll 1") for (int rep_ = 0; rep_ < DUPREPS(3); ++rep_)
    {
        WSP(bf16_t, Z, WS_Z) WSP(float, GATES, WS_GATES) WSP(bf16_t, MIX, WS_MIX)
        {
            MlF MP{Z, GATES, MIX, prm.in[4], prm.in[5]};
            _Pragma("unroll 1") for (int rep2_ = 0; rep2_ < DUPREPS(30); ++rep2_)
            for (int un = BX; un < BATCH * 4; un += GRIDN) mlstm_unit_v2(MP, un >> 2, un & 3, (LAS3 unsigned char*)lds, TID);
        }
        __syncthreads();
        {
            WSP(bf16_t, KCB, WS_KCB) WSP(bf16_t, VCT, WS_VCT) WSP(bf16_t, VST, WS_VST) WSP(bf16_t, VWT, WS_VWT)
            NsaF NP{Z, GATES, KCB, VCT, VST, VWT, MIX};
            unsigned* qctr; { unsigned char* w_ = prm.ws; asm volatile("" : "+s"(w_)); qctr = (unsigned*)(w_ + WS_CTL) + 64; }
            volatile LAS3 int* slot = (volatile LAS3 int*)((LAS3 unsigned char*)lds + NC_QSLOT);
            _Pragma("unroll 1") for (int rep2_ = 0; rep2_ < DUPREPS(31); ++rep2_) {
            int tk = 0;
            if (TID == 0) tk = (int)atomicAdd(qctr + 64 * rep2_, 1u);
            for (;;) {
                if (TID == 0) { *slot = tk; if (tk < BATCH * 2 * 64) tk = (int)atomicAdd(qctr + 64 * rep2_, 1u); }
                __syncthreads();
                const int grp = *slot;
                __syncthreads();
                if (grp >= BATCH * 2 * 64) break;
#ifdef NSA_DRY
                nsa_unit_coop(NP, (grp >> 1) & 15, grp & 1, 63 - (grp >> 5), (LAS3 unsigned char*)lds, TID, rep2_ ? NSA_DRY : 0);
#else
                nsa_unit_coop(NP, (grp >> 1) & 15, grp & 1, 63 - (grp >> 5), (LAS3 unsigned char*)lds, TID);
#endif
            } }
        }
    }
    xcd_barrier(xbar);
    STAMP(4);

    _Pragma("unroll 1") for (int rep_ = 0; rep_ < DUPREPS(4); ++rep_)
    {
        WSP(bf16_t, MIX, WS_MIX) WSP(bf16_t, Wout_t, WS_WOUT) WSP(bf16_t, XB, WS_XB) WSP(float, RS2, WS_RS2)
        pg8::Gemm g{MIX, Wout_t, MTOK, DM, DM}; pg8::PanelOrder S; S.init(MTOK, GRIDN, BX);
        pg8::EpiRes<true> E{prm.in[0], nullptr, XB, RS2};
        pg8::gemm_phase<pg8::EpiRes<true>, pg8::PanelOrder, true, true>(ldsl, g, S, E);
        WSP(float, RSTD2, WS_RSTD2)
        asm volatile("s_waitcnt vmcnt(0)" ::: "memory"); __syncthreads();
        for (int p = BX; p < MTOK / 256; p += GRIDN) if (TID < 256) { const int row = p * 256 + TID; RSTD2[row] = pg8::row_rstd(RS2, row); }
    }
    xcd_barrier(xbar);
    STAMP(5);

    _Pragma("unroll 1") for (int rep_ = 0; rep_ < DUPREPS(5); ++rep_)
    {
        WSP(bf16_t, XB, WS_XB) WSP(bf16_t, Wup_t, WS_WUP) WSP(bf16_t, ACT, WS_ACT) WSP(float, RS2, WS_RSTD2)
        PG8_LAS float* car = (PG8_LAS float*)(ldsl + 131072 + 1024);
        pg8::Gemm g{XB, Wup_t, MTOK, 4096, DM, 0, 0}; pg8::ChainOrder S{BX};
        pg8::EpiUpConv E{ACT, RS2, prm.in[15], prm.in[16], car};
        pg8::gemm_phase<pg8::EpiUpConv, pg8::ChainOrder, true, true>(ldsl, g, S, E);
    }
    xcd_barrier(xbar);
    STAMP(6);

    _Pragma("unroll 1") for (int rep_ = 0; rep_ < DUPREPS(7); ++rep_)
    {
        WSP(bf16_t, ACT, WS_ACT) WSP(bf16_t, Wdn_t, WS_WDN) WSP(bf16_t, XB, WS_XB) WSP(float, RS3, WS_RS3)
        pg8::Gemm g{ACT, Wdn_t, MTOK, DM, DFF}; pg8::PanelOrder S; S.init(MTOK, GRIDN, BX);
        pg8::EpiRes<false> E{nullptr, XB, XB, RS3};
        pg8::gemm_phase<pg8::EpiRes<false>, pg8::PanelOrder, true, true>(ldsl, g, S, E);
        WSP(float, RSTD3, WS_RSTD3)
        asm volatile("s_waitcnt vmcnt(0)" ::: "memory"); __syncthreads();
        for (int p = BX; p < MTOK / 256; p += GRIDN) if (TID < 256) { const int row = p * 256 + TID; RSTD3[row] = pg8::row_rstd(RS3, row); }
    }
    _Pragma("unroll 1") for (int rep_ = 0; rep_ < DUPREPS(8); ++rep_)
    {
        WSP(bf16_t, PB, WS_PB) WSP(bf16_t, Wpp_t, WS_WPP) WSP(bf16_t, PROJ, WS_PROJ)
        pg8::Gemm g{PB, Wpp_t, MTOK, DM, PLE}; pg8::StaticOrder S; S.init(MTOK, DM, GRIDN, BX);
        pg8::EpiBf<false> E{PROJ, DM, nullptr};
        pg8::gemm_phase<pg8::EpiBf<false>, pg8::StaticOrder, true, true>(ldsl, g, S, E);
    }
    xcd_barrier(xbar);
    STAMP(8);

    _Pragma("unroll 1") for (int rep_ = 0; rep_ < DUPREPS(9); ++rep_)
    {
        WSP(bf16_t, XB, WS_XB) WSP(bf16_t, Wpg_t, WS_WPG) WSP(bf16_t, PROJ, WS_PROJ) WSP(float, RS3, WS_RSTD3)
        pg8::Gemm g{XB, Wpg_t, MTOK, DM, DM}; pg8::PanelOrder S; S.init(MTOK, GRIDN, BX);
        WSP(bf16_t, X3B, WS_ACT) WSP(float, RS4, WS_RS2)
        pg8::EpiPle E{XB, PROJ, RS3, X3B, RS4};
        pg8::gemm_phase<pg8::EpiPle, pg8::PanelOrder, true, true>(ldsl, g, S, E);
    }
    xcd_barrier(xbar);
    STAMP(9);

    _Pragma("unroll 1") for (int rep_ = 0; rep_ < DUPREPS(10); ++rep_)
    {
        WSP(bf16_t, X3B, WS_ACT) WSP(float, RS4, WS_RS2)
        const int lane = LANE; const int gw = BX * NWAVES + WAVE, NGW = GRIDN * NWAVES;
        const float* fg = prm.in[21]; float* out = prm.out;
        f32x4 gv[4];
#pragma unroll
        for (int j = 0; j < 4; ++j) gv[j] = ((const f32x4*)fg)[4 * lane + j];
        for (int m = 4 * gw; m < MTOK; m += 4 * NGW) {
            u32x4 xa[4][2]; float ss[4];
#pragma unroll
            for (int k = 0; k < 4; ++k) { const u32x4* xr = (const u32x4*)(X3B + (size_t)(m + k) * DM) + 2 * lane; xa[k][0] = xr[0]; xa[k][1] = xr[1];
                ss[k] = (lane < 16) ? RS4[(size_t)(m + k) * 16 + lane] : 0.f; }
#pragma unroll
            for (int k = 0; k < 4; ++k) { float s = ss[k]; s += __shfl_xor(s, 1); s += __shfl_xor(s, 2); s += __shfl_xor(s, 4); s += __shfl_xor(s, 8); s = __shfl(s, 0);
                const float rstd = __builtin_amdgcn_rsqf(s * (1.0f / DM) + EPS);
                f32x4* o = (f32x4*)(out + (size_t)(m + k) * DM) + 4 * lane;
                const u32x4 w0 = xa[k][0], w1 = xa[k][1];
                o[0] = (f32x4){bflo(w0.x), bfhi(w0.x), bflo(w0.y), bfhi(w0.y)} * rstd * gv[0]; o[1] = (f32x4){bflo(w0.z), bfhi(w0.z), bflo(w0.w), bfhi(w0.w)} * rstd * gv[1];
                o[2] = (f32x4){bflo(w1.x), bfhi(w1.x), bflo(w1.y), bfhi(w1.y)} * rstd * gv[2]; o[3] = (f32x4){bflo(w1.z), bfhi(w1.z), bflo(w1.w), bfhi(w1.w)} * rstd * gv[3]; }
        }
    }
#ifdef PROBE_A
    xcd_barrier(xbar);
    {
        unsigned char* w_ = prm.ws; asm volatile("" : "+s"(w_)); const unsigned long long* ts = (const unsigned long long*)w_;
        const float ta = (float)(ts[PROBE_A + 1] - ts[PROBE_A]) * 0.01f, tb = (float)(ts[PROBE_B + 1] - ts[PROBE_B]) * 0.01f;
        float* out = prm.out;
        if (BX == 0 && TID == 0) out[0] += ta;
        for (size_t i = (size_t)BX * NTHREADS + TID; i < (size_t)1024 * 1024; i += (size_t)GRIDN * NTHREADS) out[1024 + i] += tb * 0.01f;
    }
#endif

}

extern "C" void kernel_launch(void* const* d_in, const int* in_sizes, int n_in, void* d_out, int out_size, void* d_ws, size_t ws_size, hipStream_t stream) {
    static int grid = 0;
    if (grid == 0) {
        if (n_in != 22 || out_size != MTOK * DM || ws_size < WS_END) { fprintf(stderr, "kernel_launch: unexpected problem (n_in %d, out %d, ws %zu)\n", n_in, out_size, ws_size); grid = -1; return; }
        int dev = 0, cus = 0, per_cu = 0;
        if (hipGetDevice(&dev) != hipSuccess || hipDeviceGetAttribute(&cus, hipDeviceAttributeMultiprocessorCount, dev) != hipSuccess) { grid = -1; return; }
        if (hipFuncSetAttribute((const void*)fwd_kernel, hipFuncAttributeMaxDynamicSharedMemorySize, LDS_BYTES) != hipSuccess) { fprintf(stderr, "kernel_launch: hipFuncSetAttribute failed\n"); grid = -1; return; }
        if (hipOccupancyMaxActiveBlocksPerMultiprocessor(&per_cu, (const void*)fwd_kernel, NTHREADS, LDS_BYTES) != hipSuccess || per_cu < 1) { fprintf(stderr, "kernel_launch: occupancy query says %d\n", per_cu); (void)hipGetLastError(); per_cu = 1; }
        grid = cus * 1;
    }
    if (grid < 0) return;
    if (hipMemsetAsync((char*)d_ws + WS_CTL, 0, 65536, stream) != hipSuccess) { fprintf(stderr, "kernel_launch: hipMemsetAsync failed\n"); return; }
    Params p{};
    for (int i = 0; i < 22; ++i) p.in[i] = (const float*)d_in[i];
    p.out = (float*)d_out; p.ws = (unsigned char*)d_ws;
    void* args[] = {&p};
    hipError_t e = hipLaunchCooperativeKernel((const void*)fwd_kernel, dim3(grid), dim3(NTHREADS), args, LDS_BYTES, stream);
    if (e != hipSuccess) fprintf(stderr, "kernel_launch: cooperative launch failed: %s (grid %d)\n", hipGetErrorString(e), grid);
}
```

```cpp
#include <hip/hip_runtime.h>
#include <hip/hip_cooperative_groups.h>
#include <cstdio>
#include <cstdint>
namespace cg = cooperative_groups;
namespace pg8 {
#define PG8_LAS __attribute__((address_space(3)))
typedef unsigned short bf16_t;
typedef short bf16x8 __attribute__((ext_vector_type(8)));
typedef float f32x4 __attribute__((ext_vector_type(4)));
typedef unsigned u32x4 __attribute__((ext_vector_type(4)));
constexpr int BM = 256, BK = 64, HALF = 128, HTB = HALF * BK * 2  , STAGE_BYTES = 8 * HTB, NXCD = 8, WGM = 8;

__host__ __device__ __forceinline__ int lds_byte(int r, int c) { const int st = (r >> 4) * 2 + (c >> 5), rr = r & 15, cc = c & 31, ob = rr * 64 + cc * 2; return st * 1024 + (ob ^ (((ob >> 9) & 1) << 5)); }
__host__ __device__ __forceinline__ void stage_rc(int b, int& R, int& C) { const int st = b / 1024, sb = b % 1024, swz = sb ^ (((sb >> 9) & 1) << 5); R = (st >> 1) * 16 + swz / 64; C = (st & 1) * 32 + (swz % 64) / 2; }
__host__ __device__ __forceinline__ int perm32(int rho) { const int n = rho >> 4, i = rho & 15; return 8 * (i >> 2) + 4 * n + (i & 3); }

struct Unit { int pm, pn; };
struct Gemm { const bf16_t* A; const bf16_t* Bt; int M, N, K; int lda, kstepA; };

struct StaticOrder {
    int nM, nN, nwg, G, c;
    __host__ __device__ void init(int M, int N, int G_, int c_) { nM = M / BM; nN = N / BM; nwg = nM * nN; G = G_; c = c_; }
    __host__ __device__ bool next(int i, Unit& u) const {
        const long L = (long)i * G + c; if (L >= nwg) return false;
        int wgid = (int)L; { const int q = nwg / NXCD, r = nwg % NXCD, xcd = wgid % NXCD, off = wgid / NXCD; wgid = (xcd < r ? xcd * (q + 1) : r * (q + 1) + (xcd - r) * q) + off; }
        const int nig = WGM * nN, gid = wgid / nig, fm = gid * WGM, gsz = (nM - fm) < WGM ? (nM - fm) : WGM;
        u.pm = fm + ((wgid % nig) % gsz); u.pn = (wgid % nig) / gsz; return true;
    }
    __device__ __forceinline__ void a_ready(const Unit&) const {}
    __device__ __forceinline__ void done(const Unit&) const {}
    __device__ __forceinline__ const char* a_tile(const Gemm& g, const Unit& u, size_t tstepA) const { return (const char*)g.A + (size_t)u.pm * tstepA; }
    __device__ __forceinline__ const char* b_tile(const Gemm& g, const Unit& u, size_t tstepB) const { return (const char*)g.Bt + (size_t)u.pn * tstepB; }
};

__device__ __forceinline__ unsigned cvt_pk_bf16(float lo, float hi) { unsigned r; asm volatile("v_cvt_pk_bf16_f32 %0, %1, %2" : "=v"(r) : "v"(lo), "v"(hi)); return r; }
typedef float f32x2 __attribute__((ext_vector_type(2)));
__device__ __forceinline__ f32x2 gelu_pk(f32x2 v) {
    const f32x2 av = __builtin_elementwise_abs(v), d = av * 0.2316418882f + 1.0f;
    f32x2 t; t.x = __builtin_amdgcn_rcpf(d.x); t.y = __builtin_amdgcn_rcpf(d.y);
    f32x2 q = t * 0.5307027145f + (-0.7265760135f); q = q * t + 0.7107068705f; q = q * t + (-0.142248368f); q = q * t + 0.127414796f; q = q * t;
    const f32x2 s = (v * v) * (-0.72134752044f);
    f32x2 e; e.x = __builtin_amdgcn_exp2f(s.x); e.y = __builtin_amdgcn_exp2f(s.y);
    const f32x2 m = v * (q * e), r = v - m;
    f32x2 o; o.x = v.x < 0.f ? m.x : r.x; o.y = v.y < 0.f ? m.y : r.y; return o;
}

template <int ACT  > struct EpiBf16 {
    static constexpr bool PERM = true, AFTER_DRAIN = false; static_assert(ACT == 0 || ACT == 1, "EpiBf16: ACT is 0 (none) or 1 (gelu_pk)");
    bf16_t* O; int ldc; const float* bias; int split_cols; size_t split_stride; float scale0;
    __device__ __forceinline__ void operator()(const f32x4 (&acc)[2][2][4][2], const Unit& u, int wr, int wc, int fr, int fq) const {
        const int row0 = u.pm * BM + wr * 64 + fr; int colt = u.pn * BM; bf16_t* base = O;
        float sc = 1.f; if (split_cols) { const int t = colt / split_cols; base += (size_t)t * split_stride; colt -= t * split_cols; if (t == 0) sc = scale0; }
        const int col0 = colt + wc * 32 + 8 * fq, bcol0 = u.pn * BM + wc * 32 + 8 * fq;
        f32x4 bv[2][2];
#pragma unroll
        for (int bj = 0; bj < 2; ++bj)
#pragma unroll
            for (int n = 0; n < 2; ++n) bv[bj][n] = bias ? *(const f32x4*)(bias + bcol0 + bj * HALF + 4 * n) : (f32x4){0.f, 0.f, 0.f, 0.f};
#pragma unroll
        for (int ai = 0; ai < 2; ++ai)
#pragma unroll
            for (int m = 0; m < 4; ++m) { bf16_t* rowp = base + (size_t)(row0 + ai * HALF + m * 16) * ldc + col0;
#pragma unroll
                for (int bj = 0; bj < 2; ++bj) { f32x4 v0 = acc[ai][bj][m][0] + bv[bj][0], v1 = acc[ai][bj][m][1] + bv[bj][1];
                    if (ACT == 1) { f32x2 a = gelu_pk((f32x2){v0[0], v0[1]}), b = gelu_pk((f32x2){v0[2], v0[3]}), c = gelu_pk((f32x2){v1[0], v1[1]}), d = gelu_pk((f32x2){v1[2], v1[3]});
                        v0 = (f32x4){a.x, a.y, b.x, b.y}; v1 = (f32x4){c.x, c.y, d.x, d.y}; }
                    v0 = v0 * sc; v1 = v1 * sc; u32x4 w; w.x = cvt_pk_bf16(v0[0], v0[1]); w.y = cvt_pk_bf16(v0[2], v0[3]); w.z = cvt_pk_bf16(v1[0], v1[1]); w.w = cvt_pk_bf16(v1[2], v1[3]);
                    *(u32x4*)(rowp + bj * HALF) = w; } }
    }
};
template <class Epi, class Sched, bool ALIGN_EPI = false, bool SP2 = false>
__device__ __forceinline__ void gemm_phase(PG8_LAS unsigned char* lds, const Gemm g, const Sched& S, Epi& E) {
    int tid_ = threadIdx.x; asm volatile("" : "+v"(tid_));
    const int tid = tid_, wid = __builtin_amdgcn_readfirstlane(tid >> 6), lane = tid & 63, wr = wid >> 2, wc = wid & 3, fr = lane & 15, fq = lane >> 4;
    int K_ = g.K; asm volatile("" : "+s"(K_)); const int K = K_, nt = K / BK;
    const int lda = g.lda ? g.lda : K;
    unsigned voffA[2], voffB[2];
#pragma unroll
    for (int i = 0; i < 2; ++i) { int R, C; stage_rc(tid * 16 + i * 8192, R, C); const int Rb = Epi::PERM ? ((R & ~31) + perm32(R & 31)) : R;
        voffA[i] = (unsigned)(R * lda + C) * 2u; voffB[i] = (unsigned)(Rb * K + C) * 2u; }
    const size_t kstepB = (size_t)(BK * 2), kstepA = g.kstepA ? (size_t)g.kstepA : kstepB;
    const size_t hstepB = (size_t)HALF * K * 2, hstepA = (size_t)HALF * lda * 2;
    const size_t tstepB = 2 * hstepB, tstepA = 2 * hstepA;
    const unsigned ldsw = (unsigned)wid * 1024u;
    const int aoff = lds_byte(wr * 64 + fr, fq * 8), boff = lds_byte(wc * 32 + fr, fq * 8);
#define PG8_SA(b, h) (((b) * 2 + (h)) * HTB)
#define PG8_SB(b, h) ((4 + (b) * 2 + (h)) * HTB)
#define PG8_STAGE(bufoff, gbase, voff) do { _Pragma("unroll") for (int _i = 0; _i < 2; ++_i) \
        __builtin_amdgcn_global_load_lds((const unsigned*)((const char*)(gbase) + (voff)[_i]), (PG8_LAS unsigned*)(lds + (bufoff) + ldsw + _i * 8192), 16, 0, 0); } while (0)
#define PG8_LDA(dst, b, h) do { _Pragma("unroll") for (int m = 0; m < 4; ++m) _Pragma("unroll") for (int k = 0; k < 2; ++k) dst[m][k] = *(const PG8_LAS bf16x8*)(lds + PG8_SA(b, h) + aoff + m * 2048 + k * 1024); } while (0)
#define PG8_LDB(dst, b, h) do { _Pragma("unroll") for (int n = 0; n < 2; ++n) _Pragma("unroll") for (int k = 0; k < 2; ++k) dst[n][k] = *(const PG8_LAS bf16x8*)(lds + PG8_SB(b, h) + boff + n * 2048 + k * 1024); } while (0)
#define PG8_MMA(ai, bj, At, Bt) do { __builtin_amdgcn_s_setprio(1); _Pragma("unroll") for (int m = 0; m < 4; ++m) _Pragma("unroll") for (int n = 0; n < 2; ++n) _Pragma("unroll") for (int k = 0; k < 2; ++k) \
        acc[ai][bj][m][n] = __builtin_amdgcn_mfma_f32_16x16x32_bf16(Bt[n][k], At[m][k], acc[ai][bj][m][n], 0, 0, 0); __builtin_amdgcn_s_setprio(0); } while (0)
#define PG8_WAIT_V(n) asm volatile("s_waitcnt vmcnt(" #n ")" ::: "memory")
#define PG8_WAIT_L(n) asm volatile("s_waitcnt lgkmcnt(" #n ")" ::: "memory")
#define PG8_BAR __builtin_amdgcn_s_barrier()
#define PG8_SCHED __builtin_amdgcn_sched_barrier(0)
    Unit cur, nxt; int ui = 0;
    if (!S.next(0, cur)) return;
    f32x4 acc[2][2][4][2];
#pragma unroll
    for (int a = 0; a < 2; ++a)
#pragma unroll
        for (int b = 0; b < 2; ++b)
#pragma unroll
            for (int m = 0; m < 4; ++m)
#pragma unroll
                for (int n = 0; n < 2; ++n) acc[a][b][m][n] = (f32x4){0.f, 0.f, 0.f, 0.f};
    bf16x8 At[4][2], B0[2][2], B1[2][2];
    const char* cA = S.a_tile(g, cur, tstepA); const char* cB = S.b_tile(g, cur, tstepB);
    S.a_ready(cur);
    if constexpr (SP2) {
        PG8_STAGE(PG8_SB(0, 0), cB, voffB); PG8_STAGE(PG8_SB(0, 1), cB + hstepB, voffB); PG8_STAGE(PG8_SA(0, 0), cA, voffA); PG8_STAGE(PG8_SA(0, 1), cA + hstepA, voffA);
        if (wr == 1) PG8_BAR;
        PG8_WAIT_V(2); PG8_BAR;
        PG8_STAGE(PG8_SB(1, 0), cB + kstepB, voffB); PG8_STAGE(PG8_SA(1, 0), cA + kstepA, voffA); PG8_STAGE(PG8_SB(1, 1), cB + hstepB + kstepB, voffB);
        PG8_WAIT_V(6); PG8_BAR;
    } else {
        PG8_STAGE(PG8_SB(0, 0), cB, voffB); PG8_STAGE(PG8_SA(0, 0), cA, voffA); PG8_STAGE(PG8_SB(0, 1), cB + hstepB, voffB); PG8_STAGE(PG8_SA(0, 1), cA + hstepA, voffA);
        if (wr == 1) PG8_BAR;
        PG8_WAIT_V(4); PG8_BAR;
        PG8_STAGE(PG8_SB(1, 0), cB + kstepB, voffB); PG8_STAGE(PG8_SA(1, 0), cA + kstepA, voffA); PG8_STAGE(PG8_SB(1, 1), cB + hstepB + kstepB, voffB);
        PG8_WAIT_V(6); PG8_BAR;
    }
    for (;;) {
        const bool has_next = S.next(ui + 1, nxt);
        const char* nA = has_next ? S.a_tile(g, nxt, tstepA) : cA; const char* nB = has_next ? S.b_tile(g, nxt, tstepB) : cB;
        for (int t = 0; t < nt; t += 2) {
            const bool last = (t == nt - 2);
            const char* a1 = cA + (size_t)(t + 1) * kstepA;
            const char* a2 = last ? nA : cA + (size_t)(t + 2) * kstepA; const char* b2 = last ? nB : cB + (size_t)(t + 2) * kstepB;
            const char* a3 = a2 + kstepA; const char* b3 = b2 + kstepB;
            if (last && has_next) S.a_ready(nxt);
            if constexpr (SP2) {
            PG8_LDB(B0, 0, 0); PG8_LDB(B1, 0, 1); PG8_SCHED; PG8_LDA(At, 0, 0); PG8_STAGE(PG8_SA(1, 1), a1 + hstepA, voffA);
            PG8_WAIT_V(8); PG8_WAIT_L(0); PG8_BAR; PG8_MMA(0, 0, At, B0); PG8_MMA(0, 1, At, B1); PG8_BAR; PG8_SCHED;
            PG8_LDA(At, 0, 1); PG8_STAGE(PG8_SB(0, 0), b2, voffB); PG8_STAGE(PG8_SB(0, 1), b2 + hstepB, voffB); PG8_STAGE(PG8_SA(0, 0), a2, voffA);
            PG8_WAIT_V(8); PG8_WAIT_L(0); PG8_BAR; PG8_MMA(1, 0, At, B0); PG8_MMA(1, 1, At, B1); PG8_BAR; PG8_SCHED;
            PG8_LDB(B0, 1, 0); PG8_LDB(B1, 1, 1); PG8_SCHED; PG8_LDA(At, 1, 0); PG8_STAGE(PG8_SA(0, 1), a2 + hstepA, voffA);
            PG8_WAIT_V(8); PG8_WAIT_L(0); PG8_BAR; PG8_MMA(0, 0, At, B0); PG8_MMA(0, 1, At, B1); PG8_BAR; PG8_SCHED;
            PG8_LDA(At, 1, 1); PG8_STAGE(PG8_SB(1, 0), b3, voffB); PG8_STAGE(PG8_SB(1, 1), b3 + hstepB, voffB); PG8_STAGE(PG8_SA(1, 0), a3, voffA);
            PG8_WAIT_V(8); PG8_WAIT_L(0); PG8_BAR; PG8_MMA(1, 0, At, B0); PG8_MMA(1, 1, At, B1); PG8_BAR; PG8_SCHED;
            } else {
            PG8_LDB(B0, 0, 0); PG8_SCHED; PG8_LDA(At, 0, 0); PG8_STAGE(PG8_SA(1, 1), a1 + hstepA, voffA);
            PG8_WAIT_L(8); PG8_BAR; PG8_WAIT_L(0); PG8_MMA(0, 0, At, B0); PG8_BAR; PG8_SCHED;
            PG8_LDB(B1, 0, 1); PG8_STAGE(PG8_SB(0, 0), b2, voffB);
            PG8_BAR; PG8_WAIT_L(0); PG8_MMA(0, 1, At, B1); PG8_BAR;
            PG8_LDA(At, 0, 1); PG8_STAGE(PG8_SA(0, 0), a2, voffA);
            PG8_BAR; PG8_WAIT_L(0); PG8_MMA(1, 0, At, B0); PG8_BAR; PG8_SCHED;
            PG8_STAGE(PG8_SB(0, 1), b2 + hstepB, voffB);
            PG8_WAIT_V(6); PG8_BAR; PG8_MMA(1, 1, At, B1); PG8_BAR;
            PG8_LDB(B0, 1, 0); PG8_SCHED; PG8_LDA(At, 1, 0); PG8_STAGE(PG8_SA(0, 1), a2 + hstepA, voffA);
            PG8_WAIT_L(8); PG8_BAR; PG8_WAIT_L(0); PG8_MMA(0, 0, At, B0); PG8_BAR; PG8_SCHED;
            PG8_LDB(B1, 1, 1); PG8_STAGE(PG8_SB(1, 0), b3, voffB);
            PG8_BAR; PG8_WAIT_L(0); PG8_MMA(0, 1, At, B1); PG8_BAR;
            PG8_LDA(At, 1, 1); PG8_STAGE(PG8_SA(1, 0), a3, voffA);
            PG8_BAR; PG8_WAIT_L(0); PG8_MMA(1, 0, At, B0); PG8_BAR; PG8_SCHED;
            PG8_STAGE(PG8_SB(1, 1), b3 + hstepB, voffB);
            PG8_WAIT_V(6); PG8_BAR; PG8_MMA(1, 1, At, B1); PG8_BAR;
            }
        }
        if constexpr (ALIGN_EPI) { if (wr == 0) PG8_BAR; }
        if constexpr (!Epi::AFTER_DRAIN) { E(acc, cur, wr, wc, fr, fq); S.done(cur); }
        if (!has_next) break;
#pragma unroll
        for (int a = 0; a < 2; ++a)
#pragma unroll
            for (int b = 0; b < 2; ++b)
#pragma unroll
                for (int m = 0; m < 4; ++m)
#pragma unroll
                    for (int n = 0; n < 2; ++n) acc[a][b][m][n] = (f32x4){0.f, 0.f, 0.f, 0.f};
        cur = nxt; cA = nA; cB = nB; ++ui;
        if constexpr (ALIGN_EPI) { if (wr == 1) PG8_BAR; }
    }
    PG8_WAIT_V(0);
    if constexpr (!ALIGN_EPI) { if (wr == 0) PG8_BAR; }
    PG8_BAR;
    if constexpr (Epi::AFTER_DRAIN) { E.fused(acc, cur, wr, wc, fr, fq, lds, wid, lane); S.done(cur); }
#undef PG8_SA
#undef PG8_SB
#undef PG8_STAGE
#undef PG8_LDA
#undef PG8_LDB
#undef PG8_MMA
#undef PG8_WAIT_V
#undef PG8_WAIT_L
#undef PG8_BAR
#undef PG8_SCHED
}
}

constexpr int BATCH = 16, SEQ = 4096, DM = 1024, MTOK = BATCH * SEQ;
constexpr int NZ = 3584;
constexpr int ZC_MQ = 0, ZC_MK = 512, ZC_MV = 1024, ZC_MO = 1536, ZC_AQ = 2056, ZC_AKC = 2568, ZC_AVC = 2696, ZC_AKS = 2824, ZC_AVS = 2952, ZC_AKW = 3080, ZC_AVW = 3208;
constexpr int DFF = 2048, PLE = 256, NCMP = 255;
constexpr float EPS = 1e-6f;
constexpr int NWAVES = 8, NTHREADS = 512;
constexpr int LDS_BYTES = 163840;
constexpr int XBAR_LDS = 163840 - 256;

typedef unsigned short bf16_t;
typedef float f32x4 __attribute__((ext_vector_type(4)));
typedef unsigned u32x4 __attribute__((ext_vector_type(4)));
typedef unsigned u32x2 __attribute__((ext_vector_type(2)));

constexpr size_t MiB = 1u << 20;
constexpr size_t WS_CTL = 0;
constexpr size_t WS_WIN = 1 * MiB, WS_WOUT = 8 * MiB, WS_WUP = 10 * MiB, WS_WDN = 18 * MiB, WS_WPG = 22 * MiB, WS_WPP = 24 * MiB;
constexpr size_t WS_W1T = 25 * MiB, WS_W2T = 26 * MiB, WS_C1 = WS_CTL + 32768, WS_KCB = 29 * MiB, WS_VCT = 30 * MiB;
constexpr size_t WS_GATES = 32 * MiB, WS_PB = 40 * MiB, WS_XB = 72 * MiB;
constexpr size_t WS_MIX = 200 * MiB, WS_ACT = 200 * MiB;
constexpr size_t WS_Z = 456 * MiB, WS_U = 456 * MiB, WS_PROJ = 456 * MiB;
constexpr size_t WS_RS2 = 968 * MiB, WS_RS3 = 972 * MiB;
constexpr size_t WS_RSTD2 = 31 * MiB, WS_RSTD3 = 31 * MiB + 512 * 1024;
constexpr size_t WS_VST = 976 * MiB, WS_VWT = 992 * MiB;
constexpr size_t WS_END = 1008 * MiB;

struct Params { const float* in[22]; float* out; unsigned char* ws; };

__device__ __forceinline__ float bf2f(unsigned u16) { return __uint_as_float(u16 << 16); }
__device__ __forceinline__ float bflo(unsigned w) { return __uint_as_float(w << 16); }
__device__ __forceinline__ float bfhi(unsigned w) { return __uint_as_float(w & 0xffff0000u); }
__device__ __forceinline__ unsigned f2bf(float f) { unsigned u = __float_as_uint(f); return (u + 0x7fffu + ((u >> 16) & 1u)) >> 16; }
__device__ __forceinline__ unsigned pk2(float lo, float hi) { return f2bf(lo) | (f2bf(hi) << 16); }
__device__ __forceinline__ float wave_sum(float v) {
#pragma unroll
    for (int o = 1; o < 64; o <<= 1) v += __shfl_xor(v, o);
    return v;
}
__device__ __forceinline__ float wave_max(float v) {
#pragma unroll
    for (int o = 1; o < 64; o <<= 1) v = fmaxf(v, __shfl_xor(v, o));
    return v;
}
__device__ __forceinline__ float sigmoidf_(float x) { return __builtin_amdgcn_rcpf(1.0f + __expf(-x)); }
__device__ __forceinline__ float log_sigmoidf_(float x) { return fminf(x, 0.f) - __logf(1.0f + __expf(-fabsf(x))); }
#define WAVE_LDS_SYNC() asm volatile("s_waitcnt lgkmcnt(0)" ::: "memory")

namespace pg8 {
__device__ __forceinline__ float row_rstd(const float* rs, int row) {
    const f32x4* p = (const f32x4*)(rs + (size_t)row * 16); const f32x4 a = p[0], b = p[1], c = p[2], d = p[3];
    const float s = (((a[0] + a[1]) + (a[2] + a[3])) + ((b[0] + b[1]) + (b[2] + b[3]))) + (((c[0] + c[1]) + (c[2] + c[3])) + ((d[0] + d[1]) + (d[2] + d[3])));
    return 1.0f / sqrtf(s * (1.0f / 1024.0f) + EPS);
}
struct EpiZ {
    static constexpr bool PERM = true, AFTER_DRAIN = false;
    bf16_t* Z; float* gates;
    __device__ __forceinline__ void operator()(const f32x4 (&acc)[2][2][4][2], const Unit& u, int wr, int wc, int fr, int fq) {
        const int row0 = u.pm * BM + wr * 64 + fr; const int col0 = u.pn * BM + wc * 32 + 8 * fq;
#pragma unroll
        for (int ai = 0; ai < 2; ++ai)
#pragma unroll
            for (int m = 0; m < 4; ++m) { const int row = row0 + ai * HALF + m * 16; bf16_t* rowp = Z + (size_t)row * NZ + col0;
#pragma unroll
                for (int bj = 0; bj < 2; ++bj) { const f32x4 v0 = acc[ai][bj][m][0], v1 = acc[ai][bj][m][1];
                    u32x4 w; w.x = cvt_pk_bf16(v0[0], v0[1]); w.y = cvt_pk_bf16(v0[2], v0[3]); w.z = cvt_pk_bf16(v1[0], v1[1]); w.w = cvt_pk_bf16(v1[2], v1[3]);
                    *(u32x4*)(rowp + bj * HALF) = w; }
                if (wc == 0) {
                    if ((u.pn == 8 && fq == 0) || (u.pn == 13 && fq >= 1)) {
                        float* gp = gates + (size_t)row * 32 + 8 * fq;
                        *(f32x4*)(gp) = acc[ai][0][m][0]; *(f32x4*)(gp + 4) = acc[ai][0][m][1];
                    }
                }
            }
    }
};
template <bool ROWSCALE> struct EpiBf {
    static constexpr bool PERM = true, AFTER_DRAIN = false;
    bf16_t* O; int ldc; const float* rs;
    __device__ __forceinline__ void operator()(const f32x4 (&acc)[2][2][4][2], const Unit& u, int wr, int wc, int fr, int fq) {
        const int row0 = u.pm * BM + wr * 64 + fr; const int col0 = u.pn * BM + wc * 32 + 8 * fq;
#pragma unroll
        for (int ai = 0; ai < 2; ++ai)
#pragma unroll
            for (int m = 0; m < 4; ++m) { const int row = row0 + ai * HALF + m * 16; bf16_t* rowp = O + (size_t)row * ldc + col0;
                float sc = 1.f;
                if (ROWSCALE) sc = row_rstd(rs, row);
#pragma unroll
                for (int bj = 0; bj < 2; ++bj) { const f32x4 v0 = acc[ai][bj][m][0] * sc, v1 = acc[ai][bj][m][1] * sc;
                    u32x4 w; w.x = cvt_pk_bf16(v0[0], v0[1]); w.y = cvt_pk_bf16(v0[2], v0[3]); w.z = cvt_pk_bf16(v1[0], v1[1]); w.w = cvt_pk_bf16(v1[2], v1[3]);
                    *(u32x4*)(rowp + bj * HALF) = w; }
            }
    }
};
template <bool BASE_F32> struct EpiRes {
    static constexpr bool PERM = true, AFTER_DRAIN = false;
    const float* basef; const bf16_t* baseb; bf16_t* xb; float* rs;
    __device__ __forceinline__ void operator()(const f32x4 (&acc)[2][2][4][2], const Unit& u, int wr, int wc, int fr, int fq) const {
        const int row0 = u.pm * BM + wr * 64 + fr, col0 = u.pn * BM + wc * 32 + 8 * fq;
#pragma unroll
        for (int ai = 0; ai < 2; ++ai)
#pragma unroll
            for (int m = 0; m < 4; ++m) { const int row = row0 + ai * HALF + m * 16; const size_t off = (size_t)row * DM + col0; float s = 0.f;
#pragma unroll
                for (int bj = 0; bj < 2; ++bj) { f32x4 b0, b1;
                    if (BASE_F32) { b0 = *(const f32x4*)(basef + off + bj * HALF); b1 = *(const f32x4*)(basef + off + bj * HALF + 4); }
                    else { const u32x4 w = *(const u32x4*)(baseb + off + bj * HALF); b0 = (f32x4){bflo(w.x), bfhi(w.x), bflo(w.y), bfhi(w.y)}; b1 = (f32x4){bflo(w.z), bfhi(w.z), bflo(w.w), bfhi(w.w)}; }
                    const f32x4 o0 = b0 + acc[ai][bj][m][0], o1 = b1 + acc[ai][bj][m][1];
                    u32x4 w; w.x = cvt_pk_bf16(o0[0], o0[1]); w.y = cvt_pk_bf16(o0[2], o0[3]); w.z = cvt_pk_bf16(o1[0], o1[1]); w.w = cvt_pk_bf16(o1[2], o1[3]);
                    *(u32x4*)(xb + off + bj * HALF) = w;
                    s += ((o0[0] * o0[0] + o0[1] * o0[1]) + (o0[2] * o0[2] + o0[3] * o0[3])) + ((o1[0] * o1[0] + o1[1] * o1[1]) + (o1[2] * o1[2] + o1[3] * o1[3])); }
                s += __shfl_xor(s, 16); s += __shfl_xor(s, 32);
                if (fq == 0) rs[(size_t)row * 16 + u.pn * 4 + wc] = s; }
    }
};
struct EpiPle {
    static constexpr bool PERM = true, AFTER_DRAIN = false;
    const bf16_t* x2b; const bf16_t* proj; const float* rstd; bf16_t* x3b; float* rs;
    __device__ __forceinline__ void operator()(const f32x4 (&acc)[2][2][4][2], const Unit& u, int wr, int wc, int fr, int fq) const {
        const int row0 = u.pm * BM + wr * 64 + fr, col0 = u.pn * BM + wc * 32 + 8 * fq;
#pragma unroll
        for (int ai = 0; ai < 2; ++ai)
#pragma unroll
            for (int m = 0; m < 4; ++m) { const int row = row0 + ai * HALF + m * 16; const size_t off = (size_t)row * DM + col0; float s = 0.f;
                const float sc = rstd[row];
#pragma unroll
                for (int bj = 0; bj < 2; ++bj) { const u32x4 xw = *(const u32x4*)(x2b + off + bj * HALF), pw = *(const u32x4*)(proj + off + bj * HALF);
                    const f32x4 a0 = acc[ai][bj][m][0] * sc, a1 = acc[ai][bj][m][1] * sc; f32x4 o0, o1;
                    o0[0] = bflo(xw.x) + sigmoidf_(a0[0]) * bflo(pw.x); o0[1] = bfhi(xw.x) + sigmoidf_(a0[1]) * bfhi(pw.x); o0[2] = bflo(xw.y) + sigmoidf_(a0[2]) * bflo(pw.y); o0[3] = bfhi(xw.y) + sigmoidf_(a0[3]) * bfhi(pw.y);
                    o1[0] = bflo(xw.z) + sigmoidf_(a1[0]) * bflo(pw.z); o1[1] = bfhi(xw.z) + sigmoidf_(a1[1]) * bfhi(pw.z); o1[2] = bflo(xw.w) + sigmoidf_(a1[2]) * bflo(pw.w); o1[3] = bfhi(xw.w) + sigmoidf_(a1[3]) * bfhi(pw.w);
                    u32x4 w; w.x = cvt_pk_bf16(o0[0], o0[1]); w.y = cvt_pk_bf16(o0[2], o0[3]); w.z = cvt_pk_bf16(o1[0], o1[1]); w.w = cvt_pk_bf16(o1[2], o1[3]);
                    *(u32x4*)(x3b + off + bj * HALF) = w;
                    s += ((o0[0] * o0[0] + o0[1] * o0[1]) + (o0[2] * o0[2] + o0[3] * o0[3])) + ((o1[0] * o1[0] + o1[1] * o1[1]) + (o1[2] * o1[2] + o1[3] * o1[3])); }
                s += __shfl_xor(s, 16); s += __shfl_xor(s, 32);
                if (fq == 0) rs[(size_t)row * 16 + u.pn * 4 + wc] = s; }
    }
};
struct PanelOrder {
    int nM, G, c, nN = 4;
    __host__ __device__ void init(int M, int G_, int c_, int nN_ = 4) { nM = M / BM; G = G_; c = c_; nN = nN_; }
    __host__ __device__ bool next(int i, Unit& u) const { const int p = c + G * (i / nN); if (p >= nM) return false; u.pm = p; u.pn = i % nN; return true; }
    __device__ __forceinline__ void a_ready(const Unit&) const {}
    __device__ __forceinline__ void done(const Unit&) const {}
    __device__ __forceinline__ const char* a_tile(const Gemm& g, const Unit& u, size_t tstepA) const { return (const char*)g.A + (size_t)u.pm * tstepA; }
    __device__ __forceinline__ const char* b_tile(const Gemm& g, const Unit& u, size_t tstepB) const { return (const char*)g.Bt + (size_t)u.pn * tstepB; }
};
struct ChainOrder {
    int c;
    __host__ __device__ bool next(int i, Unit& u) const { if (i >= 16) return false; u.pm = (c >> 4) * 16 + i; u.pn = c & 15; return true; }
    __device__ __forceinline__ void a_ready(const Unit&) const {}
    __device__ __forceinline__ void done(const Unit&) const {}
    __device__ __forceinline__ const char* a_tile(const Gemm& g, const Unit& u, size_t tstepA) const { return (const char*)g.A + (size_t)u.pm * tstepA; }
    __device__ __forceinline__ const char* b_tile(const Gemm& g, const Unit& u, size_t tstepB) const { return (const char*)g.Bt + (size_t)u.pn * tstepB; }
};
__device__ __forceinline__ float dpp_ror1(float v) { return __builtin_bit_cast(float, __builtin_amdgcn_update_dpp(0, __builtin_bit_cast(int, v), 0x121, 0xf, 0xf, false)); }
__device__ __forceinline__ float dpp_ror2(float v) { return __builtin_bit_cast(float, __builtin_amdgcn_update_dpp(0, __builtin_bit_cast(int, v), 0x122, 0xf, 0xf, false)); }
struct EpiUpConv {
    static constexpr bool PERM = true, AFTER_DRAIN = false;
    bf16_t* ACT; const float* rs; const float* cw; const float* cb; PG8_LAS float* car;
    __device__ __forceinline__ void operator()(f32x4 (&acc)[2][2][4][2], const Unit& u, int wr, int wc, int fr, int fq) const {
        const int par = u.pm & 1; const bool first = (u.pm & 15) == 0;
        const int colg = 32 * wc + 8 * fq, gc = 128 * u.pn + colg;
#pragma unroll
        for (int ai = 0; ai < 2; ++ai)
#pragma unroll
            for (int m = 0; m < 4; ++m) { const float sc = rs[u.pm * BM + ai * HALF + wr * 64 + m * 16 + fr];
#pragma unroll
                for (int n = 0; n < 2; ++n) { acc[ai][0][m][n] *= sc; acc[ai][1][m][n] *= sc; } }
        if (fr >= 14) {
#pragma unroll
            for (int ai = 0; ai < 2; ++ai)
#pragma unroll
                for (int n = 0; n < 2; ++n) *(PG8_LAS f32x4*)(car + ((par * 4 + 2 * ai + wr) * 2 + (fr - 14)) * 128 + colg + 4 * n) = acc[ai][0][3][n]; }
        asm volatile("s_waitcnt lgkmcnt(0)" ::: "memory"); __builtin_amdgcn_s_barrier(); asm volatile("" ::: "memory");
#pragma unroll
        for (int ai = 0; ai < 2; ++ai) { const int sl = 2 * ai + wr;
            const PG8_LAS float* src = (sl == 0) ? car + ((par ^ 1) * 4 + 3) * 256 : car + (par * 4 + sl - 1) * 256;
            const bool zero_in = first && sl == 0;
#pragma unroll
            for (int n = 0; n < 2; ++n) {
                asm volatile("" ::: "memory");
                f32x4 c2 = *(const PG8_LAS f32x4*)(src + colg + 4 * n), c1 = *(const PG8_LAS f32x4*)(src + 128 + colg + 4 * n);
                if (zero_in) { c2 = (f32x4){0.f, 0.f, 0.f, 0.f}; c1 = c2; }
                const f32x4 w0 = *(const f32x4*)(cw + gc + 4 * n), w1 = *(const f32x4*)(cw + DFF + gc + 4 * n), w2 = *(const f32x4*)(cw + 2 * DFF + gc + 4 * n), bb = *(const f32x4*)(cb + gc + 4 * n);
#pragma unroll
                for (int e = 0; e < 4; ++e) { float tm1 = c1[e], tm2 = (fr == 1) ? c1[e] : c2[e];
#pragma unroll
                    for (int m = 0; m < 4; ++m) { const float x = acc[ai][0][m][n][e]; const float t1 = dpp_ror1(x), t2 = dpp_ror2(x);
                        const float p1 = fr >= 1 ? t1 : tm1, p2 = fr >= 2 ? t2 : tm2;
                        const float cv = w0[e] * p2 + w1[e] * p1 + w2[e] * x + bb[e];
                        acc[ai][1][m][n][e] = cv * __builtin_amdgcn_rcpf(1.0f + __expf(-cv)) * acc[ai][1][m][n][e];
                        tm1 = t1; tm2 = t2; } } }
#pragma unroll
            for (int m = 0; m < 4; ++m) { const int row = u.pm * BM + ai * HALF + wr * 64 + m * 16 + fr; const f32x4 v0 = acc[ai][1][m][0], v1 = acc[ai][1][m][1];
                u32x4 w; w.x = cvt_pk_bf16(v0[0], v0[1]); w.y = cvt_pk_bf16(v0[2], v0[3]); w.z = cvt_pk_bf16(v1[0], v1[1]); w.w = cvt_pk_bf16(v1[2], v1[3]);
                *(u32x4*)(ACT + (size_t)row * DFF + gc) = w; } }
    }
};
struct CmpOrder {
    int c; const bf16_t* Z; const bf16_t* w1t;
    __host__ __device__ bool next(int i, Unit& u) const { if (i > 0 || c >= 64) return false; u.pm = c; u.pn = 0; return true; }
    __device__ __forceinline__ void a_ready(const Unit&) const {}
    __device__ __forceinline__ void done(const Unit&) const {}
    __device__ __forceinline__ const char* a_tile(const Gemm&, const Unit& u, size_t) const { const int kv = u.pm >> 5, b = (u.pm >> 1) & 15, gg = u.pm & 1; return (const char*)(Z + (size_t)b * SEQ * NZ + (kv ? ZC_AVC : ZC_AKC) + gg * 64); }
    __device__ __forceinline__ const char* b_tile(const Gemm&, const Unit& u, size_t) const { return (const char*)(w1t + (size_t)(u.pm >> 5) * 256 * 1024); }
};
struct EpiCmp {
    static constexpr bool PERM = false, AFTER_DRAIN = true;
    const float* c1; const bf16_t* w2t; bf16_t* kcb; bf16_t* vct;
    __device__ __forceinline__ void fused(f32x4 (&acc)[2][2][4][2], const Unit& u, int wr, int wc, int fr, int fq, PG8_LAS unsigned char* lds, int wid, int lane) const {
        const int kv = u.pm >> 5, bgi = u.pm & 31;
        const int cc0 = 32 * wc + 4 * fq;
#pragma unroll
        for (int ai = 0; ai < 2; ++ai)
#pragma unroll
            for (int m = 0; m < 4; ++m) { const int r = 128 * ai + 64 * wr + 16 * m + fr;
#pragma unroll
                for (int n = 0; n < 2; ++n) *(PG8_LAS f32x4*)(lds + (r * 128 + cc0 + 16 * n) * 4) = acc[ai][1][m][n]; }
        asm volatile("s_waitcnt lgkmcnt(0)" ::: "memory"); __builtin_amdgcn_s_barrier(); asm volatile("" ::: "memory");
#pragma unroll
        for (int ai = 0; ai < 2; ++ai)
#pragma unroll
            for (int m = 0; m < 4; ++m) { const int r = 128 * ai + 64 * wr + 16 * m + fr; const int rr = r < 255 ? r + 1 : 255;
#pragma unroll
                for (int n = 0; n < 2; ++n) { const f32x4 rv = *(const PG8_LAS f32x4*)(lds + (rr * 128 + cc0 + 16 * n) * 4); const f32x4 bv = *(const f32x4*)(c1 + kv * 128 + cc0 + 16 * n);
                    f32x4 x = acc[ai][0][m][n] + rv + bv;
#pragma unroll
                    for (int e = 0; e < 4; ++e) { const float y = 1.5957691216057308f * (x[e] + 0.044715f * x[e] * x[e] * x[e]); x[e] = x[e] * __builtin_amdgcn_rcpf(1.0f + __expf(-y)); }
                    acc[ai][0][m][n] = x; } }
        asm volatile("s_waitcnt lgkmcnt(0)" ::: "memory"); __builtin_amdgcn_s_barrier(); asm volatile("" ::: "memory");
#pragma unroll
        for (int ai = 0; ai < 2; ++ai)
#pragma unroll
            for (int m = 0; m < 4; ++m) { const int r = 128 * ai + 64 * wr + 16 * m + fr;
#pragma unroll
                for (int n = 0; n < 2; ++n) { const f32x4 x = acc[ai][0][m][n]; u32x2 w; w.x = cvt_pk_bf16(x[0], x[1]); w.y = cvt_pk_bf16(x[2], x[3]); *(PG8_LAS u32x2*)(lds + r * 272 + (cc0 + 16 * n) * 2) = w; } }
        { const int t = wid * 64 + lane, d = t >> 3, ch = t & 7; const u32x4* src = (const u32x4*)(w2t + (size_t)kv * 64 * 128 + d * 128 + ch * 16);
          *(PG8_LAS u32x4*)(lds + 69632 + d * 272 + ch * 32) = src[0]; *(PG8_LAS u32x4*)(lds + 69632 + d * 272 + ch * 32 + 16) = src[1]; }
        asm volatile("s_waitcnt vmcnt(0) lgkmcnt(0)" ::: "memory"); __builtin_amdgcn_s_barrier(); asm volatile("" ::: "memory");
        typedef float f32x16_ __attribute__((ext_vector_type(16)));
        const int tq = lane & 31, hi = lane >> 5;
        f32x16_ O0, O1;
#pragma unroll
        for (int i = 0; i < 16; ++i) { O0[i] = 0.f; O1[i] = 0.f; }
#pragma unroll
        for (int kk = 0; kk < 8; ++kk) { const bf16x8 a = *(const PG8_LAS bf16x8*)(lds + (32 * wid + tq) * 272 + (16 * kk + 8 * hi) * 2);
            const bf16x8 b0 = *(const PG8_LAS bf16x8*)(lds + 69632 + tq * 272 + (16 * kk + 8 * hi) * 2), b1 = *(const PG8_LAS bf16x8*)(lds + 69632 + (32 + tq) * 272 + (16 * kk + 8 * hi) * 2);
            O0 = __builtin_amdgcn_mfma_f32_32x32x16_bf16(a, b0, O0, 0, 0, 0); O1 = __builtin_amdgcn_mfma_f32_32x32x16_bf16(a, b1, O1, 0, 0, 0); }
#pragma unroll
        for (int i = 0; i < 16; ++i) { const int nrow = 32 * wid + (i & 3) + 8 * (i >> 2) + 4 * hi; const bool ok = nrow < NCMP;
            const unsigned v0 = ok ? (cvt_pk_bf16(O0[i], 0.f) & 0xffffu) : 0u, v1 = ok ? (cvt_pk_bf16(O1[i], 0.f) & 0xffffu) : 0u;
            if (kv == 0) { bf16_t* p = kcb + ((size_t)bgi * 256 + nrow) * 64 + tq; p[0] = (bf16_t)v0; p[32] = (bf16_t)v1; }
            else { const int n16 = nrow & 15; const int np = (nrow & ~15) + 8 * ((n16 >> 2) & 1) + (n16 & 3) + 4 * (n16 >> 3); bf16_t* p = vct + ((size_t)bgi * 64 + tq) * 256 + np; p[0] = (bf16_t)v0; p[32 * 256] = (bf16_t)v1; } }
    }
};
}

template <bool UPMAP = false>
__device__ __forceinline__ void p0_transpose_item(const float* W, const float* gk, int K, int N, bf16_t* WT, float* scr, int item, int lane) {
    const int nblk = N / 32, kb = item / nblk, nb = item % nblk, k0 = 64 * kb, n0 = 32 * nb;
    const int r0 = UPMAP ? (((n0 & 2047) >> 7) * 256 + (n0 >> 11) * 128 + (n0 & 127)) : n0;
#pragma unroll 8
    for (int i = 0; i < 32; ++i) { const int kk = 2 * i + (lane >> 5); float w = W[(size_t)(k0 + kk) * N + n0 + (lane & 31)]; if (gk) w *= gk[k0 + kk]; scr[kk * 33 + (lane & 31)] = w; }
    WAVE_LDS_SYNC();
    const int c = lane & 7;
#pragma unroll
    for (int j = 0; j < 4; ++j) { const int n = (lane >> 3) + 8 * j; const float* s = scr + (8 * c) * 33 + n;
        u32x4 o; o.x = pk2(s[0 * 33], s[1 * 33]); o.y = pk2(s[2 * 33], s[3 * 33]); o.z = pk2(s[4 * 33], s[5 * 33]); o.w = pk2(s[6 * 33], s[7 * 33]);
        *(u32x4*)(WT + (size_t)(r0 + n) * K + k0 + 8 * c) = o; }
    WAVE_LDS_SYNC();
}

#define LAS3 __attribute__((address_space(3)))
typedef short bf16x8 __attribute__((ext_vector_type(8)));
typedef float f32x16 __attribute__((ext_vector_type(16)));
typedef float f32x2_t __attribute__((ext_vector_type(2)));
typedef __bf16 bf16x2_t __attribute__((ext_vector_type(2)));
__device__ __forceinline__ unsigned cvtpk(float lo, float hi) { f32x2_t v = {lo, hi}; bf16x2_t b = __builtin_convertvector(v, bf16x2_t); return __builtin_bit_cast(unsigned, b); }
#define MFMA32(a, b, c) __builtin_amdgcn_mfma_f32_32x32x16_bf16((a), (b), (c), 0, 0, 0)
__device__ __forceinline__ bf16x8 pack8(const f32x16& x, int s) {
    u32x4 p; p.x = cvtpk(x[8 * s], x[8 * s + 1]); p.y = cvtpk(x[8 * s + 2], x[8 * s + 3]); p.z = cvtpk(x[8 * s + 4], x[8 * s + 5]); p.w = cvtpk(x[8 * s + 6], x[8 * s + 7]);
    return __builtin_bit_cast(bf16x8, p);
}
#define NEG_INF (-__builtin_inff())
constexpr float LOG2E = 1.4426950408889634f;
__device__ __forceinline__ unsigned other_half_u(unsigned v, int hi) { auto rr = __builtin_amdgcn_permlane32_swap(v, v, false, false); return hi ? rr[0] : rr[1]; }
__device__ __forceinline__ float other_half_f(float v, int hi) { return __uint_as_float(other_half_u(__float_as_uint(v), hi)); }
__device__ __forceinline__ float max16(const f32x16& u) {
    float a = fmaxf(fmaxf(u[0], u[1]), fmaxf(u[2], u[3])), b = fmaxf(fmaxf(u[4], u[5]), fmaxf(u[6], u[7]));
    float c = fmaxf(fmaxf(u[8], u[9]), fmaxf(u[10], u[11])), d = fmaxf(fmaxf(u[12], u[13]), fmaxf(u[14], u[15]));
    return fmaxf(fmaxf(a, b), fmaxf(c, d));
}
__device__ __forceinline__ unsigned long long spread_even(unsigned x) {
    unsigned long long s = x;
    s = (s | (s << 16)) & 0x0000FFFF0000FFFFull; s = (s | (s << 8)) & 0x00FF00FF00FF00FFull; s = (s | (s << 4)) & 0x0F0F0F0F0F0F0F0Full;
    s = (s | (s << 2)) & 0x3333333333333333ull; s = (s | (s << 1)) & 0x5555555555555555ull; return s;
}
struct NsaF { const bf16_t* Z; const float* gates; const bf16_t* KCB; const bf16_t* VCT; const bf16_t* VST; const bf16_t* VWT; bf16_t* MIX; };

__device__ __forceinline__ void nsa_load_q(bf16x8 (&qf)[4], const bf16_t* qp) {
    const float QSC = 0.125f * LOG2E;
#pragma unroll
    for (int s = 0; s < 4; ++s) { const u32x4 w = *(const u32x4*)(qp + 16 * s); u32x4 o;
        o.x = cvtpk(bflo(w.x) * QSC, bfhi(w.x) * QSC); o.y = cvtpk(bflo(w.y) * QSC, bfhi(w.y) * QSC); o.z = cvtpk(bflo(w.z) * QSC, bfhi(w.z) * QSC); o.w = cvtpk(bflo(w.w) * QSC, bfhi(w.w) * QSC);
        qf[s] = __builtin_bit_cast(bf16x8, o); }
}
__device__ __forceinline__ f32x16 nsa_st(const bf16_t* kp, const bf16x8 (&qf)[4], const f32x16& cinit) {
    f32x16 acc = MFMA32(*(const bf16x8*)(kp), qf[0], cinit);
    acc = MFMA32(*(const bf16x8*)(kp + 16), qf[1], acc); acc = MFMA32(*(const bf16x8*)(kp + 32), qf[2], acc); acc = MFMA32(*(const bf16x8*)(kp + 48), qf[3], acc);
    return acc;
}
struct NsaK { bf16x8 k[4]; };
struct NsaV { bf16x8 v0[2]; bf16x8 v1[2]; };
__device__ __forceinline__ void nsa_ldk(NsaK& R, const bf16_t* ku, unsigned ko) {
    R.k[0] = *(const bf16x8*)(ku + ko); R.k[1] = *(const bf16x8*)(ku + ko + 16); R.k[2] = *(const bf16x8*)(ku + ko + 32); R.k[3] = *(const bf16x8*)(ku + ko + 48);
}
__device__ __forceinline__ void nsa_ldv(NsaV& R, const bf16_t* vu, const bf16_t* vu2, unsigned vo) {
    R.v0[0] = *(const bf16x8*)(vu + vo); R.v0[1] = *(const bf16x8*)(vu + vo + 16); R.v1[0] = *(const bf16x8*)(vu2 + vo); R.v1[1] = *(const bf16x8*)(vu2 + vo + 16);
}
__device__ __forceinline__ f32x16 nsa_st_r(const NsaK& R, const bf16x8 (&qf)[4], const f32x16& cinit) {
    f32x16 acc = MFMA32(R.k[0], qf[0], cinit); acc = MFMA32(R.k[1], qf[1], acc); acc = MFMA32(R.k[2], qf[2], acc); acc = MFMA32(R.k[3], qf[3], acc); return acc;
}
__device__ __forceinline__ void nsa_soft_pv(f32x16& u, float tb, float& M, float& l, f32x16& O0, f32x16& O1, const NsaV& R, int hi) {
    float tm = max16(u); tm = fmaxf(tm, other_half_f(tm, hi));
    const float cand = tm + tb;
    if (__any(cand > M)) { const float mn = fmaxf(M, cand); const float al = __builtin_amdgcn_exp2f(M - mn); l *= al; O0 *= al; O1 *= al; M = mn; }
    const float ms = M - tb; float sum = 0.f;
#pragma unroll
    for (int i = 0; i < 16; ++i) { const float p = __builtin_amdgcn_exp2f(u[i] - ms); u[i] = p; sum += p; }
    l += sum;
    u32x4 a, b2;
    a.x = cvtpk(u[0], u[1]); a.y = cvtpk(u[2], u[3]); a.z = cvtpk(u[4], u[5]); a.w = cvtpk(u[6], u[7]);
    b2.x = cvtpk(u[8], u[9]); b2.y = cvtpk(u[10], u[11]); b2.z = cvtpk(u[12], u[13]); b2.w = cvtpk(u[14], u[15]);
    const bf16x8 p0 = __builtin_bit_cast(bf16x8, a), p1 = __builtin_bit_cast(bf16x8, b2);
    O0 = MFMA32(R.v0[0], p0, O0); O0 = MFMA32(R.v0[1], p1, O0);
    O1 = MFMA32(R.v1[0], p0, O1); O1 = MFMA32(R.v1[1], p1, O1);
}
__device__ __forceinline__ void nsa_mask_lt(f32x16& u, int limh) {
    asm volatile("" : "+v"(limh));
#pragma unroll
    for (int i = 0; i < 16; ++i) { const int c = (i & 3) + 8 * (i >> 2); if (!(c < limh)) u[i] = NEG_INF; }
}
__device__ __forceinline__ void nsa_mask_gt(f32x16& u, int limh) {
    asm volatile("" : "+v"(limh));
#pragma unroll
    for (int i = 0; i < 16; ++i) { const int c = (i & 3) + 8 * (i >> 2); if (!(c > limh)) u[i] = NEG_INF; }
}

__device__ __forceinline__ void vt_unit(const bf16_t* Z, int zcol, bf16_t* VT, int b, int g, int ch, unsigned short* tile  , int tid) {
    { const int pos = tid >> 3, c8 = (tid & 7) * 8;
      const u32x4 w = *(const u32x4*)(Z + ((size_t)b * SEQ + ch * 64 + pos) * NZ + zcol + g * 64 + c8);
      *(u32x4*)(tile + pos * 72 + c8) = w; }
    __syncthreads();
    { const int d = tid >> 3, chunk = tid & 7, gi = chunk >> 1, h = chunk & 1; unsigned short e[8];
#pragma unroll
      for (int j = 0; j < 8; ++j) { const int pos = 16 * gi + 8 * (j >> 2) + 4 * h + (j & 3); e[j] = tile[pos * 72 + d]; }
      u32x4 o; o.x = e[0] | ((unsigned)e[1] << 16); o.y = e[2] | ((unsigned)e[3] << 16); o.z = e[4] | ((unsigned)e[5] << 16); o.w = e[6] | ((unsigned)e[7] << 16);
      *(u32x4*)(VT + (((size_t)b * 2 + g) * 64 + d) * SEQ + ch * 64 + chunk * 8) = o; }
    __syncthreads();
}

constexpr int NC_KC = 0, NC_RING = 32768, NC_IMP = 81920, NC_LIST = 147456, NC_UEX = 148480, NC_QSLOT = 148512;
#define NC_WAITBAR(N) asm volatile("s_waitcnt vmcnt(" #N ") lgkmcnt(0)\n\ts_barrier" ::: "memory")

__device__ __forceinline__ void nsa_unit_coop(const NsaF& P, int b, int g, int tp, LAS3 unsigned char* L, int tid, const int dry = 0) {
    if (dry & 2048) return;
    const int lane = tid & 63, wave = __builtin_amdgcn_readfirstlane(tid >> 6), tbsel = wave >> 2, r = wave & 3, tq = lane & 31, hi = lane >> 5;
    const int tb = 2 * tp + tbsel, t0 = 32 * tb, t0u = 64 * tp, cur = tp, hh = g * 4 + r;
    const size_t rowq = (size_t)b * SEQ + t0 + tq;
    const size_t bg = (size_t)b * 2 + g;
    const int nval = max(0, 2 * tb + 1 - (tq < 31 ? 1 : 0) - (tq < 15 ? 1 : 0));
    const int ntc = (2 * tb + 1 + 31) >> 5, ntc_u = (2 * (2 * tp + 1) + 1 + 31) >> 5;
    const int tqh = tq - 4 * hi;
    const float hif = (float)(4 * hi);
    const float slope2 = __builtin_amdgcn_exp2f(-(float)(hh + 1)) * LOG2E;
    bf16x8 qf[4]; if (!(dry & 1024)) nsa_load_q(qf, P.Z + rowq * NZ + ZC_AQ + hh * 64 + 8 * hi); else { qf[0] = qf[1] = qf[2] = qf[3] = (bf16x8){0, 0, 0, 0, 0, 0, 0, 0}; }
    const float* gp = (dry & 1024) ? P.gates : P.gates + rowq * 32 + 8 + hh * 3;
    const float gt0 = sigmoidf_(gp[0]), gt1 = sigmoidf_(gp[1]), gt2 = sigmoidf_(gp[2]);
    asm volatile("s_waitcnt vmcnt(0)" ::: "memory");
    if (dry & 16384) return;
    const int ks = wave & 3, vdt = (wave & 3) >> 1, vs = wave & 1;
    const bool isK = wave < 4;
    const bf16_t* srcC = isK ? P.KCB + (bg * 256 + tq) * 64 + 16 * ks + 8 * hi : P.VCT + (bg * 64 + 32 * vdt + tq) * 256 + 16 * vs + 8 * hi;
    const bf16_t* srcW = isK ? P.Z + ((size_t)b * SEQ + tq) * NZ + ZC_AKW + g * 64 + 16 * ks + 8 * hi : P.VWT + (bg * 64 + 32 * vdt + tq) * SEQ + 16 * vs + 8 * hi;
    const bf16_t* srcS = isK ? P.Z + ((size_t)b * SEQ + tq) * NZ + ZC_AKS + g * 64 + 16 * ks + 8 * hi : P.VST + (bg * 64 + 32 * vdt + tq) * SEQ + 16 * vs + 8 * hi;
    const size_t stepC = isK ? 32 * 64 : 32, stepP = isK ? (size_t)NZ : 1;
    volatile LAS3 int* list = (volatile LAS3 int*)(L + NC_LIST);
#define NC_DMA_E(i, ent) do { const int e_ = (ent); const int tag_ = (e_ >> 16) & 3, val_ = ((e_ & 0xffff) == 0xffff) ? 0 : (e_ & 0xffff); \
        const bf16_t* s_ = (tag_ == 0) ? srcC + (size_t)val_ * stepC : ((tag_ == 1) ? srcW : srcS) + (size_t)val_ * stepP; \
        __builtin_amdgcn_global_load_lds((const unsigned*)s_, (LAS3 unsigned*)(L + NC_RING + (((i) >> 1) % 3) * 16384 + ((i) & 1) * 8192 + wave * 1024), 16, 0, 0); } while (0)
#define NC_DMA(i) NC_DMA_E(i, __builtin_amdgcn_readfirstlane(list[1 + (i)]))
    const bool topk = cur >= 16 && !(dry & 1);
    if (topk && wave < ntc_u) {
#pragma unroll
        for (int s = 0; s < 4; ++s) __builtin_amdgcn_global_load_lds((const unsigned*)(P.KCB + (bg * 256 + 32 * wave + tq) * 64 + 16 * s + 8 * hi), (LAS3 unsigned*)(L + NC_KC + wave * 4096 + s * 1024), 16, 0, 0);
    }
#define NC_FLAGS(tag_, val_, t0_, ntc_, cf_) (((tag_) == 0) ? (((val_) < (ntc_) ? 1 : 0) | ((val_) >= (cf_) ? 8 : 0)) : (((tag_) == 1) ? ((((val_) <= (t0_) && (val_) >= (t0_) - 512) ? 1 : 0) | ((val_) == (t0_) ? 2 : 0) | ((val_) == (t0_) - 512 ? 4 : 0)) : ((((val_) <= (t0_)) ? 1 : 0) | ((val_) == (t0_) ? 2 : 0))))
#define NC_ENTRY(tag_, val_) ((val_) | ((tag_) << 16) | (NC_FLAGS(tag_, val_, t0u, ntcA, cfA) << 18) | (NC_FLAGS(tag_, val_, t0u + 32, ntcB, cfB) << 22))
    const int ntcA = (2 * (2 * tp) + 1 + 31) >> 5, ntcB = ntc_u, cfA = (2 * (2 * tp) - 1) >> 5, cfB = (2 * (2 * tp + 1) - 1) >> 5;
    const int ncmp = ntc_u + (ntc_u & 1);
    const int nsl0 = min(18, 2 * tp + 2), nsl = nsl0 + (nsl0 & 1);
    if (wave == 0) {
        if (lane < ncmp) list[1 + lane] = (lane < ntc_u) ? NC_ENTRY(0, ntc_u - 1 - lane) : 0xffff;
        else if (lane < ncmp + nsl) { const int k = lane - ncmp; list[1 + lane] = (k < nsl0) ? NC_ENTRY(1, t0u + 32 - 32 * k) : ((1 << 16) | 0xffff); }
        if (lane == 0) list[0] = ncmp + nsl; }
    asm volatile("s_waitcnt lgkmcnt(0)\n\ts_barrier" ::: "memory");
    if (dry & 8192) return;
    int nlist = __builtin_amdgcn_readfirstlane(list[0]);
    if (!(dry & 4096)) { NC_DMA(0); NC_DMA(1); NC_DMA(2); NC_DMA(3); }
    unsigned long long selmask, Utb;
    if (!topk) { selmask = (2ull << cur) - 1ull; Utb = selmask; }
    else {
        NC_WAITBAR(4);
        float* il = (float*)0; (void)il;
        LAS3 float* ip0 = (LAS3 float*)(L + NC_IMP + (wave * 32) * 256) + lane;
#pragma unroll
        for (int q = 0; q < 32; ++q) ip0[64 * q] = 0.f;
        {
            f32x16 cb;
            { float hf = hif; asm volatile("" : "+v"(hf));
#pragma unroll
              for (int i = 0; i < 16; ++i) cb[i] = slope2 * 16.0f * ((float)((i & 3) + 8 * (i >> 2)) + hf); }
            float M = -1.0e30f, l = 0.f;
#pragma unroll 1
            for (int nt = ntc - 1; nt >= 0; --nt) {
                const LAS3 unsigned char* kp = L + NC_KC + nt * 4096 + lane * 16;
                f32x16 u = MFMA32(*(const LAS3 bf16x8*)(kp), qf[0], cb); u = MFMA32(*(const LAS3 bf16x8*)(kp + 1024), qf[1], u); u = MFMA32(*(const LAS3 bf16x8*)(kp + 2048), qf[2], u); u = MFMA32(*(const LAS3 bf16x8*)(kp + 3072), qf[3], u);
                nsa_mask_lt(u, nval - 32 * nt - 4 * hi);
                const float tbs = slope2 * 512.0f * (float)nt;
                float tm = max16(u); tm = fmaxf(tm, other_half_f(tm, hi));
                const float mn = fmaxf(M, tm + tbs); float sum = 0.f; const float ms = mn - tbs;
#pragma unroll
                for (int i = 0; i < 16; ++i) sum += __builtin_amdgcn_exp2f(u[i] - ms);
                l = l * __builtin_amdgcn_exp2f(M - mn) + sum; M = mn;
            }
            const float lt = l + other_half_f(l, hi); const float linv = lt > 0.f ? 1.0f / lt : 0.f;
            float carry = 0.f;
#pragma unroll 1
            for (int nt = 0; nt < ntc; ++nt) {
                const LAS3 unsigned char* kp = L + NC_KC + nt * 4096 + lane * 16;
                f32x16 u = MFMA32(*(const LAS3 bf16x8*)(kp), qf[0], cb); u = MFMA32(*(const LAS3 bf16x8*)(kp + 1024), qf[1], u); u = MFMA32(*(const LAS3 bf16x8*)(kp + 2048), qf[2], u); u = MFMA32(*(const LAS3 bf16x8*)(kp + 3072), qf[3], u);
                nsa_mask_lt(u, nval - 32 * nt - 4 * hi);
                const float ms = M - slope2 * 512.0f * (float)nt;
#pragma unroll
                for (int i = 0; i < 16; ++i) u[i] = __builtin_amdgcn_exp2f(u[i] - ms) * linv;
                float x[4], qs[4];
#pragma unroll
                for (int gq = 0; gq < 4; ++gq) { qs[gq] = (u[4 * gq] + u[4 * gq + 1]) + (u[4 * gq + 2] + u[4 * gq + 3]); x[gq] = other_half_f(u[4 * gq + 3], hi); }
                LAS3 float* ip = ip0 + 256 * nt;
                ip[0] += qs[0] + (hi ? x[0] : carry); ip[64] += qs[1] + (hi ? x[1] : x[0]); ip[128] += qs[2] + (hi ? x[2] : x[1]); ip[192] += qs[3] + (hi ? x[3] : x[2]);
                carry = x[3];
            }
        }
        asm volatile("s_waitcnt lgkmcnt(0)\n\ts_barrier" ::: "memory");
        unsigned uu[32];
        const int qlo = hi ? 0 : 1, qhi = (cur - 2 - hi) >> 1;
        const unsigned candm = (unsigned)((2ull << qhi) - 1ull) & ~((1u << qlo) - 1u);
        { const LAS3 float* pp = (const LAS3 float*)(L + NC_IMP + (tbsel * 4 * 32) * 256) + lane;
#pragma unroll
          for (int q = 0; q < 32; ++q) { const float v = (pp[64 * q] + pp[64 * (32 + q)]) + (pp[64 * (64 + q)] + pp[64 * (96 + q)]); uu[q] = __float_as_uint(v) & 0xffff0000u & (unsigned)(-(int)((candm >> q) & 1u)); } }
        unsigned T = 0u;
#pragma unroll 1
        for (int bit = 30; bit >= 16; --bit) { const unsigned c = T | (1u << bit); unsigned cnt = 0;
#pragma unroll
            for (int q = 0; q < 32; ++q) cnt += (uu[q] >= c) ? 1u : 0u;
            cnt += other_half_u(cnt, hi);
            if (cnt >= 13u) T = c; }
        unsigned gtm = 0u, eqm = 0u;
#pragma unroll
        for (int q = 0; q < 32; ++q) { gtm |= (uu[q] > T ? 1u : 0u) << q; eqm |= (uu[q] == T ? 1u : 0u) << q; }
        eqm &= candm;
        const unsigned ogt = other_half_u(gtm, hi), oeq = other_half_u(eqm, hi);
        const unsigned long long fgt = spread_even(hi ? ogt : gtm) | (spread_even(hi ? gtm : ogt) << 1);
        const unsigned long long feq = spread_even(hi ? oeq : eqm) | (spread_even(hi ? eqm : oeq) << 1);
        const int need = 13 - __builtin_popcountll(fgt);
        unsigned long long rem = feq;
#pragma unroll 1
        for (int i = 0; i < 13; ++i) if (i < need) rem &= rem - 1ull;
        selmask = fgt | (feq & ~rem) | 1ull | (3ull << (cur - 1));
        unsigned ulo = (unsigned)selmask, uhi = (unsigned)(selmask >> 32);
#pragma unroll
        for (int o = 1; o < 32; o <<= 1) { ulo |= __shfl_xor(ulo, o); uhi |= __shfl_xor(uhi, o); }
        Utb = ((unsigned long long)__builtin_amdgcn_readfirstlane(uhi) << 32) | (unsigned long long)__builtin_amdgcn_readfirstlane(ulo);
        if (r == 0 && lane == 0) { ((volatile LAS3 unsigned*)(L + NC_UEX))[2 * tbsel] = (unsigned)Utb; ((volatile LAS3 unsigned*)(L + NC_UEX))[2 * tbsel + 1] = (unsigned)(Utb >> 32); }
        asm volatile("s_waitcnt lgkmcnt(0)\n\ts_barrier" ::: "memory");
    }
    if (dry & 32768) return;
    if (wave == 0) {
        unsigned long long U;
        if (topk) { volatile LAS3 unsigned* ux = (volatile LAS3 unsigned*)(L + NC_UEX); U = ((unsigned long long)(ux[1] | ux[3]) << 32) | (unsigned long long)(ux[0] | ux[2]); } else U = (2ull << cur) - 1ull;
        const int n0 = ncmp + nsl;
        if ((U >> lane) & 1ull) { const int pos = n0 + 2 * __builtin_popcountll(lane == 63 ? 0ull : (U >> (lane + 1))); list[1 + pos] = NC_ENTRY(2, 64 * lane + 32); list[2 + pos] = NC_ENTRY(2, 64 * lane); }
        if (lane == 0) list[0] = n0 + 2 * __builtin_popcountll(U); }
    asm volatile("s_waitcnt lgkmcnt(0)\n\ts_barrier" ::: "memory");
    if (dry & 65536) return;
    nlist = __builtin_amdgcn_readfirstlane(list[0]);
    const int lv0 = list[1 + lane], lv1 = list[65 + lane], lv2 = list[129 + lane];
#define NC_ENT(i) (((i) < 64) ? __builtin_amdgcn_readlane(lv0, (i)) : (((i) < 128) ? __builtin_amdgcn_readlane(lv1, (i) - 64) : __builtin_amdgcn_readlane(lv2, (i) - 128)))
    LAS3 float* al = (LAS3 float*)(L + NC_IMP + wave * 8192) + lane;
    f32x16 O0, O1, O2, cb;
#pragma unroll
    for (int i = 0; i < 16; ++i) { al[64 * i] = 0.f; al[64 * (16 + i)] = 0.f; O0[i] = 0.f; O1[i] = 0.f; O2[i] = 0.f; cb[i] = 0.f; }
    const unsigned onesw = (tq == 0) ? 0x3f803f80u : 0u;
    const bf16x8 onesf = __builtin_bit_cast(bf16x8, (u32x4){onesw, onesw, onesw, onesw});
    float M = -1.0e30f, l = 0.f; int curtag = -1;
#define NC_FINAL() do { const float l0_ = O2[0]; const float lt_ = l0_ + other_half_f(l0_, hi);     const float g_ = (curtag == 0) ? gt0 : ((curtag == 1) ? gt2 : gt1); const float sc_ = lt_ > 0.f ? g_ / lt_ : 0.f; \
        _Pragma("unroll") for (int k_ = 0; k_ < 16; ++k_) { al[64 * k_] += O0[k_] * sc_; al[64 * (16 + k_)] += O1[k_] * sc_; } } while (0)
#define NC_SWITCH(tag) do { if ((tag) != curtag) { if (curtag >= 0) NC_FINAL(); curtag = (tag); M = -1.0e30f; l = 0.f; \
            float hf_ = hif; asm volatile("" : "+v"(hf_)); const float cs_ = ((tag) == 0) ? slope2 * 16.0f : slope2; \
            _Pragma("unroll") for (int k_ = 0; k_ < 16; ++k_) { O0[k_] = 0.f; O1[k_] = 0.f; O2[k_] = 0.f; cb[k_] = cs_ * ((float)((k_ & 3) + 8 * (k_ >> 2)) + hf_); } } } while (0)
#define NC_NEED(tag, val) (((tag) == 0) ? ((val) < ntc) : (((tag) == 1) ? (((val) <= t0) && ((val) >= t0 - 512)) : ((((Utb >> ((val) >> 6)) & 1ull) != 0ull) && ((val) <= t0))))
#define NC_TBIAS(tag, val) (((tag) == 0) ? slope2 * 512.0f * (float)(val) : slope2 * (float)((val) - t0))
#define NC_ST(u, sp) do { u = MFMA32(*(const LAS3 bf16x8*)(sp), qf[0], cb); u = MFMA32(*(const LAS3 bf16x8*)((sp) + 1024), qf[1], u); u = MFMA32(*(const LAS3 bf16x8*)((sp) + 2048), qf[2], u); u = MFMA32(*(const LAS3 bf16x8*)((sp) + 3072), qf[3], u); } while (0)
#define NC_MASK(u, tag, val) do { if ((tag) == 0) nsa_mask_lt(u, nval - 32 * (val) - 4 * hi); else { if ((val) == t0) nsa_mask_lt(u, tqh + 1); if ((tag) == 1 && (val) == t0 - 512) nsa_mask_gt(u, tqh); \
            if ((tag) == 2 && !((selmask >> ((val) >> 6)) & 1ull)) { _Pragma("unroll") for (int k_ = 0; k_ < 16; ++k_) u[k_] = NEG_INF; } } } while (0)
#define NC_LDV(V, sp) do { V.v0[0] = *(const LAS3 bf16x8*)((sp) + 4096); V.v0[1] = *(const LAS3 bf16x8*)((sp) + 5120); V.v1[0] = *(const LAS3 bf16x8*)((sp) + 6144); V.v1[1] = *(const LAS3 bf16x8*)((sp) + 7168); } while (0)
    const int npair = (dry & 8) ? 0 : (nlist >> 1);
    const int cfull = (2 * tb - 1) >> 5;
#pragma unroll 1
    for (int p = 0; p < npair; ++p) {
        if (dry & 256) { asm volatile("s_waitcnt lgkmcnt(0)\n\ts_barrier" ::: "memory"); } else { if (p + 1 < npair) NC_WAITBAR(2); else NC_WAITBAR(0); }
        if (!(dry & 512) && p + 2 < npair) { const int i2 = 2 * (p + 2); NC_DMA_E(i2, NC_ENT(i2)); NC_DMA_E(i2 + 1, NC_ENT(i2 + 1)); }
        const int e0 = NC_ENT(2 * p), e1 = NC_ENT(2 * p + 1);
        const int tag = (e0 >> 16) & 3, val0 = e0 & 0xffff, val1 = e1 & 0xffff;
        const int f0 = (e0 >> (18 + 4 * tbsel)) & 15, f1 = (e1 >> (18 + 4 * tbsel)) & 15;
        if (tag != curtag) { asm volatile("" ::: "memory"); NC_SWITCH(tag); }
        const bool sel = (tag == 2);
        const bool need0 = !(dry & 2) && (f0 & 1) && (!sel || ((Utb >> (val0 >> 6)) & 1ull)), need1 = !(dry & 2) && (f1 & 1) && (!sel || ((Utb >> (val1 >> 6)) & 1ull));
        if (need0 || need1) {
            const LAS3 unsigned char* sp0 = L + NC_RING + (p % 3) * 16384 + lane * 16; const LAS3 unsigned char* sp1 = sp0 + 8192;
            f32x16 u0, u1; if (dry & 128) { u0 = cb; u1 = cb; } else { NC_ST(u0, sp0); NC_ST(u1, sp1); }
            const bool nm0 = sel && !__all((int)((selmask >> (val0 >> 6)) & 1ull)), nm1 = sel && !__all((int)((selmask >> (val1 >> 6)) & 1ull));
            if (!need0 || (f0 & 14) || nm0) { asm volatile("" ::: "memory");
                if (!need0) { _Pragma("unroll") for (int k_ = 0; k_ < 16; ++k_) u0[k_] = NEG_INF; } else NC_MASK(u0, tag, val0); }
            if (!need1 || (f1 & 14) || nm1) { asm volatile("" ::: "memory");
                if (!need1) { _Pragma("unroll") for (int k_ = 0; k_ < 16; ++k_) u1[k_] = NEG_INF; } else NC_MASK(u1, tag, val1); }
            const float tb0 = NC_TBIAS(tag, val0), tb1 = NC_TBIAS(tag, val1);
            const float tm0 = (dry & 16) ? 0.f : max16(u0), tm1 = (dry & 16) ? 0.f : max16(u1);
            float cand = fmaxf(tm0 + tb0, tm1 + tb1); if (!(dry & 16)) cand = fmaxf(cand, other_half_f(cand, hi));
            if (!(dry & 16) && __any(cand > M)) { asm volatile("" ::: "memory"); const float mn = fmaxf(M, cand); const float al_ = __builtin_amdgcn_exp2f(M - mn); O0 *= al_; O1 *= al_; O2 *= al_; M = mn; }
            const float ms0 = M - tb0, ms1 = M - tb1;
#pragma unroll
            for (int i = 0; i < 16; ++i) { if (dry & 32) { u0[i] = u0[i] - ms0; u1[i] = u1[i] - ms1; } else { u0[i] = __builtin_amdgcn_exp2f(u0[i] - ms0); u1[i] = __builtin_amdgcn_exp2f(u1[i] - ms1); } }
            asm volatile("" ::: "memory");
            NsaV Va, Vb; NC_LDV(Va, sp0); NC_LDV(Vb, sp1);
            const bf16x8 pa0 = pack8(u0, 0), pa1 = pack8(u0, 1), pb0 = pack8(u1, 0), pb1 = pack8(u1, 1);
            if (dry & 64) { O0[0] += __builtin_bit_cast(float, pa0[0] ^ pa1[1] ^ pb0[2] ^ pb1[3]) + __builtin_bit_cast(float, (int)(Va.v0[0][0] ^ Va.v1[1][1] ^ Vb.v0[0][2] ^ Vb.v1[1][3])); } else {
            O0 = MFMA32(Va.v0[0], pa0, O0); O1 = MFMA32(Va.v1[0], pa0, O1); O0 = MFMA32(Va.v0[1], pa1, O0); O1 = MFMA32(Va.v1[1], pa1, O1);
            O0 = MFMA32(Vb.v0[0], pb0, O0); O1 = MFMA32(Vb.v1[0], pb0, O1); O0 = MFMA32(Vb.v0[1], pb1, O0); O1 = MFMA32(Vb.v1[1], pb1, O1);
            O2 = MFMA32(onesf, pa0, O2); O2 = MFMA32(onesf, pa1, O2); O2 = MFMA32(onesf, pb0, O2); O2 = MFMA32(onesf, pb1, O2); }
        }
    }
    if (curtag >= 0) NC_FINAL();
#undef NC_FINAL
#undef NC_SWITCH
#undef NC_NEED
#undef NC_TBIAS
#undef NC_ST
#undef NC_MASK
#undef NC_LDV
#undef NC_DMA
#undef NC_DMA_E
#undef NC_ENT
#undef NC_FLAGS
#undef NC_ENTRY
    bf16_t* op = P.MIX + rowq * DM + 512 + hh * 64 + 4 * hi;
    if (!(dry & 4))
#pragma unroll
    for (int q4 = 0; q4 < 4; ++q4) {
        u32x2 w0; w0.x = cvtpk(al[64 * (4 * q4)], al[64 * (4 * q4 + 1)]); w0.y = cvtpk(al[64 * (4 * q4 + 2)], al[64 * (4 * q4 + 3)]); *(u32x2*)(op + 8 * q4) = w0;
        u32x2 w1; w1.x = cvtpk(al[64 * (16 + 4 * q4)], al[64 * (16 + 4 * q4 + 1)]); w1.y = cvtpk(al[64 * (16 + 4 * q4 + 2)], al[64 * (16 + 4 * q4 + 3)]); *(u32x2*)(op + 32 + 8 * q4) = w1; }
}

struct MlF { const bf16_t* Z; const float* gates; bf16_t* MIX; const float* gate_bias; const float* mnorm_g; };
constexpr int M2_QC = 0, M2_KC = 17408, M2_K2 = 34816, M2_VC = 55296, M2_EG = 75776, M2_N = 76032, M2_SSQ = 77056, M2_CF = 78080, M2_G = 110848, M2_END = 111360;
constexpr int M2_RS = 272, M2_TS = 320;
typedef short v4i16_t __attribute__((ext_vector_type(4)));
__device__ __forceinline__ v4i16_t ml_tr(const LAS3 unsigned char* p) { return __builtin_amdgcn_ds_read_tr16_b64_v4i16((LAS3 v4i16_t*)p); }
__device__ __forceinline__ bf16x8 ml_cat(v4i16_t a, v4i16_t b) { return (bf16x8){a[0], a[1], a[2], a[3], b[0], b[1], b[2], b[3]}; }
__device__ __forceinline__ float dpp_f(float ident, float v, const int ctrl_dummy) { return v; }
#define ML_DPP(ident, v, ctrl, rmask) __builtin_bit_cast(float, __builtin_amdgcn_update_dpp(__builtin_bit_cast(int, (float)(ident)), __builtin_bit_cast(int, (float)(v)), (ctrl), (rmask), 0xf, false))
__device__ __forceinline__ float scan_add64_dpp(float v) {
    v += ML_DPP(0.f, v, 0x111, 0xf); v += ML_DPP(0.f, v, 0x112, 0xf); v += ML_DPP(0.f, v, 0x114, 0xf); v += ML_DPP(0.f, v, 0x118, 0xf);
    v += ML_DPP(0.f, v, 0x142, 0xa); v += ML_DPP(0.f, v, 0x143, 0xc); return v;
}
__device__ __forceinline__ float scan_max64_dpp(float v) {
    const float NI = -__builtin_inff();
    v = fmaxf(v, ML_DPP(NI, v, 0x111, 0xf)); v = fmaxf(v, ML_DPP(NI, v, 0x112, 0xf)); v = fmaxf(v, ML_DPP(NI, v, 0x114, 0xf)); v = fmaxf(v, ML_DPP(NI, v, 0x118, 0xf));
    v = fmaxf(v, ML_DPP(NI, v, 0x142, 0xa)); v = fmaxf(v, ML_DPP(NI, v, 0x143, 0xc)); return v;
}
struct Ml2Scal { float w, inter_s, rowf_s, floorv, decay, mnew; };
__device__ __forceinline__ Ml2Scal ml2_scalars(float ipre, float fpre, float m) {
    const float lf = log_sigmoidf_(fpre);
    const float bcs = scan_add64_dpp(lf);
    const float bL = __builtin_bit_cast(float, __builtin_amdgcn_readlane(__builtin_bit_cast(int, bcs), 63));
    const float g = ipre - bcs;
    const float pm = scan_max64_dpp(g);
    const float gmax = __builtin_bit_cast(float, __builtin_amdgcn_readlane(__builtin_bit_cast(int, pm), 63));
    const float mm = fmaxf(m, pm), mg = fmaxf(m, gmax);
    Ml2Scal s; const float scale = 0.08838834764831845f;
    s.w = __expf(g - mg); s.inter_s = __expf(m - mm) * scale; s.rowf_s = __expf(mg - mm) * scale; s.floorv = __expf(-bcs - mm);
    s.decay = __expf(m - mg); s.mnew = bL + mg;
    return s;
}

__device__ __forceinline__ void mlstm_unit_v2(const MlF& P, int b, int h, LAS3 unsigned char* L, int tid) {
    const int lane = tid & 63, wave = __builtin_amdgcn_readfirstlane(tid >> 6), lt = wave >> 2, tq = lane & 31, hi = lane >> 5;
    const float bi = P.gate_bias[h], bff = P.gate_bias[4 + h];
    const size_t row0 = (size_t)b * SEQ;
    const int ss = tid >> 3, d0 = 8 * (tid & 7);
    const bf16_t* zst = P.Z + (row0 + ss) * NZ + h * 128 + d0;
    const int wv_ = tid >> 6, ltv = wv_ >> 2, dvtv = wv_ & 3;
    const int lrow = 32 * ltv + tq;
    const int i16 = lane & 15, g16 = lane >> 4;
    const unsigned tr_lane = (unsigned)((4 * hi + (i16 >> 2)) * M2_TS + (16 * (g16 & 1) + 4 * (i16 & 3)) * 2);
    const unsigned a_qc = M2_QC + lrow * M2_RS + 16 * hi, a_qp = M2_QC + lrow * M2_RS + 8 * hi, a_kc = M2_KC + tq * M2_RS + 16 * hi, a_cf = M2_CF + (dvtv * 512 + lane) * 16;
    const unsigned a_vt = M2_VC + tr_lane + (32 * dvtv) * 2, a_kt = M2_K2 + tr_lane + (64 * ltv) * 2, a_eg = M2_EG + 16 * hi, a_n = M2_N + 256 * hi;
    f32x16 C0, C1;
#pragma unroll
    for (int i = 0; i < 16; ++i) { C0[i] = 0.f; C1[i] = 0.f; }
    for (int i = tid; i < 256; i += NTHREADS) ((LAS3 float*)(L + M2_N))[i] = 0.f;
    if (tid < 128) ((LAS3 float*)(L + M2_G))[tid] = P.mnorm_g[h * 128 + tid];
    for (int i = tid; i < 32768 / 16; i += NTHREADS) ((LAS3 u32x4*)(L + M2_CF))[i] = (u32x4){0u, 0u, 0u, 0u};
    float mst = 0.f;
    u32x4 rq[2], rk[2], rv[2]; float gi_, gf_;
#pragma unroll
    for (int p = 0; p < 2; ++p) { rq[p] = *(const u32x4*)(zst + ZC_MQ + 64 * p); rk[p] = *(const u32x4*)(zst + ZC_MK + 64 * p); rv[p] = *(const u32x4*)(zst + ZC_MV + 64 * p); }
    { const float* gr = P.gates + (row0 + lane) * 32; gi_ = gr[h] + bi; gf_ = gr[4 + h] + bff; }
    Ml2Scal sc = ml2_scalars(gi_, gf_, mst);
#define ML2_STAGE() do { \
        const float ws_ = __shfl(sc.w, ss); \
        _Pragma("unroll") for (int p = 0; p < 2; ++p) { \
            *(LAS3 u32x4*)(L + M2_QC + ss * M2_RS + (d0 + 64 * p) * 2) = rq[p]; \
            *(LAS3 u32x4*)(L + M2_KC + ss * M2_RS + (d0 + 64 * p) * 2) = rk[p]; *(LAS3 u32x4*)(L + M2_K2 + ss * M2_TS + (d0 + 64 * p) * 2) = rk[p]; \
            u32x4 o_; o_.x = cvtpk(bflo(rv[p].x) * ws_, bfhi(rv[p].x) * ws_); o_.y = cvtpk(bflo(rv[p].y) * ws_, bfhi(rv[p].y) * ws_); o_.z = cvtpk(bflo(rv[p].z) * ws_, bfhi(rv[p].z) * ws_); o_.w = cvtpk(bflo(rv[p].w) * ws_, bfhi(rv[p].w) * ws_); \
            *(LAS3 u32x4*)(L + M2_VC + ss * M2_TS + (d0 + 64 * p) * 2) = o_; } \
        if (wave == 0) ((LAS3 float*)(L + M2_EG))[lane] = sc.w; } while (0)
    __syncthreads();
    ML2_STAGE();
    float inter_s = __shfl(sc.inter_s, lrow), rowf_s = __shfl(sc.rowf_s, lrow), floorv = __shfl(sc.floorv, lrow), decay = sc.decay;
    mst = sc.mnew;
    u32x2 mo[4];
#define ML2_PREFETCH(cn) do { \
        if ((cn) < SEQ / 64) { const bf16_t* zn = zst + (size_t)(cn) * 64 * NZ; \
            _Pragma("unroll") for (int p = 0; p < 2; ++p) { rq[p] = *(const u32x4*)(zn + ZC_MQ + 64 * p); rk[p] = *(const u32x4*)(zn + ZC_MK + 64 * p); rv[p] = *(const u32x4*)(zn + ZC_MV + 64 * p); } \
            const float* gr = P.gates + (row0 + (size_t)(cn) * 64 + lane) * 32; gi_ = gr[h] + bi; gf_ = gr[4 + h] + bff; } \
        { const size_t orow_ = row0 + (size_t)((cn) - 1) * 64 + lrow; \
          _Pragma("unroll") for (int q = 0; q < 4; ++q) mo[q] = *(const u32x2*)(P.Z + orow_ * NZ + ZC_MO + h * 128 + 32 * dvtv + 8 * q + 4 * hi); } } while (0)
    ML2_PREFETCH(1);
#pragma unroll 1
    for (int c = 0; c < SEQ / 64; ++c) {
        __syncthreads();
        const bool more = (c + 1 < SEQ / 64);
        const size_t orow = row0 + (size_t)c * 64 + lrow;
        float den = 0.f;
        bf16x8 xf[4];
        {
            bf16x8 qf[8];
#pragma unroll
            for (int kk = 0; kk < 8; ++kk) qf[kk] = *(const LAS3 bf16x8*)(L + a_qc + 32 * kk);
#pragma unroll
            for (int st = 0; st < 2; ++st) {
                if (st <= lt) {
                    f32x16 X;
#pragma unroll
                    for (int i = 0; i < 16; ++i) X[i] = 0.f;
#pragma unroll
                    for (int kk = 0; kk < 8; ++kk) X = MFMA32(*(const LAS3 bf16x8*)(L + a_kc + 32 * st * M2_RS + 32 * kk), qf[kk], X);
                    const bool diag = (st == lt);
                    int tqo = tq - 4 * hi; asm volatile("" : "+v"(tqo));
                    float dsum = 0.f;
#pragma unroll
                    for (int q = 0; q < 4; ++q) { const f32x4 e4 = *(const LAS3 f32x4*)(L + a_eg + (32 * st + 8 * q) * 4);
#pragma unroll
                        for (int e = 0; e < 4; ++e) { const int i = 4 * q + e; float x = X[i] * rowf_s; if (diag && (8 * q + e > tqo)) x = 0.f; X[i] = x; dsum += x * e4[e]; } }
                    den += dsum;
                    xf[2 * st] = pack8(X, 0); xf[2 * st + 1] = pack8(X, 1);
                }
            }
        }
        den += other_half_f(den, hi);
        asm volatile("" ::: "memory");
        f32x16 acc;
#pragma unroll
        for (int i = 0; i < 16; ++i) acc[i] = 0.f;
#pragma unroll
        for (int kk = 0; kk < 8; ++kk) { const u32x2 qa = *(const LAS3 u32x2*)(L + a_qp + 32 * kk), qb = *(const LAS3 u32x2*)(L + a_qp + 32 * kk + 16);
            const u32x4 qq = (u32x4){qa.x, qa.y, qb.x, qb.y};
            acc = MFMA32(*(const LAS3 bf16x8*)(L + a_cf + kk * 1024), __builtin_bit_cast(bf16x8, qq), acc); }
        asm volatile("" ::: "memory");
        float qn = 0.f;
        { const unsigned an = a_n + (c & 1) * 512; const unsigned aq = M2_QC + lrow * M2_RS + 128 * hi;
#pragma unroll
          for (int k8 = 0; k8 < 8; ++k8) { const u32x4 w = *(const LAS3 u32x4*)(L + aq + 16 * k8); const f32x4 n0 = *(const LAS3 f32x4*)(L + an + 32 * k8), n1 = *(const LAS3 f32x4*)(L + an + 32 * k8 + 16);
              qn += bflo(w.x) * n0[0] + bfhi(w.x) * n0[1] + bflo(w.y) * n0[2] + bfhi(w.y) * n0[3] + bflo(w.z) * n1[0] + bfhi(w.z) * n1[1] + bflo(w.w) * n1[2] + bfhi(w.w) * n1[3]; } }
        qn += other_half_f(qn, hi);
        acc *= inter_s;
        bf16x8 vf[4];
#pragma unroll
        for (int s4 = 0; s4 < 4; ++s4) vf[s4] = ml_cat(ml_tr(L + a_vt + 16 * s4 * M2_TS), ml_tr(L + a_vt + (16 * s4 + 8) * M2_TS));
#pragma unroll
        for (int s4 = 0; s4 < 4; ++s4) if ((s4 >> 1) <= lt) acc = MFMA32(vf[s4], xf[s4], acc);
        den = inter_s * qn + den;
        const float inv = __builtin_amdgcn_rcpf(fmaxf(fabsf(den), floorv));
        float ssq = 0.f;
#pragma unroll
        for (int i = 0; i < 16; ++i) { acc[i] *= inv; ssq += acc[i] * acc[i]; }
        ssq += other_half_f(ssq, hi);
        if (hi == 0) *(LAS3 float*)(L + M2_SSQ + (dvtv * 64 + lrow) * 4) = ssq;
        asm volatile("" ::: "memory");
        C0 *= decay; C1 *= decay;
#pragma unroll
        for (int s4 = 0; s4 < 4; ++s4) {
            C0 = MFMA32(ml_cat(ml_tr(L + a_kt + 16 * s4 * M2_TS), ml_tr(L + a_kt + (16 * s4 + 8) * M2_TS)), vf[s4], C0);
            C1 = MFMA32(ml_cat(ml_tr(L + a_kt + 64 + 16 * s4 * M2_TS), ml_tr(L + a_kt + 64 + (16 * s4 + 8) * M2_TS)), vf[s4], C1); }
        if (tid < 128) { float a = 0.f;
#pragma unroll 16
            for (int s = 0; s < 64; ++s) a += ((const LAS3 float*)(L + M2_EG))[s] * bf2f(*(const LAS3 unsigned short*)(L + M2_KC + s * M2_RS + tid * 2));
            LAS3 float* nn = (LAS3 float*)(L + M2_N);
            nn[((c + 1) & 1) * 128 + tid] = decay * nn[(c & 1) * 128 + tid] + a; }
        __syncthreads();
        { const LAS3 float* sq = (const LAS3 float*)(L + M2_SSQ + lrow * 4); const float ss4 = (sq[0] + sq[64]) + (sq[128] + sq[192]);
          const float rstd = __builtin_amdgcn_rsqf(ss4 * (1.0f / 128.0f) + EPS);
          bf16_t* op = P.MIX + orow * DM + h * 128 + 32 * dvtv + 4 * hi;
#pragma unroll
          for (int q = 0; q < 4; ++q) { const f32x4 gg = *(const LAS3 f32x4*)(L + M2_G + (32 * dvtv + 8 * q + 4 * hi) * 4);
              const float o0 = acc[4 * q] * rstd * gg[0] * sigmoidf_(bflo(mo[q].x)), o1 = acc[4 * q + 1] * rstd * gg[1] * sigmoidf_(bfhi(mo[q].x));
              const float o2 = acc[4 * q + 2] * rstd * gg[2] * sigmoidf_(bflo(mo[q].y)), o3 = acc[4 * q + 3] * rstd * gg[3] * sigmoidf_(bfhi(mo[q].y));
              u32x2 w; w.x = cvtpk(o0, o1); w.y = cvtpk(o2, o3); *(u32x2*)(op + 8 * q) = w; } }
        { const unsigned aw = a_cf + ltv * 4096;
          *(LAS3 bf16x8*)(L + aw) = pack8(C0, 0); *(LAS3 bf16x8*)(L + aw + 1024) = pack8(C0, 1); *(LAS3 bf16x8*)(L + aw + 2048) = pack8(C1, 0); *(LAS3 bf16x8*)(L + aw + 3072) = pack8(C1, 1); }
        if (more) {
            sc = ml2_scalars(gi_, gf_, mst);
            ML2_STAGE();
            inter_s = __shfl(sc.inter_s, lrow); rowf_s = __shfl(sc.rowf_s, lrow); floorv = __shfl(sc.floorv, lrow); decay = sc.decay; mst = sc.mnew;
            ML2_PREFETCH(c + 2);
        }
    }
#undef ML2_PREFETCH
#undef ML2_STAGE
    __syncthreads();
}

#define LAS __attribute__((address_space(3)))
#define XB_TMO      128
#define XB_XCNT(j)  (256  + 64 * (j))
#define XB_XSUB(j)  (1280 + 64 * (j))
#define XB_XGEN(j)  (2304 + 64 * (j))
#define XB_TOP      3328
#define XB_TOPGEN   3392
#define XCD_BAR_WORDS 3456
#define XB_SPIN_CAP (1u << 18)

__device__ __forceinline__ unsigned xb_ld(unsigned* p)              { return __hip_atomic_load(p, __ATOMIC_RELAXED, __HIP_MEMORY_SCOPE_AGENT); }
__device__ __forceinline__ unsigned xb_add(unsigned* p, unsigned v) { return __hip_atomic_fetch_add(p, v, __ATOMIC_RELAXED, __HIP_MEMORY_SCOPE_AGENT); }
__device__ __forceinline__ unsigned xb_xcc_id() { return (unsigned)__builtin_amdgcn_s_getreg((3 << 11) | 20) & 0xFu; }
#define XB_SPIN(cond, bar) do { unsigned _sp = 0; while (cond) { __builtin_amdgcn_s_sleep(1); \
    if ((++_sp & 255u) == 0u) { if (xb_ld(&(bar)[XB_TMO])) break; if (_sp > XB_SPIN_CAP) { atomicAdd(&(bar)[XB_TMO], 1u); break; } } } } while (0)

struct XcdBarrier {
    unsigned* bar; unsigned x;
    volatile LAS unsigned* st;
};

__device__ __forceinline__ XcdBarrier xcd_barrier_post(unsigned* bar, volatile LAS unsigned* st) {
    XcdBarrier b; b.bar = bar; b.x = xb_xcc_id(); b.st = st;
    if (threadIdx.x == 0) (void)xb_add(&bar[XB_XCNT(b.x)], 1u);
    return b;
}
__device__ __forceinline__ void xcd_barrier_complete(unsigned* bar, unsigned x, unsigned& nloc, unsigned& nx) {
    const unsigned G = gridDim.x * gridDim.y * gridDim.z;
    unsigned sum, cnt, mine, sp = 0u;
    for (;;) {
        sum = 0u; cnt = 0u; mine = 0u;
#pragma unroll
        for (unsigned j = 0; j < 16; ++j) { const unsigned c = xb_ld(&bar[XB_XCNT(j)]); sum += c; cnt += (c > 0u) ? 1u : 0u; mine = (j == x) ? c : mine; }
        if (sum == G) break;
        __builtin_amdgcn_s_sleep(1);
        if ((++sp & 255u) == 0u) { if (xb_ld(&bar[XB_TMO])) break; if (sp > XB_SPIN_CAP) { atomicAdd(&bar[XB_TMO], 1u); break; } }
    }
    nloc = mine > 0u ? mine : 1u; nx = cnt > 0u ? cnt : 1u;
}

__device__ __forceinline__ void xcd_barrier(const XcdBarrier& b) {
    asm volatile("s_waitcnt vmcnt(0)" ::: "memory");
    __syncthreads();
    if (threadIdx.x == 0) {
        unsigned* bar = b.bar;
        __builtin_amdgcn_s_waitcnt(0);
        unsigned nloc = b.st[0], nx = b.st[1];
        if (nloc == 0u) { xcd_barrier_complete(bar, b.x, nloc, nx); b.st[0] = nloc; b.st[1] = nx; }
        const unsigned old = xb_add(&bar[XB_XSUB(b.x)], 1u);
        const unsigned gen = old / nloc;
        if (old + 1u == (gen + 1u) * nloc) {
            __builtin_amdgcn_fence(__ATOMIC_RELEASE, "agent");
            asm volatile("s_waitcnt vmcnt(0)" ::: "memory");
            const unsigned og = xb_add(&bar[XB_TOP], 1u);
            const unsigned tg = og / nx;
            if (og + 1u == (tg + 1u) * nx) xb_add(&bar[XB_TOPGEN], 1u);
            else XB_SPIN(xb_ld(&bar[XB_TOPGEN]) == tg, bar);
            __builtin_amdgcn_fence(__ATOMIC_ACQUIRE, "agent");
            xb_add(&bar[XB_XGEN(b.x)], 1u);
            asm volatile("s_waitcnt vmcnt(0)" ::: "memory");
        } else {
            XB_SPIN(xb_ld(&bar[XB_XGEN(b.x)]) == gen, bar);
            __builtin_amdgcn_fence(__ATOMIC_ACQUIRE, "agent");
            asm volatile("s_waitcnt vmcnt(0)" ::: "memory");
        }
    }
    __syncthreads();
}

__global__ void __launch_bounds__(NTHREADS, 2) fwd_kernel(Params prm) {
    extern __shared__ __attribute__((aligned(16))) unsigned char lds[];
    cg::grid_group grid = cg::this_grid();
    PG8_LAS unsigned char* ldsl = (PG8_LAS unsigned char*)lds;
    float* lds_f = (float*)lds;
#define TID ((int)threadIdx.x)
#define LANE ((int)(threadIdx.x & 63))
#define WAVE (__builtin_amdgcn_readfirstlane((int)(threadIdx.x >> 6)))
#define GRIDN ((int)gridDim.x)
#define BX ((int)blockIdx.x)
#define WSP(T, name, off) T* name; { unsigned char* w_ = prm.ws; asm volatile("" : "+s"(w_)); name = (T*)(w_ + (off)); }
    { volatile LAS unsigned* st0 = (volatile LAS unsigned*)((LAS unsigned char*)lds + XBAR_LDS); if (threadIdx.x < 2) st0[threadIdx.x] = 0u; }
    __syncthreads();
    XcdBarrier xbar; { unsigned char* w_ = prm.ws; asm volatile("" : "+s"(w_)); xbar = xcd_barrier_post((unsigned*)(w_ + WS_CTL) + 4096, (volatile LAS unsigned*)((LAS unsigned char*)lds + XBAR_LDS)); }
#ifndef DUP_PHASE
#define DUPREPS(k) 1
#else
#define DUPREPS(k) ((k) == DUP_PHASE ? 2 : 1)
#endif
#ifdef PROBE_A
#define STAMP(k) do { if (BX == 0 && TID == 0) { unsigned char* w_ = prm.ws; asm volatile("" : "+s"(w_)); ((unsigned long long*)w_)[k] = __builtin_amdgcn_s_memrealtime(); } } while (0)
#else
#define STAMP(k) do { } while (0)
#endif
    STAMP(0);

    _Pragma("unroll 1") for (int rep_ = 0; rep_ < DUPREPS(0); ++rep_)
    {
        const int lane = LANE, wave = WAVE, G = GRIDN, bx = BX, tid = TID; const int gw = bx * NWAVES + wave, NGW = G * NWAVES;
        WSP(bf16_t, Win_t, WS_WIN) WSP(bf16_t, Wout_t, WS_WOUT) WSP(bf16_t, Wup_t, WS_WUP) WSP(bf16_t, Wdn_t, WS_WDN) WSP(bf16_t, Wpg_t, WS_WPG) WSP(bf16_t, Wpp_t, WS_WPP)
        WSP(bf16_t, XB, WS_XB) WSP(bf16_t, PB, WS_PB) WSP(bf16_t, W1T, WS_W1T) WSP(bf16_t, W2T, WS_W2T) WSP(float, C1, WS_C1)
        const float* x = prm.in[0]; const float* pin = prm.in[1];
        float* scr = lds_f + wave * 4096;
        constexpr int I_IN = (DM / 64) * (3360 / 32), I_OUT = (DM / 64) * (DM / 32), I_UP = (DM / 64) * (4096 / 32), I_DN = (DFF / 64) * (DM / 32), I_PG = I_OUT, I_PP = (PLE / 64) * (DM / 32);
        constexpr int I_W1 = 4 * 64, I_W2 = 2 * 4;
        constexpr int NITEMS = I_IN + I_OUT + I_UP + I_DN + I_PG + I_PP + I_W1 + I_W2;
        for (int it = gw; it < NITEMS; it += NGW) {
            int r = it;
            if (r < I_IN) { p0_transpose_item(prm.in[3], nullptr, DM, 3360, Win_t, scr, r, lane); continue; } r -= I_IN;
            if (r < I_OUT) { p0_transpose_item(prm.in[12], nullptr, DM, DM, Wout_t, scr, r, lane); continue; } r -= I_OUT;
            if (r < I_UP) { p0_transpose_item<true>(prm.in[14], prm.in[13], DM, 4096, Wup_t, scr, r, lane); continue; } r -= I_UP;
            if (r < I_DN) { p0_transpose_item(prm.in[17], nullptr, DFF, DM, Wdn_t, scr, r, lane); continue; } r -= I_DN;
            if (r < I_PG) { p0_transpose_item(prm.in[19], prm.in[18], DM, DM, Wpg_t, scr, r, lane); continue; } r -= I_PG;
            if (r < I_PP) { p0_transpose_item(prm.in[20], nullptr, PLE, DM, Wpp_t, scr, r, lane); continue; } r -= I_PP;
            if (r < I_W1) { const int q = r >> 6, kv = q >> 1, half = q & 1;
                p0_transpose_item(prm.in[kv ? 10 : 8] + (size_t)half * 1024 * 128, nullptr, 1024, 128, W1T + (size_t)kv * 256 * 1024 + (size_t)half * 128 * 1024, scr, r & 63, lane); continue; } r -= I_W1;
            { const int kv = r >> 2; p0_transpose_item(prm.in[kv ? 11 : 9], nullptr, 128, 64, W2T + (size_t)kv * 64 * 128, scr, r & 3, lane); }
        }
        if (tid < 256) { const int kv = tid >> 7, j = tid & 127; const float* pe = prm.in[kv ? 7 : 6]; const float* w1 = prm.in[kv ? 10 : 8]; float a = 0.f;
            const int per = (2048 + G - 1) / G; const int l0 = bx * per, l1 = min(2048, l0 + per);
            for (int ld = l0; ld < l1; ++ld) a += pe[ld] * w1[(size_t)ld * 128 + j];
            if (l0 < l1) atomicAdd(C1 + kv * 128 + j, a); }
        for (int i = bx * NTHREADS + tid; i < (NZ - 3360) * DM / 8; i += G * NTHREADS) ((u32x4*)(Win_t + (size_t)3360 * DM))[i] = (u32x4){0u, 0u, 0u, 0u};
        const float* g1 = prm.in[2];
        f32x4 gv[4];
#pragma unroll
        for (int j = 0; j < 4; ++j) gv[j] = ((const f32x4*)g1)[lane + 64 * j];
        for (int m = 2 * gw; m < MTOK; m += 2 * NGW) {
            f32x4 v[2][4]; float sq[2];
#pragma unroll
            for (int k = 0; k < 2; ++k) { const f32x4* xr = (const f32x4*)(x + (size_t)(m + k) * DM) + lane;
#pragma unroll
                for (int j = 0; j < 4; ++j) v[k][j] = xr[64 * j]; }
#pragma unroll
            for (int k = 0; k < 2; ++k) { float s = 0.f;
#pragma unroll
                for (int j = 0; j < 4; ++j) s += (v[k][j][0] * v[k][j][0] + v[k][j][1] * v[k][j][1]) + (v[k][j][2] * v[k][j][2] + v[k][j][3] * v[k][j][3]);
                sq[k] = s; }
#pragma unroll
            for (int o = 1; o < 64; o <<= 1) { sq[0] += __shfl_xor(sq[0], o); sq[1] += __shfl_xor(sq[1], o); }
#pragma unroll
            for (int k = 0; k < 2; ++k) { const float rstd = 1.0f / sqrtf(sq[k] * (1.0f / DM) + EPS);
                u32x2* o8 = (u32x2*)(XB + (size_t)(m + k) * DM) + lane;
#pragma unroll
                for (int j = 0; j < 4; ++j) { u32x2 w; w.x = pk2(v[k][j][0] * rstd * gv[j][0], v[k][j][1] * rstd * gv[j][1]); w.y = pk2(v[k][j][2] * rstd * gv[j][2], v[k][j][3] * rstd * gv[j][3]); o8[64 * j] = w; } }
        }
        for (size_t i = (size_t)bx * NTHREADS + tid; i < (size_t)MTOK * PLE / 8; i += (size_t)G * NTHREADS) {
            const f32x4 a = ((const f32x4*)pin)[2 * i], c = ((const f32x4*)pin)[2 * i + 1];
            u32x4 w; w.x = pk2(a[0], a[1]); w.y = pk2(a[2], a[3]); w.z = pk2(c[0], c[1]); w.w = pk2(c[2], c[3]); ((u32x4*)PB)[i] = w; }
    }
    grid.sync();
    STAMP(1);

    _Pragma("unroll 1") for (int rep_ = 0; rep_ < DUPREPS(1); ++rep_)
    {
        WSP(bf16_t, XB, WS_XB) WSP(bf16_t, Win_t, WS_WIN) WSP(bf16_t, Z, WS_Z) WSP(float, GATES, WS_GATES)
        pg8::Gemm g{XB, Win_t, MTOK, NZ, DM}; pg8::StaticOrder S; S.init(MTOK, NZ, GRIDN, BX);
#ifdef P1_PLAIN_DUP
        if (rep_ > 0) { pg8::EpiBf<false> E2{Z, NZ, nullptr}; pg8::gemm_phase<pg8::EpiBf<false>, pg8::StaticOrder, true, true>(ldsl, g, S, E2); } else
#endif
        { pg8::EpiZ E{Z, GATES};
        pg8::gemm_phase<pg8::EpiZ, pg8::StaticOrder, true, true>(ldsl, g, S, E); }
    }
    xcd_barrier(xbar);
    STAMP(2);

    _Pragma("unroll 1") for (int rep_ = 0; rep_ < DUPREPS(2); ++rep_)
    {
        WSP(bf16_t, Z, WS_Z) WSP(bf16_t, KCB, WS_KCB) WSP(bf16_t, VCT, WS_VCT) WSP(bf16_t, VST, WS_VST) WSP(bf16_t, VWT, WS_VWT)
        const bool split = GRIDN > 128;
        if (!split || BX < 64) {
            WSP(bf16_t, W1T, WS_W1T) WSP(bf16_t, W2T, WS_W2T) WSP(float, C1, WS_C1)
            for (int un = BX; un < 64; un += (split ? 64 : GRIDN)) {
                pg8::Gemm g{nullptr, nullptr, 256, 256, 1024, 16 * NZ, NZ * 2}; pg8::CmpOrder S{un, Z, W1T};
                pg8::EpiCmp E{C1, W2T, KCB, VCT};
                pg8::gemm_phase<pg8::EpiCmp, pg8::CmpOrder, true, true>(ldsl, g, S, E);
                __syncthreads();
            }
        }
        if (!split || BX >= 64)
        for (int un = split ? BX - 64 : BX; un < BATCH * 2 * 2 * 64; un += (split ? GRIDN - 64 : GRIDN)) {
            const int ch = un & 63, br = (un >> 6) & 1, g = (un >> 7) & 1, b = un >> 8;
            vt_unit(Z, br ? ZC_AVW : ZC_AVS, br ? VWT : VST, b, g, ch, (unsigned short*)lds, TID);
        }
    }
    xcd_barrier(xbar);
    STAMP(3);

    _Pragma("unroll 1") for (int rep_ = 0; rep_ < DUPREPS(3); ++rep_)
    {
        WSP(bf16_t, Z, WS_Z) WSP(float, GATES, WS_GATES) WSP(bf16_t, MIX, WS_MIX)
        {
            MlF MP{Z, GATES, MIX, prm.in[4], prm.in[5]};
            _Pragma("unroll 1") for (int rep2_ = 0; rep2_ < DUPREPS(30); ++rep2_)
            for (int un = BX; un < BATCH * 4; un += GRIDN) mlstm_unit_v2(MP, un >> 2, un & 3, (LAS3 unsigned char*)lds, TID);
        }
        __syncthreads();
        {
            WSP(bf16_t, KCB, WS_KCB) WSP(bf16_t, VCT, WS_VCT) WSP(bf16_t, VST, WS_VST) WSP(bf16_t, VWT, WS_VWT)
            NsaF NP{Z, GATES, KCB, VCT, VST, VWT, MIX};
            unsigned* qctr; { unsigned char* w_ = prm.ws; asm volatile("" : "+s"(w_)); qctr = (unsigned*)(w_ + WS_CTL) + 64; }
            volatile LAS3 int* slot = (volatile LAS3 int*)((LAS3 unsigned char*)lds + NC_QSLOT);
            _Pragma("unroll 1") for (int rep2_ = 0; rep2_ < DUPREPS(31); ++rep2_) {
            int tk = 0;
            if (TID == 0) tk = (int)atomicAdd(qctr + 64 * rep2_, 1u);
            for (;;) {
                if (TID == 0) { *slot = tk; if (tk < BATCH * 2 * 64) tk = (int)atomicAdd(qctr + 64 * rep2_, 1u); }
                __syncthreads();
                const int grp = *slot;
                __syncthreads();
                if (grp >= BATCH * 2 * 64) break;
#ifdef NSA_DRY
                nsa_unit_coop(NP, (grp >> 1) & 15, grp & 1, 63 - (grp >> 5), (LAS3 unsigned char*)lds, TID, rep2_ ? NSA_DRY : 0);
#else
                nsa_unit_coop(NP, (grp >> 1) & 15, grp & 1, 63 - (grp >> 5), (LAS3 unsigned char*)lds, TID);
#endif
            } }
        }
    }
    xcd_barrier(xbar);
    STAMP(4);

    _Pragma("unroll 1") for (int rep_ = 0; rep_ < DUPREPS(4); ++rep_)
    {
        WSP(bf16_t, MIX, WS_MIX) WSP(bf16_t, Wout_t, WS_WOUT) WSP(bf16_t, XB, WS_XB) WSP(float, RS2, WS_RS2)
        pg8::Gemm g{MIX, Wout_t, MTOK, DM, DM}; pg8::PanelOrder S; S.init(MTOK, GRIDN, BX);
        pg8::EpiRes<true> E{prm.in[0], nullptr, XB, RS2};
        pg8::gemm_phase<pg8::EpiRes<true>, pg8::PanelOrder, true, true>(ldsl, g, S, E);
        WSP(float, RSTD2, WS_RSTD2)
        asm volatile("s_waitcnt vmcnt(0)" ::: "memory"); __syncthreads();
        for (int p = BX; p < MTOK / 256; p += GRIDN) if (TID < 256) { const int row = p * 256 + TID; RSTD2[row] = pg8::row_rstd(RS2, row); }
    }
    xcd_barrier(xbar);
    STAMP(5);

    _Pragma("unroll 1") for (int rep_ = 0; rep_ < DUPREPS(5); ++rep_)
    {
        WSP(bf16_t, XB, WS_XB) WSP(bf16_t, Wup_t, WS_WUP) WSP(bf16_t, ACT, WS_ACT) WSP(float, RS2, WS_RSTD2)
        PG8_LAS float* car = (PG8_LAS float*)(ldsl + 131072 + 1024);
        pg8::Gemm g{XB, Wup_t, MTOK, 4096, DM, 0, 0}; pg8::ChainOrder S{BX};
        pg8::EpiUpConv E{ACT, RS2, prm.in[15], prm.in[16], car};
        pg8::gemm_phase<pg8::EpiUpConv, pg8::ChainOrder, true, true>(ldsl, g, S, E);
    }
    xcd_barrier(xbar);
    STAMP(6);

    _Pragma("unroll 1") for (int rep_ = 0; rep_ < DUPREPS(7); ++rep_)
    {
        WSP(bf16_t, ACT, WS_ACT) WSP(bf16_t, Wdn_t, WS_WDN) WSP(bf16_t, XB, WS_XB) WSP(float, RS3, WS_RS3)
        pg8::Gemm g{ACT, Wdn_t, MTOK, DM, DFF}; pg8::PanelOrder S; S.init(MTOK, GRIDN, BX);
        pg8::EpiRes<false> E{nullptr, XB, XB, RS3};
        pg8::gemm_phase<pg8::EpiRes<false>, pg8::PanelOrder, true, true>(ldsl, g, S, E);
        WSP(float, RSTD3, WS_RSTD3)
        asm volatile("s_waitcnt vmcnt(0)" ::: "memory"); __syncthreads();
        for (int p = BX; p < MTOK / 256; p += GRIDN) if (TID < 256) { const int row = p * 256 + TID; RSTD3[row] = pg8::row_rstd(RS3, row); }
    }
    _Pragma("unroll 1") for (int rep_ = 0; rep_ < DUPREPS(8); ++rep_)
    {
        WSP(bf16_t, PB, WS_PB) WSP(bf16_t, Wpp_t, WS_WPP) WSP(bf16_t, PROJ, WS_PROJ)
        pg8::Gemm g{PB, Wpp_t, MTOK, DM, PLE}; pg8::StaticOrder S; S.init(MTOK, DM, GRIDN, BX);
        pg8::EpiBf<false> E{PROJ, DM, nullptr};
        pg8::gemm_phase<pg8::EpiBf<false>, pg8::StaticOrder, true, true>(ldsl, g, S, E);
    }
    xcd_barrier(xbar);
    STAMP(8);

    _Pragma("unroll 1") for (int rep_ = 0; rep_ < DUPREPS(9); ++rep_)
    {
        WSP(bf16_t, XB, WS_XB) WSP(bf16_t, Wpg_t, WS_WPG) WSP(bf16_t, PROJ, WS_PROJ) WSP(float, RS3, WS_RSTD3)
        pg8::Gemm g{XB, Wpg_t, MTOK, DM, DM}; pg8::PanelOrder S; S.init(MTOK, GRIDN, BX);
        WSP(bf16_t, X3B, WS_ACT) WSP(float, RS4, WS_RS2)
        pg8::EpiPle E{XB, PROJ, RS3, X3B, RS4};
        pg8::gemm_phase<pg8::EpiPle, pg8::PanelOrder, true, true>(ldsl, g, S, E);
    }
    xcd_barrier(xbar);
    STAMP(9);

    _Pragma("unroll 1") for (int rep_ = 0; rep_ < DUPREPS(10); ++rep_)
    {
        WSP(bf16_t, X3B, WS_ACT) WSP(float, RS4, WS_RS2)
        const int lane = LANE; const int gw = BX * NWAVES + WAVE, NGW = GRIDN * NWAVES;
        const float* fg = prm.in[21]; float* out = prm.out;
        f32x4 gv[4];
#pragma unroll
        for (int j = 0; j < 4; ++j) gv[j] = ((const f32x4*)fg)[4 * lane + j];
        for (int m = 4 * gw; m < MTOK; m += 4 * NGW) {
            u32x4 xa[4][2]; float ss[4];
#pragma unroll
            for (int k = 0; k < 4; ++k) { const u32x4* xr = (const u32x4*)(X3B + (size_t)(m + k) * DM) + 2 * lane; xa[k][0] = xr[0]; xa[k][1] = xr[1];
                ss[k] = (lane < 16) ? RS4[(size_t)(m + k) * 16 + lane] : 0.f; }
#pragma unroll
            for (int k = 0; k < 4; ++k) { float s = ss[k]; s += __shfl_xor(s, 1); s += __shfl_xor(s, 2); s += __shfl_xor(s, 4); s += __shfl_xor(s, 8); s = __shfl(s, 0);
                const float rstd = __builtin_amdgcn_rsqf(s * (1.0f / DM) + EPS);
                f32x4* o = (f32x4*)(out + (size_t)(m + k) * DM) + 4 * lane;
                const u32x4 w0 = xa[k][0], w1 = xa[k][1];
                o[0] = (f32x4){bflo(w0.x), bfhi(w0.x), bflo(w0.y), bfhi(w0.y)} * rstd * gv[0]; o[1] = (f32x4){bflo(w0.z), bfhi(w0.z), bflo(w0.w), bfhi(w0.w)} * rstd * gv[1];
                o[2] = (f32x4){bflo(w1.x), bfhi(w1.x), bflo(w1.y), bfhi(w1.y)} * rstd * gv[2]; o[3] = (f32x4){bflo(w1.z), bfhi(w1.z), bflo(w1.w), bfhi(w1.w)} * rstd * gv[3]; }
        }
    }
#ifdef PROBE_A
    xcd_barrier(xbar);
    {
        unsigned char* w_ = prm.ws; asm volatile("" : "+s"(w_)); const unsigned long long* ts = (const unsigned long long*)w_;
        const float ta = (float)(ts[PROBE_A + 1] - ts[PROBE_A]) * 0.01f, tb = (float)(ts[PROBE_B + 1] - ts[PROBE_B]) * 0.01f;
        float* out = prm.out;
        if (BX == 0 && TID == 0) out[0] += ta;
        for (size_t i = (size_t)BX * NTHREADS + TID; i < (size_t)1024 * 1024; i += (size_t)GRIDN * NTHREADS) out[1024 + i] += tb * 0.01f;
    }
#endif

}

extern "C" void kernel_launch(void* const* d_in, const int* in_sizes, int n_in, void* d_out, int out_size, void* d_ws, size_t ws_size, hipStream_t stream) {
    static int grid = 0;
    if (grid == 0) {
        if (n_in != 22 || out_size != MTOK * DM || ws_size < WS_END) { fprintf(stderr, "kernel_launch: unexpected problem (n_in %d, out %d, ws %zu)\n", n_in, out_size, ws_size); grid = -1; return; }
        int dev = 0, cus = 0, per_cu = 0;
        if (hipGetDevice(&dev) != hipSuccess || hipDeviceGetAttribute(&cus, hipDeviceAttributeMultiprocessorCount, dev) != hipSuccess) { grid = -1; return; }
        if (hipFuncSetAttribute((const void*)fwd_kernel, hipFuncAttributeMaxDynamicSharedMemorySize, LDS_BYTES) != hipSuccess) { fprintf(stderr, "kernel_launch: hipFuncSetAttribute failed\n"); grid = -1; return; }
        if (hipOccupancyMaxActiveBlocksPerMultiprocessor(&per_cu, (const void*)fwd_kernel, NTHREADS, LDS_BYTES) != hipSuccess || per_cu < 1) { fprintf(stderr, "kernel_launch: occupancy query says %d\n", per_cu); (void)hipGetLastError(); per_cu = 1; }
        grid = cus * 1;
    }
    if (grid < 0) return;
    if (hipMemsetAsync((char*)d_ws + WS_CTL, 0, 65536, stream) != hipSuccess) { fprintf(stderr, "kernel_launch: hipMemsetAsync failed\n"); return; }
    Params p{};
    for (int i = 0; i < 22; ++i) p.in[i] = (const float*)d_in[i];
    p.out = (float*)d_out; p.ws = (unsigned char*)d_ws;
    void* args[] = {&p};
    hipError_t e = hipLaunchCooperativeKernel((const void*)fwd_kernel, dim3(grid), dim3(NTHREADS), args, LDS_BYTES, stream);
    if (e != hipSuccess) fprintf(stderr, "kernel_launch: cooperative launch failed: %s (grid %d)\n", hipGetErrorString(e), grid);
}
```

```cpp
#include <hip/hip_runtime.h>
#include <hip/hip_cooperative_groups.h>
#include <cstdio>
#include <cstdint>
namespace cg = cooperative_groups;
namespace pg8 {
#define PG8_LAS __attribute__((address_space(3)))
typedef unsigned short bf16_t;
typedef short bf16x8 __attribute__((ext_vector_type(8)));
typedef float f32x4 __attribute__((ext_vector_type(4)));
typedef unsigned u32x4 __attribute__((ext_vector_type(4)));
constexpr int BM = 256, BK = 64, HALF = 128, HTB = HALF * BK * 2  , STAGE_BYTES = 8 * HTB, NXCD = 8, WGM = 8;

__host__ __device__ __forceinline__ int lds_byte(int r, int c) { const int st = (r >> 4) * 2 + (c >> 5), rr = r & 15, cc = c & 31, ob = rr * 64 + cc * 2; return st * 1024 + (ob ^ (((ob >> 9) & 1) << 5)); }
__host__ __device__ __forceinline__ void stage_rc(int b, int& R, int& C) { const int st = b / 1024, sb = b % 1024, swz = sb ^ (((sb >> 9) & 1) << 5); R = (st >> 1) * 16 + swz / 64; C = (st & 1) * 32 + (swz % 64) / 2; }
__host__ __device__ __forceinline__ int perm32(int rho) { const int n = rho >> 4, i = rho & 15; return 8 * (i >> 2) + 4 * n + (i & 3); }

struct Unit { int pm, pn; };
struct Gemm { const bf16_t* A; const bf16_t* Bt; int M, N, K; int lda, kstepA; };

struct StaticOrder {
    int nM, nN, nwg, G, c;
    __host__ __device__ void init(int M, int N, int G_, int c_) { nM = M / BM; nN = N / BM; nwg = nM * nN; G = G_; c = c_; }
    __host__ __device__ bool next(int i, Unit& u) const {
        const long L = (long)i * G + c; if (L >= nwg) return false;
        int wgid = (int)L; { const int q = nwg / NXCD, r = nwg % NXCD, xcd = wgid % NXCD, off = wgid / NXCD; wgid = (xcd < r ? xcd * (q + 1) : r * (q + 1) + (xcd - r) * q) + off; }
        const int nig = WGM * nN, gid = wgid / nig, fm = gid * WGM, gsz = (nM - fm) < WGM ? (nM - fm) : WGM;
        u.pm = fm + ((wgid % nig) % gsz); u.pn = (wgid % nig) / gsz; return true;
    }
    __device__ __forceinline__ void a_ready(const Unit&) const {}
    __device__ __forceinline__ void done(const Unit&) const {}
    __device__ __forceinline__ const char* a_tile(const Gemm& g, const Unit& u, size_t tstepA) const { return (const char*)g.A + (size_t)u.pm * tstepA; }
    __device__ __forceinline__ const char* b_tile(const Gemm& g, const Unit& u, size_t tstepB) const { return (const char*)g.Bt + (size_t)u.pn * tstepB; }
};

__device__ __forceinline__ unsigned cvt_pk_bf16(float lo, float hi) { unsigned r; asm volatile("v_cvt_pk_bf16_f32 %0, %1, %2" : "=v"(r) : "v"(lo), "v"(hi)); return r; }
typedef float f32x2 __attribute__((ext_vector_type(2)));
__device__ __forceinline__ f32x2 gelu_pk(f32x2 v) {
    const f32x2 av = __builtin_elementwise_abs(v), d = av * 0.2316418882f + 1.0f;
    f32x2 t; t.x = __builtin_amdgcn_rcpf(d.x); t.y = __builtin_amdgcn_rcpf(d.y);
    f32x2 q = t * 0.5307027145f + (-0.7265760135f); q = q * t + 0.7107068705f; q = q * t + (-0.142248368f); q = q * t + 0.127414796f; q = q * t;
    const f32x2 s = (v * v) * (-0.72134752044f);
    f32x2 e; e.x = __builtin_amdgcn_exp2f(s.x); e.y = __builtin_amdgcn_exp2f(s.y);
    const f32x2 m = v * (q * e), r = v - m;
    f32x2 o; o.x = v.x < 0.f ? m.x : r.x; o.y = v.y < 0.f ? m.y : r.y; return o;
}

template <int ACT  > struct EpiBf16 {
    static constexpr bool PERM = true, AFTER_DRAIN = false; static_assert(ACT == 0 || ACT == 1, "EpiBf16: ACT is 0 (none) or 1 (gelu_pk)");
    bf16_t* O; int ldc; const float* bias; int split_cols; size_t split_stride; float scale0;
    __device__ __forceinline__ void operator()(const f32x4 (&acc)[2][2][4][2], const Unit& u, int wr, int wc, int fr, int fq) const {
        const int row0 = u.pm * BM + wr * 64 + fr; int colt = u.pn * BM; bf16_t* base = O;
        float sc = 1.f; if (split_cols) { const int t = colt / split_cols; base += (size_t)t * split_stride; colt -= t * split_cols; if (t == 0) sc = scale0; }
        const int col0 = colt + wc * 32 + 8 * fq, bcol0 = u.pn * BM + wc * 32 + 8 * fq;
        f32x4 bv[2][2];
#pragma unroll
        for (int bj = 0; bj < 2; ++bj)
#pragma unroll
            for (int n = 0; n < 2; ++n) bv[bj][n] = bias ? *(const f32x4*)(bias + bcol0 + bj * HALF + 4 * n) : (f32x4){0.f, 0.f, 0.f, 0.f};
#pragma unroll
        for (int ai = 0; ai < 2; ++ai)
#pragma unroll
            for (int m = 0; m < 4; ++m) { bf16_t* rowp = base + (size_t)(row0 + ai * HALF + m * 16) * ldc + col0;
#pragma unroll
                for (int bj = 0; bj < 2; ++bj) { f32x4 v0 = acc[ai][bj][m][0] + bv[bj][0], v1 = acc[ai][bj][m][1] + bv[bj][1];
                    if (ACT == 1) { f32x2 a = gelu_pk((f32x2){v0[0], v0[1]}), b = gelu_pk((f32x2){v0[2], v0[3]}), c = gelu_pk((f32x2){v1[0], v1[1]}), d = gelu_pk((f32x2){v1[2], v1[3]});
                        v0 = (f32x4){a.x, a.y, b.x, b.y}; v1 = (f32x4){c.x, c.y, d.x, d.y}; }
                    v0 = v0 * sc; v1 = v1 * sc; u32x4 w; w.x = cvt_pk_bf16(v0[0], v0[1]); w.y = cvt_pk_bf16(v0[2], v0[3]); w.z = cvt_pk_bf16(v1[0], v1[1]); w.w = cvt_pk_bf16(v1[2], v1[3]);
                    *(u32x4*)(rowp + bj * HALF) = w; } }
    }
};
template <class Epi, class Sched, bool ALIGN_EPI = false, bool SP2 = false>
__device__ __forceinline__ void gemm_phase(PG8_LAS unsigned char* lds, const Gemm g, const Sched& S, Epi& E) {
    int tid_ = threadIdx.x; asm volatile("" : "+v"(tid_));
    const int tid = tid_, wid = __builtin_amdgcn_readfirstlane(tid >> 6), lane = tid & 63, wr = wid >> 2, wc = wid & 3, fr = lane & 15, fq = lane >> 4;
    int K_ = g.K; asm volatile("" : "+s"(K_)); const int K = K_, nt = K / BK;
    const int lda = g.lda ? g.lda : K;
    unsigned voffA[2], voffB[2];
#pragma unroll
    for (int i = 0; i < 2; ++i) { int R, C; stage_rc(tid * 16 + i * 8192, R, C); const int Rb = Epi::PERM ? ((R & ~31) + perm32(R & 31)) : R;
        voffA[i] = (unsigned)(R * lda + C) * 2u; voffB[i] = (unsigned)(Rb * K + C) * 2u; }
    const size_t kstepB = (size_t)(BK * 2), kstepA = g.kstepA ? (size_t)g.kstepA : kstepB;
    const size_t hstepB = (size_t)HALF * K * 2, hstepA = (size_t)HALF * lda * 2;
    const size_t tstepB = 2 * hstepB, tstepA = 2 * hstepA;
    const unsigned ldsw = (unsigned)wid * 1024u;
    const int aoff = lds_byte(wr * 64 + fr, fq * 8), boff = lds_byte(wc * 32 + fr, fq * 8);
#define PG8_SA(b, h) (((b) * 2 + (h)) * HTB)
#define PG8_SB(b, h) ((4 + (b) * 2 + (h)) * HTB)
#define PG8_STAGE(bufoff, gbase, voff) do { _Pragma("unroll") for (int _i = 0; _i < 2; ++_i) \
        __builtin_amdgcn_global_load_lds((const unsigned*)((const char*)(gbase) + (voff)[_i]), (PG8_LAS unsigned*)(lds + (bufoff) + ldsw + _i * 8192), 16, 0, 0); } while (0)
#define PG8_LDA(dst, b, h) do { _Pragma("unroll") for (int m = 0; m < 4; ++m) _Pragma("unroll") for (int k = 0; k < 2; ++k) dst[m][k] = *(const PG8_LAS bf16x8*)(lds + PG8_SA(b, h) + aoff + m * 2048 + k * 1024); } while (0)
#define PG8_LDB(dst, b, h) do { _Pragma("unroll") for (int n = 0; n < 2; ++n) _Pragma("unroll") for (int k = 0; k < 2; ++k) dst[n][k] = *(const PG8_LAS bf16x8*)(lds + PG8_SB(b, h) + boff + n * 2048 + k * 1024); } while (0)
#define PG8_MMA(ai, bj, At, Bt) do { __builtin_amdgcn_s_setprio(1); _Pragma("unroll") for (int m = 0; m < 4; ++m) _Pragma("unroll") for (int n = 0; n < 2; ++n) _Pragma("unroll") for (int k = 0; k < 2; ++k) \
        acc[ai][bj][m][n] = __builtin_amdgcn_mfma_f32_16x16x32_bf16(Bt[n][k], At[m][k], acc[ai][bj][m][n], 0, 0, 0); __builtin_amdgcn_s_setprio(0); } while (0)
#define PG8_WAIT_V(n) asm volatile("s_waitcnt vmcnt(" #n ")" ::: "memory")
#define PG8_WAIT_L(n) asm volatile("s_waitcnt lgkmcnt(" #n ")" ::: "memory")
#define PG8_BAR __builtin_amdgcn_s_barrier()
#define PG8_SCHED __builtin_amdgcn_sched_barrier(0)
    Unit cur, nxt; int ui = 0;
    if (!S.next(0, cur)) return;
    f32x4 acc[2][2][4][2];
#pragma unroll
    for (int a = 0; a < 2; ++a)
#pragma unroll
        for (int b = 0; b < 2; ++b)
#pragma unroll
            for (int m = 0; m < 4; ++m)
#pragma unroll
                for (int n = 0; n < 2; ++n) acc[a][b][m][n] = (f32x4){0.f, 0.f, 0.f, 0.f};
    bf16x8 At[4][2], B0[2][2], B1[2][2];
    const char* cA = S.a_tile(g, cur, tstepA); const char* cB = S.b_tile(g, cur, tstepB);
    S.a_ready(cur);
    if constexpr (SP2) {
        PG8_STAGE(PG8_SB(0, 0), cB, voffB); PG8_STAGE(PG8_SB(0, 1), cB + hstepB, voffB); PG8_STAGE(PG8_SA(0, 0), cA, voffA); PG8_STAGE(PG8_SA(0, 1), cA + hstepA, voffA);
        if (wr == 1) PG8_BAR;
        PG8_WAIT_V(2); PG8_BAR;
        PG8_STAGE(PG8_SB(1, 0), cB + kstepB, voffB); PG8_STAGE(PG8_SA(1, 0), cA + kstepA, voffA); PG8_STAGE(PG8_SB(1, 1), cB + hstepB + kstepB, voffB);
        PG8_WAIT_V(6); PG8_BAR;
    } else {
        PG8_STAGE(PG8_SB(0, 0), cB, voffB); PG8_STAGE(PG8_SA(0, 0), cA, voffA); PG8_STAGE(PG8_SB(0, 1), cB + hstepB, voffB); PG8_STAGE(PG8_SA(0, 1), cA + hstepA, voffA);
        if (wr == 1) PG8_BAR;
        PG8_WAIT_V(4); PG8_BAR;
        PG8_STAGE(PG8_SB(1, 0), cB + kstepB, voffB); PG8_STAGE(PG8_SA(1, 0), cA + kstepA, voffA); PG8_STAGE(PG8_SB(1, 1), cB + hstepB + kstepB, voffB);
        PG8_WAIT_V(6); PG8_BAR;
    }
    for (;;) {
        const bool has_next = S.next(ui + 1, nxt);
        const char* nA = has_next ? S.a_tile(g, nxt, tstepA) : cA; const char* nB = has_next ? S.b_tile(g, nxt, tstepB) : cB;
        for (int t = 0; t < nt; t += 2) {
            const bool last = (t == nt - 2);
            const char* a1 = cA + (size_t)(t + 1) * kstepA;
            const char* a2 = last ? nA : cA + (size_t)(t + 2) * kstepA; const char* b2 = last ? nB : cB + (size_t)(t + 2) * kstepB;
            const char* a3 = a2 + kstepA; const char* b3 = b2 + kstepB;
            if (last && has_next) S.a_ready(nxt);
            if constexpr (SP2) {
            PG8_LDB(B0, 0, 0); PG8_LDB(B1, 0, 1); PG8_SCHED; PG8_LDA(At, 0, 0); PG8_STAGE(PG8_SA(1, 1), a1 + hstepA, voffA);
            PG8_WAIT_V(8); PG8_WAIT_L(0); PG8_BAR; PG8_MMA(0, 0, At, B0); PG8_MMA(0, 1, At, B1); PG8_BAR; PG8_SCHED;
            PG8_LDA(At, 0, 1); PG8_STAGE(PG8_SB(0, 0), b2, voffB); PG8_STAGE(PG8_SB(0, 1), b2 + hstepB, voffB); PG8_STAGE(PG8_SA(0, 0), a2, voffA);
            PG8_WAIT_V(8); PG8_WAIT_L(0); PG8_BAR; PG8_MMA(1, 0, At, B0); PG8_MMA(1, 1, At, B1); PG8_BAR; PG8_SCHED;
            PG8_LDB(B0, 1, 0); PG8_LDB(B1, 1, 1); PG8_SCHED; PG8_LDA(At, 1, 0); PG8_STAGE(PG8_SA(0, 1), a2 + hstepA, voffA);
            PG8_WAIT_V(8); PG8_WAIT_L(0); PG8_BAR; PG8_MMA(0, 0, At, B0); PG8_MMA(0, 1, At, B1); PG8_BAR; PG8_SCHED;
            PG8_LDA(At, 1, 1); PG8_STAGE(PG8_SB(1, 0), b3, voffB); PG8_STAGE(PG8_SB(1, 1), b3 + hstepB, voffB); PG8_STAGE(PG8_SA(1, 0), a3, voffA);
            PG8_WAIT_V(8); PG8_WAIT_L(0); PG8_BAR; PG8_MMA(1, 0, At, B0); PG8_MMA(1, 1, At, B1); PG8_BAR; PG8_SCHED;
            } else {
            PG8_LDB(B0, 0, 0); PG8_SCHED; PG8_LDA(At, 0, 0); PG8_STAGE(PG8_SA(1, 1), a1 + hstepA, voffA);
            PG8_WAIT_L(8); PG8_BAR; PG8_WAIT_L(0); PG8_MMA(0, 0, At, B0); PG8_BAR; PG8_SCHED;
            PG8_LDB(B1, 0, 1); PG8_STAGE(PG8_SB(0, 0), b2, voffB);
            PG8_BAR; PG8_WAIT_L(0); PG8_MMA(0, 1, At, B1); PG8_BAR;
            PG8_LDA(At, 0, 1); PG8_STAGE(PG8_SA(0, 0), a2, voffA);
            PG8_BAR; PG8_WAIT_L(0); PG8_MMA(1, 0, At, B0); PG8_BAR; PG8_SCHED;
            PG8_STAGE(PG8_SB(0, 1), b2 + hstepB, voffB);
            PG8_WAIT_V(6); PG8_BAR; PG8_MMA(1, 1, At, B1); PG8_BAR;
            PG8_LDB(B0, 1, 0); PG8_SCHED; PG8_LDA(At, 1, 0); PG8_STAGE(PG8_SA(0, 1), a2 + hstepA, voffA);
            PG8_WAIT_L(8); PG8_BAR; PG8_WAIT_L(0); PG8_MMA(0, 0, At, B0); PG8_BAR; PG8_SCHED;
            PG8_LDB(B1, 1, 1); PG8_STAGE(PG8_SB(1, 0), b3, voffB);
            PG8_BAR; PG8_WAIT_L(0); PG8_MMA(0, 1, At, B1); PG8_BAR;
            PG8_LDA(At, 1, 1); PG8_STAGE(PG8_SA(1, 0), a3, voffA);
            PG8_BAR; PG8_WAIT_L(0); PG8_MMA(1, 0, At, B0); PG8_BAR; PG8_SCHED;
            PG8_STAGE(PG8_SB(1, 1), b3 + hstepB, voffB);
            PG8_WAIT_V(6); PG8_BAR; PG8_MMA(1, 1, At, B1); PG8_BAR;
            }
        }
        if constexpr (ALIGN_EPI) { if (wr == 0) PG8_BAR; }
        if constexpr (!Epi::AFTER_DRAIN) { E(acc, cur, wr, wc, fr, fq); S.done(cur); }
        if (!has_next) break;
#pragma unroll
        for (int a = 0; a < 2; ++a)
#pragma unroll
            for (int b = 0; b < 2; ++b)
#pragma unroll
                for (int m = 0; m < 4; ++m)
#pragma unroll
                    for (int n = 0; n < 2; ++n) acc[a][b][m][n] = (f32x4){0.f, 0.f, 0.f, 0.f};
        cur = nxt; cA = nA; cB = nB; ++ui;
        if constexpr (ALIGN_EPI) { if (wr == 1) PG8_BAR; }
    }
    PG8_WAIT_V(0);
    if constexpr (!ALIGN_EPI) { if (wr == 0) PG8_BAR; }
    PG8_BAR;
    if constexpr (Epi::AFTER_DRAIN) { E.fused(acc, cur, wr, wc, fr, fq, lds, wid, lane); S.done(cur); }
#undef PG8_SA
#undef PG8_SB
#undef PG8_STAGE
#undef PG8_LDA
#undef PG8_LDB
#undef PG8_MMA
#undef PG8_WAIT_V
#undef PG8_WAIT_L
#undef PG8_BAR
#undef PG8_SCHED
}
}

constexpr int BATCH = 16, SEQ = 4096, DM = 1024, MTOK = BATCH * SEQ;
constexpr int NZ = 3584;
constexpr int ZC_MQ = 0, ZC_MK = 512, ZC_MV = 1024, ZC_MO = 1536, ZC_AQ = 2056, ZC_AKC = 2568, ZC_AVC = 2696, ZC_AKS = 2824, ZC_AVS = 2952, ZC_AKW = 3080, ZC_AVW = 3208;
constexpr int DFF = 2048, PLE = 256, NCMP = 255;
constexpr float EPS = 1e-6f;
constexpr int NWAVES = 8, NTHREADS = 512;
constexpr int LDS_BYTES = 163840;
constexpr int XBAR_LDS = 163840 - 256;

typedef unsigned short bf16_t;
typedef float f32x4 __attribute__((ext_vector_type(4)));
typedef unsigned u32x4 __attribute__((ext_vector_type(4)));
typedef unsigned u32x2 __attribute__((ext_vector_type(2)));

constexpr size_t MiB = 1u << 20;
constexpr size_t WS_CTL = 0;
constexpr size_t WS_WIN = 1 * MiB, WS_WOUT = 8 * MiB, WS_WUP = 10 * MiB, WS_WDN = 18 * MiB, WS_WPG = 22 * MiB, WS_WPP = 24 * MiB;
constexpr size_t WS_W1T = 25 * MiB, WS_W2T = 26 * MiB, WS_C1 = WS_CTL + 32768, WS_KCB = 29 * MiB, WS_VCT = 30 * MiB;
constexpr size_t WS_GATES = 32 * MiB, WS_PB = 40 * MiB, WS_XB = 72 * MiB;
constexpr size_t WS_MIX = 200 * MiB, WS_ACT = 200 * MiB;
constexpr size_t WS_Z = 456 * MiB, WS_U = 456 * MiB, WS_PROJ = 456 * MiB;
constexpr size_t WS_RS2 = 968 * MiB, WS_RS3 = 972 * MiB;
constexpr size_t WS_RSTD2 = 31 * MiB, WS_RSTD3 = 31 * MiB + 512 * 1024;
constexpr size_t WS_VST = 976 * MiB, WS_VWT = 992 * MiB;
constexpr size_t WS_END = 1008 * MiB;

struct Params { const float* in[22]; float* out; unsigned char* ws; };

__device__ __forceinline__ float bf2f(unsigned u16) { return __uint_as_float(u16 << 16); }
__device__ __forceinline__ float bflo(unsigned w) { return __uint_as_float(w << 16); }
__device__ __forceinline__ float bfhi(unsigned w) { return __uint_as_float(w & 0xffff0000u); }
__device__ __forceinline__ unsigned f2bf(float f) { unsigned u = __float_as_uint(f); return (u + 0x7fffu + ((u >> 16) & 1u)) >> 16; }
__device__ __forceinline__ unsigned pk2(float lo, float hi) { return f2bf(lo) | (f2bf(hi) << 16); }
__device__ __forceinline__ float wave_sum(float v) {
#pragma unroll
    for (int o = 1; o < 64; o <<= 1) v += __shfl_xor(v, o);
    return v;
}
__device__ __forceinline__ float wave_max(float v) {
#pragma unroll
    for (int o = 1; o < 64; o <<= 1) v = fmaxf(v, __shfl_xor(v, o));
    return v;
}
__device__ __forceinline__ float sigmoidf_(float x) { return __builtin_amdgcn_rcpf(1.0f + __expf(-x)); }
__device__ __forceinline__ float log_sigmoidf_(float x) { return fminf(x, 0.f) - __logf(1.0f + __expf(-fabsf(x))); }
#define WAVE_LDS_SYNC() asm volatile("s_waitcnt lgkmcnt(0)" ::: "memory")

namespace pg8 {
__device__ __forceinline__ float row_rstd(const float* rs, int row) {
    const f32x4* p = (const f32x4*)(rs + (size_t)row * 16); const f32x4 a = p[0], b = p[1], c = p[2], d = p[3];
    const float s = (((a[0] + a[1]) + (a[2] + a[3])) + ((b[0] + b[1]) + (b[2] + b[3]))) + (((c[0] + c[1]) + (c[2] + c[3])) + ((d[0] + d[1]) + (d[2] + d[3])));
    return 1.0f / sqrtf(s * (1.0f / 1024.0f) + EPS);
}
struct EpiZ {
    static constexpr bool PERM = true, AFTER_DRAIN = false;
    bf16_t* Z; float* gates;
    __device__ __forceinline__ void operator()(const f32x4 (&acc)[2][2][4][2], const Unit& u, int wr, int wc, int fr, int fq) {
        const int row0 = u.pm * BM + wr * 64 + fr; const int col0 = u.pn * BM + wc * 32 + 8 * fq;
#pragma unroll
        for (int ai = 0; ai < 2; ++ai)
#pragma unroll
            for (int m = 0; m < 4; ++m) { const int row = row0 + ai * HALF + m * 16; bf16_t* rowp = Z + (size_t)row * NZ + col0;
#pragma unroll
                for (int bj = 0; bj < 2; ++bj) { const f32x4 v0 = acc[ai][bj][m][0], v1 = acc[ai][bj][m][1];
                    u32x4 w; w.x = cvt_pk_bf16(v0[0], v0[1]); w.y = cvt_pk_bf16(v0[2], v0[3]); w.z = cvt_pk_bf16(v1[0], v1[1]); w.w = cvt_pk_bf16(v1[2], v1[3]);
                    *(u32x4*)(rowp + bj * HALF) = w; }
                if (wc == 0) {
                    if ((u.pn == 8 && fq == 0) || (u.pn == 13 && fq >= 1)) {
                        float* gp = gates + (size_t)row * 32 + 8 * fq;
                        *(f32x4*)(gp) = acc[ai][0][m][0]; *(f32x4*)(gp + 4) = acc[ai][0][m][1];
                    }
                }
            }
    }
};
template <bool ROWSCALE> struct EpiBf {
    static constexpr bool PERM = true, AFTER_DRAIN = false;
    bf16_t* O; int ldc; const float* rs;
    __device__ __forceinline__ void operator()(const f32x4 (&acc)[2][2][4][2], const Unit& u, int wr, int wc, int fr, int fq) {
        const int row0 = u.pm * BM + wr * 64 + fr; const int col0 = u.pn * BM + wc * 32 + 8 * fq;
#pragma unroll
        for (int ai = 0; ai < 2; ++ai)
#pragma unroll
            for (int m = 0; m < 4; ++m) { const int row = row0 + ai * HALF + m * 16; bf16_t* rowp = O + (size_t)row * ldc + col0;
                float sc = 1.f;
                if (ROWSCALE) sc = row_rstd(rs, row);
#pragma unroll
                for (int bj = 0; bj < 2; ++bj) { const f32x4 v0 = acc[ai][bj][m][0] * sc, v1 = acc[ai][bj][m][1] * sc;
                    u32x4 w; w.x = cvt_pk_bf16(v0[0], v0[1]); w.y = cvt_pk_bf16(v0[2], v0[3]); w.z = cvt_pk_bf16(v1[0], v1[1]); w.w = cvt_pk_bf16(v1[2], v1[3]);
                    *(u32x4*)(rowp + bj * HALF) = w; }
            }
    }
};
template <bool BASE_F32> struct EpiRes {
    static constexpr bool PERM = true, AFTER_DRAIN = false;
    const float* basef; const bf16_t* baseb; bf16_t* xb; float* rs;
    __device__ __forceinline__ void operator()(const f32x4 (&acc)[2][2][4][2], const Unit& u, int wr, int wc, int fr, int fq) const {
        const int row0 = u.pm * BM + wr * 64 + fr, col0 = u.pn * BM + wc * 32 + 8 * fq;
#pragma unroll
        for (int ai = 0; ai < 2; ++ai)
#pragma unroll
            for (int m = 0; m < 4; ++m) { const int row = row0 + ai * HALF + m * 16; const size_t off = (size_t)row * DM + col0; float s = 0.f;
#pragma unroll
                for (int bj = 0; bj < 2; ++bj) { f32x4 b0, b1;
                    if (BASE_F32) { b0 = *(const f32x4*)(basef + off + bj * HALF); b1 = *(const f32x4*)(basef + off + bj * HALF + 4); }
                    else { const u32x4 w = *(const u32x4*)(baseb + off + bj * HALF); b0 = (f32x4){bflo(w.x), bfhi(w.x), bflo(w.y), bfhi(w.y)}; b1 = (f32x4){bflo(w.z), bfhi(w.z), bflo(w.w), bfhi(w.w)}; }
                    const f32x4 o0 = b0 + acc[ai][bj][m][0], o1 = b1 + acc[ai][bj][m][1];
                    u32x4 w; w.x = cvt_pk_bf16(o0[0], o0[1]); w.y = cvt_pk_bf16(o0[2], o0[3]); w.z = cvt_pk_bf16(o1[0], o1[1]); w.w = cvt_pk_bf16(o1[2], o1[3]);
                    *(u32x4*)(xb + off + bj * HALF) = w;
                    s += ((o0[0] * o0[0] + o0[1] * o0[1]) + (o0[2] * o0[2] + o0[3] * o0[3])) + ((o1[0] * o1[0] + o1[1] * o1[1]) + (o1[2] * o1[2] + o1[3] * o1[3])); }
                s += __shfl_xor(s, 16); s += __shfl_xor(s, 32);
                if (fq == 0) rs[(size_t)row * 16 + u.pn * 4 + wc] = s; }
    }
};
struct EpiPle {
    static constexpr bool PERM = true, AFTER_DRAIN = false;
    const bf16_t* x2b; const bf16_t* proj; const float* rstd; bf16_t* x3b; float* rs;
    __device__ __forceinline__ void operator()(const f32x4 (&acc)[2][2][4][2], const Unit& u, int wr, int wc, int fr, int fq) const {
        const int row0 = u.pm * BM + wr * 64 + fr, col0 = u.pn * BM + wc * 32 + 8 * fq;
#pragma unroll
        for (int ai = 0; ai < 2; ++ai)
#pragma unroll
            for (int m = 0; m < 4; ++m) { const int row = row0 + ai * HALF + m * 16; const size_t off = (size_t)row * DM + col0; float s = 0.f;
                const float sc = rstd[row];
#pragma unroll
                for (int bj = 0; bj < 2; ++bj) { const u32x4 xw = *(const u32x4*)(x2b + off + bj * HALF), pw = *(const u32x4*)(proj + off + bj * HALF);
                    const f32x4 a0 = acc[ai][bj][m][0] * sc, a1 = acc[ai][bj][m][1] * sc; f32x4 o0, o1;
                    o0[0] = bflo(xw.x) + sigmoidf_(a0[0]) * bflo(pw.x); o0[1] = bfhi(xw.x) + sigmoidf_(a0[1]) * bfhi(pw.x); o0[2] = bflo(xw.y) + sigmoidf_(a0[2]) * bflo(pw.y); o0[3] = bfhi(xw.y) + sigmoidf_(a0[3]) * bfhi(pw.y);
                    o1[0] = bflo(xw.z) + sigmoidf_(a1[0]) * bflo(pw.z); o1[1] = bfhi(xw.z) + sigmoidf_(a1[1]) * bfhi(pw.z); o1[2] = bflo(xw.w) + sigmoidf_(a1[2]) * bflo(pw.w); o1[3] = bfhi(xw.w) + sigmoidf_(a1[3]) * bfhi(pw.w);
                    u32x4 w; w.x = cvt_pk_bf16(o0[0], o0[1]); w.y = cvt_pk_bf16(o0[2], o0[3]); w.z = cvt_pk_bf16(o1[0], o1[1]); w.w = cvt_pk_bf16(o1[2], o1[3]);
                    *(u32x4*)(x3b + off + bj * HALF) = w;
                    s += ((o0[0] * o0[0] + o0[1] * o0[1]) + (o0[2] * o0[2] + o0[3] * o0[3])) + ((o1[0] * o1[0] + o1[1] * o1[1]) + (o1[2] * o1[2] + o1[3] * o1[3])); }
                s += __shfl_xor(s, 16); s += __shfl_xor(s, 32);
                if (fq == 0) rs[(size_t)row * 16 + u.pn * 4 + wc] = s; }
    }
};
struct PanelOrder {
    int nM, G, c, nN = 4;
    __host__ __device__ void init(int M, int G_, int c_, int nN_ = 4) { nM = M / BM; G = G_; c = c_; nN = nN_; }
    __host__ __device__ bool next(int i, Unit& u) const { const int p = c + G * (i / nN); if (p >= nM) return false; u.pm = p; u.pn = i % nN; return true; }
    __device__ __forceinline__ void a_ready(const Unit&) const {}
    __device__ __forceinline__ void done(const Unit&) const {}
    __device__ __forceinline__ const char* a_tile(const Gemm& g, const Unit& u, size_t tstepA) const { return (const char*)g.A + (size_t)u.pm * tstepA; }
    __device__ __forceinline__ const char* b_tile(const Gemm& g, const Unit& u, size_t tstepB) const { return (const char*)g.Bt + (size_t)u.pn * tstepB; }
};
struct ChainOrder {
    int c;
    __host__ __device__ bool next(int i, Unit& u) const { if (i >= 16) return false; u.pm = (c >> 4) * 16 + i; u.pn = c & 15; return true; }
    __device__ __forceinline__ void a_ready(const Unit&) const {}
    __device__ __forceinline__ void done(const Unit&) const {}
    __device__ __forceinline__ const char* a_tile(const Gemm& g, const Unit& u, size_t tstepA) const { return (const char*)g.A + (size_t)u.pm * tstepA; }
    __device__ __forceinline__ const char* b_tile(const Gemm& g, const Unit& u, size_t tstepB) const { return (const char*)g.Bt + (size_t)u.pn * tstepB; }
};
__device__ __forceinline__ float dpp_ror1(float v) { return __builtin_bit_cast(float, __builtin_amdgcn_update_dpp(0, __builtin_bit_cast(int, v), 0x121, 0xf, 0xf, false)); }
__device__ __forceinline__ float dpp_ror2(float v) { return __builtin_bit_cast(float, __builtin_amdgcn_update_dpp(0, __builtin_bit_cast(int, v), 0x122, 0xf, 0xf, false)); }
struct EpiUpConv {
    static constexpr bool PERM = true, AFTER_DRAIN = false;
    bf16_t* ACT; const float* rs; const float* cw; const float* cb; PG8_LAS float* car;
    __device__ __forceinline__ void operator()(f32x4 (&acc)[2][2][4][2], const Unit& u, int wr, int wc, int fr, int fq) const {
        const int par = u.pm & 1; const bool first = (u.pm & 15) == 0;
        const int colg = 32 * wc + 8 * fq, gc = 128 * u.pn + colg;
#pragma unroll
        for (int ai = 0; ai < 2; ++ai)
#pragma unroll
            for (int m = 0; m < 4; ++m) { const float sc = rs[u.pm * BM + ai * HALF + wr * 64 + m * 16 + fr];
#pragma unroll
                for (int n = 0; n < 2; ++n) { acc[ai][0][m][n] *= sc; acc[ai][1][m][n] *= sc; } }
        if (fr >= 14) {
#pragma unroll
            for (int ai = 0; ai < 2; ++ai)
#pragma unroll
                for (int n = 0; n < 2; ++n) *(PG8_LAS f32x4*)(car + ((par * 4 + 2 * ai + wr) * 2 + (fr - 14)) * 128 + colg + 4 * n) = acc[ai][0][3][n]; }
        asm volatile("s_waitcnt lgkmcnt(0)" ::: "memory"); __builtin_amdgcn_s_barrier(); asm volatile("" ::: "memory");
#pragma unroll
        for (int ai = 0; ai < 2; ++ai) { const int sl = 2 * ai + wr;
            const PG8_LAS float* src = (sl == 0) ? car + ((par ^ 1) * 4 + 3) * 256 : car + (par * 4 + sl - 1) * 256;
            const bool zero_in = first && sl == 0;
#pragma unroll
            for (int n = 0; n < 2; ++n) {
                asm volatile("" ::: "memory");
                f32x4 c2 = *(const PG8_LAS f32x4*)(src + colg + 4 * n), c1 = *(const PG8_LAS f32x4*)(src + 128 + colg + 4 * n);
                if (zero_in) { c2 = (f32x4){0.f, 0.f, 0.f, 0.f}; c1 = c2; }
                const f32x4 w0 = *(const f32x4*)(cw + gc + 4 * n), w1 = *(const f32x4*)(cw + DFF + gc + 4 * n), w2 = *(const f32x4*)(cw + 2 * DFF + gc + 4 * n), bb = *(const f32x4*)(cb + gc + 4 * n);
#pragma unroll
                for (int e = 0; e < 4; ++e) { float tm1 = c1[e], tm2 = (fr == 1) ? c1[e] : c2[e];
#pragma unroll
                    for (int m = 0; m < 4; ++m) { const float x = acc[ai][0][m][n][e]; const float t1 = dpp_ror1(x), t2 = dpp_ror2(x);
                        const float p1 = fr >= 1 ? t1 : tm1, p2 = fr >= 2 ? t2 : tm2;
                        const float cv = w0[e] * p2 + w1[e] * p1 + w2[e] * x + bb[e];
                        acc[ai][1][m][n][e] = cv * __builtin_amdgcn_rcpf(1.0f + __expf(-cv)) * acc[ai][1][m][n][e];
                        tm1 = t1; tm2 = t2; } } }
#pragma unroll
            for (int m = 0; m < 4; ++m) { const int row = u.pm * BM + ai * HALF + wr * 64 + m * 16 + fr; const f32x4 v0 = acc[ai][1][m][0], v1 = acc[ai][1][m][1];
                u32x4 w; w.x = cvt_pk_bf16(v0[0], v0[1]); w.y = cvt_pk_bf16(v0[2], v0[3]); w.z = cvt_pk_bf16(v1[0], v1[1]); w.w = cvt_pk_bf16(v1[2], v1[3]);
                *(u32x4*)(ACT + (size_t)row * DFF + gc) = w; } }
    }
};
struct CmpOrder {
    int c; const bf16_t* Z; const bf16_t* w1t;
    __host__ __device__ bool next(int i, Unit& u) const { if (i > 0 || c >= 64) return false; u.pm = c; u.pn = 0; return true; }
    __device__ __forceinline__ void a_ready(const Unit&) const {}
    __device__ __forceinline__ void done(const Unit&) const {}
    __device__ __forceinline__ const char* a_tile(const Gemm&, const Unit& u, size_t) const { const int kv = u.pm >> 5, b = (u.pm >> 1) & 15, gg = u.pm & 1; return (const char*)(Z + (size_t)b * SEQ * NZ + (kv ? ZC_AVC : ZC_AKC) + gg * 64); }
    __device__ __forceinline__ const char* b_tile(const Gemm&, const Unit& u, size_t) const { return (const char*)(w1t + (size_t)(u.pm >> 5) * 256 * 1024); }
};
struct EpiCmp {
    static constexpr bool PERM = false, AFTER_DRAIN = true;
    const float* c1; const bf16_t* w2t; bf16_t* kcb; bf16_t* vct;
    __device__ __forceinline__ void fused(f32x4 (&acc)[2][2][4][2], const Unit& u, int wr, int wc, int fr, int fq, PG8_LAS unsigned char* lds, int wid, int lane) const {
        const int kv = u.pm >> 5, bgi = u.pm & 31;
        const int cc0 = 32 * wc + 4 * fq;
#pragma unroll
        for (int ai = 0; ai < 2; ++ai)
#pragma unroll
            for (int m = 0; m < 4; ++m) { const int r = 128 * ai + 64 * wr + 16 * m + fr;
#pragma unroll
                for (int n = 0; n < 2; ++n) *(PG8_LAS f32x4*)(lds + (r * 128 + cc0 + 16 * n) * 4) = acc[ai][1][m][n]; }
        asm volatile("s_waitcnt lgkmcnt(0)" ::: "memory"); __builtin_amdgcn_s_barrier(); asm volatile("" ::: "memory");
#pragma unroll
        for (int ai = 0; ai < 2; ++ai)
#pragma unroll
            for (int m = 0; m < 4; ++m) { const int r = 128 * ai + 64 * wr + 16 * m + fr; const int rr = r < 255 ? r + 1 : 255;
#pragma unroll
                for (int n = 0; n < 2; ++n) { const f32x4 rv = *(const PG8_LAS f32x4*)(lds + (rr * 128 + cc0 + 16 * n) * 4); const f32x4 bv = *(const f32x4*)(c1 + kv * 128 + cc0 + 16 * n);
                    f32x4 x = acc[ai][0][m][n] + rv + bv;
#pragma unroll
                    for (int e = 0; e < 4; ++e) { const float y = 1.5957691216057308f * (x[e] + 0.044715f * x[e] * x[e] * x[e]); x[e] = x[e] * __builtin_amdgcn_rcpf(1.0f + __expf(-y)); }
                    acc[ai][0][m][n] = x; } }
        asm volatile("s_waitcnt lgkmcnt(0)" ::: "memory"); __builtin_amdgcn_s_barrier(); asm volatile("" ::: "memory");
#pragma unroll
        for (int ai = 0; ai < 2; ++ai)
#pragma unroll
            for (int m = 0; m < 4; ++m) { const int r = 128 * ai + 64 * wr + 16 * m + fr;
#pragma unroll
                for (int n = 0; n < 2; ++n) { const f32x4 x = acc[ai][0][m][n]; u32x2 w; w.x = cvt_pk_bf16(x[0], x[1]); w.y = cvt_pk_bf16(x[2], x[3]); *(PG8_LAS u32x2*)(lds + r * 272 + (cc0 + 16 * n) * 2) = w; } }
        { const int t = wid * 64 + lane, d = t >> 3, ch = t & 7; const u32x4* src = (const u32x4*)(w2t + (size_t)kv * 64 * 128 + d * 128 + ch * 16);
          *(PG8_LAS u32x4*)(lds + 69632 + d * 272 + ch * 32) = src[0]; *(PG8_LAS u32x4*)(lds + 69632 + d * 272 + ch * 32 + 16) = src[1]; }
        asm volatile("s_waitcnt vmcnt(0) lgkmcnt(0)" ::: "memory"); __builtin_amdgcn_s_barrier(); asm volatile("" ::: "memory");
        typedef float f32x16_ __attribute__((ext_vector_type(16)));
        const int tq = lane & 31, hi = lane >> 5;
        f32x16_ O0, O1;
#pragma unroll
        for (int i = 0; i < 16; ++i) { O0[i] = 0.f; O1[i] = 0.f; }
#pragma unroll
        for (int kk = 0; kk < 8; ++kk) { const bf16x8 a = *(const PG8_LAS bf16x8*)(lds + (32 * wid + tq) * 272 + (16 * kk + 8 * hi) * 2);
            const bf16x8 b0 = *(const PG8_LAS bf16x8*)(lds + 69632 + tq * 272 + (16 * kk + 8 * hi) * 2), b1 = *(const PG8_LAS bf16x8*)(lds + 69632 + (32 + tq) * 272 + (16 * kk + 8 * hi) * 2);
            O0 = __builtin_amdgcn_mfma_f32_32x32x16_bf16(a, b0, O0, 0, 0, 0); O1 = __builtin_amdgcn_mfma_f32_32x32x16_bf16(a, b1, O1, 0, 0, 0); }
#pragma unroll
        for (int i = 0; i < 16; ++i) { const int nrow = 32 * wid + (i & 3) + 8 * (i >> 2) + 4 * hi; const bool ok = nrow < NCMP;
            const unsigned v0 = ok ? (cvt_pk_bf16(O0[i], 0.f) & 0xffffu) : 0u, v1 = ok ? (cvt_pk_bf16(O1[i], 0.f) & 0xffffu) : 0u;
            if (kv == 0) { bf16_t* p = kcb + ((size_t)bgi * 256 + nrow) * 64 + tq; p[0] = (bf16_t)v0; p[32] = (bf16_t)v1; }
            else { const int n16 = nrow & 15; const int np = (nrow & ~15) + 8 * ((n16 >> 2) & 1) + (n16 & 3) + 4 * (n16 >> 3); bf16_t* p = vct + ((size_t)bgi * 64 + tq) * 256 + np; p[0] = (bf16_t)v0; p[32 * 256] = (bf16_t)v1; } }
    }
};
}

template <bool UPMAP = false>
__device__ __forceinline__ void p0_transpose_item(const float* W, const float* gk, int K, int N, bf16_t* WT, float* scr, int item, int lane) {
    const int nblk = N / 32, kb = item / nblk, nb = item % nblk, k0 = 64 * kb, n0 = 32 * nb;
    const int r0 = UPMAP ? (((n0 & 2047) >> 7) * 256 + (n0 >> 11) * 128 + (n0 & 127)) : n0;
#pragma unroll 8
    for (int i = 0; i < 32; ++i) { const int kk = 2 * i + (lane >> 5); float w = W[(size_t)(k0 + kk) * N + n0 + (lane & 31)]; if (gk) w *= gk[k0 + kk]; scr[kk * 33 + (lane & 31)] = w; }
    WAVE_LDS_SYNC();
    const int c = lane & 7;
#pragma unroll
    for (int j = 0; j < 4; ++j) { const int n = (lane >> 3) + 8 * j; const float* s = scr + (8 * c) * 33 + n;
        u32x4 o; o.x = pk2(s[0 * 33], s[1 * 33]); o.y = pk2(s[2 * 33], s[3 * 33]); o.z = pk2(s[4 * 33], s[5 * 33]); o.w = pk2(s[6 * 33], s[7 * 33]);
        *(u32x4*)(WT + (size_t)(r0 + n) * K + k0 + 8 * c) = o; }
    WAVE_LDS_SYNC();
}

#define LAS3 __attribute__((address_space(3)))
typedef short bf16x8 __attribute__((ext_vector_type(8)));
typedef float f32x16 __attribute__((ext_vector_type(16)));
typedef float f32x2_t __attribute__((ext_vector_type(2)));
typedef __bf16 bf16x2_t __attribute__((ext_vector_type(2)));
__device__ __forceinline__ unsigned cvtpk(float lo, float hi) { f32x2_t v = {lo, hi}; bf16x2_t b = __builtin_convertvector(v, bf16x2_t); return __builtin_bit_cast(unsigned, b); }
#define MFMA32(a, b, c) __builtin_amdgcn_mfma_f32_32x32x16_bf16((a), (b), (c), 0, 0, 0)
__device__ __forceinline__ bf16x8 pack8(const f32x16& x, int s) {
    u32x4 p; p.x = cvtpk(x[8 * s], x[8 * s + 1]); p.y = cvtpk(x[8 * s + 2], x[8 * s + 3]); p.z = cvtpk(x[8 * s + 4], x[8 * s + 5]); p.w = cvtpk(x[8 * s + 6], x[8 * s + 7]);
    return __builtin_bit_cast(bf16x8, p);
}
#define NEG_INF (-__builtin_inff())
constexpr float LOG2E = 1.4426950408889634f;
__device__ __forceinline__ unsigned other_half_u(unsigned v, int hi) { auto rr = __builtin_amdgcn_permlane32_swap(v, v, false, false); return hi ? rr[0] : rr[1]; }
__device__ __forceinline__ float other_half_f(float v, int hi) { return __uint_as_float(other_half_u(__float_as_uint(v), hi)); }
__device__ __forceinline__ float max16(const f32x16& u) {
    float a = fmaxf(fmaxf(u[0], u[1]), fmaxf(u[2], u[3])), b = fmaxf(fmaxf(u[4], u[5]), fmaxf(u[6], u[7]));
    float c = fmaxf(fmaxf(u[8], u[9]), fmaxf(u[10], u[11])), d = fmaxf(fmaxf(u[12], u[13]), fmaxf(u[14], u[15]));
    return fmaxf(fmaxf(a, b), fmaxf(c, d));
}
__device__ __forceinline__ unsigned long long spread_even(unsigned x) {
    unsigned long long s = x;
    s = (s | (s << 16)) & 0x0000FFFF0000FFFFull; s = (s | (s << 8)) & 0x00FF00FF00FF00FFull; s = (s | (s << 4)) & 0x0F0F0F0F0F0F0F0Full;
    s = (s | (s << 2)) & 0x3333333333333333ull; s = (s | (s << 1)) & 0x5555555555555555ull; return s;
}
struct NsaF { const bf16_t* Z; const float* gates; const bf16_t* KCB; const bf16_t* VCT; const bf16_t* VST; const bf16_t* VWT; bf16_t* MIX; };

__device__ __forceinline__ void nsa_load_q(bf16x8 (&qf)[4], const bf16_t* qp) {
    const float QSC = 0.125f * LOG2E;
#pragma unroll
    for (int s = 0; s < 4; ++s) { const u32x4 w = *(const u32x4*)(qp + 16 * s); u32x4 o;
        o.x = cvtpk(bflo(w.x) * QSC, bfhi(w.x) * QSC); o.y = cvtpk(bflo(w.y) * QSC, bfhi(w.y) * QSC); o.z = cvtpk(bflo(w.z) * QSC, bfhi(w.z) * QSC); o.w = cvtpk(bflo(w.w) * QSC, bfhi(w.w) * QSC);
        qf[s] = __builtin_bit_cast(bf16x8, o); }
}
__device__ __forceinline__ f32x16 nsa_st(const bf16_t* kp, const bf16x8 (&qf)[4], const f32x16& cinit) {
    f32x16 acc = MFMA32(*(const bf16x8*)(kp), qf[0], cinit);
    acc = MFMA32(*(const bf16x8*)(kp + 16), qf[1], acc); acc = MFMA32(*(const bf16x8*)(kp + 32), qf[2], acc); acc = MFMA32(*(const bf16x8*)(kp + 48), qf[3], acc);
    return acc;
}
struct NsaK { bf16x8 k[4]; };
struct NsaV { bf16x8 v0[2]; bf16x8 v1[2]; };
__device__ __forceinline__ void nsa_ldk(NsaK& R, const bf16_t* ku, unsigned ko) {
    R.k[0] = *(const bf16x8*)(ku + ko); R.k[1] = *(const bf16x8*)(ku + ko + 16); R.k[2] = *(const bf16x8*)(ku + ko + 32); R.k[3] = *(const bf16x8*)(ku + ko + 48);
}
__device__ __forceinline__ void nsa_ldv(NsaV& R, const bf16_t* vu, const bf16_t* vu2, unsigned vo) {
    R.v0[0] = *(const bf16x8*)(vu + vo); R.v0[1] = *(const bf16x8*)(vu + vo + 16); R.v1[0] = *(const bf16x8*)(vu2 + vo); R.v1[1] = *(const bf16x8*)(vu2 + vo + 16);
}
__device__ __forceinline__ f32x16 nsa_st_r(const NsaK& R, const bf16x8 (&qf)[4], const f32x16& cinit) {
    f32x16 acc = MFMA32(R.k[0], qf[0], cinit); acc = MFMA32(R.k[1], qf[1], acc); acc = MFMA32(R.k[2], qf[2], acc); acc = MFMA32(R.k[3], qf[3], acc); return acc;
}
__device__ __forceinline__ void nsa_soft_pv(f32x16& u, float tb, float& M, float& l, f32x16& O0, f32x16& O1, const NsaV& R, int hi) {
    float tm = max16(u); tm = fmaxf(tm, other_half_f(tm, hi));
    const float cand = tm + tb;
    if (__any(cand > M)) { const float mn = fmaxf(M, cand); const float al = __builtin_amdgcn_exp2f(M - mn); l *= al; O0 *= al; O1 *= al; M = mn; }
    const float ms = M - tb; float sum = 0.f;
#pragma unroll
    for (int i = 0; i < 16; ++i) { const float p = __builtin_amdgcn_exp2f(u[i] - ms); u[i] = p; sum += p; }
    l += sum;
    u32x4 a, b2;
    a.x = cvtpk(u[0], u[1]); a.y = cvtpk(u[2], u[3]); a.z = cvtpk(u[4], u[5]); a.w = cvtpk(u[6], u[7]);
    b2.x = cvtpk(u[8], u[9]); b2.y = cvtpk(u[10], u[11]); b2.z = cvtpk(u[12], u[13]); b2.w = cvtpk(u[14], u[15]);
    const bf16x8 p0 = __builtin_bit_cast(bf16x8, a), p1 = __builtin_bit_cast(bf16x8, b2);
    O0 = MFMA32(R.v0[0], p0, O0); O0 = MFMA32(R.v0[1], p1, O0);
    O1 = MFMA32(R.v1[0], p0, O1); O1 = MFMA32(R.v1[1], p1, O1);
}
__device__ __forceinline__ void nsa_mask_lt(f32x16& u, int limh) {
    asm volatile("" : "+v"(limh));
#pragma unroll
    for (int i = 0; i < 16; ++i) { const int c = (i & 3) + 8 * (i >> 2); if (!(c < limh)) u[i] = NEG_INF; }
}
__device__ __forceinline__ void nsa_mask_gt(f32x16& u, int limh) {
    asm volatile("" : "+v"(limh));
#pragma unroll
    for (int i = 0; i < 16; ++i) { const int c = (i & 3) + 8 * (i >> 2); if (!(c > limh)) u[i] = NEG_INF; }
}

__device__ __forceinline__ void vt_unit(const bf16_t* Z, int zcol, bf16_t* VT, int b, int g, int ch, unsigned short* tile  , int tid) {
    { const int pos = tid >> 3, c8 = (tid & 7) * 8;
      const u32x4 w = *(const u32x4*)(Z + ((size_t)b * SEQ + ch * 64 + pos) * NZ + zcol + g * 64 + c8);
      *(u32x4*)(tile + pos * 72 + c8) = w; }
    __syncthreads();
    { const int d = tid >> 3, chunk = tid & 7, gi = chunk >> 1, h = chunk & 1; unsigned short e[8];
#pragma unroll
      for (int j = 0; j < 8; ++j) { const int pos = 16 * gi + 8 * (j >> 2) + 4 * h + (j & 3); e[j] = tile[pos * 72 + d]; }
      u32x4 o; o.x = e[0] | ((unsigned)e[1] << 16); o.y = e[2] | ((unsigned)e[3] << 16); o.z = e[4] | ((unsigned)e[5] << 16); o.w = e[6] | ((unsigned)e[7] << 16);
      *(u32x4*)(VT + (((size_t)b * 2 + g) * 64 + d) * SEQ + ch * 64 + chunk * 8) = o; }
    __syncthreads();
}

constexpr int NC_KC = 0, NC_RING = 32768, NC_IMP = 81920, NC_LIST = 147456, NC_UEX = 148480, NC_QSLOT = 148512, NC_LINV = 148608;
#define NC_WAITBAR(N) asm volatile("s_waitcnt vmcnt(" #N ") lgkmcnt(0)\n\ts_barrier" ::: "memory")

__device__ __forceinline__ void nsa_unit_coop(const NsaF& P, int b, int g, int tp, LAS3 unsigned char* L, int tid, const int dry = 0) {
    if (dry & 2048) return;
    const int lane = tid & 63, wave = __builtin_amdgcn_readfirstlane(tid >> 6), tbsel = wave >> 2, r = wave & 3, tq = lane & 31, hi = lane >> 5;
    const int tb = 2 * tp + tbsel, t0 = 32 * tb, t0u = 64 * tp, cur = tp, hh = g * 4 + r;
    const size_t rowq = (size_t)b * SEQ + t0 + tq;
    const size_t bg = (size_t)b * 2 + g;
    const int nval = max(0, 2 * tb + 1 - (tq < 31 ? 1 : 0) - (tq < 15 ? 1 : 0));
    const int ntc = (2 * tb + 1 + 31) >> 5, ntc_u = (2 * (2 * tp + 1) + 1 + 31) >> 5;
    const int tqh = tq - 4 * hi;
    const float hif = (float)(4 * hi);
    const float slope2 = __builtin_amdgcn_exp2f(-(float)(hh + 1)) * LOG2E;
    bf16x8 qf[4]; if (!(dry & 1024)) nsa_load_q(qf, P.Z + rowq * NZ + ZC_AQ + hh * 64 + 8 * hi); else { qf[0] = qf[1] = qf[2] = qf[3] = (bf16x8){0, 0, 0, 0, 0, 0, 0, 0}; }
    const float* gp = (dry & 1024) ? P.gates : P.gates + rowq * 32 + 8 + hh * 3;
    const float gt0 = sigmoidf_(gp[0]), gt1 = sigmoidf_(gp[1]), gt2 = sigmoidf_(gp[2]);
    asm volatile("s_waitcnt vmcnt(0)" ::: "memory");
    if (dry & 16384) return;
    const int ks = wave & 3, vdt = (wave & 3) >> 1, vs = wave & 1;
    const bool isK = wave < 4;
    const bf16_t* srcC = isK ? P.KCB + (bg * 256 + tq) * 64 + 16 * ks + 8 * hi : P.VCT + (bg * 64 + 32 * vdt + tq) * 256 + 16 * vs + 8 * hi;
    const bf16_t* srcW = isK ? P.Z + ((size_t)b * SEQ + tq) * NZ + ZC_AKW + g * 64 + 16 * ks + 8 * hi : P.VWT + (bg * 64 + 32 * vdt + tq) * SEQ + 16 * vs + 8 * hi;
    const bf16_t* srcS = isK ? P.Z + ((size_t)b * SEQ + tq) * NZ + ZC_AKS + g * 64 + 16 * ks + 8 * hi : P.VST + (bg * 64 + 32 * vdt + tq) * SEQ + 16 * vs + 8 * hi;
    const size_t stepC = isK ? 32 * 64 : 32, stepP = isK ? (size_t)NZ : 1;
    volatile LAS3 int* list = (volatile LAS3 int*)(L + NC_LIST);
#define NC_DMA_E(i, ent) do { const int e_ = (ent); const int tag_ = (e_ >> 16) & 3, val_ = ((e_ & 0xffff) == 0xffff) ? 0 : (e_ & 0xffff); \
        const bf16_t* s_ = (tag_ == 0) ? srcC + (size_t)val_ * stepC : ((tag_ == 1) ? srcW : srcS) + (size_t)val_ * stepP; \
        __builtin_amdgcn_global_load_lds((const unsigned*)s_, (LAS3 unsigned*)(L + NC_RING + (((i) >> 1) % 3) * 16384 + ((i) & 1) * 8192 + wave * 1024), 16, 0, 0); } while (0)
#define NC_DMA(i) NC_DMA_E(i, __builtin_amdgcn_readfirstlane(list[1 + (i)]))
    const bool topk = cur >= 16 && !(dry & 1);
    if (topk && wave < ntc_u) {
#pragma unroll
        for (int s = 0; s < 4; ++s) __builtin_amdgcn_global_load_lds((const unsigned*)(P.KCB + (bg * 256 + 32 * wave + tq) * 64 + 16 * s + 8 * hi), (LAS3 unsigned*)(L + NC_KC + wave * 4096 + s * 1024), 16, 0, 0);
    }
#define NC_FLAGS(tag_, val_, t0_, ntc_, cf_) (((tag_) == 0) ? (((val_) < (ntc_) ? 1 : 0) | ((val_) >= (cf_) ? 8 : 0)) : (((tag_) == 1) ? ((((val_) <= (t0_) && (val_) >= (t0_) - 512) ? 1 : 0) | ((val_) == (t0_) ? 2 : 0) | ((val_) == (t0_) - 512 ? 4 : 0)) : ((((val_) <= (t0_)) ? 1 : 0) | ((val_) == (t0_) ? 2 : 0))))
#define NC_ENTRY(tag_, val_) ((val_) | ((tag_) << 16) | (NC_FLAGS(tag_, val_, t0u, ntcA, cfA) << 18) | (NC_FLAGS(tag_, val_, t0u + 32, ntcB, cfB) << 22))
    const int ntcA = (2 * (2 * tp) + 1 + 31) >> 5, ntcB = ntc_u, cfA = (2 * (2 * tp) - 1) >> 5, cfB = (2 * (2 * tp + 1) - 1) >> 5;
    const int ncmp = ntc_u + (ntc_u & 1);
    const int nsl0 = min(18, 2 * tp + 2), nsl = nsl0 + (nsl0 & 1);
    if (wave == 0) {
        if (lane < ncmp) list[1 + lane] = (lane < ntc_u) ? NC_ENTRY(0, ntc_u - 1 - lane) : 0xffff;
        else if (lane < ncmp + nsl) { const int k = lane - ncmp; list[1 + lane] = (k < nsl0) ? NC_ENTRY(1, t0u + 32 - 32 * k) : ((1 << 16) | 0xffff); }
        if (lane == 0) list[0] = ncmp + nsl; }
    asm volatile("s_waitcnt lgkmcnt(0)\n\ts_barrier" ::: "memory");
    if (dry & 8192) return;
    int nlist = __builtin_amdgcn_readfirstlane(list[0]);
    if (!(dry & 4096)) { NC_DMA(0); NC_DMA(1); NC_DMA(2); NC_DMA(3); }
    unsigned long long selmask, Utb;
    if (!topk) { selmask = (2ull << cur) - 1ull; Utb = selmask; }
    else {
        NC_WAITBAR(4);
        float* il = (float*)0; (void)il;
        LAS3 float* ip0 = (LAS3 float*)(L + NC_IMP + (wave * 32) * 256) + lane;
#pragma unroll
        for (int q = 0; q < 32; ++q) ip0[64 * q] = 0.f;
        {
            f32x16 cb;
            { float hf = hif; asm volatile("" : "+v"(hf));
#pragma unroll
              for (int i = 0; i < 16; ++i) cb[i] = slope2 * 16.0f * ((float)((i & 3) + 8 * (i >> 2)) + hf); }
            float M = -1.0e30f, l = 0.f;
#pragma unroll 1
            for (int nt = ntc - 1; nt >= 0; --nt) {
                const LAS3 unsigned char* kp = L + NC_KC + nt * 4096 + lane * 16;
                f32x16 u = MFMA32(*(const LAS3 bf16x8*)(kp), qf[0], cb); u = MFMA32(*(const LAS3 bf16x8*)(kp + 1024), qf[1], u); u = MFMA32(*(const LAS3 bf16x8*)(kp + 2048), qf[2], u); u = MFMA32(*(const LAS3 bf16x8*)(kp + 3072), qf[3], u);
                nsa_mask_lt(u, nval - 32 * nt - 4 * hi);
                const float tbs = slope2 * 512.0f * (float)nt;
                float tm = max16(u); tm = fmaxf(tm, other_half_f(tm, hi));
                const float cand = tm + tbs;
                if (__any(cand > M)) { asm volatile("" ::: "memory"); const float mn = fmaxf(M, cand); const float al_ = __builtin_amdgcn_exp2f(M - mn); l *= al_; M = mn;
#pragma unroll
                    for (int q = 0; q < 32; ++q) ip0[64 * q] *= al_; }
                const float ms = M - tbs; float sum = 0.f;
#pragma unroll
                for (int i = 0; i < 16; ++i) { u[i] = __builtin_amdgcn_exp2f(u[i] - ms); sum += u[i]; }
                l += sum;
                float x[4], qs[4];
#pragma unroll
                for (int gq = 0; gq < 4; ++gq) { qs[gq] = (u[4 * gq] + u[4 * gq + 1]) + (u[4 * gq + 2] + u[4 * gq + 3]); x[gq] = other_half_f(u[4 * gq + 3], hi); }
                LAS3 float* ip = ip0 + 256 * nt;
                ip[0] += qs[0] + (hi ? x[0] : 0.f); ip[64] += qs[1] + (hi ? x[1] : x[0]); ip[128] += qs[2] + (hi ? x[2] : x[1]); ip[192] += qs[3] + (hi ? x[3] : x[2]);
                if (nt < 7) ip[256] += hi ? 0.f : x[3];
            }
            const float lt = l + other_half_f(l, hi);
            if (hi == 0) *(LAS3 float*)(L + NC_LINV + (wave * 32 + tq) * 4) = lt > 0.f ? 1.0f / lt : 0.f;
        }
        asm volatile("s_waitcnt lgkmcnt(0)\n\ts_barrier" ::: "memory");
        unsigned uu[32];
        const int qlo = hi ? 0 : 1, qhi = (cur - 2 - hi) >> 1;
        const unsigned candm = (unsigned)((2ull << qhi) - 1ull) & ~((1u << qlo) - 1u);
        { const LAS3 float* pp = (const LAS3 float*)(L + NC_IMP + (tbsel * 4 * 32) * 256) + lane;
          const LAS3 float* li = (const LAS3 float*)(L + NC_LINV + (tbsel * 4 * 32 + tq) * 4); const float i0 = li[0], i1 = li[32], i2 = li[64], i3 = li[96];
#pragma unroll
          for (int q = 0; q < 32; ++q) { const float v = (pp[64 * q] * i0 + pp[64 * (32 + q)] * i1) + (pp[64 * (64 + q)] * i2 + pp[64 * (96 + q)] * i3); uu[q] = __float_as_uint(v) & 0xffff0000u & (unsigned)(-(int)((candm >> q) & 1u)); } }
        unsigned T = 0u;
#pragma unroll 1
        for (int bit = 30; bit >= 16; --bit) { const unsigned c = T | (1u << bit); unsigned cnt = 0;
#pragma unroll
            for (int q = 0; q < 32; ++q) cnt += (uu[q] >= c) ? 1u : 0u;
            cnt += other_half_u(cnt, hi);
            if (cnt >= 13u) T = c; }
        unsigned gtm = 0u, eqm = 0u;
#pragma unroll
        for (int q = 0; q < 32; ++q) { gtm |= (uu[q] > T ? 1u : 0u) << q; eqm |= (uu[q] == T ? 1u : 0u) << q; }
        eqm &= candm;
        const unsigned ogt = other_half_u(gtm, hi), oeq = other_half_u(eqm, hi);
        const unsigned long long fgt = spread_even(hi ? ogt : gtm) | (spread_even(hi ? gtm : ogt) << 1);
        const unsigned long long feq = spread_even(hi ? oeq : eqm) | (spread_even(hi ? eqm : oeq) << 1);
        const int need = 13 - __builtin_popcountll(fgt);
        unsigned long long rem = feq;
#pragma unroll 1
        for (int i = 0; i < 13; ++i) if (i < need) rem &= rem - 1ull;
        selmask = fgt | (feq & ~rem) | 1ull | (3ull << (cur - 1));
        unsigned ulo = (unsigned)selmask, uhi = (unsigned)(selmask >> 32);
#pragma unroll
        for (int o = 1; o < 32; o <<= 1) { ulo |= __shfl_xor(ulo, o); uhi |= __shfl_xor(uhi, o); }
        Utb = ((unsigned long long)__builtin_amdgcn_readfirstlane(uhi) << 32) | (unsigned long long)__builtin_amdgcn_readfirstlane(ulo);
        if (r == 0 && lane == 0) { ((volatile LAS3 unsigned*)(L + NC_UEX))[2 * tbsel] = (unsigned)Utb; ((volatile LAS3 unsigned*)(L + NC_UEX))[2 * tbsel + 1] = (unsigned)(Utb >> 32); }
        asm volatile("s_waitcnt lgkmcnt(0)\n\ts_barrier" ::: "memory");
    }
    if (dry & 32768) return;
    if (wave == 0) {
        unsigned long long U;
        if (topk) { volatile LAS3 unsigned* ux = (volatile LAS3 unsigned*)(L + NC_UEX); U = ((unsigned long long)(ux[1] | ux[3]) << 32) | (unsigned long long)(ux[0] | ux[2]); } else U = (2ull << cur) - 1ull;
        const int n0 = ncmp + nsl;
        if ((U >> lane) & 1ull) { const int pos = n0 + 2 * __builtin_popcountll(lane == 63 ? 0ull : (U >> (lane + 1))); list[1 + pos] = NC_ENTRY(2, 64 * lane + 32); list[2 + pos] = NC_ENTRY(2, 64 * lane); }
        if (lane == 0) list[0] = n0 + 2 * __builtin_popcountll(U); }
    asm volatile("s_waitcnt lgkmcnt(0)\n\ts_barrier" ::: "memory");
    if (dry & 65536) return;
    nlist = __builtin_amdgcn_readfirstlane(list[0]);
    const int lv0 = list[1 + lane], lv1 = list[65 + lane], lv2 = list[129 + lane];
#define NC_ENT(i) (((i) < 64) ? __builtin_amdgcn_readlane(lv0, (i)) : (((i) < 128) ? __builtin_amdgcn_readlane(lv1, (i) - 64) : __builtin_amdgcn_readlane(lv2, (i) - 128)))
    LAS3 float* al = (LAS3 float*)(L + NC_IMP + wave * 8192) + lane;
    f32x16 O0, O1, O2, cb;
#pragma unroll
    for (int i = 0; i < 16; ++i) { al[64 * i] = 0.f; al[64 * (16 + i)] = 0.f; O0[i] = 0.f; O1[i] = 0.f; O2[i] = 0.f; cb[i] = 0.f; }
    const unsigned onesw = (tq == 0) ? 0x3f803f80u : 0u;
    const bf16x8 onesf = __builtin_bit_cast(bf16x8, (u32x4){onesw, onesw, onesw, onesw});
    float M = -1.0e30f, l = 0.f; int curtag = -1;
#define NC_FINAL() do { const float l0_ = O2[0]; const float lt_ = l0_ + other_half_f(l0_, hi);     const float g_ = (curtag == 0) ? gt0 : ((curtag == 1) ? gt2 : gt1); const float sc_ = lt_ > 0.f ? g_ / lt_ : 0.f; \
        _Pragma("unroll") for (int k_ = 0; k_ < 16; ++k_) { al[64 * k_] += O0[k_] * sc_; al[64 * (16 + k_)] += O1[k_] * sc_; } } while (0)
#define NC_SWITCH(tag) do { if ((tag) != curtag) { if (curtag >= 0) NC_FINAL(); curtag = (tag); M = -1.0e30f; l = 0.f; \
            float hf_ = hif; asm volatile("" : "+v"(hf_)); const float cs_ = ((tag) == 0) ? slope2 * 16.0f : slope2; \
            _Pragma("unroll") for (int k_ = 0; k_ < 16; ++k_) { O0[k_] = 0.f; O1[k_] = 0.f; O2[k_] = 0.f; cb[k_] = cs_ * ((float)((k_ & 3) + 8 * (k_ >> 2)) + hf_); } } } while (0)
#define NC_NEED(tag, val) (((tag) == 0) ? ((val) < ntc) : (((tag) == 1) ? (((val) <= t0) && ((val) >= t0 - 512)) : ((((Utb >> ((val) >> 6)) & 1ull) != 0ull) && ((val) <= t0))))
#define NC_TBIAS(tag, val) (((tag) == 0) ? slope2 * 512.0f * (float)(val) : slope2 * (float)((val) - t0))
#define NC_ST(u, sp) do { u = MFMA32(*(const LAS3 bf16x8*)(sp), qf[0], cb); u = MFMA32(*(const LAS3 bf16x8*)((sp) + 1024), qf[1], u); u = MFMA32(*(const LAS3 bf16x8*)((sp) + 2048), qf[2], u); u = MFMA32(*(const LAS3 bf16x8*)((sp) + 3072), qf[3], u); } while (0)
#define NC_MASK(u, tag, val) do { if ((tag) == 0) nsa_mask_lt(u, nval - 32 * (val) - 4 * hi); else { if ((val) == t0) nsa_mask_lt(u, tqh + 1); if ((tag) == 1 && (val) == t0 - 512) nsa_mask_gt(u, tqh); \
            if ((tag) == 2 && !((selmask >> ((val) >> 6)) & 1ull)) { _Pragma("unroll") for (int k_ = 0; k_ < 16; ++k_) u[k_] = NEG_INF; } } } while (0)
#define NC_LDV(V, sp) do { V.v0[0] = *(const LAS3 bf16x8*)((sp) + 4096); V.v0[1] = *(const LAS3 bf16x8*)((sp) + 5120); V.v1[0] = *(const LAS3 bf16x8*)((sp) + 6144); V.v1[1] = *(const LAS3 bf16x8*)((sp) + 7168); } while (0)
    const int npair = (dry & 8) ? 0 : (nlist >> 1);
    const int cfull = (2 * tb - 1) >> 5;
#pragma unroll 1
    for (int p = 0; p < npair; ++p) {
        if (dry & 256) { asm volatile("s_waitcnt lgkmcnt(0)\n\ts_barrier" ::: "memory"); } else { if (p + 1 < npair) NC_WAITBAR(2); else NC_WAITBAR(0); }
        if (!(dry & 512) && p + 2 < npair) { const int i2 = 2 * (p + 2); NC_DMA_E(i2, NC_ENT(i2)); NC_DMA_E(i2 + 1, NC_ENT(i2 + 1)); }
        const int e0 = NC_ENT(2 * p), e1 = NC_ENT(2 * p + 1);
        const int tag = (e0 >> 16) & 3, val0 = e0 & 0xffff, val1 = e1 & 0xffff;
        const int f0 = (e0 >> (18 + 4 * tbsel)) & 15, f1 = (e1 >> (18 + 4 * tbsel)) & 15;
        if (tag != curtag) { asm volatile("" ::: "memory"); NC_SWITCH(tag); }
        const bool sel = (tag == 2);
        const bool need0 = !(dry & 2) && (f0 & 1) && (!sel || ((Utb >> (val0 >> 6)) & 1ull)), need1 = !(dry & 2) && (f1 & 1) && (!sel || ((Utb >> (val1 >> 6)) & 1ull));
        if (need0 || need1) {
            const LAS3 unsigned char* sp0 = L + NC_RING + (p % 3) * 16384 + lane * 16; const LAS3 unsigned char* sp1 = sp0 + 8192;
            f32x16 u0, u1; if (dry & 128) { u0 = cb; u1 = cb; } else { NC_ST(u0, sp0); NC_ST(u1, sp1); }
            const bool nm0 = sel && !__all((int)((selmask >> (val0 >> 6)) & 1ull)), nm1 = sel && !__all((int)((selmask >> (val1 >> 6)) & 1ull));
            if (!need0 || (f0 & 14) || nm0) { asm volatile("" ::: "memory");
                if (!need0) { _Pragma("unroll") for (int k_ = 0; k_ < 16; ++k_) u0[k_] = NEG_INF; } else NC_MASK(u0, tag, val0); }
            if (!need1 || (f1 & 14) || nm1) { asm volatile("" ::: "memory");
                if (!need1) { _Pragma("unroll") for (int k_ = 0; k_ < 16; ++k_) u1[k_] = NEG_INF; } else NC_MASK(u1, tag, val1); }
            const float tb0 = NC_TBIAS(tag, val0), tb1 = NC_TBIAS(tag, val1);
            const float tm0 = (dry & 16) ? 0.f : max16(u0), tm1 = (dry & 16) ? 0.f : max16(u1);
            float cand = fmaxf(tm0 + tb0, tm1 + tb1); if (!(dry & 16)) cand = fmaxf(cand, other_half_f(cand, hi));
            if (!(dry & 16) && __any(cand > M)) { asm volatile("" ::: "memory"); const float mn = fmaxf(M, cand); const float al_ = __builtin_amdgcn_exp2f(M - mn); O0 *= al_; O1 *= al_; O2 *= al_; M = mn; }
            const float ms0 = M - tb0, ms1 = M - tb1;
#pragma unroll
            for (int i = 0; i < 16; ++i) { if (dry & 32) { u0[i] = u0[i] - ms0; u1[i] = u1[i] - ms1; } else { u0[i] = __builtin_amdgcn_exp2f(u0[i] - ms0); u1[i] = __builtin_amdgcn_exp2f(u1[i] - ms1); } }
            asm volatile("" ::: "memory");
            NsaV Va, Vb; NC_LDV(Va, sp0); NC_LDV(Vb, sp1);
            const bf16x8 pa0 = pack8(u0, 0), pa1 = pack8(u0, 1), pb0 = pack8(u1, 0), pb1 = pack8(u1, 1);
            if (dry & 64) { O0[0] += __builtin_bit_cast(float, pa0[0] ^ pa1[1] ^ pb0[2] ^ pb1[3]) + __builtin_bit_cast(float, (int)(Va.v0[0][0] ^ Va.v1[1][1] ^ Vb.v0[0][2] ^ Vb.v1[1][3])); } else {
            O0 = MFMA32(Va.v0[0], pa0, O0); O1 = MFMA32(Va.v1[0], pa0, O1); O0 = MFMA32(Va.v0[1], pa1, O0); O1 = MFMA32(Va.v1[1], pa1, O1);
            O0 = MFMA32(Vb.v0[0], pb0, O0); O1 = MFMA32(Vb.v1[0], pb0, O1); O0 = MFMA32(Vb.v0[1], pb1, O0); O1 = MFMA32(Vb.v1[1], pb1, O1);
            O2 = MFMA32(onesf, pa0, O2); O2 = MFMA32(onesf, pa1, O2); O2 = MFMA32(onesf, pb0, O2); O2 = MFMA32(onesf, pb1, O2); }
        }
    }
    if (curtag >= 0) NC_FINAL();
#undef NC_FINAL
#undef NC_SWITCH
#undef NC_NEED
#undef NC_TBIAS
#undef NC_ST
#undef NC_MASK
#undef NC_LDV
#undef NC_DMA
#undef NC_DMA_E
#undef NC_ENT
#undef NC_FLAGS
#undef NC_ENTRY
    bf16_t* op = P.MIX + rowq * DM + 512 + hh * 64 + 4 * hi;
    if (!(dry & 4))
#pragma unroll
    for (int q4 = 0; q4 < 4; ++q4) {
        u32x2 w0; w0.x = cvtpk(al[64 * (4 * q4)], al[64 * (4 * q4 + 1)]); w0.y = cvtpk(al[64 * (4 * q4 + 2)], al[64 * (4 * q4 + 3)]); *(u32x2*)(op + 8 * q4) = w0;
        u32x2 w1; w1.x = cvtpk(al[64 * (16 + 4 * q4)], al[64 * (16 + 4 * q4 + 1)]); w1.y = cvtpk(al[64 * (16 + 4 * q4 + 2)], al[64 * (16 + 4 * q4 + 3)]); *(u32x2*)(op + 32 + 8 * q4) = w1; }
}

struct MlF { const bf16_t* Z; const float* gates; bf16_t* MIX; const float* gate_bias; const float* mnorm_g; };
constexpr int M2_QC = 0, M2_KC = 17408, M2_K2 = 34816, M2_VC = 55296, M2_EG = 75776, M2_N = 76032, M2_SSQ = 77056, M2_CF = 78080, M2_G = 110848, M2_END = 111360;
constexpr int M2_RS = 272, M2_TS = 320;
typedef short v4i16_t __attribute__((ext_vector_type(4)));
__device__ __forceinline__ v4i16_t ml_tr(const LAS3 unsigned char* p) { return __builtin_amdgcn_ds_read_tr16_b64_v4i16((LAS3 v4i16_t*)p); }
__device__ __forceinline__ bf16x8 ml_cat(v4i16_t a, v4i16_t b) { return (bf16x8){a[0], a[1], a[2], a[3], b[0], b[1], b[2], b[3]}; }
__device__ __forceinline__ float dpp_f(float ident, float v, const int ctrl_dummy) { return v; }
#define ML_DPP(ident, v, ctrl, rmask) __builtin_bit_cast(float, __builtin_amdgcn_update_dpp(__builtin_bit_cast(int, (float)(ident)), __builtin_bit_cast(int, (float)(v)), (ctrl), (rmask), 0xf, false))
__device__ __forceinline__ float scan_add64_dpp(float v) {
    v += ML_DPP(0.f, v, 0x111, 0xf); v += ML_DPP(0.f, v, 0x112, 0xf); v += ML_DPP(0.f, v, 0x114, 0xf); v += ML_DPP(0.f, v, 0x118, 0xf);
    v += ML_DPP(0.f, v, 0x142, 0xa); v += ML_DPP(0.f, v, 0x143, 0xc); return v;
}
__device__ __forceinline__ float scan_max64_dpp(float v) {
    const float NI = -__builtin_inff();
    v = fmaxf(v, ML_DPP(NI, v, 0x111, 0xf)); v = fmaxf(v, ML_DPP(NI, v, 0x112, 0xf)); v = fmaxf(v, ML_DPP(NI, v, 0x114, 0xf)); v = fmaxf(v, ML_DPP(NI, v, 0x118, 0xf));
    v = fmaxf(v, ML_DPP(NI, v, 0x142, 0xa)); v = fmaxf(v, ML_DPP(NI, v, 0x143, 0xc)); return v;
}
struct Ml2Scal { float w, inter_s, rowf_s, floorv, decay, mnew; };
__device__ __forceinline__ Ml2Scal ml2_scalars(float ipre, float fpre, float m) {
    const float lf = log_sigmoidf_(fpre);
    const float bcs = scan_add64_dpp(lf);
    const float bL = __builtin_bit_cast(float, __builtin_amdgcn_readlane(__builtin_bit_cast(int, bcs), 63));
    const float g = ipre - bcs;
    const float pm = scan_max64_dpp(g);
    const float gmax = __builtin_bit_cast(float, __builtin_amdgcn_readlane(__builtin_bit_cast(int, pm), 63));
    const float mm = fmaxf(m, pm), mg = fmaxf(m, gmax);
    Ml2Scal s; const float scale = 0.08838834764831845f;
    s.w = __expf(g - mg); s.inter_s = __expf(m - mm) * scale; s.rowf_s = __expf(mg - mm) * scale; s.floorv = __expf(-bcs - mm);
    s.decay = __expf(m - mg); s.mnew = bL + mg;
    return s;
}

__device__ __forceinline__ void mlstm_unit_v2(const MlF& P, int b, int h, LAS3 unsigned char* L, int tid) {
    const int lane = tid & 63, wave = __builtin_amdgcn_readfirstlane(tid >> 6), lt = wave >> 2, tq = lane & 31, hi = lane >> 5;
    const float bi = P.gate_bias[h], bff = P.gate_bias[4 + h];
    const size_t row0 = (size_t)b * SEQ;
    const int ss = tid >> 3, d0 = 8 * (tid & 7);
    const bf16_t* zst = P.Z + (row0 + ss) * NZ + h * 128 + d0;
    const int wv_ = tid >> 6, ltv = wv_ >> 2, dvtv = wv_ & 3;
    const int lrow = 32 * ltv + tq;
    const int i16 = lane & 15, g16 = lane >> 4;
    const unsigned tr_lane = (unsigned)((4 * hi + (i16 >> 2)) * M2_TS + (16 * (g16 & 1) + 4 * (i16 & 3)) * 2);
    const unsigned a_qc = M2_QC + lrow * M2_RS + 16 * hi, a_qp = M2_QC + lrow * M2_RS + 8 * hi, a_kc = M2_KC + tq * M2_RS + 16 * hi, a_cf = M2_CF + (dvtv * 512 + lane) * 16;
    const unsigned a_vt = M2_VC + tr_lane + (32 * dvtv) * 2, a_kt = M2_K2 + tr_lane + (64 * ltv) * 2, a_eg = M2_EG + 16 * hi, a_n = M2_N + 256 * hi;
    f32x16 C0, C1;
#pragma unroll
    for (int i = 0; i < 16; ++i) { C0[i] = 0.f; C1[i] = 0.f; }
    for (int i = tid; i < 256; i += NTHREADS) ((LAS3 float*)(L + M2_N))[i] = 0.f;
    if (tid < 128) ((LAS3 float*)(L + M2_G))[tid] = P.mnorm_g[h * 128 + tid];
    for (int i = tid; i < 32768 / 16; i += NTHREADS) ((LAS3 u32x4*)(L + M2_CF))[i] = (u32x4){0u, 0u, 0u, 0u};
    float mst = 0.f;
    u32x4 rq[2], rk[2], rv[2]; float gi_, gf_;
#pragma unroll
    for (int p = 0; p < 2; ++p) { rq[p] = *(const u32x4*)(zst + ZC_MQ + 64 * p); rk[p] = *(const u32x4*)(zst + ZC_MK + 64 * p); rv[p] = *(const u32x4*)(zst + ZC_MV + 64 * p); }
    { const float* gr = P.gates + (row0 + lane) * 32; gi_ = gr[h] + bi; gf_ = gr[4 + h] + bff; }
    Ml2Scal sc = ml2_scalars(gi_, gf_, mst);
#define ML2_STAGE() do { \
        const float ws_ = __shfl(sc.w, ss); \
        _Pragma("unroll") for (int p = 0; p < 2; ++p) { \
            *(LAS3 u32x4*)(L + M2_QC + ss * M2_RS + (d0 + 64 * p) * 2) = rq[p]; \
            *(LAS3 u32x4*)(L + M2_KC + ss * M2_RS + (d0 + 64 * p) * 2) = rk[p]; *(LAS3 u32x4*)(L + M2_K2 + ss * M2_TS + (d0 + 64 * p) * 2) = rk[p]; \
            u32x4 o_; o_.x = cvtpk(bflo(rv[p].x) * ws_, bfhi(rv[p].x) * ws_); o_.y = cvtpk(bflo(rv[p].y) * ws_, bfhi(rv[p].y) * ws_); o_.z = cvtpk(bflo(rv[p].z) * ws_, bfhi(rv[p].z) * ws_); o_.w = cvtpk(bflo(rv[p].w) * ws_, bfhi(rv[p].w) * ws_); \
            *(LAS3 u32x4*)(L + M2_VC + ss * M2_TS + (d0 + 64 * p) * 2) = o_; } \
        if (wave == 0) ((LAS3 float*)(L + M2_EG))[lane] = sc.w; } while (0)
    __syncthreads();
    ML2_STAGE();
    float inter_s = __shfl(sc.inter_s, lrow), rowf_s = __shfl(sc.rowf_s, lrow), floorv = __shfl(sc.floorv, lrow), decay = sc.decay;
    mst = sc.mnew;
    u32x2 mo[4];
#define ML2_PREFETCH(cn) do { \
        if ((cn) < SEQ / 64) { const bf16_t* zn = zst + (size_t)(cn) * 64 * NZ; \
            _Pragma("unroll") for (int p = 0; p < 2; ++p) { rq[p] = *(const u32x4*)(zn + ZC_MQ + 64 * p); rk[p] = *(const u32x4*)(zn + ZC_MK + 64 * p); rv[p] = *(const u32x4*)(zn + ZC_MV + 64 * p); } \
            const float* gr = P.gates + (row0 + (size_t)(cn) * 64 + lane) * 32; gi_ = gr[h] + bi; gf_ = gr[4 + h] + bff; } \
        { const size_t orow_ = row0 + (size_t)((cn) - 1) * 64 + lrow; \
          _Pragma("unroll") for (int q = 0; q < 4; ++q) mo[q] = *(const u32x2*)(P.Z + orow_ * NZ + ZC_MO + h * 128 + 32 * dvtv + 8 * q + 4 * hi); } } while (0)
    ML2_PREFETCH(1);
#pragma unroll 1
    for (int c = 0; c < SEQ / 64; ++c) {
        __syncthreads();
        const bool more = (c + 1 < SEQ / 64);
        const size_t orow = row0 + (size_t)c * 64 + lrow;
        float den = 0.f;
        bf16x8 xf[4];
        {
            bf16x8 qf[8];
#pragma unroll
            for (int kk = 0; kk < 8; ++kk) qf[kk] = *(const LAS3 bf16x8*)(L + a_qc + 32 * kk);
#pragma unroll
            for (int st = 0; st < 2; ++st) {
                if (st <= lt) {
                    f32x16 X;
#pragma unroll
                    for (int i = 0; i < 16; ++i) X[i] = 0.f;
#pragma unroll
                    for (int kk = 0; kk < 8; ++kk) X = MFMA32(*(const LAS3 bf16x8*)(L + a_kc + 32 * st * M2_RS + 32 * kk), qf[kk], X);
                    const bool diag = (st == lt);
                    int tqo = tq - 4 * hi; asm volatile("" : "+v"(tqo));
                    float dsum = 0.f;
#pragma unroll
                    for (int q = 0; q < 4; ++q) { const f32x4 e4 = *(const LAS3 f32x4*)(L + a_eg + (32 * st + 8 * q) * 4);
#pragma unroll
                        for (int e = 0; e < 4; ++e) { const int i = 4 * q + e; float x = X[i] * rowf_s; if (diag && (8 * q + e > tqo)) x = 0.f; X[i] = x; dsum += x * e4[e]; } }
                    den += dsum;
                    xf[2 * st] = pack8(X, 0); xf[2 * st + 1] = pack8(X, 1);
                }
            }
        }
        den += other_half_f(den, hi);
        asm volatile("" ::: "memory");
        f32x16 acc;
#pragma unroll
        for (int i = 0; i < 16; ++i) acc[i] = 0.f;
#pragma unroll
        for (int kk = 0; kk < 8; ++kk) { const u32x2 qa = *(const LAS3 u32x2*)(L + a_qp + 32 * kk), qb = *(const LAS3 u32x2*)(L + a_qp + 32 * kk + 16);
            const u32x4 qq = (u32x4){qa.x, qa.y, qb.x, qb.y};
            acc = MFMA32(*(const LAS3 bf16x8*)(L + a_cf + kk * 1024), __builtin_bit_cast(bf16x8, qq), acc); }
        asm volatile("" ::: "memory");
        float qn = 0.f;
        { const unsigned an = a_n + (c & 1) * 512; const unsigned aq = M2_QC + lrow * M2_RS + 128 * hi;
#pragma unroll
          for (int k8 = 0; k8 < 8; ++k8) { const u32x4 w = *(const LAS3 u32x4*)(L + aq + 16 * k8); const f32x4 n0 = *(const LAS3 f32x4*)(L + an + 32 * k8), n1 = *(const LAS3 f32x4*)(L + an + 32 * k8 + 16);
              qn += bflo(w.x) * n0[0] + bfhi(w.x) * n0[1] + bflo(w.y) * n0[2] + bfhi(w.y) * n0[3] + bflo(w.z) * n1[0] + bfhi(w.z) * n1[1] + bflo(w.w) * n1[2] + bfhi(w.w) * n1[3]; } }
        qn += other_half_f(qn, hi);
        acc *= inter_s;
        bf16x8 vf[4];
#pragma unroll
        for (int s4 = 0; s4 < 4; ++s4) vf[s4] = ml_cat(ml_tr(L + a_vt + 16 * s4 * M2_TS), ml_tr(L + a_vt + (16 * s4 + 8) * M2_TS));
#pragma unroll
        for (int s4 = 0; s4 < 4; ++s4) if ((s4 >> 1) <= lt) acc = MFMA32(vf[s4], xf[s4], acc);
        den = inter_s * qn + den;
        const float inv = __builtin_amdgcn_rcpf(fmaxf(fabsf(den), floorv));
        float ssq = 0.f;
#pragma unroll
        for (int i = 0; i < 16; ++i) { acc[i] *= inv; ssq += acc[i] * acc[i]; }
        ssq += other_half_f(ssq, hi);
        if (hi == 0) *(LAS3 float*)(L + M2_SSQ + (dvtv * 64 + lrow) * 4) = ssq;
        asm volatile("" ::: "memory");
        C0 *= decay; C1 *= decay;
#pragma unroll
        for (int s4 = 0; s4 < 4; ++s4) {
            C0 = MFMA32(ml_cat(ml_tr(L + a_kt + 16 * s4 * M2_TS), ml_tr(L + a_kt + (16 * s4 + 8) * M2_TS)), vf[s4], C0);
            C1 = MFMA32(ml_cat(ml_tr(L + a_kt + 64 + 16 * s4 * M2_TS), ml_tr(L + a_kt + 64 + (16 * s4 + 8) * M2_TS)), vf[s4], C1); }
        if (tid < 128) { float a = 0.f;
#pragma unroll 16
            for (int s = 0; s < 64; ++s) a += ((const LAS3 float*)(L + M2_EG))[s] * bf2f(*(const LAS3 unsigned short*)(L + M2_KC + s * M2_RS + tid * 2));
            LAS3 float* nn = (LAS3 float*)(L + M2_N);
            nn[((c + 1) & 1) * 128 + tid] = decay * nn[(c & 1) * 128 + tid] + a; }
        __syncthreads();
        { const LAS3 float* sq = (const LAS3 float*)(L + M2_SSQ + lrow * 4); const float ss4 = (sq[0] + sq[64]) + (sq[128] + sq[192]);
          const float rstd = __builtin_amdgcn_rsqf(ss4 * (1.0f / 128.0f) + EPS);
          bf16_t* op = P.MIX + orow * DM + h * 128 + 32 * dvtv + 4 * hi;
#pragma unroll
          for (int q = 0; q < 4; ++q) { const f32x4 gg = *(const LAS3 f32x4*)(L + M2_G + (32 * dvtv + 8 * q + 4 * hi) * 4);
              const float o0 = acc[4 * q] * rstd * gg[0] * sigmoidf_(bflo(mo[q].x)), o1 = acc[4 * q + 1] * rstd * gg[1] * sigmoidf_(bfhi(mo[q].x));
              const float o2 = acc[4 * q + 2] * rstd * gg[2] * sigmoidf_(bflo(mo[q].y)), o3 = acc[4 * q + 3] * rstd * gg[3] * sigmoidf_(bfhi(mo[q].y));
              u32x2 w; w.x = cvtpk(o0, o1); w.y = cvtpk(o2, o3); *(u32x2*)(op + 8 * q) = w; } }
        { const unsigned aw = a_cf + ltv * 4096;
          *(LAS3 bf16x8*)(L + aw) = pack8(C0, 0); *(LAS3 bf16x8*)(L + aw + 1024) = pack8(C0, 1); *(LAS3 bf16x8*)(L + aw + 2048) = pack8(C1, 0); *(LAS3 bf16x8*)(L + aw + 3072) = pack8(C1, 1); }
        if (more) {
            sc = ml2_scalars(gi_, gf_, mst);
            ML2_STAGE();
            inter_s = __shfl(sc.inter_s, lrow); rowf_s = __shfl(sc.rowf_s, lrow); floorv = __shfl(sc.floorv, lrow); decay = sc.decay; mst = sc.mnew;
            ML2_PREFETCH(c + 2);
        }
    }
#undef ML2_PREFETCH
#undef ML2_STAGE
    __syncthreads();
}

#define LAS __attribute__((address_space(3)))
#define XB_TMO      128
#define XB_XCNT(j)  (256  + 64 * (j))
#define XB_XSUB(j)  (1280 + 64 * (j))
#define XB_XGEN(j)  (2304 + 64 * (j))
#define XB_TOP      3328
#define XB_TOPGEN   3392
#define XCD_BAR_WORDS 3456
#define XB_SPIN_CAP (1u << 18)

__device__ __forceinline__ unsigned xb_ld(unsigned* p)              { return __hip_atomic_load(p, __ATOMIC_RELAXED, __HIP_MEMORY_SCOPE_AGENT); }
__device__ __forceinline__ unsigned xb_add(unsigned* p, unsigned v) { return __hip_atomic_fetch_add(p, v, __ATOMIC_RELAXED, __HIP_MEMORY_SCOPE_AGENT); }
__device__ __forceinline__ unsigned xb_xcc_id() { return (unsigned)__builtin_amdgcn_s_getreg((3 << 11) | 20) & 0xFu; }
#define XB_SPIN(cond, bar) do { unsigned _sp = 0; while (cond) { __builtin_amdgcn_s_sleep(1); \
    if ((++_sp & 255u) == 0u) { if (xb_ld(&(bar)[XB_TMO])) break; if (_sp > XB_SPIN_CAP) { atomicAdd(&(bar)[XB_TMO], 1u); break; } } } } while (0)

struct XcdBarrier {
    unsigned* bar; unsigned x;
    volatile LAS unsigned* st;
};

__device__ __forceinline__ XcdBarrier xcd_barrier_post(unsigned* bar, volatile LAS unsigned* st) {
    XcdBarrier b; b.bar = bar; b.x = xb_xcc_id(); b.st = st;
    if (threadIdx.x == 0) (void)xb_add(&bar[XB_XCNT(b.x)], 1u);
    return b;
}
__device__ __forceinline__ void xcd_barrier_complete(unsigned* bar, unsigned x, unsigned& nloc, unsigned& nx) {
    const unsigned G = gridDim.x * gridDim.y * gridDim.z;
    unsigned sum, cnt, mine, sp = 0u;
    for (;;) {
        sum = 0u; cnt = 0u; mine = 0u;
#pragma unroll
        for (unsigned j = 0; j < 16; ++j) { const unsigned c = xb_ld(&bar[XB_XCNT(j)]); sum += c; cnt += (c > 0u) ? 1u : 0u; mine = (j == x) ? c : mine; }
        if (sum == G) break;
        __builtin_amdgcn_s_sleep(1);
        if ((++sp & 255u) == 0u) { if (xb_ld(&bar[XB_TMO])) break; if (sp > XB_SPIN_CAP) { atomicAdd(&bar[XB_TMO], 1u); break; } }
    }
    nloc = mine > 0u ? mine : 1u; nx = cnt > 0u ? cnt : 1u;
}

__device__ __forceinline__ void xcd_barrier(const XcdBarrier& b) {
    asm volatile("s_waitcnt vmcnt(0)" ::: "memory");
    __syncthreads();
    if (threadIdx.x == 0) {
        unsigned* bar = b.bar;
        __builtin_amdgcn_s_waitcnt(0);
        unsigned nloc = b.st[0], nx = b.st[1];
        if (nloc == 0u) { xcd_barrier_complete(bar, b.x, nloc, nx); b.st[0] = nloc; b.st[1] = nx; }
        const unsigned old = xb_add(&bar[XB_XSUB(b.x)], 1u);
        const unsigned gen = old / nloc;
        if (old + 1u == (gen + 1u) * nloc) {
            __builtin_amdgcn_fence(__ATOMIC_RELEASE, "agent");
            asm volatile("s_waitcnt vmcnt(0)" ::: "memory");
            const unsigned og = xb_add(&bar[XB_TOP], 1u);
            const unsigned tg = og / nx;
            if (og + 1u == (tg + 1u) * nx) xb_add(&bar[XB_TOPGEN], 1u);
            else XB_SPIN(xb_ld(&bar[XB_TOPGEN]) == tg, bar);
            __builtin_amdgcn_fence(__ATOMIC_ACQUIRE, "agent");
            xb_add(&bar[XB_XGEN(b.x)], 1u);
            asm volatile("s_waitcnt vmcnt(0)" ::: "memory");
        } else {
            XB_SPIN(xb_ld(&bar[XB_XGEN(b.x)]) == gen, bar);
            __builtin_amdgcn_fence(__ATOMIC_ACQUIRE, "agent");
            asm volatile("s_waitcnt vmcnt(0)" ::: "memory");
        }
    }
    __syncthreads();
}

__global__ void __launch_bounds__(NTHREADS, 2) fwd_kernel(Params prm) {
    extern __shared__ __attribute__((aligned(16))) unsigned char lds[];
    cg::grid_group grid = cg::this_grid();
    PG8_LAS unsigned char* ldsl = (PG8_LAS unsigned char*)lds;
    float* lds_f = (float*)lds;
#define TID ((int)threadIdx.x)
#define LANE ((int)(threadIdx.x & 63))
#define WAVE (__builtin_amdgcn_readfirstlane((int)(threadIdx.x >> 6)))
#define GRIDN ((int)gridDim.x)
#define BX ((int)blockIdx.x)
#define WSP(T, name, off) T* name; { unsigned char* w_ = prm.ws; asm volatile("" : "+s"(w_)); name = (T*)(w_ + (off)); }
    { volatile LAS unsigned* st0 = (volatile LAS unsigned*)((LAS unsigned char*)lds + XBAR_LDS); if (threadIdx.x < 2) st0[threadIdx.x] = 0u; }
    __syncthreads();
    XcdBarrier xbar; { unsigned char* w_ = prm.ws; asm volatile("" : "+s"(w_)); xbar = xcd_barrier_post((unsigned*)(w_ + WS_CTL) + 4096, (volatile LAS unsigned*)((LAS unsigned char*)lds + XBAR_LDS)); }
#ifndef DUP_PHASE
#define DUPREPS(k) 1
#else
#define DUPREPS(k) ((k) == DUP_PHASE ? 2 : 1)
#endif
#ifdef PROBE_A
#define STAMP(k) do { if (BX == 0 && TID == 0) { unsigned char* w_ = prm.ws; asm volatile("" : "+s"(w_)); ((unsigned long long*)w_)[k] = __builtin_amdgcn_s_memrealtime(); } } while (0)
#else
#define STAMP(k) do { } while (0)
#endif
    STAMP(0);

    _Pragma("unroll 1") for (int rep_ = 0; rep_ < DUPREPS(0); ++rep_)
    {
        const int lane = LANE, wave = WAVE, G = GRIDN, bx = BX, tid = TID; const int gw = bx * NWAVES + wave, NGW = G * NWAVES;
        WSP(bf16_t, Win_t, WS_WIN) WSP(bf16_t, Wout_t, WS_WOUT) WSP(bf16_t, Wup_t, WS_WUP) WSP(bf16_t, Wdn_t, WS_WDN) WSP(bf16_t, Wpg_t, WS_WPG) WSP(bf16_t, Wpp_t, WS_WPP)
        WSP(bf16_t, XB, WS_XB) WSP(bf16_t, PB, WS_PB) WSP(bf16_t, W1T, WS_W1T) WSP(bf16_t, W2T, WS_W2T) WSP(float, C1, WS_C1)
        const float* x = prm.in[0]; const float* pin = prm.in[1];
        float* scr = lds_f + wave * 4096;
        constexpr int I_IN = (DM / 64) * (3360 / 32), I_OUT = (DM / 64) * (DM / 32), I_UP = (DM / 64) * (4096 / 32), I_DN = (DFF / 64) * (DM / 32), I_PG = I_OUT, I_PP = (PLE / 64) * (DM / 32);
        constexpr int I_W1 = 4 * 64, I_W2 = 2 * 4;
        constexpr int NITEMS = I_IN + I_OUT + I_UP + I_DN + I_PG + I_PP + I_W1 + I_W2;
        for (int it = gw; it < NITEMS; it += NGW) {
            int r = it;
            if (r < I_IN) { p0_transpose_item(prm.in[3], nullptr, DM, 3360, Win_t, scr, r, lane); continue; } r -= I_IN;
            if (r < I_OUT) { p0_transpose_item(prm.in[12], nullptr, DM, DM, Wout_t, scr, r, lane); continue; } r -= I_OUT;
            if (r < I_UP) { p0_transpose_item<true>(prm.in[14], prm.in[13], DM, 4096, Wup_t, scr, r, lane); continue; } r -= I_UP;
            if (r < I_DN) { p0_transpose_item(prm.in[17], nullptr, DFF, DM, Wdn_t, scr, r, lane); continue; } r -= I_DN;
            if (r < I_PG) { p0_transpose_item(prm.in[19], prm.in[18], DM, DM, Wpg_t, scr, r, lane); continue; } r -= I_PG;
            if (r < I_PP) { p0_transpose_item(prm.in[20], nullptr, PLE, DM, Wpp_t, scr, r, lane); continue; } r -= I_PP;
            if (r < I_W1) { const int q = r >> 6, kv = q >> 1, half = q & 1;
                p0_transpose_item(prm.in[kv ? 10 : 8] + (size_t)half * 1024 * 128, nullptr, 1024, 128, W1T + (size_t)kv * 256 * 1024 + (size_t)half * 128 * 1024, scr, r & 63, lane); continue; } r -= I_W1;
            { const int kv = r >> 2; p0_transpose_item(prm.in[kv ? 11 : 9], nullptr, 128, 64, W2T + (size_t)kv * 64 * 128, scr, r & 3, lane); }
        }
        if (tid < 256) { const int kv = tid >> 7, j = tid & 127; const float* pe = prm.in[kv ? 7 : 6]; const float* w1 = prm.in[kv ? 10 : 8]; float a = 0.f;
            const int per = (2048 + G - 1) / G; const int l0 = bx * per, l1 = min(2048, l0 + per);
            for (int ld = l0; ld < l1; ++ld) a += pe[ld] * w1[(size_t)ld * 128 + j];
            if (l0 < l1) atomicAdd(C1 + kv * 128 + j, a); }
        for (int i = bx * NTHREADS + tid; i < (NZ - 3360) * DM / 8; i += G * NTHREADS) ((u32x4*)(Win_t + (size_t)3360 * DM))[i] = (u32x4){0u, 0u, 0u, 0u};
        const float* g1 = prm.in[2];
        f32x4 gv[4];
#pragma unroll
        for (int j = 0; j < 4; ++j) gv[j] = ((const f32x4*)g1)[lane + 64 * j];
        for (int m = 2 * gw; m < MTOK; m += 2 * NGW) {
            f32x4 v[2][4]; float sq[2];
#pragma unroll
            for (int k = 0; k < 2; ++k) { const f32x4* xr = (const f32x4*)(x + (size_t)(m + k) * DM) + lane;
#pragma unroll
                for (int j = 0; j < 4; ++j) v[k][j] = xr[64 * j]; }
#pragma unroll
            for (int k = 0; k < 2; ++k) { float s = 0.f;
#pragma unroll
                for (int j = 0; j < 4; ++j) s += (v[k][j][0] * v[k][j][0] + v[k][j][1] * v[k][j][1]) + (v[k][j][2] * v[k][j][2] + v[k][j][3] * v[k][j][3]);
                sq[k] = s; }
#pragma unroll
            for (int o = 1; o < 64; o <<= 1) { sq[0] += __shfl_xor(sq[0], o); sq[1] += __shfl_xor(sq[1], o); }
#pragma unroll
            for (int k = 0; k < 2; ++k) { const float rstd = 1.0f / sqrtf(sq[k] * (1.0f / DM) + EPS);
                u32x2* o8 = (u32x2*)(XB + (size_t)(m + k) * DM) + lane;
#pragma unroll
                for (int j = 0; j < 4; ++j) { u32x2 w; w.x = pk2(v[k][j][0] * rstd * gv[j][0], v[k][j][1] * rstd * gv[j][1]); w.y = pk2(v[k][j][2] * rstd * gv[j][2], v[k][j][3] * rstd * gv[j][3]); o8[64 * j] = w; } }
        }
        for (size_t i = (size_t)bx * NTHREADS + tid; i < (size_t)MTOK * PLE / 8; i += (size_t)G * NTHREADS) {
            const f32x4 a = ((const f32x4*)pin)[2 * i], c = ((const f32x4*)pin)[2 * i + 1];
            u32x4 w; w.x = pk2(a[0], a[1]); w.y = pk2(a[2], a[3]); w.z = pk2(c[0], c[1]); w.w = pk2(c[2], c[3]); ((u32x4*)PB)[i] = w; }
    }
    grid.sync();
    STAMP(1);

    _Pragma("unroll 1") for (int rep_ = 0; rep_ < DUPREPS(1); ++rep_)
    {
        WSP(bf16_t, XB, WS_XB) WSP(bf16_t, Win_t, WS_WIN) WSP(bf16_t, Z, WS_Z) WSP(float, GATES, WS_GATES)
        pg8::Gemm g{XB, Win_t, MTOK, NZ, DM}; pg8::StaticOrder S; S.init(MTOK, NZ, GRIDN, BX);
#ifdef P1_PLAIN_DUP
        if (rep_ > 0) { pg8::EpiBf<false> E2{Z, NZ, nullptr}; pg8::gemm_phase<pg8::EpiBf<false>, pg8::StaticOrder, true, true>(ldsl, g, S, E2); } else
#endif
        { pg8::EpiZ E{Z, GATES};
        pg8::gemm_phase<pg8::EpiZ, pg8::StaticOrder, true, true>(ldsl, g, S, E); }
    }
    xcd_barrier(xbar);
    STAMP(2);

    _Pragma("unroll 1") for (int rep_ = 0; rep_ < DUPREPS(2); ++rep_)
    {
        WSP(bf16_t, Z, WS_Z) WSP(bf16_t, KCB, WS_KCB) WSP(bf16_t, VCT, WS_VCT) WSP(bf16_t, VST, WS_VST) WSP(bf16_t, VWT, WS_VWT)
        const bool split = GRIDN > 128;
        if (!split || BX < 64) {
            WSP(bf16_t, W1T, WS_W1T) WSP(bf16_t, W2T, WS_W2T) WSP(float, C1, WS_C1)
            for (int un = BX; un < 64; un += (split ? 64 : GRIDN)) {
                pg8::Gemm g{nullptr, nullptr, 256, 256, 1024, 16 * NZ, NZ * 2}; pg8::CmpOrder S{un, Z, W1T};
                pg8::EpiCmp E{C1, W2T, KCB, VCT};
                pg8::gemm_phase<pg8::EpiCmp, pg8::CmpOrder, true, true>(ldsl, g, S, E);
                __syncthreads();
            }
        }
        if (!split || BX >= 64)
        for (int un = split ? BX - 64 : BX; un < BATCH * 2 * 2 * 64; un += (split ? GRIDN - 64 : GRIDN)) {
            const int ch = un & 63, br = (un >> 6) & 1, g = (un >> 7) & 1, b = un >> 8;
            vt_unit(Z, br ? ZC_AVW : ZC_AVS, br ? VWT : VST, b, g, ch, (unsigned short*)lds, TID);
        }
    }
    xcd_barrier(xbar);
    STAMP(3);

    _Pragma("unroll 1") for (int rep_ = 0; rep_ < DUPREPS(3); ++rep_)
    {
        WSP(bf16_t, Z, WS_Z) WSP(float, GATES, WS_GATES) WSP(bf16_t, MIX, WS_MIX)
        {
            MlF MP{Z, GATES, MIX, prm.in[4], prm.in[5]};
            _Pragma("unroll 1") for (int rep2_ = 0; rep2_ < DUPREPS(30); ++rep2_)
            for (int un = BX; un < BATCH * 4; un += GRIDN) mlstm_unit_v2(MP, un >> 2, un & 3, (LAS3 unsigned char*)lds, TID);
        }
        __syncthreads();
        {
            WSP(bf16_t, KCB, WS_KCB) WSP(bf16_t, VCT, WS_VCT) WSP(bf16_t, VST, WS_VST) WSP(bf16_t, VWT, WS_VWT)
            NsaF NP{Z, GATES, KCB, VCT, VST, VWT, MIX};
            unsigned* qctr; { unsigned char* w_ = prm.ws; asm volatile("" : "+s"(w_)); qctr = (unsigned*)(w_ + WS_CTL) + 64; }
            volatile LAS3 int* slot = (volatile LAS3 int*)((LAS3 unsigned char*)lds + NC_QSLOT);
            _Pragma("unroll 1") for (int rep2_ = 0; rep2_ < DUPREPS(31); ++rep2_) {
            int tk = 0;
            if (TID == 0) tk = (int)atomicAdd(qctr + 64 * rep2_, 1u);
            for (;;) {
                if (TID == 0) { *slot = tk; if (tk < BATCH * 2 * 64) tk = (int)atomicAdd(qctr + 64 * rep2_, 1u); }
                __syncthreads();
                const int grp = *slot;
                __syncthreads();
                if (grp >= BATCH * 2 * 64) break;
#ifdef NSA_DRY
                nsa_unit_coop(NP, (grp >> 1) & 15, grp & 1, 63 - (grp >> 5), (LAS3 unsigned char*)lds, TID, rep2_ ? NSA_DRY : 0);
#else
                nsa_unit_coop(NP, (grp >> 1) & 15, grp & 1, 63 - (grp >> 5), (LAS3 unsigned char*)lds, TID);
#endif
            } }
        }
    }
    xcd_barrier(xbar);
    STAMP(4);

    _Pragma("unroll 1") for (int rep_ = 0; rep_ < DUPREPS(4); ++rep_)
    {
        WSP(bf16_t, MIX, WS_MIX) WSP(bf16_t, Wout_t, WS_WOUT) WSP(bf16_t, XB, WS_XB) WSP(float, RS2, WS_RS2)
        pg8::Gemm g{MIX, Wout_t, MTOK, DM, DM}; pg8::PanelOrder S; S.init(MTOK, GRIDN, BX);
        pg8::EpiRes<true> E{prm.in[0], nullptr, XB, RS2};
        pg8::gemm_phase<pg8::EpiRes<true>, pg8::PanelOrder, true, true>(ldsl, g, S, E);
        WSP(float, RSTD2, WS_RSTD2)
        asm volatile("s_waitcnt vmcnt(0)" ::: "memory"); __syncthreads();
        for (int p = BX; p < MTOK / 256; p += GRIDN) if (TID < 256) { const int row = p * 256 + TID; RSTD2[row] = pg8::row_rstd(RS2, row); }
    }
    xcd_barrier(xbar);
    STAMP(5);

    _Pragma("unroll 1") for (int rep_ = 0; rep_ < DUPREPS(5); ++rep_)
    {
        WSP(bf16_t, XB, WS_XB) WSP(bf16_t, Wup_t, WS_WUP) WSP(bf16_t, ACT, WS_ACT) WSP(float, RS2, WS_RSTD2)
        PG8_LAS float* car = (PG8_LAS float*)(ldsl + 131072 + 1024);
        pg8::Gemm g{XB, Wup_t, MTOK, 4096, DM, 0, 0}; pg8::ChainOrder S{BX};
        pg8::EpiUpConv E{ACT, RS2, prm.in[15], prm.in[16], car};
        pg8::gemm_phase<pg8::EpiUpConv, pg8::ChainOrder, true, true>(ldsl, g, S, E);
    }
    xcd_barrier(xbar);
    STAMP(6);

    _Pragma("unroll 1") for (int rep_ = 0; rep_ < DUPREPS(7); ++rep_)
    {
        WSP(bf16_t, ACT, WS_ACT) WSP(bf16_t, Wdn_t, WS_WDN) WSP(bf16_t, XB, WS_XB) WSP(float, RS3, WS_RS3)
        pg8::Gemm g{ACT, Wdn_t, MTOK, DM, DFF}; pg8::PanelOrder S; S.init(MTOK, GRIDN, BX);
        pg8::EpiRes<false> E{nullptr, XB, XB, RS3};
        pg8::gemm_phase<pg8::EpiRes<false>, pg8::PanelOrder, true, true>(ldsl, g, S, E);
        WSP(float, RSTD3, WS_RSTD3)
        asm volatile("s_waitcnt vmcnt(0)" ::: "memory"); __syncthreads();
        for (int p = BX; p < MTOK / 256; p += GRIDN) if (TID < 256) { const int row = p * 256 + TID; RSTD3[row] = pg8::row_rstd(RS3, row); }
    }
    _Pragma("unroll 1") for (int rep_ = 0; rep_ < DUPREPS(8); ++rep_)
    {
        WSP(bf16_t, PB, WS_PB) WSP(bf16_t, Wpp_t, WS_WPP) WSP(bf16_t, PROJ, WS_PROJ)
        pg8::Gemm g{PB, Wpp_t, MTOK, DM, PLE}; pg8::StaticOrder S; S.init(MTOK, DM, GRIDN, BX);
        pg8::EpiBf<false> E{PROJ, DM, nullptr};
        pg8::gemm_phase<pg8::EpiBf<false>, pg8::StaticOrder, true, true>(ldsl, g, S, E);
    }
    xcd_barrier(xbar);
    STAMP(8);

    _Pragma("unroll 1") for (int rep_ = 0; rep_ < DUPREPS(9); ++rep_)
    {
        WSP(bf16_t, XB, WS_XB) WSP(bf16_t, Wpg_t, WS_WPG) WSP(bf16_t, PROJ, WS_PROJ) WSP(float, RS3, WS_RSTD3)
        pg8::Gemm g{XB, Wpg_t, MTOK, DM, DM}; pg8::PanelOrder S; S.init(MTOK, GRIDN, BX);
        WSP(bf16_t, X3B, WS_ACT) WSP(float, RS4, WS_RS2)
        pg8::EpiPle E{XB, PROJ, RS3, X3B, RS4};
        pg8::gemm_phase<pg8::EpiPle, pg8::PanelOrder, true, true>(ldsl, g, S, E);
    }
    xcd_barrier(xbar);
    STAMP(9);

    _Pragma("unroll 1") for (int rep_ = 0; rep_ < DUPREPS(10); ++rep_)
    {
        WSP(bf16_t, X3B, WS_ACT) WSP(float, RS4, WS_RS2)
        const int lane = LANE; const int gw = BX * NWAVES + WAVE, NGW = GRIDN * NWAVES;
        const float* fg = prm.in[21]; float* out = prm.out;
        f32x4 gv[4];
#pragma unroll
        for (int j = 0; j < 4; ++j) gv[j] = ((const f32x4*)fg)[4 * lane + j];
        for (int m = 4 * gw; m < MTOK; m += 4 * NGW) {
            u32x4 xa[4][2]; float ss[4];
#pragma unroll
            for (int k = 0; k < 4; ++k) { const u32x4* xr = (const u32x4*)(X3B + (size_t)(m + k) * DM) + 2 * lane; xa[k][0] = xr[0]; xa[k][1] = xr[1];
                ss[k] = (lane < 16) ? RS4[(size_t)(m + k) * 16 + lane] : 0.f; }
#pragma unroll
            for (int k = 0; k < 4; ++k) { float s = ss[k]; s += __shfl_xor(s, 1); s += __shfl_xor(s, 2); s += __shfl_xor(s, 4); s += __shfl_xor(s, 8); s = __shfl(s, 0);
                const float rstd = __builtin_amdgcn_rsqf(s * (1.0f / DM) + EPS);
                f32x4* o = (f32x4*)(out + (size_t)(m + k) * DM) + 4 * lane;
                const u32x4 w0 = xa[k][0], w1 = xa[k][1];
                o[0] = (f32x4){bflo(w0.x), bfhi(w0.x), bflo(w0.y), bfhi(w0.y)} * rstd * gv[0]; o[1] = (f32x4){bflo(w0.z), bfhi(w0.z), bflo(w0.w), bfhi(w0.w)} * rstd * gv[1];
                o[2] = (f32x4){bflo(w1.x), bfhi(w1.x), bflo(w1.y), bfhi(w1.y)} * rstd * gv[2]; o[3] = (f32x4){bflo(w1.z), bfhi(w1.z), bflo(w1.w), bfhi(w1.w)} * rstd * gv[3]; }
        }
    }
#ifdef PROBE_A
    xcd_barrier(xbar);
    {
        unsigned char* w_ = prm.ws; asm volatile("" : "+s"(w_)); const unsigned long long* ts = (const unsigned long long*)w_;
        const float ta = (float)(ts[PROBE_A + 1] - ts[PROBE_A]) * 0.01f, tb = (float)(ts[PROBE_B + 1] - ts[PROBE_B]) * 0.01f;
        float* out = prm.out;
        if (BX == 0 && TID == 0) out[0] += ta;
        for (size_t i = (size_t)BX * NTHREADS + TID; i < (size_t)1024 * 1024; i += (size_t)GRIDN * NTHREADS) out[1024 + i] += tb * 0.01f;
    }
#endif

}

extern "C" void kernel_launch(void* const* d_in, const int* in_sizes, int n_in, void* d_out, int out_size, void* d_ws, size_t ws_size, hipStream_t stream) {
    static int grid = 0;
    if (grid == 0) {
        if (n_in != 22 || out_size != MTOK * DM || ws_size < WS_END) { fprintf(stderr, "kernel_launch: unexpected problem (n_in %d, out %d, ws %zu)\n", n_in, out_size, ws_size); grid = -1; return; }
        int dev = 0, cus = 0, per_cu = 0;
        if (hipGetDevice(&dev) != hipSuccess || hipDeviceGetAttribute(&cus, hipDeviceAttributeMultiprocessorCount, dev) != hipSuccess) { grid = -1; return; }
        if (hipFuncSetAttribute((const void*)fwd_kernel, hipFuncAttributeMaxDynamicSharedMemorySize, LDS_BYTES) != hipSuccess) { fprintf(stderr, "kernel_launch: hipFuncSetAttribute failed\n"); grid = -1; return; }
        if (hipOccupancyMaxActiveBlocksPerMultiprocessor(&per_cu, (const void*)fwd_kernel, NTHREADS, LDS_BYTES) != hipSuccess || per_cu < 1) { fprintf(stderr, "kernel_launch: occupancy query says %d\n", per_cu); (void)hipGetLastError(); per_cu = 1; }
        grid = cus * 1;
    }
    if (grid < 0) return;
    if (hipMemsetAsync((char*)d_ws + WS_CTL, 0, 65536, stream) != hipSuccess) { fprintf(stderr, "kernel_launch: hipMemsetAsync failed\n"); return; }
    Params p{};
    for (int i = 0; i < 22; ++i) p.in[i] = (const float*)d_in[i];
    p.out = (float*)d_out; p.ws = (unsigned char*)d_ws;
    void* args[] = {&p};
    hipError_t e = hipLaunchCooperativeKernel((const void*)fwd_kernel, dim3(grid), dim3(NTHREADS), args, LDS_BYTES, stream);
    if (e != hipSuccess) fprintf(stderr, "kernel_launch: cooperative launch failed: %s (grid %d)\n", hipGetErrorString(e), grid);
}
```
